# Optimizing an MI355X kernel written in HIP

```python
import jax, jax.numpy as jnp
from jax import lax
import numpy as np

D_MODEL = 1024
BATCH = 8
SEQ = 2048
DEPTH = 4

CHUNK = 64
Q_BLOCK = 128
EPS = 1e-6
NEG_INF = -1e30

FOX_HEADS = 8
FOX_HEAD_DIM = 64
FOX_WIDTH = FOX_HEADS * FOX_HEAD_DIM
CONV_WIDTH = D_MODEL - FOX_WIDTH
CONV_TAPS = 3
FOX_GATE_BIAS_MEAN = 2.0
AB_IN_COLS = 3 * FOX_WIDTH + FOX_HEADS + 3 * CONV_WIDTH

HGRN_HEADS = 8
HGRN_HEAD_DIM = D_MODEL // HGRN_HEADS
HGRN_WIDTH = HGRN_HEADS * HGRN_HEAD_DIM
C_IN_COLS = 4 * HGRN_WIDTH

FFN_HIDDEN = -(-8 * D_MODEL // (3 * 256)) * 256

N_AB_LAYERS = (DEPTH + 1) // 2
N_C_LAYERS = DEPTH // 2

kernel_name = "hybrid_fox_shortconv_hgrn2_trunk"


def rms_norm(x, g):
    xf = x.astype(jnp.float32)
    y = xf * lax.rsqrt(jnp.mean(xf * xf, axis=-1, keepdims=True) + EPS)
    return (y * g.astype(jnp.float32)).astype(x.dtype)


def forgetting_attention(q, k, v, f_logit):
    S = q.shape[1]
    scale = FOX_HEAD_DIM ** -0.5
    c = jnp.cumsum(jax.nn.log_sigmoid(f_logit.astype(jnp.float32)), axis=1)
    c = jnp.transpose(c, (0, 2, 1))
    outs = []
    for blk in range(S // Q_BLOCK):
        q0 = blk * Q_BLOCK
        q1 = q0 + Q_BLOCK
        s = jnp.einsum('bqhd,bkhd->bhqk', q[:, q0:q1], k[:, :q1],
                       preferred_element_type=jnp.float32) * scale
        s = s + c[:, :, q0:q1, None] - c[:, :, None, :q1]
        mask = (q0 + jnp.arange(Q_BLOCK))[:, None] >= jnp.arange(q1)[None, :]
        s = jnp.where(mask, s, NEG_INF)
        p = jax.nn.softmax(s, axis=-1)
        outs.append(jnp.einsum('bhqk,bkhd->bqhd', p.astype(v.dtype), v[:, :q1]))
    return jnp.concatenate(outs, axis=1)


def short_gated_conv(u_b, u_c, u_x, conv_w):
    S = u_x.shape[1]
    z = u_c * u_x
    zp = jnp.pad(z, ((0, 0), (CONV_TAPS - 1, 0), (0, 0)))
    y = conv_w[0] * zp[:, 0:S]
    for j in range(1, CONV_TAPS):
        y = y + conv_w[j] * zp[:, j:j + S]
    return u_b * y


def hgrn2_chunkwise(q, k, v, log_f):
    Bn, S, H, Dk = q.shape
    Dv = v.shape[-1]
    n = S // CHUNK

    def to_chunks(a):
        return jnp.transpose(a.reshape(Bn, n, CHUNK, H, a.shape[-1]), (1, 0, 3, 2, 4))

    qc, kc, vc, gc = to_chunks(q), to_chunks(k), to_chunks(v), to_chunks(log_f)
    causal = jnp.tril(jnp.ones((CHUNK, CHUNK), dtype=bool))

    def step(state, inp):
        qi, ki, vi, gi = inp
        b = jnp.cumsum(gi, axis=2)
        o_inter = jnp.einsum('bhtd,bhde->bhte', qi * jnp.exp(b), state)
        rel = jnp.where(causal[:, :, None], b[:, :, :, None, :] - b[:, :, None, :, :], -jnp.inf)
        a = jnp.einsum('bhtd,bhsd,bhtsd->bhts', qi, ki, jnp.exp(rel))
        o = o_inter + jnp.einsum('bhts,bhse->bhte', a, vi)
        b_last = b[:, :, -1]
        k_dec = ki * jnp.exp(b_last[:, :, None, :] - b)
        state = jnp.exp(b_last)[..., None] * state + jnp.einsum('bhsd,bhse->bhde', k_dec, vi)
        return state, o

    s0 = jnp.zeros((Bn, H, Dk, Dv), jnp.float32)
    _, o = lax.scan(step, s0, (qc, kc, vc, gc))
    return jnp.transpose(o, (1, 0, 3, 2, 4)).reshape(Bn, S, H, Dv)


def fox_conv_layer(h, w_in, f_bias, conv_w, w_out):
    Bn, S, _ = h.shape
    proj = h @ w_in
    cuts = [FOX_WIDTH, 2 * FOX_WIDTH, 3 * FOX_WIDTH, 3 * FOX_WIDTH + FOX_HEADS,
            3 * FOX_WIDTH + FOX_HEADS + CONV_WIDTH, 3 * FOX_WIDTH + FOX_HEADS + 2 * CONV_WIDTH]
    q, k, v, f_logit, u_b, u_c, u_x = jnp.split(proj, cuts, axis=-1)
    heads = lambda a: a.reshape(Bn, S, FOX_HEADS, FOX_HEAD_DIM)
    a_out = forgetting_attention(heads(q), heads(k), heads(v), f_logit + f_bias)
    a_out = a_out.reshape(Bn, S, FOX_WIDTH).astype(h.dtype)
    b_out = short_gated_conv(u_b, u_c, u_x, conv_w).astype(h.dtype)
    return (jnp.concatenate([a_out, b_out], axis=-1) @ w_out).astype(h.dtype)


def hgrn2_layer(h, w_in, lower_bound, head_norm, w_out):
    Bn, S, _ = h.shape
    proj = (h @ w_in).astype(jnp.float32)
    q, f_logit, i_in, g_out = jnp.split(proj, 4, axis=-1)
    f = lower_bound + (1.0 - lower_bound) * jax.nn.sigmoid(f_logit)
    log_f = jnp.log(f)
    k = 1.0 - f
    heads = lambda a: a.reshape(Bn, S, HGRN_HEADS, HGRN_HEAD_DIM)
    o = hgrn2_chunkwise(heads(q), heads(k), heads(i_in), heads(log_f))
    o = o * lax.rsqrt(jnp.mean(o * o, axis=-1, keepdims=True) + EPS)
    o = o * head_norm.astype(jnp.float32).reshape(HGRN_HEADS, HGRN_HEAD_DIM)
    o = o.reshape(Bn, S, HGRN_WIDTH) * jax.nn.silu(g_out)
    return (o.astype(h.dtype) @ w_out).astype(h.dtype)


def swiglu(h, w_in, w_out):
    gate, up = jnp.split(h @ w_in, 2, axis=-1)
    return ((jax.nn.silu(gate) * up) @ w_out).astype(h.dtype)


def setup_inputs(seed: int = 0) -> dict:
    key = jax.random.key(seed)
    ks = jax.random.split(key, 14)
    f32 = jnp.float32

    def w(k, shape, fan_in):
        return jax.random.normal(k, shape, f32) * (fan_in ** -0.5)

    def gain(k, shape):
        return 1.0 + 0.02 * jax.random.normal(k, shape, f32)

    return {
        "x": jax.random.normal(ks[0], (BATCH, SEQ, D_MODEL), f32),
        "norm_mix": gain(ks[1], (DEPTH, D_MODEL)),
        "norm_ffn": gain(ks[2], (DEPTH, D_MODEL)),
        "final_norm": gain(ks[3], (D_MODEL,)),
        "ab_w_in": w(ks[4], (N_AB_LAYERS, D_MODEL, AB_IN_COLS), D_MODEL),
        "fox_f_bias": FOX_GATE_BIAS_MEAN + 0.5 * jax.random.normal(ks[5], (N_AB_LAYERS, FOX_HEADS), f32),
        "conv_w": w(ks[6], (N_AB_LAYERS, CONV_TAPS, CONV_WIDTH), CONV_TAPS),
        "ab_w_out": w(ks[7], (N_AB_LAYERS, D_MODEL, D_MODEL), D_MODEL),
        "c_w_in": w(ks[8], (N_C_LAYERS, D_MODEL, C_IN_COLS), D_MODEL),
        "c_lower_bounds": 0.5 * jax.random.normal(ks[9], (N_C_LAYERS, HGRN_WIDTH), f32),
        "c_head_norm": gain(ks[10], (N_C_LAYERS, HGRN_WIDTH)),
        "c_w_out": w(ks[11], (N_C_LAYERS, HGRN_WIDTH, D_MODEL), HGRN_WIDTH),
        "ffn_w_in": w(ks[12], (DEPTH, D_MODEL, 2 * FFN_HIDDEN), D_MODEL),
        "ffn_w_out": w(ks[13], (DEPTH, FFN_HIDDEN, D_MODEL), FFN_HIDDEN),
    }


def reference(x, norm_mix, norm_ffn, final_norm, ab_w_in, fox_f_bias, conv_w, ab_w_out,
              c_w_in, c_lower_bounds, c_head_norm, c_w_out, ffn_w_in, ffn_w_out):
    lb = jax.nn.softmax(c_lower_bounds.astype(jnp.float32), axis=0)
    lb = jnp.cumsum(lb, axis=0) - lb[0]
    for layer in range(DEPTH):
        h = rms_norm(x, norm_mix[layer])
        j = layer // 2
        if layer % 2 == 0:
            mix = fox_conv_layer(h, ab_w_in[j], fox_f_bias[j], conv_w[j], ab_w_out[j])
        else:
            mix = hgrn2_layer(h, c_w_in[j], lb[j], c_head_norm[j], c_w_out[j])
        x = x + mix.astype(x.dtype)
        h = rms_norm(x, norm_ffn[layer])
        x = x + swiglu(h, ffn_w_in[layer], ffn_w_out[layer]).astype(x.dtype)
    return rms_norm(x, final_norm)
```

```cpp
#include <hip/hip_runtime.h>
#include <cstdio>
#include <cstdint>
#include <cmath>
namespace pg8 {
#define PG8_LAS __attribute__((address_space(3)))
typedef unsigned short bf16_t;
typedef short bf16x8 __attribute__((ext_vector_type(8)));
typedef float f32x4 __attribute__((ext_vector_type(4)));
typedef unsigned u32x4 __attribute__((ext_vector_type(4)));
constexpr int BM = 256, BK = 64, HALF = 128, HTB = HALF * BK * 2  , STAGE_BYTES = 8 * HTB, NXCD = 8, WGM = 8;

__host__ __device__ __forceinline__ int lds_byte(int r, int c) { const int st = (r >> 4) * 2 + (c >> 5), rr = r & 15, cc = c & 31, ob = rr * 64 + cc * 2; return st * 1024 + (ob ^ (((ob >> 9) & 1) << 5)); }
__host__ __device__ __forceinline__ void stage_rc(int b, int& R, int& C) { const int st = b / 1024, sb = b % 1024, swz = sb ^ (((sb >> 9) & 1) << 5); R = (st >> 1) * 16 + swz / 64; C = (st & 1) * 32 + (swz % 64) / 2; }
__host__ __device__ __forceinline__ int perm32(int rho) { const int n = rho >> 4, i = rho & 15; return 8 * (i >> 2) + 4 * n + (i & 3); }

struct Unit { int pm, pn; };
struct Gemm { const bf16_t* A; const bf16_t* Bt; int M, N, K; };

struct StaticOrder {
    int nM, nN, nwg, G, c;
    __host__ __device__ void init(int M, int N, int G_, int c_) { nM = M / BM; nN = N / BM; nwg = nM * nN; G = G_; c = c_; }
    __host__ __device__ bool next(int i, Unit& u) const {
        const long L = (long)i * G + c; if (L >= nwg) return false;
        int wgid = (int)L; { const int q = nwg / NXCD, r = nwg % NXCD, xcd = wgid % NXCD, off = wgid / NXCD; wgid = (xcd < r ? xcd * (q + 1) : r * (q + 1) + (xcd - r) * q) + off; }
        const int nig = WGM * nN, gid = wgid / nig, fm = gid * WGM, gsz = (nM - fm) < WGM ? (nM - fm) : WGM;
        u.pm = fm + ((wgid % nig) % gsz); u.pn = (wgid % nig) / gsz; return true;
    }
    __device__ __forceinline__ void a_ready(const Unit&) const {}
    __device__ __forceinline__ void done(const Unit&) const {}
};


__device__ __forceinline__ unsigned cvt_pk_bf16(float lo, float hi) { unsigned r; asm volatile("v_cvt_pk_bf16_f32 %0, %1, %2" : "=v"(r) : "v"(lo), "v"(hi)); return r; }
typedef unsigned u32x2 __attribute__((ext_vector_type(2)));
constexpr float RMS_EPS = 1e-6f;
__device__ __forceinline__ float row_rstd(const float* ssq, int row) {
    const f32x4* p = (const f32x4*)(ssq + (size_t)row * 16);
    const f32x4 a = p[0], b = p[1], c = p[2], d = p[3];
    const float s = (((a[0] + a[1]) + (a[2] + a[3])) + ((b[0] + b[1]) + (b[2] + b[3]))) + (((c[0] + c[1]) + (c[2] + c[3])) + ((d[0] + d[1]) + (d[2] + d[3])));
    return __builtin_amdgcn_rsqf(s * (1.0f / 1024.0f) + RMS_EPS);
}
__device__ __forceinline__ float row_rstd_q(const float* ssq, int row, int fq) {
    const f32x4 a = *((const f32x4*)(ssq + (size_t)row * 16) + fq);
    float s = (a[0] + a[1]) + (a[2] + a[3]);
    s += __shfl_xor(s, 16); s += __shfl_xor(s, 32);
    return __builtin_amdgcn_rsqf(s * (1.0f / 1024.0f) + RMS_EPS);
}
__device__ __forceinline__ float sigmoid_f(float z) { return __builtin_amdgcn_rcpf(1.0f + __expf(-z)); }

struct EpiAB {
    static constexpr bool PERM = true, AFTER_DRAIN = false;
    bf16_t* O; size_t tstride; const float* ssq; float qscale;
    __device__ __forceinline__ void operator()(const f32x4 (&acc)[2][2][4][2], const Unit& u, int wr, int wc, int fr, int fq) const {
        const int t = u.pn >> 1; bf16_t* base = O + (size_t)t * tstride;
        const int col0 = (u.pn & 1) * 256 + wc * 32 + 8 * fq, row0 = u.pm * BM + wr * 64 + fr;
        const float sc0 = (t == 0) ? qscale : 1.0f;
#pragma unroll
        for (int ai = 0; ai < 2; ++ai)
#pragma unroll
            for (int m = 0; m < 4; ++m) { const int row = row0 + ai * HALF + m * 16; const float rs = row_rstd_q(ssq, row, fq) * sc0; bf16_t* rowp = base + (size_t)row * 512 + col0;
#pragma unroll
                for (int bj = 0; bj < 2; ++bj) { const f32x4 v0 = acc[ai][bj][m][0] * rs, v1 = acc[ai][bj][m][1] * rs;
                    u32x4 w; w.x = cvt_pk_bf16(v0[0], v0[1]); w.y = cvt_pk_bf16(v0[2], v0[3]); w.z = cvt_pk_bf16(v1[0], v1[1]); w.w = cvt_pk_bf16(v1[2], v1[3]);
                    *(u32x4*)(rowp + bj * HALF) = w; } }
    }
};
struct EpiRes {
    static constexpr bool PERM = false, AFTER_DRAIN = false;
    const float* base; float* out; bf16_t* xb; float* ssq;
    __device__ __forceinline__ void operator()(const f32x4 (&acc)[2][2][4][2], const Unit& u, int wr, int wc, int fr, int fq) const {
        const int col0 = u.pn * BM + wc * 32 + 4 * fq;
#pragma unroll
        for (int ai = 0; ai < 2; ++ai)
#pragma unroll
            for (int m = 0; m < 4; ++m) { const int row = u.pm * BM + ai * HALF + wr * 64 + m * 16 + fr; const size_t off = (size_t)row * 1024 + col0; float s = 0.f;
#pragma unroll
                for (int bj = 0; bj < 2; ++bj)
#pragma unroll
                    for (int n = 0; n < 2; ++n) { const size_t o = off + bj * HALF + n * 16; const f32x4 x = *(const f32x4*)(base + o) + acc[ai][bj][m][n];
                        *(f32x4*)(out + o) = x; u32x2 w; w.x = cvt_pk_bf16(x[0], x[1]); w.y = cvt_pk_bf16(x[2], x[3]); *(u32x2*)(xb + o) = w;
                        s += (x[0] * x[0] + x[1] * x[1]) + (x[2] * x[2] + x[3] * x[3]); }
                s += __shfl_xor(s, 16); s += __shfl_xor(s, 32);
                if (fq == 0) ssq[(size_t)row * 16 + u.pn * 4 + wc] = s; }
    }
};
struct EpiHG {
    static constexpr bool PERM = true, AFTER_DRAIN = false;
    bf16_t* Q; float* LF; size_t tstride; const float* lb; const float* ssq; bool lbzero;
    __device__ __forceinline__ void operator()(const f32x4 (&acc)[2][2][4][2], const Unit& u, int wr, int wc, int fr, int fq) const {
        const int tt = u.pn >> 2; const int col0 = (u.pn & 3) * 256 + wc * 32 + 8 * fq, row0 = u.pm * BM + wr * 64 + fr;
        bf16_t* const dbase = Q + (size_t)(tt - (tt > 0 ? 1 : 0)) * tstride;
        f32x4 lbv[2][2];
        if (tt == 1) {
#pragma unroll
            for (int bj = 0; bj < 2; ++bj)
#pragma unroll
                for (int n = 0; n < 2; ++n) lbv[bj][n] = *(const f32x4*)(lb + col0 + bj * HALF + 4 * n);
        }
#pragma unroll
        for (int ai = 0; ai < 2; ++ai)
#pragma unroll
            for (int m = 0; m < 4; ++m) { const int row = row0 + ai * HALF + m * 16; const float rs = row_rstd_q(ssq, row, fq); const size_t off = (size_t)row * 1024 + col0;
#pragma unroll
                for (int bj = 0; bj < 2; ++bj) { f32x4 v0 = acc[ai][bj][m][0] * rs, v1 = acc[ai][bj][m][1] * rs;
                    if (tt == 1) {
#pragma unroll
                        for (int n = 0; n < 2; ++n) { f32x4 z = n ? v1 : v0; f32x4 r;
#pragma unroll
                            for (int i = 0; i < 4; ++i) { const float zz = z[i], e = __expf(-fabsf(zz));
                                if (lbzero) r[i] = fminf(zz, 0.f) - __logf(1.0f + e);
                                else { const float d = __builtin_amdgcn_rcpf(1.0f + e), sg = zz >= 0.f ? d : e * d, l = lbv[bj][n][i]; r[i] = __logf(l + (1.0f - l) * sg); } }
                            *(f32x4*)(LF + off + bj * HALF + 4 * n) = r; }
                    } else {
                        if (tt == 3) {
#pragma unroll
                            for (int i = 0; i < 4; ++i) { v0[i] = v0[i] * sigmoid_f(v0[i]); v1[i] = v1[i] * sigmoid_f(v1[i]); } }
                        bf16_t* dst = dbase + off + bj * HALF;
                        u32x4 w; w.x = cvt_pk_bf16(v0[0], v0[1]); w.y = cvt_pk_bf16(v0[2], v0[3]); w.z = cvt_pk_bf16(v1[0], v1[1]); w.w = cvt_pk_bf16(v1[2], v1[3]);
                        *(u32x4*)dst = w; } } }
    }
};
struct EpiSwi {
    static constexpr bool PERM = true, AFTER_DRAIN = false;
    bf16_t* H; const float* ssq;
    __device__ __forceinline__ void operator()(const f32x4 (&acc)[2][2][4][2], const Unit& u, int wr, int wc, int fr, int fq) const {
        const int col0 = u.pn * HALF + wc * 32 + 8 * fq, row0 = u.pm * BM + wr * 64 + fr;
#pragma unroll
        for (int ai = 0; ai < 2; ++ai)
#pragma unroll
            for (int m = 0; m < 4; ++m) { const int row = row0 + ai * HALF + m * 16; const float rs = row_rstd_q(ssq, row, fq);
                f32x4 h[2];
#pragma unroll
                for (int n = 0; n < 2; ++n) { const f32x4 g = acc[ai][0][m][n] * rs, uu = acc[ai][1][m][n] * rs;
#pragma unroll
                    for (int i = 0; i < 4; ++i) h[n][i] = g[i] * sigmoid_f(g[i]) * uu[i]; }
                u32x4 w; w.x = cvt_pk_bf16(h[0][0], h[0][1]); w.y = cvt_pk_bf16(h[0][2], h[0][3]); w.z = cvt_pk_bf16(h[1][0], h[1][1]); w.w = cvt_pk_bf16(h[1][2], h[1][3]);
                *(u32x4*)(H + (size_t)row * 2816 + col0) = w; }
    }
};
template <class Epi, class Sched, bool ALIGN_EPI = false, bool SP2 = false>
__device__ __forceinline__ void gemm_phase(PG8_LAS unsigned char* lds, const Gemm g, const Sched& S, const Epi& E) {
    int tid_ = threadIdx.x; asm volatile("" : "+v"(tid_));
    const int tid = tid_, wid = __builtin_amdgcn_readfirstlane(tid >> 6), lane = tid & 63, wr = wid >> 2, wc = wid & 3, fr = lane & 15, fq = lane >> 4;
    const int K = g.K, nt = K / BK;
    unsigned voffA[2], voffB[2];
#pragma unroll
    for (int i = 0; i < 2; ++i) { int R, C; stage_rc(tid * 16 + i * 8192, R, C); const int Rb = Epi::PERM ? ((R & ~31) + perm32(R & 31)) : R;
        voffA[i] = (unsigned)(R * K + C) * 2u; voffB[i] = (unsigned)(Rb * K + C) * 2u; }
    const size_t kstep = (size_t)(BK * 2);
    const size_t hstep = (size_t)HALF * K * 2;
    const size_t tstep = 2 * hstep;
    const unsigned ldsw = (unsigned)wid * 1024u;
    const int aoff = lds_byte(wr * 64 + fr, fq * 8), boff = lds_byte(wc * 32 + fr, fq * 8);
#define PG8_SA(b, h) (((b) * 2 + (h)) * HTB)
#define PG8_SB(b, h) ((4 + (b) * 2 + (h)) * HTB)
#define PG8_STAGE(bufoff, gbase, voff) do { _Pragma("unroll") for (int _i = 0; _i < 2; ++_i) \
        __builtin_amdgcn_global_load_lds((const unsigned*)((const char*)(gbase) + (voff)[_i]), (PG8_LAS unsigned*)(lds + (bufoff) + ldsw + _i * 8192), 16, 0, 0); } while (0)
#define PG8_LDA(dst, b, h) do { _Pragma("unroll") for (int m = 0; m < 4; ++m) _Pragma("unroll") for (int k = 0; k < 2; ++k) dst[m][k] = *(const PG8_LAS bf16x8*)(lds + PG8_SA(b, h) + aoff + m * 2048 + k * 1024); } while (0)
#define PG8_LDB(dst, b, h) do { _Pragma("unroll") for (int n = 0; n < 2; ++n) _Pragma("unroll") for (int k = 0; k < 2; ++k) dst[n][k] = *(const PG8_LAS bf16x8*)(lds + PG8_SB(b, h) + boff + n * 2048 + k * 1024); } while (0)
#define PG8_MMA(ai, bj, At, Bt) do { __builtin_amdgcn_s_setprio(1); _Pragma("unroll") for (int m = 0; m < 4; ++m) _Pragma("unroll") for (int n = 0; n < 2; ++n) _Pragma("unroll") for (int k = 0; k < 2; ++k) \
        acc[ai][bj][m][n] = __builtin_amdgcn_mfma_f32_16x16x32_bf16(Bt[n][k], At[m][k], acc[ai][bj][m][n], 0, 0, 0); __builtin_amdgcn_s_setprio(0); } while (0)
#define PG8_WAIT_V(n) asm volatile("s_waitcnt vmcnt(" #n ")" ::: "memory")
#define PG8_WAIT_L(n) asm volatile("s_waitcnt lgkmcnt(" #n ")" ::: "memory")
#define PG8_BAR __builtin_amdgcn_s_barrier()
#define PG8_SCHED __builtin_amdgcn_sched_barrier(0)
    Unit cur, nxt; int ui = 0;
    if (!S.next(0, cur)) return;
    f32x4 acc[2][2][4][2];
#pragma unroll
    for (int a = 0; a < 2; ++a)
#pragma unroll
        for (int b = 0; b < 2; ++b)
#pragma unroll
            for (int m = 0; m < 4; ++m)
#pragma unroll
                for (int n = 0; n < 2; ++n) acc[a][b][m][n] = (f32x4){0.f, 0.f, 0.f, 0.f};
    bf16x8 At[4][2], B0[2][2], B1[2][2];
    const char* cA = (const char*)g.A + (size_t)cur.pm * tstep; const char* cB = (const char*)g.Bt + (size_t)cur.pn * tstep;
    S.a_ready(cur);
    if constexpr (SP2) {
        PG8_STAGE(PG8_SB(0, 0), cB, voffB); PG8_STAGE(PG8_SB(0, 1), cB + hstep, voffB); PG8_STAGE(PG8_SA(0, 0), cA, voffA); PG8_STAGE(PG8_SA(0, 1), cA + hstep, voffA);
        if (wr == 1) PG8_BAR;
        PG8_WAIT_V(2); PG8_BAR;
        PG8_STAGE(PG8_SB(1, 0), cB + kstep, voffB); PG8_STAGE(PG8_SA(1, 0), cA + kstep, voffA); PG8_STAGE(PG8_SB(1, 1), cB + hstep + kstep, voffB);
        PG8_WAIT_V(6); PG8_BAR;
    } else {
        PG8_STAGE(PG8_SB(0, 0), cB, voffB); PG8_STAGE(PG8_SA(0, 0), cA, voffA); PG8_STAGE(PG8_SB(0, 1), cB + hstep, voffB); PG8_STAGE(PG8_SA(0, 1), cA + hstep, voffA);
        if (wr == 1) PG8_BAR;
        PG8_WAIT_V(4); PG8_BAR;
        PG8_STAGE(PG8_SB(1, 0), cB + kstep, voffB); PG8_STAGE(PG8_SA(1, 0), cA + kstep, voffA); PG8_STAGE(PG8_SB(1, 1), cB + hstep + kstep, voffB);
        PG8_WAIT_V(6); PG8_BAR;
    }
    for (;;) {
        const bool has_next = S.next(ui + 1, nxt);
        const char* nA = has_next ? (const char*)g.A + (size_t)nxt.pm * tstep : cA; const char* nB = has_next ? (const char*)g.Bt + (size_t)nxt.pn * tstep : cB;
        for (int t = 0; t < nt; t += 2) {
            const bool last = (t == nt - 2);
            const char* a1 = cA + (size_t)(t + 1) * kstep;
            const char* a2 = last ? nA : cA + (size_t)(t + 2) * kstep; const char* b2 = last ? nB : cB + (size_t)(t + 2) * kstep;
            const char* a3 = a2 + kstep; const char* b3 = b2 + kstep;
            if (last && has_next) S.a_ready(nxt);
            if constexpr (SP2) {
            PG8_LDB(B0, 0, 0); PG8_LDB(B1, 0, 1); PG8_SCHED; PG8_LDA(At, 0, 0); PG8_STAGE(PG8_SA(1, 1), a1 + hstep, voffA);
            PG8_WAIT_V(8); PG8_WAIT_L(0); PG8_BAR; PG8_MMA(0, 0, At, B0); PG8_MMA(0, 1, At, B1); PG8_BAR; PG8_SCHED;
            PG8_LDA(At, 0, 1); PG8_STAGE(PG8_SB(0, 0), b2, voffB); PG8_STAGE(PG8_SB(0, 1), b2 + hstep, voffB); PG8_STAGE(PG8_SA(0, 0), a2, voffA);
            PG8_WAIT_V(8); PG8_WAIT_L(0); PG8_BAR; PG8_MMA(1, 0, At, B0); PG8_MMA(1, 1, At, B1); PG8_BAR; PG8_SCHED;
            PG8_LDB(B0, 1, 0); PG8_LDB(B1, 1, 1); PG8_SCHED; PG8_LDA(At, 1, 0); PG8_STAGE(PG8_SA(0, 1), a2 + hstep, voffA);
            PG8_WAIT_V(8); PG8_WAIT_L(0); PG8_BAR; PG8_MMA(0, 0, At, B0); PG8_MMA(0, 1, At, B1); PG8_BAR; PG8_SCHED;
            PG8_LDA(At, 1, 1); PG8_STAGE(PG8_SB(1, 0), b3, voffB); PG8_STAGE(PG8_SB(1, 1), b3 + hstep, voffB); PG8_STAGE(PG8_SA(1, 0), a3, voffA);
            PG8_WAIT_V(8); PG8_WAIT_L(0); PG8_BAR; PG8_MMA(1, 0, At, B0); PG8_MMA(1, 1, At, B1); PG8_BAR; PG8_SCHED;
            } else {
            PG8_LDB(B0, 0, 0); PG8_SCHED; PG8_LDA(At, 0, 0); PG8_STAGE(PG8_SA(1, 1), a1 + hstep, voffA);
            PG8_WAIT_L(8); PG8_BAR; PG8_WAIT_L(0); PG8_MMA(0, 0, At, B0); PG8_BAR; PG8_SCHED;
            PG8_LDB(B1, 0, 1); PG8_STAGE(PG8_SB(0, 0), b2, voffB);
            PG8_BAR; PG8_WAIT_L(0); PG8_MMA(0, 1, At, B1); PG8_BAR;
            PG8_LDA(At, 0, 1); PG8_STAGE(PG8_SA(0, 0), a2, voffA);
            PG8_BAR; PG8_WAIT_L(0); PG8_MMA(1, 0, At, B0); PG8_BAR; PG8_SCHED;
            PG8_STAGE(PG8_SB(0, 1), b2 + hstep, voffB);
            PG8_WAIT_V(6); PG8_BAR; PG8_MMA(1, 1, At, B1); PG8_BAR;
            PG8_LDB(B0, 1, 0); PG8_SCHED; PG8_LDA(At, 1, 0); PG8_STAGE(PG8_SA(0, 1), a2 + hstep, voffA);
            PG8_WAIT_L(8); PG8_BAR; PG8_WAIT_L(0); PG8_MMA(0, 0, At, B0); PG8_BAR; PG8_SCHED;
            PG8_LDB(B1, 1, 1); PG8_STAGE(PG8_SB(1, 0), b3, voffB);
            PG8_BAR; PG8_WAIT_L(0); PG8_MMA(0, 1, At, B1); PG8_BAR;
            PG8_LDA(At, 1, 1); PG8_STAGE(PG8_SA(1, 0), a3, voffA);
            PG8_BAR; PG8_WAIT_L(0); PG8_MMA(1, 0, At, B0); PG8_BAR; PG8_SCHED;
            PG8_STAGE(PG8_SB(1, 1), b3 + hstep, voffB);
            PG8_WAIT_V(6); PG8_BAR; PG8_MMA(1, 1, At, B1); PG8_BAR;
            }
        }
        if constexpr (ALIGN_EPI) { if (wr == 0) PG8_BAR; }
        if constexpr (!Epi::AFTER_DRAIN) { E(acc, cur, wr, wc, fr, fq); S.done(cur); }
        if (!has_next) break;
#pragma unroll
        for (int a = 0; a < 2; ++a)
#pragma unroll
            for (int b = 0; b < 2; ++b)
#pragma unroll
                for (int m = 0; m < 4; ++m)
#pragma unroll
                    for (int n = 0; n < 2; ++n) acc[a][b][m][n] = (f32x4){0.f, 0.f, 0.f, 0.f};
        cur = nxt; cA = nA; cB = nB; ++ui;
        if constexpr (ALIGN_EPI) { if (wr == 1) PG8_BAR; }
    }
    PG8_WAIT_V(0);
    if constexpr (!ALIGN_EPI) { if (wr == 0) PG8_BAR; }
    PG8_BAR;
    if constexpr (Epi::AFTER_DRAIN) { E.fused(acc, cur, wr, wc, fr, fq, lds, wid, lane); S.done(cur); }
#undef PG8_SA
#undef PG8_SB
#undef PG8_STAGE
#undef PG8_LDA
#undef PG8_LDB
#undef PG8_MMA
#undef PG8_WAIT_V
#undef PG8_WAIT_L
#undef PG8_BAR
#undef PG8_SCHED
}
}

#define GAS __attribute__((address_space(1)))
#define LAS __attribute__((address_space(3)))
typedef unsigned short bf16;
typedef unsigned v4u __attribute__((ext_vector_type(4)));
typedef float f32x4 __attribute__((ext_vector_type(4)));
typedef short bf16x8 __attribute__((ext_vector_type(8)));
typedef GAS unsigned gu32;
typedef GAS unsigned long long gu64;
#define RLX_AGENT __ATOMIC_RELAXED, __HIP_MEMORY_SCOPE_AGENT
#define LDS_WAIT() asm volatile("s_waitcnt lgkmcnt(0)" ::: "memory")
#define VM_WAIT() asm volatile("s_waitcnt vmcnt(0)" ::: "memory")
__device__ __forceinline__ unsigned long long rt() { return __builtin_amdgcn_s_memrealtime(); }
__device__ __forceinline__ unsigned f2bf(float f) { unsigned u = __builtin_bit_cast(unsigned, f); return (u + 0x7fffu + ((u >> 16) & 1u)) >> 16; }
__device__ __forceinline__ unsigned pk2(float lo, float hi) { return f2bf(lo) | (f2bf(hi) << 16); }

#define XB_TMO      128
#define XB_XCNT(j)  (256  + 64 * (j))
#define XB_XSUB(j)  (1280 + 64 * (j))
#define XB_XGEN(j)  (2304 + 64 * (j))
#define XB_TOP      3328
#define XB_TOPGEN   3392
#define XCD_BAR_WORDS 3456
#define XB_SPIN_CAP (1u << 18)

__device__ __forceinline__ unsigned xb_ld(unsigned* p)              { return __hip_atomic_load(p, __ATOMIC_RELAXED, __HIP_MEMORY_SCOPE_AGENT); }
__device__ __forceinline__ unsigned xb_add(unsigned* p, unsigned v) { return __hip_atomic_fetch_add(p, v, __ATOMIC_RELAXED, __HIP_MEMORY_SCOPE_AGENT); }
__device__ __forceinline__ unsigned xb_xcc_id() { return (unsigned)__builtin_amdgcn_s_getreg((3 << 11) | 20) & 0xFu; }
#define XB_SPIN(cond, bar) do { unsigned _sp = 0; while (cond) { __builtin_amdgcn_s_sleep(1); \
    if ((++_sp & 255u) == 0u) { if (xb_ld(&(bar)[XB_TMO])) break; if (_sp > XB_SPIN_CAP) { atomicAdd(&(bar)[XB_TMO], 1u); break; } } } } while (0)

struct XcdBarrier {
    unsigned* bar; unsigned x;
    volatile LAS unsigned* st;
};

__device__ __forceinline__ XcdBarrier xcd_barrier_post(unsigned* bar, volatile LAS unsigned* st) {
    XcdBarrier b; b.bar = bar; b.x = xb_xcc_id(); b.st = st;
    if (threadIdx.x == 0) (void)xb_add(&bar[XB_XCNT(b.x)], 1u);
    return b;
}
__device__ __forceinline__ void xcd_barrier_complete(unsigned* bar, unsigned x, unsigned& nloc, unsigned& nx) {
    const unsigned G = gridDim.x * gridDim.y * gridDim.z;
    unsigned sum, cnt, mine, sp = 0u;
    for (;;) {
        sum = 0u; cnt = 0u; mine = 0u;
#pragma unroll
        for (unsigned j = 0; j < 16; ++j) { const unsigned c = xb_ld(&bar[XB_XCNT(j)]); sum += c; cnt += (c > 0u) ? 1u : 0u; mine = (j == x) ? c : mine; }
        if (sum == G) break;
        __builtin_amdgcn_s_sleep(1);
        if ((++sp & 255u) == 0u) { if (xb_ld(&bar[XB_TMO])) break; if (sp > XB_SPIN_CAP) { atomicAdd(&bar[XB_TMO], 1u); break; } }
    }
    nloc = mine > 0u ? mine : 1u; nx = cnt > 0u ? cnt : 1u;
}

__device__ __forceinline__ void xcd_barrier(const XcdBarrier& b) {
    asm volatile("s_waitcnt vmcnt(0)" ::: "memory");
    __syncthreads();
    if (threadIdx.x == 0) {
        unsigned* bar = b.bar;
        __builtin_amdgcn_s_waitcnt(0);
        unsigned nloc = b.st[0], nx = b.st[1];
        if (nloc == 0u) { xcd_barrier_complete(bar, b.x, nloc, nx); b.st[0] = nloc; b.st[1] = nx; }
        const unsigned old = xb_add(&bar[XB_XSUB(b.x)], 1u);
        const unsigned gen = old / nloc;
        if (old + 1u == (gen + 1u) * nloc) {
            __builtin_amdgcn_fence(__ATOMIC_RELEASE, "agent");
            asm volatile("s_waitcnt vmcnt(0)" ::: "memory");
            const unsigned og = xb_add(&bar[XB_TOP], 1u);
            const unsigned tg = og / nx;
            if (og + 1u == (tg + 1u) * nx) xb_add(&bar[XB_TOPGEN], 1u);
            else XB_SPIN(xb_ld(&bar[XB_TOPGEN]) == tg, bar);
            __builtin_amdgcn_fence(__ATOMIC_ACQUIRE, "agent");
            xb_add(&bar[XB_XGEN(b.x)], 1u);
            asm volatile("s_waitcnt vmcnt(0)" ::: "memory");
        } else {
            XB_SPIN(xb_ld(&bar[XB_XGEN(b.x)]) == gen, bar);
            __builtin_amdgcn_fence(__ATOMIC_ACQUIRE, "agent");
            asm volatile("s_waitcnt vmcnt(0)" ::: "memory");
        }
    }
    __syncthreads();
}

constexpr int NWAVES = 8;
constexpr int BATCH = 8, SEQ = 2048, D = 1024, DEPTH = 4, M = BATCH * SEQ;
constexpr int FOXH = 8, FOXD = 64, FOXW = 512, CONVW = 512, AB_COLS = 3080, AB_N = 3072;
constexpr int HGH = 8, HGD = 128, C_COLS = 4096;
constexpr int FFH = 2816, FF2 = 5632;
constexpr float EPS = 1e-6f;
constexpr float LOG2E = 1.4426950408889634f;
constexpr float QSCALE = 0.125f * LOG2E;

constexpr size_t MiB = 1u << 20;
constexpr size_t WS_CTL = 0, CTL_ZERO_BYTES = 1 * MiB;
constexpr size_t WS_SSQ = 1 * MiB;
constexpr size_t WS_CL = 2 * MiB;
constexpr size_t WS_BT = WS_CL + 512 * 1024;
constexpr size_t WS_WF = WS_BT + 64 * 1024;
constexpr size_t WS_LB = WS_WF + 64 * 1024;
constexpr size_t WS_W = 4 * MiB;
constexpr size_t W_ABIN = 0, SZ_ABIN = (size_t)AB_N * D * 2;
constexpr size_t W_ABOUT = W_ABIN + 2 * SZ_ABIN, SZ_ABOUT = (size_t)D * D * 2;
constexpr size_t W_CIN = W_ABOUT + 2 * SZ_ABOUT, SZ_CIN = (size_t)C_COLS * D * 2;
constexpr size_t W_COUT = W_CIN + 2 * SZ_CIN, SZ_COUT = (size_t)D * D * 2;
constexpr size_t W_FIN = W_COUT + 2 * SZ_COUT, SZ_FIN = (size_t)FF2 * D * 2;
constexpr size_t W_FOUT = W_FIN + 4 * SZ_FIN, SZ_FOUT = (size_t)D * FFH * 2;
constexpr size_t W_END = W_FOUT + 4 * SZ_FOUT;
static_assert(WS_W + W_END <= 108 * MiB, "weights region");
constexpr size_t WS_XB = 108 * MiB;
constexpr size_t WS_MIX = 140 * MiB;
constexpr size_t WS_H = WS_MIX;
constexpr size_t WS_QKVU = WS_MIX, T512 = (size_t)M * 512 * 2, WS_AO = WS_MIX + 6 * T512;
constexpr size_t WS_LF = WS_MIX, WS_HQ = WS_MIX + 64 * MiB, WS_HV = WS_HQ + 32 * MiB, WS_HG = WS_HV + 32 * MiB, WS_HO = WS_HG + 32 * MiB, WS_END = WS_HO + 32 * MiB;
static_assert(WS_END <= 352 * MiB, "workspace budget");
constexpr int CW_TMO = 0, CW_BAR = 4096;

constexpr int RING_OFF = 0, RING_BYTES = 131072;
constexpr int LDSCTL_OFF = RING_BYTES, MISC_OFF = LDSCTL_OFF + 320;
constexpr int LDS_BYTES = 147456;
static_assert(MISC_OFF + 128 <= LDS_BYTES, "LDS map");

struct Args { const float* in[14]; float* out; unsigned char* ws; int ph_lo, ph_hi, li, pad; };

struct Frame {
    LAS unsigned char* lds; volatile LAS unsigned* MISC; gu32* ctl;
    int wave, vcu, G;
};
#define LANE_IDS() int tid_l = threadIdx.x; asm volatile("" : "+v"(tid_l)); const int TID = tid_l, LANE = tid_l & 63
__device__ __forceinline__ float wave_sum(float v) {
#pragma unroll
    for (int o = 1; o < 64; o <<= 1) v += __shfl_xor(v, o);
    return v;
}
__device__ __forceinline__ float bf_lo(unsigned w) { return __uint_as_float(w << 16); }
__device__ __forceinline__ float bf_hi(unsigned w) { return __uint_as_float(w & 0xffff0000u); }

__device__ __forceinline__ void p0_item(const float* W, int ldn, int ksrc0, int nsrc0, const float* gain, bf16* WT, int K, int drow0, LAS float* scr, int lane) {
#pragma unroll 8
    for (int i = 0; i < 32; ++i) { const int kk = 2 * i + (lane >> 5); float w = W[(size_t)(ksrc0 + kk) * ldn + nsrc0 + (lane & 31)]; if (gain) w *= gain[ksrc0 + kk]; scr[kk * 33 + (lane & 31)] = w; }
    LDS_WAIT(); asm volatile("" ::: "memory");
    const int c = lane & 7;
#pragma unroll
    for (int j = 0; j < 4; ++j) { const int n = (lane >> 3) + 8 * j; const LAS float* s = scr + (8 * c) * 33 + n;
        v4u o; o.x = pk2(s[0 * 33], s[1 * 33]); o.y = pk2(s[2 * 33], s[3 * 33]); o.z = pk2(s[4 * 33], s[5 * 33]); o.w = pk2(s[6 * 33], s[7 * 33]);
        *(v4u*)(WT + (size_t)(drow0 + n) * K + ksrc0 + 8 * c) = o; }
    LDS_WAIT(); asm volatile("" ::: "memory");
}
__device__ __forceinline__ void p0_prologue(Frame& F, const Args& a) {
    LANE_IDS();
    LAS float* scr = (LAS float*)(F.lds + RING_OFF + F.wave * 16384);
    const int gw = F.vcu * NWAVES + F.wave, NGW = F.G * NWAVES;
    unsigned char* ws = a.ws; bf16* wb = (bf16*)(ws + WS_W);
    constexpr int I_ABIN = 16 * (AB_N / 32), I_SQ = 16 * (D / 32), I_CIN = 16 * (C_COLS / 32), I_FIN = 16 * (FF2 / 32), I_FOUT = (FFH / 64) * (D / 32);
    constexpr int T0 = 2 * I_ABIN, T1 = T0 + 2 * I_SQ, T2 = T1 + 2 * I_CIN, T3 = T2 + 2 * I_SQ, T4 = T3 + 4 * I_FIN, T5 = T4 + 4 * I_FOUT;
    for (int it = gw; it < T5; it += NGW) {
        if (it < T0) { const int j = it / I_ABIN, r = it % I_ABIN, nb = r % (AB_N / 32), kb = r / (AB_N / 32); const int n0 = 32 * nb;
            p0_item(a.in[4] + (size_t)j * D * AB_COLS, AB_COLS, 64 * kb, n0 + (n0 >= 1536 ? 8 : 0), a.in[1] + (2 * j) * D, (bf16*)((unsigned char*)wb + W_ABIN + j * SZ_ABIN), D, n0, scr, LANE); }
        else if (it < T1) { const int q = it - T0, j = q / I_SQ, r = q % I_SQ, nb = r % 32, kb = r / 32;
            p0_item(a.in[7] + (size_t)j * D * D, D, 64 * kb, 32 * nb, nullptr, (bf16*)((unsigned char*)wb + W_ABOUT + j * SZ_ABOUT), D, 32 * nb, scr, LANE); }
        else if (it < T2) { const int q = it - T1, j = q / I_CIN, r = q % I_CIN, nb = r % 128, kb = r / 128;
            p0_item(a.in[8] + (size_t)j * D * C_COLS, C_COLS, 64 * kb, 32 * nb, a.in[1] + (2 * j + 1) * D, (bf16*)((unsigned char*)wb + W_CIN + j * SZ_CIN), D, 32 * nb, scr, LANE); }
        else if (it < T3) { const int q = it - T2, j = q / I_SQ, r = q % I_SQ, nb = r % 32, kb = r / 32;
            p0_item(a.in[11] + (size_t)j * D * D, D, 64 * kb, 32 * nb, nullptr, (bf16*)((unsigned char*)wb + W_COUT + j * SZ_COUT), D, 32 * nb, scr, LANE); }
        else if (it < T4) { const int q = it - T3, l = q / I_FIN, r = q % I_FIN, nb = r % (FF2 / 32), kb = r / (FF2 / 32); const int c0 = 32 * nb;
            const int drow = c0 < FFH ? 256 * (c0 / 128) + (c0 % 128) : 256 * ((c0 - FFH) / 128) + 128 + ((c0 - FFH) % 128);
            p0_item(a.in[12] + (size_t)l * D * FF2, FF2, 64 * kb, c0, a.in[2] + l * D, (bf16*)((unsigned char*)wb + W_FIN + l * SZ_FIN), D, drow, scr, LANE); }
        else { const int q = it - T4, l = q / I_FOUT, r = q % I_FOUT, nb = r % 32, kb = r / 32;
            p0_item(a.in[13] + (size_t)l * FFH * D, D, 64 * kb, 32 * nb, nullptr, (bf16*)((unsigned char*)wb + W_FOUT + l * SZ_FOUT), FFH, 32 * nb, scr, LANE); }
    }
    { const float* x = a.in[0]; bf16* xb = (bf16*)(ws + WS_XB); float* ssq = (float*)(ws + WS_SSQ);
      for (int m = gw; m < M; m += NGW) {
        const f32x4* xr = (const f32x4*)(x + (size_t)m * D) + LANE; f32x4 v[4]; float s = 0.f;
#pragma unroll
        for (int j = 0; j < 4; ++j) { v[j] = xr[64 * j]; s += (v[j][0] * v[j][0] + v[j][1] * v[j][1]) + (v[j][2] * v[j][2] + v[j][3] * v[j][3]); }
        s = wave_sum(s);
        unsigned long long* o8 = (unsigned long long*)(xb + (size_t)m * D) + LANE;
#pragma unroll
        for (int j = 0; j < 4; ++j) o8[64 * j] = (unsigned long long)pk2(v[j][0], v[j][1]) | ((unsigned long long)pk2(v[j][2], v[j][3]) << 32);
        if (LANE < 16) ssq[(size_t)m * 16 + LANE] = LANE == 0 ? s : 0.f;
      } }
    { const int gt = (F.vcu * NWAVES + F.wave) * 64 + LANE, NGT = NGW * 64; float* wf = (float*)(ws + WS_WF); float* lb = (float*)(ws + WS_LB);
      for (int i = gt; i < 2 * 8 * D; i += NGT) { const int j = i / (8 * D), h = (i / D) % 8, k = i % D; wf[i] = a.in[4][(size_t)j * D * AB_COLS + (size_t)k * AB_COLS + 1536 + h] * a.in[1][(2 * j) * D + k]; }
      for (int i = gt; i < D; i += NGT) { const float c0 = a.in[9][i], c1 = a.in[9][D + i]; lb[i] = 0.f; lb[D + i] = 1.0f / (1.0f + expf(c0 - c1)); } }
}

__device__ __forceinline__ void fgate_job(Frame& F, const Args& a, int j, const float* x, int jb) {
    LANE_IDS();
    unsigned char* ws = a.ws; const float* wf = (const float*)(ws + WS_WF) + (size_t)j * 8 * D; const float* ssq = (const float*)(ws + WS_SSQ);
    float* cl = (float*)(ws + WS_CL); float* bt = (float*)(ws + WS_BT); const float* bias = a.in[5] + j * 8;
    LAS float* tmp = (LAS float*)(F.lds + RING_OFF);
#pragma unroll 1
    for (int i = 0; i < 8; ++i) { const int rl = F.wave * 8 + i, row = jb * 64 + rl;
        const f32x4* xr = (const f32x4*)(x + (size_t)row * D) + LANE; f32x4 v[4];
#pragma unroll
        for (int q = 0; q < 4; ++q) v[q] = xr[64 * q];
        const float rs = pg8::row_rstd(ssq, row); float mine = 0.f;
#pragma unroll 1
        for (int h = 0; h < 8; ++h) { float s = 0.f; const f32x4* wr_ = (const f32x4*)(wf + (size_t)h * D) + LANE;
#pragma unroll
            for (int q = 0; q < 4; ++q) { const f32x4 w = wr_[64 * q]; s += (v[q][0] * w[0] + v[q][1] * w[1]) + (v[q][2] * w[2] + v[q][3] * w[3]); }
            s = wave_sum(s); if (LANE == h) mine = s; }
        if (LANE < 8) { const float z = mine * rs + bias[LANE]; tmp[rl * 8 + LANE] = fminf(z, 0.f) - log1pf(expf(-fabsf(z))); }
    }
    LDS_WAIT(); __syncthreads();
    if (TID < 8) { float c = 0.f; for (int r = 0; r < 64; ++r) { c += tmp[r * 8 + TID]; cl[(size_t)(jb * 64 + r) * 8 + TID] = c; } bt[jb * 8 + TID] = c; }
    __syncthreads();
}

__device__ __forceinline__ void conv_job(Frame& F, const Args& a, int j, int jb) {
    LANE_IDS();
    unsigned char* ws = a.ws; const bf16* ub = (const bf16*)(ws + WS_QKVU + 3 * T512); const bf16* uc = (const bf16*)(ws + WS_QKVU + 4 * T512); const bf16* ux = (const bf16*)(ws + WS_QKVU + 5 * T512);
    bf16* ao = (bf16*)(ws + WS_AO); const float* cw = a.in[6] + (size_t)j * 3 * CONVW;
    for (int it = TID; it < 64 * 64; it += NWAVES * 64) { const int rl = it >> 6, ch = (it & 63) * 8, row = jb * 64 + rl, t = row & (SEQ - 1);
        float z[3][8];
#pragma unroll
        for (int d = 0; d < 3; ++d) { const int tt = t - 2 + d;
            if (tt >= 0) { const v4u cv = *(const v4u*)(uc + (size_t)(row - 2 + d) * 512 + ch), xv = *(const v4u*)(ux + (size_t)(row - 2 + d) * 512 + ch);
#pragma unroll
                for (int q = 0; q < 4; ++q) { z[d][2 * q] = bf_lo(cv[q]) * bf_lo(xv[q]); z[d][2 * q + 1] = bf_hi(cv[q]) * bf_hi(xv[q]); } }
            else {
#pragma unroll
                for (int q = 0; q < 8; ++q) z[d][q] = 0.f; } }
        const v4u bv = *(const v4u*)(ub + (size_t)row * 512 + ch); float y[8];
#pragma unroll
        for (int q = 0; q < 8; ++q) { const float b = (q & 1) ? bf_hi(bv[q >> 1]) : bf_lo(bv[q >> 1]);
            y[q] = b * (cw[ch + q] * z[0][q] + cw[CONVW + ch + q] * z[1][q] + cw[2 * CONVW + ch + q] * z[2][q]); }
        v4u o; o.x = pk2(y[0], y[1]); o.y = pk2(y[2], y[3]); o.z = pk2(y[4], y[5]); o.w = pk2(y[6], y[7]);
        *(v4u*)(ao + (size_t)row * D + 512 + ch) = o; }
}

__device__ __forceinline__ void attn_naive_unit(Frame& F, const Args& a, int unit) {
    LANE_IDS();
    unsigned char* ws = a.ws; const bf16* Q = (const bf16*)(ws + WS_QKVU); const bf16* K = (const bf16*)(ws + WS_QKVU + T512); const bf16* V = (const bf16*)(ws + WS_QKVU + 2 * T512);
    bf16* ao = (bf16*)(ws + WS_AO); const float* cl = (const float*)(ws + WS_CL); const float* bt = (const float*)(ws + WS_BT);
    const int b = unit >> 5, h = (unit >> 2) & 7, blk = unit & 3;
    LAS float* beta = (LAS float*)(F.lds + RING_OFF);
    LAS float* pre = beta + 2048;
    __syncthreads();
    if (TID == 0) { float c = 0.f; for (int i = 0; i < 32; ++i) { pre[i] = c; c += bt[(b * 32 + i) * 8 + h]; } }
    LDS_WAIT(); __syncthreads();
    for (int s = TID; s < SEQ; s += NWAVES * 64) beta[s] = -(pre[s >> 6] + cl[(size_t)(b * SEQ + s) * 8 + h]) * LOG2E;
    LDS_WAIT(); __syncthreads();
    const int t = blk * 512 + TID; const size_t rowq = (size_t)(b * SEQ + t);
    float q[64], o[64];
#pragma unroll
    for (int c = 0; c < 8; ++c) { const v4u w = *(const v4u*)(Q + rowq * 512 + h * 64 + 8 * c);
#pragma unroll
        for (int i = 0; i < 4; ++i) { q[8 * c + 2 * i] = bf_lo(w[i]); q[8 * c + 2 * i + 1] = bf_hi(w[i]); } }
#pragma unroll
    for (int d = 0; d < 64; ++d) o[d] = 0.f;
    float mx = -INFINITY, l = 0.f;
    const int send = blk * 512 + 511;
    for (int s = 0; s <= send; ++s) {
        const bf16* kr = K + (size_t)(b * SEQ + s) * 512 + h * 64; const bf16* vr = V + (size_t)(b * SEQ + s) * 512 + h * 64;
        float sc = 0.f;
#pragma unroll
        for (int c = 0; c < 8; ++c) { const v4u w = *(const v4u*)(kr + 8 * c);
#pragma unroll
            for (int i = 0; i < 4; ++i) sc += q[8 * c + 2 * i] * bf_lo(w[i]) + q[8 * c + 2 * i + 1] * bf_hi(w[i]); }
        sc += beta[s];
        if (s <= t) {
            const float mn = fmaxf(mx, sc), f = exp2f(mx - mn), p = exp2f(sc - mn); mx = mn; l = l * f + p;
#pragma unroll
            for (int c = 0; c < 8; ++c) { const v4u w = *(const v4u*)(vr + 8 * c);
#pragma unroll
                for (int i = 0; i < 4; ++i) { o[8 * c + 2 * i] = o[8 * c + 2 * i] * f + p * bf_lo(w[i]); o[8 * c + 2 * i + 1] = o[8 * c + 2 * i + 1] * f + p * bf_hi(w[i]); } }
        }
    }
    const float rl = 1.0f / l;
#pragma unroll
    for (int c = 0; c < 8; ++c) { v4u w; w.x = pk2(o[8 * c] * rl, o[8 * c + 1] * rl); w.y = pk2(o[8 * c + 2] * rl, o[8 * c + 3] * rl); w.z = pk2(o[8 * c + 4] * rl, o[8 * c + 5] * rl); w.w = pk2(o[8 * c + 6] * rl, o[8 * c + 7] * rl);
        *(v4u*)(ao + rowq * D + h * 64 + 8 * c) = w; }
}

__device__ __forceinline__ void hgrn_naive_unit(Frame& F, const Args& a, int unit) {
    LANE_IDS();
    unsigned char* ws = a.ws; const bf16* Q = (const bf16*)(ws + WS_HQ); const float* LF = (const float*)(ws + WS_LF); const bf16* V = (const bf16*)(ws + WS_HV); bf16* O = (bf16*)(ws + WS_HO);
    const int b = unit >> 5, h = (unit >> 2) & 7, eq = unit & 3; const int dg = LANE & 15, el = LANE >> 4, e = eq * 32 + F.wave * 4 + el;
    float S[8];
#pragma unroll
    for (int i = 0; i < 8; ++i) S[i] = 0.f;
    const size_t base = (size_t)b * SEQ * D + h * HGD;
#pragma unroll 4
    for (int t = 0; t < SEQ; ++t) { const size_t ro = base + (size_t)t * D;
        const v4u qw = *(const v4u*)(Q + ro + 8 * dg); const f32x4 l0 = *(const f32x4*)(LF + ro + 8 * dg), l1 = *(const f32x4*)(LF + ro + 8 * dg + 4);
        const float vv = __uint_as_float((unsigned)V[ro + e] << 16); float acc = 0.f;
#pragma unroll
        for (int i = 0; i < 8; ++i) { const float lf = i < 4 ? l0[i] : l1[i - 4]; const float f = __expf(lf); const float qq = (i & 1) ? bf_hi(qw[i >> 1]) : bf_lo(qw[i >> 1]);
            S[i] = f * S[i] + (1.0f - f) * vv; acc += qq * S[i]; }
        acc += __shfl_xor(acc, 1); acc += __shfl_xor(acc, 2); acc += __shfl_xor(acc, 4); acc += __shfl_xor(acc, 8);
        if (dg == 0) O[ro + e] = (bf16)f2bf(acc); }
}
__device__ __forceinline__ void hgrn_gate(Frame& F, const Args& a, int j) {
    LANE_IDS();
    unsigned char* ws = a.ws; const bf16* O = (const bf16*)(ws + WS_HO); const bf16* G = (const bf16*)(ws + WS_HG); bf16* AOP = (bf16*)(ws + WS_HQ); const float* hn = a.in[10] + (size_t)j * D;
    const int gw = F.vcu * NWAVES + F.wave, NGW = F.G * NWAVES;
    for (int m = gw; m < M; m += NGW) {
#pragma unroll
        for (int jj = 0; jj < 4; ++jj) { const int c = (2 * jj + (LANE >> 5)) * HGD + 4 * (LANE & 31); const size_t off = (size_t)m * D + c;
            const unsigned long long ow = *(const unsigned long long*)(O + off), gwd = *(const unsigned long long*)(G + off);
            const float o0 = bf_lo((unsigned)ow), o1 = bf_hi((unsigned)ow), o2 = bf_lo((unsigned)(ow >> 32)), o3 = bf_hi((unsigned)(ow >> 32));
            float s = (o0 * o0 + o1 * o1) + (o2 * o2 + o3 * o3);
            s += __shfl_xor(s, 1); s += __shfl_xor(s, 2); s += __shfl_xor(s, 4); s += __shfl_xor(s, 8); s += __shfl_xor(s, 16);
            const float r = __builtin_amdgcn_rsqf(s * (1.0f / HGD) + EPS); const f32x4 hv = *(const f32x4*)(hn + c);
            const float g0 = bf_lo((unsigned)gwd), g1 = bf_hi((unsigned)gwd), g2 = bf_lo((unsigned)(gwd >> 32)), g3 = bf_hi((unsigned)(gwd >> 32));
            *(unsigned long long*)(AOP + off) = (unsigned long long)pk2(o0 * r * hv[0] * g0, o1 * r * hv[1] * g1) | ((unsigned long long)pk2(o2 * r * hv[2] * g2, o3 * r * hv[3] * g3) << 32); }
    }
}
__device__ __forceinline__ void final_norm(Frame& F, const Args& a) {
    LANE_IDS();
    const int gw = F.vcu * NWAVES + F.wave, NGW = F.G * NWAVES; const float* g = a.in[3];
    f32x4 gv[4];
#pragma unroll
    for (int j = 0; j < 4; ++j) gv[j] = *((const f32x4*)g + LANE + 64 * j);
    for (int m = gw; m < M; m += NGW) { f32x4* xr = (f32x4*)(a.out + (size_t)m * D) + LANE; f32x4 v[4]; float s = 0.f;
#pragma unroll
        for (int j = 0; j < 4; ++j) { v[j] = xr[64 * j]; s += (v[j][0] * v[j][0] + v[j][1] * v[j][1]) + (v[j][2] * v[j][2] + v[j][3] * v[j][3]); }
        const float r = __builtin_amdgcn_rsqf(wave_sum(s) * (1.0f / D) + EPS);
#pragma unroll
        for (int j = 0; j < 4; ++j) xr[64 * j] = v[j] * r * gv[j]; }
}

constexpr int N_PHASES = 26;
#ifndef MK_PER_PHASE
#define MK_PER_PHASE 1
#endif
__global__ void __launch_bounds__(NWAVES * 64, 2) trunk_fwd(Args args) {
    extern __shared__ __attribute__((aligned(16))) unsigned char lds[];
    Frame F;
    F.lds = (LAS unsigned char*)lds; F.MISC = (volatile LAS unsigned*)(F.lds + MISC_OFF);
    F.wave = __builtin_amdgcn_readfirstlane((int)threadIdx.x >> 6);
    F.G = gridDim.x; { const int bx = blockIdx.x; F.vcu = (F.G % 8 == 0) ? (bx % 8) * (F.G / 8) + bx / 8 : bx; }
    unsigned char* ws = args.ws; F.ctl = (gu32*)(ws + WS_CTL);
    for (int u = threadIdx.x; u < (LDS_BYTES - LDSCTL_OFF) / 4; u += NWAVES * 64) ((LAS unsigned*)(F.lds + LDSCTL_OFF))[u] = 0u;
    __syncthreads();
    const int lo = args.ph_lo, hi = args.ph_hi;
    XcdBarrier bar; bar.bar = (unsigned*)(F.ctl + CW_BAR); bar.x = 0; bar.st = nullptr;
    if (hi - lo > 1) bar = xcd_barrier_post((unsigned*)(F.ctl + CW_BAR), F.MISC + 8);
#define IN(k) (lo <= (k) && (k) < hi)
#define SEAM(k) do { if (IN((k) + 1)) xcd_barrier(bar); } while (0)
    bf16* const wb = (bf16*)(ws + WS_W); bf16* const XB = (bf16*)(ws + WS_XB); float* const SSQ = (float*)(ws + WS_SSQ);

    if (IN(0)) { p0_prologue(F, args); SEAM(0); }
#pragma unroll 1
    for (int l = 0; l < DEPTH; ++l) {
        const int pb = 1 + 6 * l, j = l >> 1; const bool even = (l & 1) == 0;
        const float* xin = (l == 0) ? args.in[0] : args.out;
        if (IN(pb)) {
            if (even) {
                pg8::Gemm g{XB, (const bf16*)((unsigned char*)wb + W_ABIN + j * SZ_ABIN), M, AB_N, D}; pg8::StaticOrder S; S.init(M, AB_N, F.G, (int)blockIdx.x);
                pg8::EpiAB E{(bf16*)(ws + WS_QKVU), (size_t)M * 512, SSQ, QSCALE};
                pg8::gemm_phase<pg8::EpiAB, pg8::StaticOrder, true, true>(F.lds + RING_OFF, g, S, E);
                for (int jb = F.vcu; jb < M / 64; jb += F.G) fgate_job(F, args, j, xin, jb);
            } else {
                pg8::Gemm g{XB, (const bf16*)((unsigned char*)wb + W_CIN + j * SZ_CIN), M, C_COLS, D}; pg8::StaticOrder S; S.init(M, C_COLS, F.G, (int)blockIdx.x);
                pg8::EpiHG E{(bf16*)(ws + WS_HQ), (float*)(ws + WS_LF), (size_t)M * D, (const float*)(ws + WS_LB) + (size_t)j * D, SSQ, j == 0};
                static_assert(WS_HV == WS_HQ + (size_t)M * D * 2 && WS_HG == WS_HV + (size_t)M * D * 2, "Q | V | G consecutive");
                pg8::gemm_phase<pg8::EpiHG, pg8::StaticOrder, true, true>(F.lds + RING_OFF, g, S, E);
            }
            SEAM(pb);
        }
        if (IN(pb + 1)) {
            if (even) {
                for (int u = F.vcu; u < 256; u += F.G) attn_naive_unit(F, args, u);
                for (int jb = F.vcu; jb < M / 64; jb += F.G) conv_job(F, args, j, jb);
                SEAM(pb + 1);
            } else {
                for (int u = F.vcu; u < 256; u += F.G) hgrn_naive_unit(F, args, u);
                SEAM(pb + 1);
            }
        }
        if (IN(pb + 2) && !even) { hgrn_gate(F, args, j); SEAM(pb + 2); }
        if (IN(pb + 3)) {
            const bf16* A = even ? (const bf16*)(ws + WS_AO) : (const bf16*)(ws + WS_HQ);
            const bf16* Bt = even ? (const bf16*)((unsigned char*)wb + W_ABOUT + j * SZ_ABOUT) : (const bf16*)((unsigned char*)wb + W_COUT + j * SZ_COUT);
            pg8::Gemm g{A, Bt, M, D, D}; pg8::StaticOrder S; S.init(M, D, F.G, (int)blockIdx.x);
            pg8::EpiRes E{xin, args.out, XB, SSQ};
            pg8::gemm_phase<pg8::EpiRes, pg8::StaticOrder, true, true>(F.lds + RING_OFF, g, S, E);
            SEAM(pb + 3);
        }
        if (IN(pb + 4)) {
            pg8::Gemm g{XB, (const bf16*)((unsigned char*)wb + W_FIN + l * SZ_FIN), M, FF2, D}; pg8::StaticOrder S; S.init(M, FF2, F.G, (int)blockIdx.x);
            pg8::EpiSwi E{(bf16*)(ws + WS_H), SSQ};
            pg8::gemm_phase<pg8::EpiSwi, pg8::StaticOrder, true, true>(F.lds + RING_OFF, g, S, E);
            SEAM(pb + 4);
        }
        if (IN(pb + 5)) {
            pg8::Gemm g{(const bf16*)(ws + WS_H), (const bf16*)((unsigned char*)wb + W_FOUT + l * SZ_FOUT), M, D, FFH}; pg8::StaticOrder S; S.init(M, D, F.G, (int)blockIdx.x);
            pg8::EpiRes E{args.out, args.out, XB, SSQ};
            pg8::gemm_phase<pg8::EpiRes, pg8::StaticOrder, true, true>(F.lds + RING_OFF, g, S, E);
            SEAM(pb + 5);
        }
    }
    if (IN(25)) final_norm(F, args);
#undef IN
#undef SEAM
}

extern "C" void kernel_launch(void* const* d_in, const int* in_sizes, int n_in, void* d_out, int out_size, void* d_ws, size_t ws_size, hipStream_t stream) {
    static int grid = 0;
    if (grid == 0) {
        if (n_in != 14 || in_sizes[0] != M * D || out_size != M * D || ws_size < WS_END) { fprintf(stderr, "kernel_launch: unexpected shapes / workspace (n_in %d, ws %zu, need %zu)\n", n_in, ws_size, (size_t)WS_END); grid = -1; return; }
        int dev = 0, cus = 0;
        if (hipGetDevice(&dev) != hipSuccess || hipDeviceGetAttribute(&cus, hipDeviceAttributeMultiprocessorCount, dev) != hipSuccess) { grid = -1; return; }
        if (hipFuncSetAttribute((const void*)trunk_fwd, hipFuncAttributeMaxDynamicSharedMemorySize, LDS_BYTES) != hipSuccess) { fprintf(stderr, "kernel_launch: hipFuncSetAttribute failed\n"); grid = -1; return; }
        int per_cu = 0; (void)hipOccupancyMaxActiveBlocksPerMultiprocessor(&per_cu, (const void*)trunk_fwd, NWAVES * 64, LDS_BYTES); (void)hipGetLastError();
        grid = cus;
    }
    if (grid < 0) return;
    (void)hipMemsetAsync((char*)d_ws + WS_CTL, 0, CTL_ZERO_BYTES, stream);
    Args a{};
    for (int i = 0; i < 14; ++i) a.in[i] = (const float*)d_in[i];
    a.out = (float*)d_out; a.ws = (unsigned char*)d_ws;
#if MK_PER_PHASE
    for (int p = 0; p < N_PHASES; ++p) { const int l = (p - 1) / 6, s = (p - 1) % 6; if (p >= 1 && p <= 24 && s == 2 && (l & 1) == 0) continue;
        a.ph_lo = p; a.ph_hi = p + 1; a.li = 0; hipLaunchKernelGGL(trunk_fwd, dim3(grid), dim3(NWAVES * 64), LDS_BYTES, stream, a); }
#else
    a.ph_lo = 0; a.ph_hi = N_PHASES; a.li = 0;
    hipLaunchKernelGGL(trunk_fwd, dim3(grid), dim3(NWAVES * 64), LDS_BYTES, stream, a);
#endif
}
```

```cpp
#include <hip/hip_runtime.h>
#include <cstdio>
#include <cstdint>
#include <cmath>
#ifndef TS_EPI
#define TS_EPI 0
#endif
namespace pg8 {
#define PG8_LAS __attribute__((address_space(3)))
typedef unsigned short bf16_t;
typedef short bf16x8 __attribute__((ext_vector_type(8)));
typedef float f32x4 __attribute__((ext_vector_type(4)));
typedef unsigned u32x4 __attribute__((ext_vector_type(4)));
constexpr int BM = 256, BK = 64, HALF = 128, HTB = HALF * BK * 2  , STAGE_BYTES = 8 * HTB, NXCD = 8, WGM = 8;

__host__ __device__ __forceinline__ int lds_byte(int r, int c) { const int st = (r >> 4) * 2 + (c >> 5), rr = r & 15, cc = c & 31, ob = rr * 64 + cc * 2; return st * 1024 + (ob ^ (((ob >> 9) & 1) << 5)); }
__host__ __device__ __forceinline__ void stage_rc(int b, int& R, int& C) { const int st = b / 1024, sb = b % 1024, swz = sb ^ (((sb >> 9) & 1) << 5); R = (st >> 1) * 16 + swz / 64; C = (st & 1) * 32 + (swz % 64) / 2; }
__host__ __device__ __forceinline__ int perm32(int rho) { const int n = rho >> 4, i = rho & 15; return 8 * (i >> 2) + 4 * n + (i & 3); }

struct Unit { int pm, pn; };
struct Gemm { const bf16_t* A; const bf16_t* Bt; int M, N, K; };

struct StaticOrder {
    int nM, nN, nwg, G, c;
    __host__ __device__ void init(int M, int N, int G_, int c_) { nM = M / BM; nN = N / BM; nwg = nM * nN; G = G_; c = c_; }
    __host__ __device__ bool next(int i, Unit& u) const {
        const long L = (long)i * G + c; if (L >= nwg) return false;
        int wgid = (int)L; { const int q = nwg / NXCD, r = nwg % NXCD, xcd = wgid % NXCD, off = wgid / NXCD; wgid = (xcd < r ? xcd * (q + 1) : r * (q + 1) + (xcd - r) * q) + off; }
        const int nig = WGM * nN, gid = wgid / nig, fm = gid * WGM, gsz = (nM - fm) < WGM ? (nM - fm) : WGM;
        u.pm = fm + ((wgid % nig) % gsz); u.pn = (wgid % nig) / gsz; return true;
    }
    __device__ __forceinline__ void a_ready(const Unit&) const {}
    __device__ __forceinline__ void done(const Unit&) const {}
};


__device__ __forceinline__ unsigned cvt_pk_bf16(float lo, float hi) { unsigned r; asm volatile("v_cvt_pk_bf16_f32 %0, %1, %2" : "=v"(r) : "v"(lo), "v"(hi)); return r; }
typedef unsigned u32x2 __attribute__((ext_vector_type(2)));
constexpr float RMS_EPS = 1e-6f;
__device__ __forceinline__ float row_rstd(const float* ssq, int row) {
    const f32x4* p = (const f32x4*)(ssq + (size_t)row * 16);
    const f32x4 a = p[0], b = p[1], c = p[2], d = p[3];
    const float s = (((a[0] + a[1]) + (a[2] + a[3])) + ((b[0] + b[1]) + (b[2] + b[3]))) + (((c[0] + c[1]) + (c[2] + c[3])) + ((d[0] + d[1]) + (d[2] + d[3])));
    return __builtin_amdgcn_rsqf(s * (1.0f / 1024.0f) + RMS_EPS);
}
__device__ __forceinline__ float row_rstd_q(const float* ssq, int row, int fq) {
    const f32x4 a = *((const f32x4*)(ssq + (size_t)row * 16) + fq);
    float s = (a[0] + a[1]) + (a[2] + a[3]);
    s += __shfl_xor(s, 16); s += __shfl_xor(s, 32);
    return __builtin_amdgcn_rsqf(s * (1.0f / 1024.0f) + RMS_EPS);
}
__device__ __forceinline__ void row_rstd_half(const float* ssq, int rowh, int fq, float (&rs)[4]) {
    f32x4 a[4];
#pragma unroll
    for (int m = 0; m < 4; ++m) a[m] = *((const f32x4*)(ssq + (size_t)(rowh + m * 16) * 16) + fq);
#pragma unroll
    for (int m = 0; m < 4; ++m) { float s = (a[m][0] + a[m][1]) + (a[m][2] + a[m][3]); s += __shfl_xor(s, 16); s += __shfl_xor(s, 32); rs[m] = __builtin_amdgcn_rsqf(s * (1.0f / 1024.0f) + RMS_EPS); }
}
__device__ __forceinline__ float sigmoid_f(float z) { return __builtin_amdgcn_rcpf(1.0f + __expf(-z)); }

struct EpiAB {
    static constexpr bool PERM = true, AFTER_DRAIN = false; static constexpr int NS_MIN = 16;
    bf16_t* O; size_t tstride; const float* ssq; float qscale;
    __device__ __forceinline__ void operator()(const f32x4 (&acc)[2][2][4][2], const Unit& u, int wr, int wc, int fr, int fq) const {
        const int t = u.pn >> 1; bf16_t* base = O + (size_t)t * tstride;
        const int col0 = (u.pn & 1) * 256 + wc * 32 + 8 * fq, row0 = u.pm * BM + wr * 64 + fr;
        const float sc0 = (t == 0) ? qscale : 1.0f;
#pragma unroll
        for (int ai = 0; ai < 2; ++ai) { float rsv[4]; row_rstd_half(ssq, row0 + ai * HALF, fq, rsv);
#pragma unroll
            for (int m = 0; m < 4; ++m) { const int row = row0 + ai * HALF + m * 16; const float rs = rsv[m] * sc0; bf16_t* rowp = base + (size_t)row * 512 + col0;
#pragma unroll
                for (int bj = 0; bj < 2; ++bj) { const f32x4 v0 = acc[ai][bj][m][0] * rs, v1 = acc[ai][bj][m][1] * rs;
                    u32x4 w; w.x = cvt_pk_bf16(v0[0], v0[1]); w.y = cvt_pk_bf16(v0[2], v0[3]); w.z = cvt_pk_bf16(v1[0], v1[1]); w.w = cvt_pk_bf16(v1[2], v1[3]);
                    *(u32x4*)(rowp + bj * HALF) = w; } } }
    }
};
struct EpiRes {
    static constexpr bool PERM = true, AFTER_DRAIN = false; static constexpr int NS_MIN = 16;
    const bf16_t* base; bf16_t* out; float* ssq;
    __device__ __forceinline__ void operator()(const f32x4 (&acc)[2][2][4][2], const Unit& u, int wr, int wc, int fr, int fq) const {
        const int col0 = u.pn * BM + wc * 32 + 8 * fq;
#pragma unroll
        for (int ai = 0; ai < 2; ++ai) {
            u32x4 b[4][2];
#pragma unroll
            for (int m = 0; m < 4; ++m)
#pragma unroll
                for (int bj = 0; bj < 2; ++bj) b[m][bj] = *(const u32x4*)(base + (size_t)(u.pm * BM + ai * HALF + wr * 64 + m * 16 + fr) * 1024 + col0 + bj * HALF);
#pragma unroll
            for (int m = 0; m < 4; ++m) { const int row = u.pm * BM + ai * HALF + wr * 64 + m * 16 + fr; const size_t off = (size_t)row * 1024 + col0; float s = 0.f;
#pragma unroll
                for (int bj = 0; bj < 2; ++bj) { const u32x4 bb = b[m][bj]; f32x4 x0 = acc[ai][bj][m][0], x1 = acc[ai][bj][m][1];
                    x0[0] += __uint_as_float(bb.x << 16); x0[1] += __uint_as_float(bb.x & 0xffff0000u); x0[2] += __uint_as_float(bb.y << 16); x0[3] += __uint_as_float(bb.y & 0xffff0000u);
                    x1[0] += __uint_as_float(bb.z << 16); x1[1] += __uint_as_float(bb.z & 0xffff0000u); x1[2] += __uint_as_float(bb.w << 16); x1[3] += __uint_as_float(bb.w & 0xffff0000u);
                    u32x4 w; w.x = cvt_pk_bf16(x0[0], x0[1]); w.y = cvt_pk_bf16(x0[2], x0[3]); w.z = cvt_pk_bf16(x1[0], x1[1]); w.w = cvt_pk_bf16(x1[2], x1[3]);
                    *(u32x4*)(out + off + bj * HALF) = w;
                    const float r0 = __uint_as_float(w.x << 16), r1 = __uint_as_float(w.x & 0xffff0000u), r2 = __uint_as_float(w.y << 16), r3 = __uint_as_float(w.y & 0xffff0000u);
                    const float r4 = __uint_as_float(w.z << 16), r5 = __uint_as_float(w.z & 0xffff0000u), r6 = __uint_as_float(w.w << 16), r7 = __uint_as_float(w.w & 0xffff0000u);
                    s += ((r0 * r0 + r1 * r1) + (r2 * r2 + r3 * r3)) + ((r4 * r4 + r5 * r5) + (r6 * r6 + r7 * r7)); }
                s += __shfl_xor(s, 16); s += __shfl_xor(s, 32);
                if (fq == 0) ssq[(size_t)row * 16 + u.pn * 4 + wc] = s; }
        }
    }
};
struct EpiResFinal {
    static constexpr bool PERM = true, AFTER_DRAIN = false; static constexpr int NS_MIN = 0;
    const bf16_t* base; float* out; float* xs; unsigned* cnt; const float* gain;
    __device__ __forceinline__ void operator()(const f32x4 (&acc)[2][2][4][2], const Unit& u, int wr, int wc, int fr, int fq) const {
        const int col0 = u.pn * BM + wc * 32 + 8 * fq, rowb = u.pm * BM + wr * 64 + fr;
#pragma unroll
        for (int ai = 0; ai < 2; ++ai) { u32x4 b[4][2];
#pragma unroll
            for (int m = 0; m < 4; ++m)
#pragma unroll
                for (int bj = 0; bj < 2; ++bj) b[m][bj] = *(const u32x4*)(base + (size_t)(rowb + ai * HALF + m * 16) * 1024 + col0 + bj * HALF);
#pragma unroll
            for (int m = 0; m < 4; ++m) { const int row = rowb + ai * HALF + m * 16; float s = 0.f;
#pragma unroll
                for (int bj = 0; bj < 2; ++bj) { const u32x4 bb = b[m][bj]; const f32x4 a0 = acc[ai][bj][m][0], a1 = acc[ai][bj][m][1];
                    const float x0 = a0[0] + __uint_as_float(bb.x << 16), x1 = a0[1] + __uint_as_float(bb.x & 0xffff0000u), x2 = a0[2] + __uint_as_float(bb.y << 16), x3 = a0[3] + __uint_as_float(bb.y & 0xffff0000u);
                    const float x4 = a1[0] + __uint_as_float(bb.z << 16), x5 = a1[1] + __uint_as_float(bb.z & 0xffff0000u), x6 = a1[2] + __uint_as_float(bb.w << 16), x7 = a1[3] + __uint_as_float(bb.w & 0xffff0000u);
                    s += ((x0 * x0 + x1 * x1) + (x2 * x2 + x3 * x3)) + ((x4 * x4 + x5 * x5) + (x6 * x6 + x7 * x7)); }
                s += __shfl_xor(s, 16); s += __shfl_xor(s, 32);
                if (fq == 0) __hip_atomic_store(xs + (size_t)row * 16 + u.pn * 4 + wc, s, __ATOMIC_RELAXED, __HIP_MEMORY_SCOPE_AGENT); } }
        asm volatile("s_waitcnt vmcnt(0)" ::: "memory");
        unsigned* const pc = cnt + 64 * u.pm;
        if ((threadIdx.x & 63) == 0) __hip_atomic_fetch_add(pc, 1u, __ATOMIC_RELAXED, __HIP_MEMORY_SCOPE_AGENT);
        { const unsigned long long t0 = __builtin_amdgcn_s_memrealtime();
          while ((unsigned)__builtin_amdgcn_readfirstlane(__hip_atomic_load(pc, __ATOMIC_RELAXED, __HIP_MEMORY_SCOPE_AGENT)) < 32u) {
              if (__builtin_amdgcn_s_memrealtime() - t0 > 2000000ull) break;
              __builtin_amdgcn_s_sleep(2); } }
        asm volatile("" ::: "memory");
        const f32x4 g0 = *(const f32x4*)(gain + col0), g1 = *(const f32x4*)(gain + col0 + 4), g2 = *(const f32x4*)(gain + col0 + HALF), g3 = *(const f32x4*)(gain + col0 + HALF + 4);
#pragma unroll
        for (int ai = 0; ai < 2; ++ai) { u32x4 b[4][2]; float rs[4];
#pragma unroll
            for (int m = 0; m < 4; ++m) { const int row = rowb + ai * HALF + m * 16; const float* xp = xs + (size_t)row * 16 + 4 * fq;
                float s = (__hip_atomic_load(xp, __ATOMIC_RELAXED, __HIP_MEMORY_SCOPE_AGENT) + __hip_atomic_load(xp + 1, __ATOMIC_RELAXED, __HIP_MEMORY_SCOPE_AGENT))
                        + (__hip_atomic_load(xp + 2, __ATOMIC_RELAXED, __HIP_MEMORY_SCOPE_AGENT) + __hip_atomic_load(xp + 3, __ATOMIC_RELAXED, __HIP_MEMORY_SCOPE_AGENT));
                s += __shfl_xor(s, 16); s += __shfl_xor(s, 32); rs[m] = __builtin_amdgcn_rsqf(s * (1.0f / 1024.0f) + RMS_EPS);
#pragma unroll
                for (int bj = 0; bj < 2; ++bj) b[m][bj] = *(const u32x4*)(base + (size_t)row * 1024 + col0 + bj * HALF); }
#pragma unroll
            for (int m = 0; m < 4; ++m) { const int row = rowb + ai * HALF + m * 16; const float r = rs[m]; float* op = out + (size_t)row * 1024 + col0;
#pragma unroll
                for (int bj = 0; bj < 2; ++bj) { const u32x4 bb = b[m][bj]; const f32x4 a0 = acc[ai][bj][m][0], a1 = acc[ai][bj][m][1]; const f32x4 ga = bj ? g2 : g0, gb = bj ? g3 : g1;
                    f32x4 o0, o1;
                    o0[0] = (a0[0] + __uint_as_float(bb.x << 16)) * r * ga[0]; o0[1] = (a0[1] + __uint_as_float(bb.x & 0xffff0000u)) * r * ga[1];
                    o0[2] = (a0[2] + __uint_as_float(bb.y << 16)) * r * ga[2]; o0[3] = (a0[3] + __uint_as_float(bb.y & 0xffff0000u)) * r * ga[3];
                    o1[0] = (a1[0] + __uint_as_float(bb.z << 16)) * r * gb[0]; o1[1] = (a1[1] + __uint_as_float(bb.z & 0xffff0000u)) * r * gb[1];
                    o1[2] = (a1[2] + __uint_as_float(bb.w << 16)) * r * gb[2]; o1[3] = (a1[3] + __uint_as_float(bb.w & 0xffff0000u)) * r * gb[3];
                    *(f32x4*)(op + bj * HALF) = o0; *(f32x4*)(op + bj * HALF + 4) = o1; } } }
    }
};
template <int SH> __device__ __forceinline__ float row_shr(float v) { return __builtin_bit_cast(float, __builtin_amdgcn_update_dpp(0, __builtin_bit_cast(int, v), 0x110 + SH, 0xf, 0xf, true)); }
__device__ __forceinline__ float rowscan16(float v) { v += row_shr<1>(v); v += row_shr<2>(v); v += row_shr<4>(v); v += row_shr<8>(v); return v; }
__device__ __forceinline__ float rowlast16(float v) { return __shfl(v, 15, 16); }
struct EpiHG {
    static constexpr bool PERM = true, AFTER_DRAIN = false; static constexpr int NS_MIN = 16;
    bf16_t* QA; bf16_t* KD; bf16_t* KT; bf16_t* V; size_t tstride; float* DEC; const float* lb; const float* ssq; bool lbzero;
    __device__ __forceinline__ void operator()(const f32x4 (&acc)[2][2][4][2], const Unit& u, int wr, int wc, int fr, int fq) const {
        const int row0 = u.pm * BM + wr * 64 + fr;
        if (u.pn >= 8) {
            const int tt = (u.pn >= 12) ? 1 : 0; const int col0 = ((u.pn - 8) & 3) * 256 + wc * 32 + 8 * fq; bf16_t* const dbase = V + (size_t)tt * tstride;
#pragma unroll
            for (int ai = 0; ai < 2; ++ai) { float rsv[4]; row_rstd_half(ssq, row0 + ai * HALF, fq, rsv);
#pragma unroll
                for (int m = 0; m < 4; ++m) { const int row = row0 + ai * HALF + m * 16; const float rs = rsv[m]; const size_t off = (size_t)row * 1024 + col0;
#pragma unroll
                    for (int bj = 0; bj < 2; ++bj) { f32x4 v0 = acc[ai][bj][m][0] * rs, v1 = acc[ai][bj][m][1] * rs;
                        if (tt == 1) {
#pragma unroll
                            for (int i = 0; i < 4; ++i) { v0[i] = v0[i] * sigmoid_f(v0[i]); v1[i] = v1[i] * sigmoid_f(v1[i]); } }
                        u32x4 w; w.x = cvt_pk_bf16(v0[0], v0[1]); w.y = cvt_pk_bf16(v0[2], v0[3]); w.z = cvt_pk_bf16(v1[0], v1[1]); w.w = cvt_pk_bf16(v1[2], v1[3]);
                        *(u32x4*)(dbase + off + bj * HALF) = w; } } }
            return;
        }
        const int colh = u.pn * HALF + wc * 32 + 8 * fq;
        f32x4 lbv[2];
#pragma unroll
        for (int n = 0; n < 2; ++n) lbv[n] = *(const f32x4*)(lb + colh + 4 * n);
#pragma unroll
        for (int ai = 0; ai < 2; ++ai) { float rsv[4]; row_rstd_half(ssq, row0 + ai * HALF, fq, rsv);
#pragma unroll
            for (int c2 = 0; c2 < 2; ++c2) {
                const int rowE = row0 + ai * HALF + (2 * c2) * 16, rowO = rowE + 16;
                const float rsE = rsv[2 * c2], rsO = rsv[2 * c2 + 1];
#pragma unroll
                for (int n = 0; n < 2; ++n) { float oq[2][4], od[2][4], ot[2][4]; f32x4 dec;
#pragma unroll
                    for (int i = 0; i < 4; ++i) {
                        float lf[2], kk[2], qq[2];
#pragma unroll
                        for (int eo = 0; eo < 2; ++eo) { const float rs = eo ? rsO : rsE; const float z = acc[ai][1][2 * c2 + eo][n][i] * rs; qq[eo] = acc[ai][0][2 * c2 + eo][n][i] * rs;
                            const float e = __builtin_amdgcn_exp2f(-fabsf(z) * 1.4426950408889634f), d = __builtin_amdgcn_rcpf(1.0f + e), sg = z >= 0.f ? d : e * d; float f;
                            if (lbzero) { f = sg; lf[eo] = fminf(z, 0.f) * 1.4426950408889634f - __builtin_amdgcn_logf(1.0f + e); }
                            else { const float l = lbv[n][i]; f = l + (1.0f - l) * sg; lf[eo] = __builtin_amdgcn_logf(f); }
                            kk[eo] = 1.0f - f; }
                        const float bE = rowscan16(lf[0]); const float totE = rowlast16(bE); const float bO = rowscan16(lf[1]) + totE; const float bl = rowlast16(bO);
                        oq[0][i] = qq[0] * __builtin_amdgcn_exp2f(bE); oq[1][i] = qq[1] * __builtin_amdgcn_exp2f(bO);
                        od[0][i] = kk[0] * __builtin_amdgcn_exp2f(fminf(-bE, 100.f)); od[1][i] = kk[1] * __builtin_amdgcn_exp2f(fminf(-bO, 100.f));
                        ot[0][i] = kk[0] * __builtin_amdgcn_exp2f(bl - bE); ot[1][i] = kk[1] * __builtin_amdgcn_exp2f(bl - bO);
                        dec[i] = __builtin_amdgcn_exp2f(bl); }
#pragma unroll
                    for (int eo = 0; eo < 2; ++eo) { const size_t off = (size_t)(eo ? rowO : rowE) * 1024 + colh + 4 * n; u32x2 w;
                        w.x = cvt_pk_bf16(oq[eo][0], oq[eo][1]); w.y = cvt_pk_bf16(oq[eo][2], oq[eo][3]); *(u32x2*)(QA + off) = w;
                        w.x = cvt_pk_bf16(od[eo][0], od[eo][1]); w.y = cvt_pk_bf16(od[eo][2], od[eo][3]); *(u32x2*)(KD + off) = w;
                        w.x = cvt_pk_bf16(ot[eo][0], ot[eo][1]); w.y = cvt_pk_bf16(ot[eo][2], ot[eo][3]); *(u32x2*)(KT + off) = w; }
                    if (fr == 0) *(f32x4*)(DEC + (size_t)(rowE >> 5) * 1024 + colh + 4 * n) = dec;
                    asm volatile("" ::: "memory"); }
            } }
    }
};
struct EpiSwi {
    static constexpr bool PERM = true, AFTER_DRAIN = false; static constexpr int NS_MIN = 8;
    bf16_t* H; const float* ssq;
    __device__ __forceinline__ void operator()(const f32x4 (&acc)[2][2][4][2], const Unit& u, int wr, int wc, int fr, int fq) const {
        const int col0 = u.pn * HALF + wc * 32 + 8 * fq, row0 = u.pm * BM + wr * 64 + fr;
#pragma unroll
        for (int ai = 0; ai < 2; ++ai) { float rsv[4]; row_rstd_half(ssq, row0 + ai * HALF, fq, rsv);
#pragma unroll
            for (int m = 0; m < 4; ++m) { const int row = row0 + ai * HALF + m * 16; const float rs = rsv[m];
                f32x4 h[2];
#pragma unroll
                for (int n = 0; n < 2; ++n) { const f32x4 g = acc[ai][0][m][n] * rs, uu = acc[ai][1][m][n] * rs;
#pragma unroll
                    for (int i = 0; i < 4; ++i) h[n][i] = g[i] * sigmoid_f(g[i]) * uu[i]; }
                u32x4 w; w.x = cvt_pk_bf16(h[0][0], h[0][1]); w.y = cvt_pk_bf16(h[0][2], h[0][3]); w.z = cvt_pk_bf16(h[1][0], h[1][1]); w.w = cvt_pk_bf16(h[1][2], h[1][3]);
                *(u32x4*)(H + (size_t)row * 2816 + col0) = w; } }
    }
};
template <class Epi, class Sched, bool ALIGN_EPI = false, bool SP2 = false>
__device__ __forceinline__ void gemm_phase(PG8_LAS unsigned char* lds, const Gemm g, const Sched& S, const Epi& E, unsigned* ts_out = nullptr) {
    int tid_ = threadIdx.x; asm volatile("" : "+v"(tid_));
    const int tid = tid_, wid = __builtin_amdgcn_readfirstlane(tid >> 6), lane = tid & 63, wr = wid >> 2, wc = wid & 3, fr = lane & 15, fq = lane >> 4;
    const int K = g.K, nt = K / BK;
    unsigned voffA[2], voffB[2];
#pragma unroll
    for (int i = 0; i < 2; ++i) { int R, C; stage_rc(tid * 16 + i * 8192, R, C); const int Rb = Epi::PERM ? ((R & ~31) + perm32(R & 31)) : R;
        voffA[i] = (unsigned)(R * K + C) * 2u; voffB[i] = (unsigned)(Rb * K + C) * 2u; }
    const size_t kstep = (size_t)(BK * 2);
    const size_t hstep = (size_t)HALF * K * 2;
    const size_t tstep = 2 * hstep;
    const unsigned ldsw = (unsigned)wid * 1024u;
    const int aoff = lds_byte(wr * 64 + fr, fq * 8), boff = lds_byte(wc * 32 + fr, fq * 8);
#define PG8_SA(b, h) (((b) * 2 + (h)) * HTB)
#define PG8_SB(b, h) ((4 + (b) * 2 + (h)) * HTB)
#define PG8_STAGE(bufoff, gbase, voff) do { _Pragma("unroll") for (int _i = 0; _i < 2; ++_i) \
        __builtin_amdgcn_global_load_lds((const unsigned*)((const char*)(gbase) + (voff)[_i]), (PG8_LAS unsigned*)(lds + (bufoff) + ldsw + _i * 8192), 16, 0, 0); } while (0)
#define PG8_LDA(dst, b, h) do { _Pragma("unroll") for (int m = 0; m < 4; ++m) _Pragma("unroll") for (int k = 0; k < 2; ++k) dst[m][k] = *(const PG8_LAS bf16x8*)(lds + PG8_SA(b, h) + aoff + m * 2048 + k * 1024); } while (0)
#define PG8_LDB(dst, b, h) do { _Pragma("unroll") for (int n = 0; n < 2; ++n) _Pragma("unroll") for (int k = 0; k < 2; ++k) dst[n][k] = *(const PG8_LAS bf16x8*)(lds + PG8_SB(b, h) + boff + n * 2048 + k * 1024); } while (0)
#define PG8_MMA(ai, bj, At, Bt) do { __builtin_amdgcn_s_setprio(1); _Pragma("unroll") for (int m = 0; m < 4; ++m) _Pragma("unroll") for (int n = 0; n < 2; ++n) _Pragma("unroll") for (int k = 0; k < 2; ++k) \
        acc[ai][bj][m][n] = __builtin_amdgcn_mfma_f32_16x16x32_bf16(Bt[n][k], At[m][k], acc[ai][bj][m][n], 0, 0, 0); __builtin_amdgcn_s_setprio(0); } while (0)
#define PG8_WAIT_V(n) asm volatile("s_waitcnt vmcnt(" #n ")" ::: "memory")
#define PG8_WAIT_V8_SEL(rlx, n) asm volatile("s_cmp_lg_u32 %0, 0\n\ts_cbranch_scc1 .Lpg8_rlx_%=\n\ts_waitcnt vmcnt(8)\n\ts_branch .Lpg8_end_%=\n.Lpg8_rlx_%=:\n\ts_waitcnt vmcnt(" #n ")\n.Lpg8_end_%=:" :: "s"(rlx) : "scc", "memory")
#define PG8_WAIT_V8_FIRST(rlx) do { if constexpr (Epi::NS_MIN >= 16) PG8_WAIT_V8_SEL(rlx, 24); else if constexpr (Epi::NS_MIN >= 8) PG8_WAIT_V8_SEL(rlx, 16); else PG8_WAIT_V(8); } while (0)
#define PG8_WAIT_L(n) asm volatile("s_waitcnt lgkmcnt(" #n ")" ::: "memory")
#define PG8_BAR __builtin_amdgcn_s_barrier()
#define PG8_SCHED __builtin_amdgcn_sched_barrier(0)
    Unit cur, nxt; int ui = 0;
#if TS_EPI
    unsigned ts_epi_ = 0;
#endif
    if (!S.next(0, cur)) return;
    f32x4 acc[2][2][4][2];
#pragma unroll
    for (int a = 0; a < 2; ++a)
#pragma unroll
        for (int b = 0; b < 2; ++b)
#pragma unroll
            for (int m = 0; m < 4; ++m)
#pragma unroll
                for (int n = 0; n < 2; ++n) acc[a][b][m][n] = (f32x4){0.f, 0.f, 0.f, 0.f};
    bf16x8 At[4][2], B0[2][2], B1[2][2];
    const char* cA = (const char*)g.A + (size_t)cur.pm * tstep; const char* cB = (const char*)g.Bt + (size_t)cur.pn * tstep;
    S.a_ready(cur);
    if constexpr (SP2) {
        PG8_STAGE(PG8_SB(0, 0), cB, voffB); PG8_STAGE(PG8_SB(0, 1), cB + hstep, voffB); PG8_STAGE(PG8_SA(0, 0), cA, voffA); PG8_STAGE(PG8_SA(0, 1), cA + hstep, voffA);
        if (wr == 1) PG8_BAR;
        PG8_WAIT_V(2); PG8_BAR;
        PG8_STAGE(PG8_SB(1, 0), cB + kstep, voffB); PG8_STAGE(PG8_SA(1, 0), cA + kstep, voffA); PG8_STAGE(PG8_SB(1, 1), cB + hstep + kstep, voffB);
        PG8_WAIT_V(6); PG8_BAR;
    } else {
        PG8_STAGE(PG8_SB(0, 0), cB, voffB); PG8_STAGE(PG8_SA(0, 0), cA, voffA); PG8_STAGE(PG8_SB(0, 1), cB + hstep, voffB); PG8_STAGE(PG8_SA(0, 1), cA + hstep, voffA);
        if (wr == 1) PG8_BAR;
        PG8_WAIT_V(4); PG8_BAR;
        PG8_STAGE(PG8_SB(1, 0), cB + kstep, voffB); PG8_STAGE(PG8_SA(1, 0), cA + kstep, voffA); PG8_STAGE(PG8_SB(1, 1), cB + hstep + kstep, voffB);
        PG8_WAIT_V(6); PG8_BAR;
    }
    for (;;) {
        const bool has_next = S.next(ui + 1, nxt);
        const char* nA = has_next ? (const char*)g.A + (size_t)nxt.pm * tstep : cA; const char* nB = has_next ? (const char*)g.Bt + (size_t)nxt.pn * tstep : cB;
#if TS_EPI == 2
        const unsigned long long tk0_ = __builtin_amdgcn_s_memtime();
#endif
        for (int t = 0; t < nt; t += 2) {
            const bool last = (t == nt - 2);
            const char* a1 = cA + (size_t)(t + 1) * kstep;
            const char* a2 = last ? nA : cA + (size_t)(t + 2) * kstep; const char* b2 = last ? nB : cB + (size_t)(t + 2) * kstep;
            const char* a3 = a2 + kstep; const char* b3 = b2 + kstep;
            if (last && has_next) S.a_ready(nxt);
            const int relax_ = __builtin_amdgcn_readfirstlane(((t == 0) && (ui > 0)) ? 1 : 0);
            if constexpr (SP2) {
            PG8_LDB(B0, 0, 0); PG8_LDB(B1, 0, 1); PG8_SCHED; PG8_LDA(At, 0, 0); PG8_STAGE(PG8_SA(1, 1), a1 + hstep, voffA);
            PG8_WAIT_V8_FIRST(relax_); PG8_WAIT_L(0); PG8_BAR; PG8_MMA(0, 0, At, B0); PG8_MMA(0, 1, At, B1); PG8_BAR; PG8_SCHED;
            PG8_LDA(At, 0, 1); PG8_STAGE(PG8_SB(0, 0), b2, voffB); PG8_STAGE(PG8_SB(0, 1), b2 + hstep, voffB); PG8_STAGE(PG8_SA(0, 0), a2, voffA);
            PG8_WAIT_V8_FIRST(relax_); PG8_WAIT_L(0); PG8_BAR; PG8_MMA(1, 0, At, B0); PG8_MMA(1, 1, At, B1); PG8_BAR; PG8_SCHED;
            PG8_LDB(B0, 1, 0); PG8_LDB(B1, 1, 1); PG8_SCHED; PG8_LDA(At, 1, 0); PG8_STAGE(PG8_SA(0, 1), a2 + hstep, voffA);
            PG8_WAIT_V(8); PG8_WAIT_L(0); PG8_BAR; PG8_MMA(0, 0, At, B0); PG8_MMA(0, 1, At, B1); PG8_BAR; PG8_SCHED;
            PG8_LDA(At, 1, 1); PG8_STAGE(PG8_SB(1, 0), b3, voffB); PG8_STAGE(PG8_SB(1, 1), b3 + hstep, voffB); PG8_STAGE(PG8_SA(1, 0), a3, voffA);
            PG8_WAIT_V(8); PG8_WAIT_L(0); PG8_BAR; PG8_MMA(1, 0, At, B0); PG8_MMA(1, 1, At, B1); PG8_BAR; PG8_SCHED;
            } else {
            PG8_LDB(B0, 0, 0); PG8_SCHED; PG8_LDA(At, 0, 0); PG8_STAGE(PG8_SA(1, 1), a1 + hstep, voffA);
            PG8_WAIT_L(8); PG8_BAR; PG8_WAIT_L(0); PG8_MMA(0, 0, At, B0); PG8_BAR; PG8_SCHED;
            PG8_LDB(B1, 0, 1); PG8_STAGE(PG8_SB(0, 0), b2, voffB);
            PG8_BAR; PG8_WAIT_L(0); PG8_MMA(0, 1, At, B1); PG8_BAR;
            PG8_LDA(At, 0, 1); PG8_STAGE(PG8_SA(0, 0), a2, voffA);
            PG8_BAR; PG8_WAIT_L(0); PG8_MMA(1, 0, At, B0); PG8_BAR; PG8_SCHED;
            PG8_STAGE(PG8_SB(0, 1), b2 + hstep, voffB);
            PG8_WAIT_V(6); PG8_BAR; PG8_MMA(1, 1, At, B1); PG8_BAR;
            PG8_LDB(B0, 1, 0); PG8_SCHED; PG8_LDA(At, 1, 0); PG8_STAGE(PG8_SA(0, 1), a2 + hstep, voffA);
            PG8_WAIT_L(8); PG8_BAR; PG8_WAIT_L(0); PG8_MMA(0, 0, At, B0); PG8_BAR; PG8_SCHED;
            PG8_LDB(B1, 1, 1); PG8_STAGE(PG8_SB(1, 0), b3, voffB);
            PG8_BAR; PG8_WAIT_L(0); PG8_MMA(0, 1, At, B1); PG8_BAR;
            PG8_LDA(At, 1, 1); PG8_STAGE(PG8_SA(1, 0), a3, voffA);
            PG8_BAR; PG8_WAIT_L(0); PG8_MMA(1, 0, At, B0); PG8_BAR; PG8_SCHED;
            PG8_STAGE(PG8_SB(1, 1), b3 + hstep, voffB);
            PG8_WAIT_V(6); PG8_BAR; PG8_MMA(1, 1, At, B1); PG8_BAR;
            }
        }
#if TS_EPI == 2
        ts_epi_ += (unsigned)(__builtin_amdgcn_s_memtime() - tk0_);
#endif
        if constexpr (ALIGN_EPI) { if (wr == 0) PG8_BAR; }
#if TS_EPI == 1
        const unsigned long long te0_ = __builtin_amdgcn_s_memrealtime();
#endif
        if constexpr (!Epi::AFTER_DRAIN) { E(acc, cur, wr, wc, fr, fq); S.done(cur); }
#if TS_EPI == 1
        asm volatile("s_waitcnt vmcnt(0)" ::: "memory");
        ts_epi_ += (unsigned)(__builtin_amdgcn_s_memrealtime() - te0_);
#endif
        if (!has_next) break;
#pragma unroll
        for (int a = 0; a < 2; ++a)
#pragma unroll
            for (int b = 0; b < 2; ++b)
#pragma unroll
                for (int m = 0; m < 4; ++m)
#pragma unroll
                    for (int n = 0; n < 2; ++n) acc[a][b][m][n] = (f32x4){0.f, 0.f, 0.f, 0.f};
        cur = nxt; cA = nA; cB = nB; ++ui;
        if constexpr (ALIGN_EPI) { if (wr == 1) PG8_BAR; }
    }
#if TS_EPI
    if (blockIdx.x == 0 && threadIdx.x == 0) *ts_out = ts_epi_;
#endif
    PG8_WAIT_V(0);
    if constexpr (!ALIGN_EPI) { if (wr == 0) PG8_BAR; }
    PG8_BAR;
    if constexpr (Epi::AFTER_DRAIN) { E.fused(acc, cur, wr, wc, fr, fq, lds, wid, lane); S.done(cur); }
#undef PG8_SA
#undef PG8_SB
#undef PG8_STAGE
#undef PG8_LDA
#undef PG8_LDB
#undef PG8_MMA
#undef PG8_WAIT_V
#undef PG8_WAIT_V8_FIRST
#undef PG8_WAIT_V8_SEL
#undef PG8_WAIT_L
#undef PG8_BAR
#undef PG8_SCHED
}
}

#include <hip/hip_bf16.h>
#include <cmath>
namespace attn_body {
using bf16=__hip_bfloat16;
using bf16x8=__attribute__((ext_vector_type(8)))short;
using s16x4=__attribute__((ext_vector_type(4)))short;
using f32x16=__attribute__((ext_vector_type(16)))float;
using u32x4=__attribute__((ext_vector_type(4)))unsigned;
using f32x4_t=__attribute__((ext_vector_type(4)))float;
constexpr int BATCH=8,NHEAD=8,SEQ=2048,D=64,DM=NHEAD*D,OPITCH=1024;
constexpr int NW=8,QBLK=32,QB=QBLK*NW,KVBLK=64,NQB=SEQ/QB;
constexpr int ATTN_PITCH=DM, ATTN_UNIT_ROWS=QB;
constexpr float ATT_LOG2E=1.4426950408889634f;
__device__ __forceinline__ int crow(int r,int hi){return (r&3)+8*(r>>2)+4*hi;}
#define SBAR() __builtin_amdgcn_sched_barrier(0)
__device__ __forceinline__ void cmask(f32x16&p0,f32x16&p1,int jb,int qrel,int hi){
  const float NEG=-INFINITY; int kb=64*jb+4*hi;
  #pragma unroll
  for(int r=0;r<16;++r){int kv=kb+(r&3)+8*(r>>2); if(kv>qrel)p0[r]=NEG; if(kv+32>qrel)p1[r]=NEG;}
}

constexpr int NSLOT=3, SLOTB=8192;
constexpr int LDS_K=0, LDS_V=NSLOT*SLOTB, LDS_WS=2*NSLOT*SLOTB, LDS_OST=LDS_WS+NW*64*4, LDS_BETA=LDS_OST+NW*4096, LDS_PRE=LDS_BETA+SEQ*4, LDS_BYTES=LDS_PRE+256;
constexpr float C2=0.125f*1.4426950408889634f;
__device__ __forceinline__ void glds16(const void*gsrc,unsigned lds_dst){unsigned keep;
  asm volatile("s_mov_b32 %0, m0\n\ts_mov_b32 m0, %2\n\ts_nop 0\n\tglobal_load_lds_dwordx4 %1, off\n\ts_mov_b32 m0, %0":"=&s"(keep):"v"(gsrc),"s"(lds_dst):"memory");}
__device__ __forceinline__ float max3f(float a,float b,float c){float r;asm("v_max3_f32 %0, %1, %2, %3":"=v"(r):"v"(a),"v"(b),"v"(c));return r;}
__device__ __forceinline__ float max2f(float a,float b){float r;asm("v_max_f32_e32 %0, %1, %2":"=v"(r):"v"(a),"v"(b));return r;}
__device__ __forceinline__ float fadd_s(float a,float b){float r;asm("v_add_f32_e32 %0, %1, %2":"=v"(r):"v"(a),"v"(b));return r;}
__device__ __forceinline__ float fsub_s(float a,float b){float r;asm("v_sub_f32_e32 %0, %1, %2":"=v"(r):"v"(a),"v"(b));return r;}
typedef float f32x2_t __attribute__((ext_vector_type(2))); typedef __bf16 bf16x2_t __attribute__((ext_vector_type(2)));
__device__ __forceinline__ unsigned cvtpk_s(float lo,float hi){f32x2_t v={lo,hi};bf16x2_t b=__builtin_convertvector(v,bf16x2_t);return __builtin_bit_cast(unsigned,b);}
#define WAIT_BAR(N) asm volatile("s_waitcnt vmcnt(" #N ") lgkmcnt(0)\n\ts_barrier":::"memory")

__device__ __forceinline__ void qkt(f32x16&p0,f32x16&p1,const char*Kslot,const bf16x8*qr,const f32x16&negm,int r32,int hi){
  const char*kb=Kslot+hi*1024+r32*16;
  #pragma unroll
  for(int d0=0;d0<4;++d0){
    const bf16x8 b0=*reinterpret_cast<const bf16x8*>(kb+d0*2048);
    const bf16x8 b1=*reinterpret_cast<const bf16x8*>(kb+d0*2048+512);
    if(d0==0){p0=__builtin_amdgcn_mfma_f32_32x32x16_bf16(b0,qr[0],negm,0,0,0);p1=__builtin_amdgcn_mfma_f32_32x32x16_bf16(b1,qr[0],negm,0,0,0);}
    else{p0=__builtin_amdgcn_mfma_f32_32x32x16_bf16(b0,qr[d0],p0,0,0,0);p1=__builtin_amdgcn_mfma_f32_32x32x16_bf16(b1,qr[d0],p1,0,0,0);}}
}
typedef __attribute__((address_space(3))) const char* lds_cptr;
typedef short v4i16_t __attribute__((ext_vector_type(4)));
__device__ __forceinline__ void kload8(bf16x8*kf,lds_cptr kp){
  kf[0]=*(const __attribute__((address_space(3))) bf16x8*)(kp);      kf[1]=*(const __attribute__((address_space(3))) bf16x8*)(kp+512);
  kf[2]=*(const __attribute__((address_space(3))) bf16x8*)(kp+2048); kf[3]=*(const __attribute__((address_space(3))) bf16x8*)(kp+2560);
  kf[4]=*(const __attribute__((address_space(3))) bf16x8*)(kp+4096); kf[5]=*(const __attribute__((address_space(3))) bf16x8*)(kp+4608);
  kf[6]=*(const __attribute__((address_space(3))) bf16x8*)(kp+6144); kf[7]=*(const __attribute__((address_space(3))) bf16x8*)(kp+6656);
}
__device__ __forceinline__ void kload2(bf16x8*kf,lds_cptr kp,int j){ kf[2*j]=*(const __attribute__((address_space(3))) bf16x8*)(kp+j*2048); kf[2*j+1]=*(const __attribute__((address_space(3))) bf16x8*)(kp+j*2048+512); }
__device__ __forceinline__ s16x4 vtr(lds_cptr p){ return __builtin_bit_cast(s16x4,__builtin_amdgcn_ds_read_tr16_b64_v4i16((__attribute__((address_space(3))) v4i16_t*)p)); }
__device__ __forceinline__ float rowmax(const f32x16&p0,const f32x16&p1){
  float a=max3f(p0[0],p0[1],p1[0]),b=max3f(p0[2],p0[3],p1[1]);a=max3f(a,p1[2],p1[3]);
  #pragma unroll
  for(int r=4;r<16;r+=4){a=max3f(a,p0[r],p0[r+1]);b=max3f(b,p0[r+2],p0[r+3]);a=max3f(a,p1[r],p1[r+1]);b=max3f(b,p1[r+2],p1[r+3]);}
  const float m=max2f(a,b);
  auto rr=__builtin_amdgcn_permlane32_swap(__float_as_uint(m),__float_as_uint(m),false,false);
  return max2f(__uint_as_float(rr[0]),__uint_as_float(rr[1]));
}
__device__ __forceinline__ void pv(f32x16*o,int vb,bf16x8 pa0,bf16x8 pa1,bf16x8 pa2,bf16x8 pa3){
  #pragma unroll
  for(int d0=0;d0<2;++d0){s16x4 lo[4],hi[4];
    #pragma unroll
    for(int ks=0;ks<4;++ks){
      asm volatile("ds_read_b64_tr_b16 %0,%1 offset:%c2":"=&v"(lo[ks]):"v"(vb),"i"(d0*4096+ks*1024):"memory");
      asm volatile("ds_read_b64_tr_b16 %0,%1 offset:%c2":"=&v"(hi[ks]):"v"(vb),"i"(d0*4096+ks*1024+512):"memory");}
    asm volatile("s_waitcnt lgkmcnt(0)":::"memory");SBAR();
    #define PK(k) (bf16x8){lo[k][0],lo[k][1],lo[k][2],lo[k][3],hi[k][0],hi[k][1],hi[k][2],hi[k][3]}
    o[d0]=__builtin_amdgcn_mfma_f32_32x32x16_bf16(pa0,PK(0),o[d0],0,0,0);
    o[d0]=__builtin_amdgcn_mfma_f32_32x32x16_bf16(pa1,PK(1),o[d0],0,0,0);
    o[d0]=__builtin_amdgcn_mfma_f32_32x32x16_bf16(pa2,PK(2),o[d0],0,0,0);
    o[d0]=__builtin_amdgcn_mfma_f32_32x32x16_bf16(pa3,PK(3),o[d0],0,0,0);
    #undef PK
  }
}

#ifndef ATTN_STORE16
#define ATTN_STORE16(p,v) (*(u32x4*)(p)=(v))
#endif
template<int THRL> __device__ __forceinline__ void attn_unit(int b,int h,int qb,const bf16*Q,const bf16*__restrict__ K,const bf16*__restrict__ V,bf16*O,char*shm){
  int tid_o=threadIdx.x; asm volatile("":"+v"(tid_o));
  const int tid=tid_o,lane=tid&63,r32=lane&31,hi=lane>>5; const int wid=__builtin_amdgcn_readfirstlane(tid>>6);
  const long rowbase=(long)b*SEQ; const int q0=qb*QB;
  const bf16*Qw=Q+(rowbase+q0+wid*QBLK)*DM+h*D;
  const bf16*Kh=K+rowbase*DM+h*D,*Vh=V+rowbase*DM+h*D;
  const unsigned lds0=(unsigned)(uintptr_t)shm;
  float*wsf=(float*)(shm+LDS_WS)+wid*64;
  const bf16*ksrc=Kh+(long)lane*DM+wid*8;
  const bf16*vsrc=Vh+(long)(16*(wid&3)+(lane>>2))*DM+(wid>>2)*32+(lane&3)*8;
  const unsigned kdst=lds0+LDS_K+wid*1024, vdst=lds0+LDS_V+wid*1024;
  #define DMA_K(t,slot) glds16(ksrc+(long)(t)*KVBLK*DM,(unsigned)__builtin_amdgcn_readfirstlane(kdst+(slot)))
  #define DMA_V(t,slot) glds16(vsrc+(long)(t)*KVBLK*DM,(unsigned)__builtin_amdgcn_readfirstlane(vdst+(slot)))
  const int vb0=(int)(lds0+LDS_V)+((lane>>4)&1)*32+(lane&3)*8+(4*hi+((lane&15)>>2))*64;
  const char*Kbase=shm+LDS_K; bf16x8 kf[8];
  const lds_cptr shm3=(lds_cptr)shm; const lds_cptr kp0=shm3+LDS_K+hi*1024+r32*16; const lds_cptr vp0=shm3+LDS_V+((lane>>4)&1)*32+(lane&3)*8+(4*hi+((lane&15)>>2))*64;
  const int NT=(q0+QB)/KVBLK;
  DMA_K(0,0);DMA_V(0,0);DMA_K(1,SLOTB);
  bf16x8 qr[4];
  #pragma unroll
  for(int d0=0;d0<4;++d0)qr[d0]=*reinterpret_cast<const bf16x8*>(&Qw[(long)r32*DM+d0*16+hi*8]);
  float m0;
  { const bf16*Kd=Kh+(long)(q0+wid*QBLK+r32)*DM+hi*8; float acc_=0.f;
    #pragma unroll
    for(int d0=0;d0<4;++d0){ const bf16x8 kd=*reinterpret_cast<const bf16x8*>(&Kd[d0*16]);
      #pragma unroll
      for(int j_=0;j_<8;++j_) acc_+=__uint_as_float((unsigned)(unsigned short)qr[d0][j_]<<16)*__uint_as_float((unsigned)(unsigned short)kd[j_]<<16); }
    auto rr_=__builtin_amdgcn_permlane32_swap(__float_as_uint(acc_),__float_as_uint(acc_),false,false);
    m0=__uint_as_float(rr_[0])+__uint_as_float(rr_[1])+((__attribute__((address_space(3))) const float*)((lds_cptr)shm+LDS_BETA))[q0+wid*QBLK+r32]; }
  float mhat=0.f,l_reg=0.f;f32x16 o[2];o[0]=f32x16{};o[1]=f32x16{};f32x16 negm=f32x16{};asm volatile("":"+v"(negm));
  const int qrel=wid*QBLK+r32;
  #define CMASK(P0,P1,t) do{int jb_=(t)-(NT-4); if(jb_>=0)cmask(P0,P1,jb_,qrel,hi);}while(0)
  typedef __attribute__((address_space(3))) const f32x4_t* lds_f4ptr;
  const lds_f4ptr betab=(lds_f4ptr)((lds_cptr)shm+LDS_BETA+16*hi);
  #define BIAS(P0,P1,t) do{ const lds_f4ptr bp_=betab+16*(t); \
    _Pragma("unroll") for(int g_=0;g_<4;++g_){ const f32x4_t b0_=bp_[2*g_], b1_=bp_[8+2*g_]; \
      _Pragma("unroll") for(int i_=0;i_<4;++i_){ P0[4*g_+i_]+=b0_[i_]; P1[4*g_+i_]+=b1_[i_]; } if(g_&1)SBAR(); } }while(0)
  bool resc=false;
  #define START(P0,P1) do{ const float rm=rowmax(P0,P1); resc=false; \
    { const float dl=max2f(rm,m0); mhat=fadd_s(mhat,dl); \
      _Pragma("unroll") for(int r=0;r<16;++r){P0[r]=fsub_s(P0[r],dl);P1[r]=fsub_s(P1[r],dl);} \
      _Pragma("unroll") for(int r=0;r<16;++r)negm[r]=-mhat; asm volatile("":"+v"(negm)); } \
    _Pragma("unroll") for(int r=0;r<16;++r)P0[r]=__builtin_amdgcn_exp2f(P0[r]); }while(0)
  #define RESC() do{ if(resc){ asm volatile("s_waitcnt lgkmcnt(0)":::"memory"); \
      _Pragma("unroll") for(int d_=0;d_<2;++d_) _Pragma("unroll") for(int r=0;r<16;++r)o[d_][r]*=wsf[crow(r,hi)]; } }while(0)
  f32x16 pA0,pA1,pB0,pB1;
  int sl_prev=0,sl_cur=0,sl_next=SLOTB;
  #define ROT() do{sl_prev=sl_cur;sl_cur=sl_next;sl_next=(sl_next==(NSLOT-1)*SLOTB)?0:sl_next+SLOTB;}while(0)
  DMA_K(2,2*SLOTB);
  WAIT_BAR(3);
  qkt(pA0,pA1,Kbase,qr,negm,r32,hi);asm volatile("s_nop 15\n\ts_nop 7":"+v"(pA0),"+v"(pA1));BIAS(pA0,pA1,0);CMASK(pA0,pA1,0);
  START(pA0,pA1);
  _Pragma("unroll") for(int r=0;r<16;++r)pA1[r]=__builtin_amdgcn_exp2f(pA1[r]);
  WAIT_BAR(0);
  DMA_K(3,0);DMA_V(1,SLOTB);
  ROT();
  kload8(kf,kp0+sl_cur);
  WAIT_BAR(2);
  s16x4 vlo[8],vhi[8]; u32x4 pw0,pw1,pw2,pw3;
  #define PKW(P,B) cvtpk_s(P[B],P[B+1])
  #define PAF(k) __builtin_bit_cast(bf16x8,pw##k)
  #define VFR(i) (bf16x8){vlo[i][0],vlo[i][1],vlo[i][2],vlo[i][3],vhi[i][0],vhi[i][1],vhi[i][2],vhi[i][3]}
  #define PIN(x) asm volatile("":"+v"(x))
  #define MX3(a,b,c) __builtin_fmaxf(__builtin_fmaxf((a),(b)),(c))
  #define GAPA(MF,A0,A1,A2,A3,W0,W1,PW) do{ MF; sacc+=A0; sacc+=A1; sacc+=A2; sacc+=A3; PIN(sacc); W0; W1; PIN(PW); SBAR(); }while(0)
  #define EX(v) __builtin_amdgcn_exp2f(v)
  #define GAPB(MF,X,B) do{ MF; X[B]=EX(X[B]); X[B+1]=EX(X[B+1]); X[B+2]=EX(X[B+2]); X[B+3]=EX(X[B+3]); PIN(X); SBAR(); }while(0)
  #define VRD(i) do{ vlo[i]=vtr(vp_+(((i)>>2)*4096+((i)&3)*1024)); vhi[i]=vtr(vp_+(((i)>>2)*4096+((i)&3)*1024+512)); }while(0)
  #define KRD(G,j) do{ if(G){ kload2(kf,kp0+sl_next,j); SBAR(); } }while(0)
  #define STEP(C0,C1,P0,P1,t,GK,GV,GL) do{ SBAR(); \
    const lds_cptr vp_=vp0+sl_prev; \
    VRD(0); SBAR(); float sacc=(P0[0]+P0[1]); \
    GAPA(C0=__builtin_amdgcn_mfma_f32_32x32x16_bf16(kf[0],qr[0],negm,0,0,0), P0[2],P0[3],P0[4],P0[5],     pw0[0]=PKW(P0,0), pw0[1]=PKW(P0,2), pw0); \
    VRD(4); SBAR(); GAPA(C1=__builtin_amdgcn_mfma_f32_32x32x16_bf16(kf[1],qr[0],negm,0,0,0), P0[6],P0[7],P0[8],P0[9],     pw0[2]=PKW(P0,4), pw0[3]=PKW(P0,6), pw0); \
    VRD(1); SBAR(); GAPA(C0=__builtin_amdgcn_mfma_f32_32x32x16_bf16(kf[2],qr[1],C0,0,0,0),   P0[10],P0[11],P0[12],P0[13], pw1[0]=PKW(P0,8), pw1[1]=PKW(P0,10), pw1); \
    VRD(5); SBAR(); GAPA(C1=__builtin_amdgcn_mfma_f32_32x32x16_bf16(kf[3],qr[1],C1,0,0,0),   P0[14],P0[15],P1[0],P1[1],   pw1[2]=PKW(P0,12),pw1[3]=PKW(P0,14), pw1); \
    VRD(2); SBAR(); GAPA(C0=__builtin_amdgcn_mfma_f32_32x32x16_bf16(kf[4],qr[2],C0,0,0,0),   P1[2],P1[3],P1[4],P1[5],     pw2[0]=PKW(P1,0), pw2[1]=PKW(P1,2), pw2); \
    VRD(6); SBAR(); GAPA(C1=__builtin_amdgcn_mfma_f32_32x32x16_bf16(kf[5],qr[2],C1,0,0,0),   P1[6],P1[7],P1[8],P1[9],     pw2[2]=PKW(P1,4), pw2[3]=PKW(P1,6), pw2); \
    VRD(3); SBAR(); GAPA(C0=__builtin_amdgcn_mfma_f32_32x32x16_bf16(kf[6],qr[3],C0,0,0,0),   P1[10],P1[11],P1[12],P1[13], pw3[0]=PKW(P1,8), pw3[1]=PKW(P1,10), pw3); \
    VRD(7); SBAR(); GAPA(C1=__builtin_amdgcn_mfma_f32_32x32x16_bf16(kf[7],qr[3],C1,0,0,0),   P1[14],P1[15],0.f,0.f,       pw3[2]=PKW(P1,12),pw3[3]=PKW(P1,14), pw3); \
    l_reg+=sacc; \
    if(GK){DMA_K((t)+3,sl_cur);} if(GV){DMA_V((t)+1,sl_next);} \
    BIAS(C0,C1,t); CMASK(C0,C1,t); \
    { float a=MX3(C0[0],C0[1],C1[0]),b=MX3(C0[2],C0[3],C1[1]); a=MX3(a,C1[2],C1[3]); \
      _Pragma("unroll") for(int r=4;r<16;r+=4){a=MX3(a,C0[r],C0[r+1]);b=MX3(b,C0[r+2],C0[r+3]);a=MX3(a,C1[r],C1[r+1]);b=MX3(b,C1[r+2],C1[r+3]);} \
      float rm=__builtin_fmaxf(a,b); { auto rr=__builtin_amdgcn_permlane32_swap(__float_as_uint(rm),__float_as_uint(rm),false,false); rm=__builtin_fmaxf(__uint_as_float(rr[0]),__uint_as_float(rr[1])); } \
      resc=false; \
      if(__builtin_expect(__any(rm>(float)THRL),0)){ const float dl=__builtin_fmaxf(rm,0.f); mhat+=dl; \
        _Pragma("unroll") for(int r=0;r<16;++r){C0[r]-=dl;C1[r]-=dl;} \
        _Pragma("unroll") for(int r=0;r<16;++r)negm[r]=-mhat; asm volatile("":"+v"(negm)); \
        const float f=__builtin_amdgcn_exp2f(-dl); l_reg*=f; if(hi==0)wsf[r32]=f; resc=true; } } \
    SBAR(); \
    GAPB(o[0]=__builtin_amdgcn_mfma_f32_32x32x16_bf16(PAF(0),VFR(0),o[0],0,0,0), C0,0); \
    GAPB(o[1]=__builtin_amdgcn_mfma_f32_32x32x16_bf16(PAF(0),VFR(4),o[1],0,0,0), C0,4); \
    KRD(GL,0); GAPB(o[0]=__builtin_amdgcn_mfma_f32_32x32x16_bf16(PAF(1),VFR(1),o[0],0,0,0), C0,8); \
    KRD(GL,1); GAPB(o[1]=__builtin_amdgcn_mfma_f32_32x32x16_bf16(PAF(1),VFR(5),o[1],0,0,0), C0,12); \
    KRD(GL,2); GAPB(o[0]=__builtin_amdgcn_mfma_f32_32x32x16_bf16(PAF(2),VFR(2),o[0],0,0,0), C1,0); \
    KRD(GL,3); GAPB(o[1]=__builtin_amdgcn_mfma_f32_32x32x16_bf16(PAF(2),VFR(6),o[1],0,0,0), C1,4); \
    GAPB(o[0]=__builtin_amdgcn_mfma_f32_32x32x16_bf16(PAF(3),VFR(3),o[0],0,0,0), C1,8); \
    GAPB(o[1]=__builtin_amdgcn_mfma_f32_32x32x16_bf16(PAF(3),VFR(7),o[1],0,0,0), C1,12); \
    }while(0)
  int t=1;
  #undef CMASK
  #define CMASK(P0,P1,t) do{}while(0)
  for(;t+5<NT;t+=2){
    STEP(pB0,pB1,pA0,pA1,t,true,true,true);     WAIT_BAR(2); RESC(); ROT();
    STEP(pA0,pA1,pB0,pB1,t+1,true,true,true);   WAIT_BAR(2); RESC(); ROT();
  }
  #undef CMASK
  #define CMASK(P0,P1,t) do{int jb_=(t)-(NT-4); if(jb_>=0)cmask(P0,P1,jb_,qrel,hi);}while(0)
  #define ENDW(tt) do{ if((tt)+3<NT){WAIT_BAR(2);} else if((tt)+2<NT){WAIT_BAR(1);} else {WAIT_BAR(0);} }while(0)
  for(;t+1<NT;t+=2){
    STEP(pB0,pB1,pA0,pA1,t,(t+3<NT),(t+1<NT),(t+1<NT));       ENDW(t);   RESC(); ROT();
    STEP(pA0,pA1,pB0,pB1,t+1,(t+4<NT),(t+2<NT),(t+2<NT));     ENDW(t+1); RESC(); ROT();
  }
  STEP(pB0,pB1,pA0,pA1,NT-1,false,false,false); RESC();
  { float sacc=pB0[0]+pB0[1]; _Pragma("unroll") for(int r=2;r<16;++r)sacc+=pB0[r]; _Pragma("unroll") for(int r=0;r<16;++r)sacc+=pB1[r]; l_reg+=sacc;
    pw0=(u32x4){PKW(pB0,0),PKW(pB0,2),PKW(pB0,4),PKW(pB0,6)};pw1=(u32x4){PKW(pB0,8),PKW(pB0,10),PKW(pB0,12),PKW(pB0,14)};pw2=(u32x4){PKW(pB1,0),PKW(pB1,2),PKW(pB1,4),PKW(pB1,6)};pw3=(u32x4){PKW(pB1,8),PKW(pB1,10),PKW(pB1,12),PKW(pB1,14)};
    SBAR(); pv(o,vb0+sl_cur,PAF(0),PAF(1),PAF(2),PAF(3)); }
  #undef PKW
  #undef PAF
  #undef VFR
  #undef PIN
  #undef MX3
  #undef GAPA
  #undef GAPB
  #undef EX
  #undef VRD
  #undef KRD
  #undef STEP
  #undef ENDW
  {auto rr=__builtin_amdgcn_permlane32_swap(__float_as_uint(l_reg),__float_as_uint(l_reg),false,false);l_reg=__uint_as_float(rr[0])+__uint_as_float(rr[1]);}
  if(hi==0)wsf[32+r32]=l_reg;asm volatile("s_waitcnt lgkmcnt(0)":::"memory");
  float rli[16];
  #pragma unroll
  for(int r=0;r<16;++r)rli[r]=__builtin_amdgcn_rcpf(wsf[32+crow(r,hi)]);
  bf16*Ow=O+(rowbase+q0+wid*QBLK)*OPITCH+h*D;
  { bf16*stg=(bf16*)(shm+LDS_OST)+wid*2048;
    #pragma unroll
    for(int r=0;r<16;++r){const int orow=crow(r,hi);
      #pragma unroll
      for(int d0=0;d0<2;++d0)stg[orow*64+d0*32+r32]=__float2bfloat16(o[d0][r]*rli[r]);}
    asm volatile("s_waitcnt lgkmcnt(0)":::"memory");
    #pragma unroll
    for(int i=0;i<4;++i){const int row=i*8+(lane>>3),ch=lane&7; const u32x4 v=*(const u32x4*)(stg+row*64+ch*8); ATTN_STORE16(Ow+(long)row*OPITCH+ch*8,v);} }
  asm volatile("s_waitcnt lgkmcnt(0)\n\ts_barrier":::"memory");
  #undef DMA_K
  #undef DMA_V
  #undef CMASK
  #undef BIAS
  #undef START
  #undef RESC
  #undef ROT
}
constexpr int ATTN_LDS_BYTES=LDS_BYTES;
struct AttnTensors { const bf16* Q; const bf16* K; const bf16* V; bf16* O; const float* cl; const float* bt; };
struct AttnUnit { int bh; int qb; };
struct StaticOrder {
  int vcu,grid;
  __device__ __forceinline__ explicit StaticOrder(int grid_,int block):vcu((grid_%8==0)?(block%8)*(grid_/8)+block/8:block),grid(grid_){}
  __device__ __forceinline__ bool next(int i,AttnUnit&u)const{ const int v=vcu+(i>>1)*grid; if(v>=BATCH*NHEAD*4)return false; const int s=v&3; u.bh=v>>2; u.qb=((i&1)==0)?7-s:s; return true; }
  __device__ __forceinline__ void a_ready(const AttnUnit&)const{}
  __device__ __forceinline__ void done(const AttnUnit&)const{}
};
__device__ __forceinline__ void build_beta(char*lds,const float*cl,const float*bt,int bh){
  int tid_o=threadIdx.x; asm volatile("":"+v"(tid_o)); const int tid=tid_o,b=bh/NHEAD,h=bh%NHEAD;
  __attribute__((address_space(3))) float*beta=(__attribute__((address_space(3))) float*)((lds_cptr)lds+LDS_BETA);
  __attribute__((address_space(3))) float*pre=(__attribute__((address_space(3))) float*)((lds_cptr)lds+LDS_PRE);
  if(tid<64){ float v=(tid<32)?bt[(b*32+tid)*8+h]:0.f; const float own=v;
    #pragma unroll
    for(int o=1;o<32;o<<=1){ const float n=__shfl_up(v,o); if((tid&63)>=o)v+=n; }
    if(tid<32)pre[tid]=v-own; }
  asm volatile("s_waitcnt lgkmcnt(0)":::"memory"); __syncthreads();
  for(int s=tid;s<SEQ;s+=NW*64) beta[s]=-(pre[s>>6]+cl[(long)(b*SEQ+s)*8+h])*ATT_LOG2E;
  asm volatile("s_waitcnt lgkmcnt(0)":::"memory"); __syncthreads();
}
template<class Sched,int THRL=8> __device__ __forceinline__ void attn_phase(char*lds,const AttnTensors&T,const Sched&S){
  AttnUnit u;
  for(int i=0;S.next(i,u);++i){ if((i&1)==0) build_beta(lds,T.cl,T.bt,u.bh);
    S.a_ready(u); attn_unit<THRL>(u.bh/NHEAD,u.bh%NHEAD,u.qb,T.Q,T.K,T.V,T.O,lds); S.done(u); }
}
#undef SBAR
#undef WAIT_BAR
}

namespace hg {
typedef short bf16x8 __attribute__((ext_vector_type(8)));
typedef short s16x4 __attribute__((ext_vector_type(4)));
typedef float f32x16 __attribute__((ext_vector_type(16)));
typedef float f32x4 __attribute__((ext_vector_type(4)));
typedef unsigned u32x4 __attribute__((ext_vector_type(4)));
typedef unsigned u32x2 __attribute__((ext_vector_type(2)));
#define HG_LAS __attribute__((address_space(3)))
#define HG_BAR() do { asm volatile("s_waitcnt lgkmcnt(0)" ::: "memory"); __builtin_amdgcn_s_barrier(); asm volatile("" ::: "memory"); } while (0)
constexpr int CH = 32, NCH = 2048 / CH;
constexpr int S_QA = 0, S_KD = 8192, S_KT = 16384, S_V = 24576, S_DEC = 26624, SLOT_BYTES = 27136;
constexpr int OFF_OPART = 2 * SLOT_BYTES, OPART_BYTES = 4 * 4096, LDS_BYTES = OFF_OPART + 2 * OPART_BYTES;
__device__ __forceinline__ int qa_off(int t, int d) { return t * 256 + ((((d >> 3) ^ (t & 15))) << 4) + (d & 7) * 2; }
__device__ __forceinline__ int kt_off(int s, int d) { return s * 256 + ((((d >> 3) ^ ((s & 3) << 2))) << 4) + (d & 7) * 2; }
__device__ __forceinline__ int v_off(int s, int e) { return s * 64 + e * 2; }
typedef short v4i16_t __attribute__((ext_vector_type(4)));
__device__ __forceinline__ s16x4 trd(const HG_LAS unsigned char* p) { return __builtin_bit_cast(s16x4, __builtin_amdgcn_ds_read_tr16_b64_v4i16((HG_LAS v4i16_t*)p)); }
__device__ __forceinline__ unsigned cvtpk(float lo, float hi) { typedef float f2 __attribute__((ext_vector_type(2))); typedef __bf16 b2 __attribute__((ext_vector_type(2))); f2 v = {lo, hi}; b2 b = __builtin_convertvector(v, b2); return __builtin_bit_cast(unsigned, b); }
__device__ __forceinline__ int crow(int r, int hi) { return (r & 3) + 8 * (r >> 2) + 4 * hi; }
__device__ __forceinline__ bf16x8 pack8(const f32x16& x, int base) {
    u32x4 w; w.x = cvtpk(x[base], x[base + 1]); w.y = cvtpk(x[base + 2], x[base + 3]); w.z = cvtpk(x[base + 4], x[base + 5]); w.w = cvtpk(x[base + 6], x[base + 7]); return __builtin_bit_cast(bf16x8, w); }
__device__ __forceinline__ bf16x8 cat64(s16x4 a, s16x4 b) { return (bf16x8){a[0], a[1], a[2], a[3], b[0], b[1], b[2], b[3]}; }

__device__ __forceinline__ void hgrn_unit(HG_LAS unsigned char* lds, const unsigned short* QA, const unsigned short* KD, const unsigned short* KT, const float* DEC, const unsigned short* V, unsigned short* O, int unit) {
    int tid_o = threadIdx.x; asm volatile("" : "+v"(tid_o));
    const int tid = tid_o, lane = tid & 63, wid = __builtin_amdgcn_readfirstlane(tid >> 6), r32 = lane & 31, hi = lane >> 5;
    const int b = unit >> 5, h = (unit >> 2) & 7, eq = unit & 3;
    const size_t gbase = (size_t)b * 2048 * 1024 + h * 128;
    __syncthreads();
    if (wid < 4) {
        const int w = wid;
        const int tq = (lane & 15) >> 2, tc = 16 * ((lane >> 4) & 1) + 4 * (lane & 3);
        f32x16 S = {};
#pragma unroll 1
        for (int i = -1; i <= NCH; ++i) {
            if (i >= 0 && i < NCH) {
                HG_LAS unsigned char* sl = lds + (i & 1) * SLOT_BYTES;
                bf16x8 kdf[2], qaf[2]; s16x4 qp[2][2], vp[2][2], ktf[2][2], vf[2][2]; f32x4 dcv[4];
#pragma unroll
                for (int ks = 0; ks < 2; ++ks) { const int o = qa_off(r32, 32 * w + 16 * ks + 8 * hi), d0 = 32 * w + 16 * ks + 4 * hi, sp = 16 * ks + 4 * hi, sn = 16 * ks + 8 * hi;
                    kdf[ks] = *(const HG_LAS bf16x8*)(sl + S_KD + o); qaf[ks] = *(const HG_LAS bf16x8*)(sl + S_QA + o);
                    qp[ks][0] = *(const HG_LAS s16x4*)(sl + S_QA + qa_off(r32, d0)); qp[ks][1] = *(const HG_LAS s16x4*)(sl + S_QA + qa_off(r32, d0 + 8));
                    vp[ks][0] = trd(sl + S_V + v_off(sp + tq, tc)); vp[ks][1] = trd(sl + S_V + v_off(sp + 8 + tq, tc));
                    ktf[ks][0] = trd(sl + S_KT + kt_off(sn + tq, 32 * w + tc)); ktf[ks][1] = trd(sl + S_KT + kt_off(sn + 4 + tq, 32 * w + tc));
                    vf[ks][0] = trd(sl + S_V + v_off(sn + tq, tc)); vf[ks][1] = trd(sl + S_V + v_off(sn + 4 + tq, tc)); }
#pragma unroll
                for (int g = 0; g < 4; ++g) dcv[g] = *(const HG_LAS f32x4*)(sl + S_DEC + (32 * w + 8 * g + 4 * hi) * 4);
                __builtin_amdgcn_sched_barrier(0);
                const bf16x8 sb0 = pack8(S, 0), sb1 = pack8(S, 8);
                f32x16 X = {}, ow = {};
#pragma unroll
                for (int g = 0; g < 4; ++g)
#pragma unroll
                    for (int q = 0; q < 4; ++q) S[4 * g + q] *= dcv[g][q];
                X = __builtin_amdgcn_mfma_f32_32x32x16_bf16(kdf[0], qaf[0], X, 0, 0, 0);
                ow = __builtin_amdgcn_mfma_f32_32x32x16_bf16(cat64(qp[0][0], qp[0][1]), sb0, ow, 0, 0, 0);
                S = __builtin_amdgcn_mfma_f32_32x32x16_bf16(cat64(ktf[0][0], ktf[0][1]), cat64(vf[0][0], vf[0][1]), S, 0, 0, 0);
                X = __builtin_amdgcn_mfma_f32_32x32x16_bf16(kdf[1], qaf[1], X, 0, 0, 0);
                ow = __builtin_amdgcn_mfma_f32_32x32x16_bf16(cat64(qp[1][0], qp[1][1]), sb1, ow, 0, 0, 0);
                S = __builtin_amdgcn_mfma_f32_32x32x16_bf16(cat64(ktf[1][0], ktf[1][1]), cat64(vf[1][0], vf[1][1]), S, 0, 0, 0);
#pragma unroll
                for (int r = 0; r < 16; ++r) X[r] = (crow(r, hi) <= r32) ? X[r] : 0.f;
                ow = __builtin_amdgcn_mfma_f32_32x32x16_bf16(pack8(X, 0), cat64(vp[0][0], vp[0][1]), ow, 0, 0, 0);
                ow = __builtin_amdgcn_mfma_f32_32x32x16_bf16(pack8(X, 8), cat64(vp[1][0], vp[1][1]), ow, 0, 0, 0);
                { HG_LAS float* op = (HG_LAS float*)(lds + OFF_OPART + (i & 1) * OPART_BYTES + w * 4096) + lane;
#pragma unroll
                  for (int r = 0; r < 16; ++r) op[r * 64] = ow[r]; }
            }
            HG_BAR();
        }
    } else {
        const int pt = tid - 256;
        const int t0 = pt >> 4, d0 = (pt & 15) * 8;
        const int vs = pt >> 3, ve = (pt & 7) * 4;
        u32x4 qaA[2], kdA[2], ktA[2], qaB[2], kdB[2], ktB[2]; u32x2 vA, vB; float dcA = 0.f, dcB = 0.f;
#define HG_LOAD(qa, kd, kt, vr, dc, c) do { const int c_ = (c) < NCH ? (c) : NCH - 1;      \
            const size_t ro_ = gbase + (size_t)c_ * CH * 1024; \
            _Pragma("unroll") for (int k_ = 0; k_ < 2; ++k_) { const size_t o_ = ro_ + (size_t)(t0 + 16 * k_) * 1024 + d0; \
                qa[k_] = *(const u32x4*)(QA + o_); kd[k_] = *(const u32x4*)(KD + o_); kt[k_] = *(const u32x4*)(KT + o_); } \
            vr = *(const u32x2*)(V + ro_ + (size_t)vs * 1024 + eq * 32 + ve); \
            dc = DEC[(size_t)(b * NCH + c_) * 1024 + h * 128 + (pt & 127)]; } while (0)
#define HG_PSTEP(i, RED, PREP, qa, kd, kt, vr, dc) do { \
            if (PREP) { \
                HG_LAS unsigned char* sl = lds + (((i) + 1) & 1) * SLOT_BYTES; \
                _Pragma("unroll") for (int k_ = 0; k_ < 2; ++k_) { const int t_ = t0 + 16 * k_; \
                    *(HG_LAS u32x4*)(sl + S_QA + qa_off(t_, d0)) = qa[k_]; *(HG_LAS u32x4*)(sl + S_KD + qa_off(t_, d0)) = kd[k_]; \
                    *(HG_LAS u32x4*)(sl + S_KT + kt_off(t_, d0)) = kt[k_]; } \
                *(HG_LAS u32x2*)(sl + S_V + v_off(vs, ve)) = vr; \
                *(HG_LAS float*)(sl + S_DEC + (pt & 127) * 4) = dc; \
                HG_LOAD(qa, kd, kt, vr, dc, (i) + 3); } \
            if (RED) { const HG_LAS float* op = (const HG_LAS float*)(lds + OFF_OPART + (((i) - 1) & 1) * OPART_BYTES); \
                const int idx = 4 * pt, reg = idx >> 6, ln = idx & 63; const HG_LAS f32x4* op4 = (const HG_LAS f32x4*)(op + idx); \
                const f32x4 v = (op4[0] + op4[256]) + (op4[512] + op4[768]);              \
                const int t = crow(reg, ln >> 5), e = ln & 31; u32x2 wv; wv.x = cvtpk(v[0], v[1]); wv.y = cvtpk(v[2], v[3]); \
                *(u32x2*)(O + gbase + (size_t)(((i) - 1) * CH + t) * 1024 + eq * 32 + e) = wv; } \
            HG_BAR(); } while (0)
        HG_LOAD(qaA, kdA, ktA, vA, dcA, 0); HG_LOAD(qaB, kdB, ktB, vB, dcB, 1);
        HG_PSTEP(-1, false, true, qaA, kdA, ktA, vA, dcA); HG_PSTEP(0, false, true, qaB, kdB, ktB, vB, dcB);
#pragma unroll 1
        for (int i = 1; i + 1 < NCH; i += 2) { HG_PSTEP(i, true, true, qaA, kdA, ktA, vA, dcA); HG_PSTEP(i + 1, true, true, qaB, kdB, ktB, vB, dcB); }
        HG_PSTEP(NCH - 1, true, false, qaA, kdA, ktA, vA, dcA); HG_PSTEP(NCH, true, false, qaB, kdB, ktB, vB, dcB);
#undef HG_PSTEP
#undef HG_LOAD
    }
}
#undef HG_LAS
#undef HG_BAR
}

#define GAS __attribute__((address_space(1)))
#define LAS __attribute__((address_space(3)))
typedef unsigned short bf16;
typedef unsigned v4u __attribute__((ext_vector_type(4)));
typedef float f32x4 __attribute__((ext_vector_type(4)));
typedef short bf16x8 __attribute__((ext_vector_type(8)));
typedef GAS unsigned gu32;
typedef GAS unsigned long long gu64;
#define RLX_AGENT __ATOMIC_RELAXED, __HIP_MEMORY_SCOPE_AGENT
#define LDS_WAIT() asm volatile("s_waitcnt lgkmcnt(0)" ::: "memory")
#define VM_WAIT() asm volatile("s_waitcnt vmcnt(0)" ::: "memory")
__device__ __forceinline__ unsigned long long rt() { return __builtin_amdgcn_s_memrealtime(); }
__device__ __forceinline__ unsigned f2bf(float f) { unsigned u = __builtin_bit_cast(unsigned, f); return (u + 0x7fffu + ((u >> 16) & 1u)) >> 16; }
__device__ __forceinline__ unsigned pk2(float lo, float hi) { return f2bf(lo) | (f2bf(hi) << 16); }

#define XB_TMO      128
#define XB_XCNT(j)  (256  + 64 * (j))
#define XB_XSUB(j)  (1280 + 64 * (j))
#define XB_XGEN(j)  (2304 + 64 * (j))
#define XB_TOP      3328
#define XB_TOPGEN   3392
#define XCD_BAR_WORDS 3456
#define XB_SPIN_CAP (1u << 18)

__device__ __forceinline__ unsigned xb_ld(unsigned* p)              { return __hip_atomic_load(p, __ATOMIC_RELAXED, __HIP_MEMORY_SCOPE_AGENT); }
__device__ __forceinline__ unsigned xb_add(unsigned* p, unsigned v) { return __hip_atomic_fetch_add(p, v, __ATOMIC_RELAXED, __HIP_MEMORY_SCOPE_AGENT); }
__device__ __forceinline__ unsigned xb_xcc_id() { return (unsigned)__builtin_amdgcn_s_getreg((3 << 11) | 20) & 0xFu; }
#define XB_SPIN(cond, bar) do { unsigned _sp = 0; while (cond) { __builtin_amdgcn_s_sleep(1); \
    if ((++_sp & 255u) == 0u) { if (xb_ld(&(bar)[XB_TMO])) break; if (_sp > XB_SPIN_CAP) { atomicAdd(&(bar)[XB_TMO], 1u); break; } } } } while (0)

struct XcdBarrier {
    unsigned* bar; unsigned x;
    volatile LAS unsigned* st;
};

__device__ __forceinline__ XcdBarrier xcd_barrier_post(unsigned* bar, volatile LAS unsigned* st) {
    XcdBarrier b; b.bar = bar; b.x = xb_xcc_id(); b.st = st;
    if (threadIdx.x == 0) (void)xb_add(&bar[XB_XCNT(b.x)], 1u);
    return b;
}
__device__ __forceinline__ void xcd_barrier_complete(unsigned* bar, unsigned x, unsigned& nloc, unsigned& nx) {
    const unsigned G = gridDim.x * gridDim.y * gridDim.z;
    unsigned sum, cnt, mine, sp = 0u;
    for (;;) {
        sum = 0u; cnt = 0u; mine = 0u;
#pragma unroll
        for (unsigned j = 0; j < 16; ++j) { const unsigned c = xb_ld(&bar[XB_XCNT(j)]); sum += c; cnt += (c > 0u) ? 1u : 0u; mine = (j == x) ? c : mine; }
        if (sum == G) break;
        __builtin_amdgcn_s_sleep(1);
        if ((++sp & 255u) == 0u) { if (xb_ld(&bar[XB_TMO])) break; if (sp > XB_SPIN_CAP) { atomicAdd(&bar[XB_TMO], 1u); break; } }
    }
    nloc = mine > 0u ? mine : 1u; nx = cnt > 0u ? cnt : 1u;
}

__device__ __forceinline__ void xcd_barrier(const XcdBarrier& b) {
    asm volatile("s_waitcnt vmcnt(0)" ::: "memory");
    __syncthreads();
    if (threadIdx.x == 0) {
        unsigned* bar = b.bar;
        __builtin_amdgcn_s_waitcnt(0);
        unsigned nloc = b.st[0], nx = b.st[1];
        if (nloc == 0u) { xcd_barrier_complete(bar, b.x, nloc, nx); b.st[0] = nloc; b.st[1] = nx; }
        const unsigned old = xb_add(&bar[XB_XSUB(b.x)], 1u);
        const unsigned gen = old / nloc;
        if (old + 1u == (gen + 1u) * nloc) {
            __builtin_amdgcn_fence(__ATOMIC_RELEASE, "agent");
            asm volatile("s_waitcnt vmcnt(0)" ::: "memory");
            const unsigned og = xb_add(&bar[XB_TOP], 1u);
            const unsigned tg = og / nx;
            if (og + 1u == (tg + 1u) * nx) xb_add(&bar[XB_TOPGEN], 1u);
            else XB_SPIN(xb_ld(&bar[XB_TOPGEN]) == tg, bar);
            __builtin_amdgcn_fence(__ATOMIC_ACQUIRE, "agent");
            xb_add(&bar[XB_XGEN(b.x)], 1u);
            asm volatile("s_waitcnt vmcnt(0)" ::: "memory");
        } else {
            XB_SPIN(xb_ld(&bar[XB_XGEN(b.x)]) == gen, bar);
            __builtin_amdgcn_fence(__ATOMIC_ACQUIRE, "agent");
            asm volatile("s_waitcnt vmcnt(0)" ::: "memory");
        }
    }
    __syncthreads();
}

#ifndef TS_P0
#define TS_P0 0
#endif

#ifndef FUSE_FINAL_NORM
#define FUSE_FINAL_NORM 0
#endif

#ifndef TS_CLOCK
#define TS_CLOCK 0
#endif

#ifndef TS_PHASE_END
#define TS_PHASE_END -1
#endif

#ifndef TS_AFTER_BAR
#define TS_AFTER_BAR 0
#endif

#ifndef TS_PHASE
#define TS_PHASE -1
#endif
#ifndef TS_DIV
#define TS_DIV 1000.0f
#endif

#ifndef PROBE_P0
#define PROBE_P0 0
#endif

constexpr int NWAVES = 8;
constexpr int BATCH = 8, SEQ = 2048, D = 1024, DEPTH = 4, M = BATCH * SEQ;
constexpr int FOXH = 8, FOXD = 64, FOXW = 512, CONVW = 512, AB_COLS = 3080, AB_N = 3072;
constexpr int HGH = 8, HGD = 128, C_COLS = 4096;
constexpr int FFH = 2816, FF2 = 5632;
constexpr float EPS = 1e-6f;
constexpr float LOG2E = 1.4426950408889634f;
constexpr float QSCALE = 0.125f * LOG2E;

constexpr size_t MiB = 1u << 20;
constexpr size_t WS_CTL = 0, CTL_ZERO_BYTES = 64 * 1024;
constexpr size_t WS_SSQ = 1 * MiB;
constexpr size_t WS_CL = 2 * MiB;
constexpr size_t WS_BT = WS_CL + 512 * 1024;
constexpr size_t WS_WF = WS_BT + 64 * 1024;
constexpr size_t WS_LB = WS_WF + 64 * 1024;
constexpr size_t WS_W = 4 * MiB;
constexpr size_t W_ABIN = 0, SZ_ABIN = (size_t)AB_N * D * 2;
constexpr size_t W_ABOUT = W_ABIN + 2 * SZ_ABIN, SZ_ABOUT = (size_t)D * D * 2;
constexpr size_t W_CIN = W_ABOUT + 2 * SZ_ABOUT, SZ_CIN = (size_t)C_COLS * D * 2;
constexpr size_t W_COUT = W_CIN + 2 * SZ_CIN, SZ_COUT = (size_t)D * D * 2;
constexpr size_t W_FIN = W_COUT + 2 * SZ_COUT, SZ_FIN = (size_t)FF2 * D * 2;
constexpr size_t W_FOUT = W_FIN + 4 * SZ_FIN, SZ_FOUT = (size_t)D * FFH * 2;
constexpr size_t W_END = W_FOUT + 4 * SZ_FOUT;
static_assert(WS_W + W_END <= 108 * MiB, "weights region");
constexpr size_t WS_XB = 108 * MiB;
constexpr size_t WS_MIX = 140 * MiB;
constexpr size_t WS_H = WS_MIX;
constexpr size_t WS_QKVU = WS_MIX, T512 = (size_t)M * 512 * 2, WS_AO = WS_MIX + 6 * T512;
constexpr size_t WS_KD = WS_MIX, WS_KT = WS_MIX + 32 * MiB, WS_HQ = WS_MIX + 64 * MiB, WS_HV = WS_HQ + 32 * MiB, WS_HG = WS_HV + 32 * MiB, WS_HO = WS_HG + 32 * MiB, WS_DEC = WS_HO + 32 * MiB, WS_END = WS_DEC + 2 * MiB;
static_assert(WS_END <= 352 * MiB, "workspace budget");
constexpr int CW_TMO = 0, CW_BAR = 4096, CW_FIN = 8192;
constexpr size_t WS_XS = 3 * MiB;

constexpr int RING_OFF = 0, RING_BYTES = 131072;
constexpr int LDSCTL_OFF = RING_BYTES, MISC_OFF = LDSCTL_OFF + 320;
constexpr int LDS_BYTES = 147456;
static_assert(MISC_OFF + 128 <= LDS_BYTES, "LDS map");
static_assert(attn_body::ATTN_LDS_BYTES <= RING_BYTES && hg::LDS_BYTES <= RING_BYTES, "mixer LDS inside the ring region");

struct Args { const float* in[14]; float* out; unsigned char* ws; int ph_lo, ph_hi, li, pad; };
typedef const __attribute__((address_space(4))) Args* KArgP;

struct Frame {
    LAS unsigned char* lds; volatile LAS unsigned* MISC; gu32* ctl;
    int wave, vcu, G;
};
#define LANE_IDS() int tid_l = threadIdx.x; asm volatile("" : "+v"(tid_l)); const int TID = tid_l, LANE = tid_l & 63
__device__ __forceinline__ float wave_sum(float v) {
#pragma unroll
    for (int o = 1; o < 64; o <<= 1) v += __shfl_xor(v, o);
    return v;
}
__device__ __forceinline__ float bf_lo(unsigned w) { return __uint_as_float(w << 16); }
__device__ __forceinline__ float bf_hi(unsigned w) { return __uint_as_float(w & 0xffff0000u); }

struct WItem { const float* W; const float* gain; bf16* WT; int ldn, ksrc0, nsrc0, K, drow0; };
constexpr int I_ABIN = 16 * (AB_N / 32), I_SQ = 16 * (D / 32), I_CIN = 16 * (C_COLS / 32), I_FIN = 16 * (FF2 / 32), I_FOUT = (FFH / 64) * (D / 32);
__host__ __device__ constexpr int layer_items(int l) { return ((l & 1) ? I_CIN : I_ABIN) + I_SQ + I_FIN + I_FOUT; }
__device__ __forceinline__ WItem layer_item(const Args& a, int l, int it) {
    unsigned char* wb = a.ws + WS_W; const int j = l >> 1; WItem w;
    const int n_in = (l & 1) ? I_CIN : I_ABIN;
    if (it < n_in) {
        if (l & 1) { const int nb = it % 128, kb = it / 128, c0 = 32 * nb;
            const int drow = c0 < 1024 ? 256 * (c0 / 128) + (c0 % 128) : (c0 < 2048 ? 256 * ((c0 - 1024) / 128) + 128 + ((c0 - 1024) % 128) : c0);
            w = WItem{a.in[8] + (size_t)j * D * C_COLS, a.in[1] + (size_t)l * D, (bf16*)(wb + W_CIN + j * SZ_CIN), C_COLS, 64 * kb, c0, D, drow}; }
        else { const int nb = it % (AB_N / 32), kb = it / (AB_N / 32), n0 = 32 * nb;
            w = WItem{a.in[4] + (size_t)j * D * AB_COLS, a.in[1] + (size_t)l * D, (bf16*)(wb + W_ABIN + j * SZ_ABIN), AB_COLS, 64 * kb, n0 + (n0 >= 1536 ? 8 : 0), D, n0}; }
        return w; }
    it -= n_in;
    if (it < I_SQ) { const int nb = it % 32, kb = it / 32;
        w = WItem{((l & 1) ? a.in[11] : a.in[7]) + (size_t)j * D * D, nullptr, (bf16*)(wb + ((l & 1) ? W_COUT + j * SZ_COUT : W_ABOUT + j * SZ_ABOUT)), D, 64 * kb, 32 * nb, D, 32 * nb}; return w; }
    it -= I_SQ;
    if (it < I_FIN) { const int nb = it % (FF2 / 32), kb = it / (FF2 / 32), c0 = 32 * nb;
        const int drow = c0 < FFH ? 256 * (c0 / 128) + (c0 % 128) : 256 * ((c0 - FFH) / 128) + 128 + ((c0 - FFH) % 128);
        w = WItem{a.in[12] + (size_t)l * D * FF2, a.in[2] + (size_t)l * D, (bf16*)(wb + W_FIN + l * SZ_FIN), FF2, 64 * kb, c0, D, drow}; return w; }
    it -= I_FIN;
    { const int nb = it % 32, kb = it / 32;
      w = WItem{a.in[13] + (size_t)l * FFH * D, nullptr, (bf16*)(wb + W_FOUT + l * SZ_FOUT), D, 64 * kb, 32 * nb, FFH, 32 * nb}; }
    return w;
}
__device__ __forceinline__ void witem_load(const WItem& w, f32x4 (&r)[8], int lane) {
    const int n4 = (lane & 7) * 4;
#pragma unroll
    for (int i = 0; i < 8; ++i) { const int kk = 8 * i + (lane >> 3); r[i] = *(const f32x4*)(w.W + (size_t)(w.ksrc0 + kk) * w.ldn + w.nsrc0 + n4); }
}
__device__ __forceinline__ void witem_finish(const WItem& w, const f32x4 (&r)[8], LAS float* scr, int lane) {
    const int n4 = (lane & 7) * 4;
#pragma unroll
    for (int i = 0; i < 8; ++i) { const int kk = 8 * i + (lane >> 3); f32x4 v = r[i]; if (w.gain) v = v * w.gain[w.ksrc0 + kk];
        LAS float* s = scr + kk * 33 + n4; s[0] = v[0]; s[1] = v[1]; s[2] = v[2]; s[3] = v[3]; }
    LDS_WAIT(); asm volatile("" ::: "memory");
    const int c = lane & 7;
#pragma unroll
    for (int j = 0; j < 4; ++j) { const int n = (lane >> 3) + 8 * j; const LAS float* s = scr + (8 * c) * 33 + n;
        v4u o; o.x = pk2(s[0 * 33], s[1 * 33]); o.y = pk2(s[2 * 33], s[3 * 33]); o.z = pk2(s[4 * 33], s[5 * 33]); o.w = pk2(s[6 * 33], s[7 * 33]);
        *(v4u*)(w.WT + (size_t)(w.drow0 + n) * w.K + w.ksrc0 + 8 * c) = o; }
    LDS_WAIT(); asm volatile("" ::: "memory");
}
__device__ __forceinline__ void convert_layer_weights(Frame& F, const Args& a, int l, int gw, int ngw) {
    LANE_IDS(); (void)TID;
    LAS float* scr = (LAS float*)(F.lds + RING_OFF + F.wave * 16384);
    const int n = layer_items(l); int it = gw; if (it >= n) return;
    WItem cur = layer_item(a, l, it); f32x4 rc[8], rn[8]; witem_load(cur, rc, LANE);
    for (;;) { const int itn = it + ngw; const bool more = itn < n; WItem nxt = cur;
        if (more) { nxt = layer_item(a, l, itn); witem_load(nxt, rn, LANE); }
        witem_finish(cur, rc, scr, LANE);
        if (!more) break;
#pragma unroll
        for (int i = 0; i < 8; ++i) rc[i] = rn[i];
        cur = nxt; it = itn; }
}
__device__ __forceinline__ void p0_prologue(Frame& F, const Args& a) {
    LANE_IDS();
    const int gw = F.vcu * NWAVES + F.wave, NGW = F.G * NWAVES;
    unsigned char* ws = a.ws;
    if (TS_P0 && blockIdx.x == 0 && TID == 0) __hip_atomic_store((unsigned*)(a.ws + WS_CTL) + 17, (unsigned)__builtin_amdgcn_s_memrealtime(), __ATOMIC_RELAXED, __HIP_MEMORY_SCOPE_AGENT);
    for (int r_ = 0; r_ < ((PROBE_P0 & 1) ? 2 : 1); ++r_)
    convert_layer_weights(F, a, 0, gw, NGW);
#if !WCONV_IN_FFN_TAIL
    for (int l = 1; l < DEPTH; ++l) convert_layer_weights(F, a, l, gw, NGW);
#endif
    if (TS_P0 == 1 && blockIdx.x == 0 && TID == 0) __hip_atomic_store((unsigned*)(a.ws + WS_CTL) + 16, (unsigned)__builtin_amdgcn_s_memrealtime() - __hip_atomic_load((unsigned*)(a.ws + WS_CTL) + 17, __ATOMIC_RELAXED, __HIP_MEMORY_SCOPE_AGENT), __ATOMIC_RELAXED, __HIP_MEMORY_SCOPE_AGENT);
    for (int r_ = 0; r_ < ((PROBE_P0 & 2) ? 2 : 1); ++r_)
    { const float* __restrict__ x = a.in[0]; bf16* __restrict__ xb = (bf16*)(ws + WS_XB); float* __restrict__ ssq = (float*)(ws + WS_SSQ);
      f32x4 v[2][4], vn[2][4];
#pragma unroll
      for (int h = 0; h < 2; ++h) { const int m0 = gw + h * NGW; const int mr = m0 < M ? m0 : gw; const f32x4* xr = (const f32x4*)(x + (size_t)mr * D) + LANE;
#pragma unroll
        for (int j = 0; j < 4; ++j) v[h][j] = xr[64 * j]; }
      for (int m = gw; m < M; m += 2 * NGW) {
#pragma unroll
        for (int h = 0; h < 2; ++h) { const int mn0 = m + (2 + h) * NGW; const int mn = mn0 < M ? mn0 : gw; const f32x4* xr = (const f32x4*)(x + (size_t)mn * D) + LANE;
#pragma unroll
          for (int j = 0; j < 4; ++j) vn[h][j] = xr[64 * j]; }
#pragma unroll
        for (int h = 0; h < 2; ++h) { const int mm = m + h * NGW; if (mm < M) { float s = 0.f;
          unsigned long long* o8 = (unsigned long long*)(xb + (size_t)mm * D) + LANE;
#pragma unroll
          for (int j = 0; j < 4; ++j) { const unsigned w0 = pk2(v[h][j][0], v[h][j][1]), w1 = pk2(v[h][j][2], v[h][j][3]); o8[64 * j] = (unsigned long long)w0 | ((unsigned long long)w1 << 32);
              const float r0 = bf_lo(w0), r1 = bf_hi(w0), r2 = bf_lo(w1), r3 = bf_hi(w1); s += (r0 * r0 + r1 * r1) + (r2 * r2 + r3 * r3); }
          s = wave_sum(s);
          if (LANE < 16) ssq[(size_t)mm * 16 + LANE] = LANE == 0 ? s : 0.f; } }
#pragma unroll
        for (int h = 0; h < 2; ++h)
#pragma unroll
          for (int j = 0; j < 4; ++j) v[h][j] = vn[h][j];
      } }
    if (TS_P0 == 2 && blockIdx.x == 0 && TID == 0) __hip_atomic_store((unsigned*)(a.ws + WS_CTL) + 16, (unsigned)__builtin_amdgcn_s_memrealtime() - __hip_atomic_load((unsigned*)(a.ws + WS_CTL) + 17, __ATOMIC_RELAXED, __HIP_MEMORY_SCOPE_AGENT), __ATOMIC_RELAXED, __HIP_MEMORY_SCOPE_AGENT);
    for (int r_ = 0; r_ < ((PROBE_P0 & 4) ? 2 : 1); ++r_)
    { const int gt = (F.vcu * NWAVES + F.wave) * 64 + LANE, NGT = NGW * 64; float* wf = (float*)(ws + WS_WF); float* lb = (float*)(ws + WS_LB);
      for (int i = gt; i < 2 * 8 * D; i += NGT) { const int j = i / (8 * D), h = (i / D) % 8, k = i % D; wf[i] = a.in[4][(size_t)j * D * AB_COLS + (size_t)k * AB_COLS + 1536 + h] * a.in[1][(2 * j) * D + k]; }
      for (int i = gt; i < D; i += NGT) { const float c0 = a.in[9][i], c1 = a.in[9][D + i]; lb[i] = 0.f; lb[D + i] = 1.0f / (1.0f + expf(c0 - c1)); } }
}

__device__ __forceinline__ void fgate_job(Frame& F, const Args& a, int j, int jb) {
    LANE_IDS();
    unsigned char* ws = a.ws; const float* wf = (const float*)(ws + WS_WF) + (size_t)j * 8 * D; const float* ssq = (const float*)(ws + WS_SSQ); const bf16* xb = (const bf16*)(ws + WS_XB);
    float* cl = (float*)(ws + WS_CL); float* bt = (float*)(ws + WS_BT); const float* bias = a.in[5] + j * 8;
    LAS float* tmp = (LAS float*)(F.lds + RING_OFF);
    f32x4 w[8][4];
#pragma unroll
    for (int h = 0; h < 8; ++h)
#pragma unroll
        for (int q = 0; q < 4; ++q) w[h][q] = *(const f32x4*)(wf + (size_t)h * D + (q >> 1) * 512 + 8 * LANE + 4 * (q & 1));
    v4u v[2], vn[2];
    { const v4u* xr = (const v4u*)(xb + (size_t)(jb * 64 + F.wave * 8) * D) + LANE; v[0] = xr[0]; v[1] = xr[64]; }
#pragma unroll 1
    for (int i = 0; i < 8; ++i) { const int rl = F.wave * 8 + i, row = jb * 64 + rl;
        { const v4u* xr = (const v4u*)(xb + (size_t)(row + (i < 7 ? 1 : 0)) * D) + LANE; vn[0] = xr[0]; vn[1] = xr[64]; }
        const float rs = pg8::row_rstd(ssq, row); float s8[8]; f32x4 xf[4];
#pragma unroll
        for (int q = 0; q < 4; ++q) { const unsigned a0 = v[q >> 1][2 * (q & 1)], a1 = v[q >> 1][2 * (q & 1) + 1]; xf[q] = (f32x4){bf_lo(a0), bf_hi(a0), bf_lo(a1), bf_hi(a1)}; }
#pragma unroll
        for (int h = 0; h < 8; ++h) { float s = 0.f;
#pragma unroll
            for (int q = 0; q < 4; ++q) s += (xf[q][0] * w[h][q][0] + xf[q][1] * w[h][q][1]) + (xf[q][2] * w[h][q][2] + xf[q][3] * w[h][q][3]);
            s8[h] = s; }
#pragma unroll
        for (int h = 0; h < 4; ++h) { const float a = s8[2 * h], b = s8[2 * h + 1]; const bool up = (LANE & 1) != 0; const float send = up ? a : b, keep = up ? b : a; s8[h] = keep + __shfl_xor(send, 1); }
#pragma unroll
        for (int h = 0; h < 2; ++h) { const float a = s8[2 * h], b = s8[2 * h + 1]; const bool up = (LANE & 2) != 0; const float send = up ? a : b, keep = up ? b : a; s8[h] = keep + __shfl_xor(send, 2); }
        { const float a = s8[0], b = s8[1]; const bool up = (LANE & 4) != 0; const float send = up ? a : b, keep = up ? b : a; s8[0] = keep + __shfl_xor(send, 4); }
        float mine = s8[0]; mine += __shfl_xor(mine, 8); mine += __shfl_xor(mine, 16); mine += __shfl_xor(mine, 32);
        const int hd = LANE & 7;
        if (LANE < 8) { const float z = mine * rs + bias[hd]; tmp[rl * 8 + hd] = fminf(z, 0.f) - log1pf(expf(-fabsf(z))); }
        v[0] = vn[0]; v[1] = vn[1];
    }
    LDS_WAIT(); __syncthreads();
    { const int h = F.wave; float c = tmp[LANE * 8 + h];
#pragma unroll
      for (int o = 1; o < 64; o <<= 1) { const float n = __shfl_up(c, o); if (LANE >= o) c += n; }
      cl[(size_t)(jb * 64 + LANE) * 8 + h] = c; if (LANE == 63) bt[jb * 8 + h] = c; }
    __syncthreads();
}

__device__ __forceinline__ void conv_job(Frame& F, const Args& a, int j, int jb) {
    LANE_IDS();
    unsigned char* ws = a.ws; const bf16* __restrict__ ub = (const bf16*)(ws + WS_QKVU + 3 * T512); const bf16* __restrict__ uc = (const bf16*)(ws + WS_QKVU + 4 * T512); const bf16* __restrict__ ux = (const bf16*)(ws + WS_QKVU + 5 * T512);
    bf16* __restrict__ ao = (bf16*)(ws + WS_AO); const float* __restrict__ cw = a.in[6] + (size_t)j * 3 * CONVW;
#pragma unroll 4
    for (int it = TID; it < 64 * 64; it += NWAVES * 64) { const int rl = it >> 6, ch = (it & 63) * 8, row = jb * 64 + rl, t = row & (SEQ - 1);
        float z[3][8];
#pragma unroll
        for (int d = 0; d < 3; ++d) { const int tt = t - 2 + d;
            if (tt >= 0) { const v4u cv = *(const v4u*)(uc + (size_t)(row - 2 + d) * 512 + ch), xv = *(const v4u*)(ux + (size_t)(row - 2 + d) * 512 + ch);
#pragma unroll
                for (int q = 0; q < 4; ++q) { z[d][2 * q] = bf_lo(cv[q]) * bf_lo(xv[q]); z[d][2 * q + 1] = bf_hi(cv[q]) * bf_hi(xv[q]); } }
            else {
#pragma unroll
                for (int q = 0; q < 8; ++q) z[d][q] = 0.f; } }
        const v4u bv = *(const v4u*)(ub + (size_t)row * 512 + ch); float y[8];
#pragma unroll
        for (int q = 0; q < 8; ++q) { const float b = (q & 1) ? bf_hi(bv[q >> 1]) : bf_lo(bv[q >> 1]);
            y[q] = b * (cw[ch + q] * z[0][q] + cw[CONVW + ch + q] * z[1][q] + cw[2 * CONVW + ch + q] * z[2][q]); }
        v4u o; o.x = pk2(y[0], y[1]); o.y = pk2(y[2], y[3]); o.z = pk2(y[4], y[5]); o.w = pk2(y[6], y[7]);
        *(v4u*)(ao + (size_t)row * D + 512 + ch) = o; }
}

__device__ __forceinline__ void attn_naive_unit(Frame& F, const Args& a, int unit) {
    LANE_IDS();
    unsigned char* ws = a.ws; const bf16* Q = (const bf16*)(ws + WS_QKVU); const bf16* K = (const bf16*)(ws + WS_QKVU + T512); const bf16* V = (const bf16*)(ws + WS_QKVU + 2 * T512);
    bf16* ao = (bf16*)(ws + WS_AO); const float* cl = (const float*)(ws + WS_CL); const float* bt = (const float*)(ws + WS_BT);
    const int b = unit >> 5, h = (unit >> 2) & 7, blk = unit & 3;
    LAS float* beta = (LAS float*)(F.lds + RING_OFF);
    LAS float* pre = beta + 2048;
    __syncthreads();
    if (TID == 0) { float c = 0.f; for (int i = 0; i < 32; ++i) { pre[i] = c; c += bt[(b * 32 + i) * 8 + h]; } }
    LDS_WAIT(); __syncthreads();
    for (int s = TID; s < SEQ; s += NWAVES * 64) beta[s] = -(pre[s >> 6] + cl[(size_t)(b * SEQ + s) * 8 + h]) * LOG2E;
    LDS_WAIT(); __syncthreads();
    const int t = blk * 512 + TID; const size_t rowq = (size_t)(b * SEQ + t);
    float q[64], o[64];
#pragma unroll
    for (int c = 0; c < 8; ++c) { const v4u w = *(const v4u*)(Q + rowq * 512 + h * 64 + 8 * c);
#pragma unroll
        for (int i = 0; i < 4; ++i) { q[8 * c + 2 * i] = bf_lo(w[i]); q[8 * c + 2 * i + 1] = bf_hi(w[i]); } }
#pragma unroll
    for (int d = 0; d < 64; ++d) o[d] = 0.f;
    float mx = -INFINITY, l = 0.f;
    const int send = blk * 512 + 511;
    for (int s = 0; s <= send; ++s) {
        const bf16* kr = K + (size_t)(b * SEQ + s) * 512 + h * 64; const bf16* vr = V + (size_t)(b * SEQ + s) * 512 + h * 64;
        float sc = 0.f;
#pragma unroll
        for (int c = 0; c < 8; ++c) { const v4u w = *(const v4u*)(kr + 8 * c);
#pragma unroll
            for (int i = 0; i < 4; ++i) sc += q[8 * c + 2 * i] * bf_lo(w[i]) + q[8 * c + 2 * i + 1] * bf_hi(w[i]); }
        sc += beta[s];
        if (s <= t) {
            const float mn = fmaxf(mx, sc), f = exp2f(mx - mn), p = exp2f(sc - mn); mx = mn; l = l * f + p;
#pragma unroll
            for (int c = 0; c < 8; ++c) { const v4u w = *(const v4u*)(vr + 8 * c);
#pragma unroll
                for (int i = 0; i < 4; ++i) { o[8 * c + 2 * i] = o[8 * c + 2 * i] * f + p * bf_lo(w[i]); o[8 * c + 2 * i + 1] = o[8 * c + 2 * i + 1] * f + p * bf_hi(w[i]); } }
        }
    }
    const float rl = 1.0f / l;
#pragma unroll
    for (int c = 0; c < 8; ++c) { v4u w; w.x = pk2(o[8 * c] * rl, o[8 * c + 1] * rl); w.y = pk2(o[8 * c + 2] * rl, o[8 * c + 3] * rl); w.z = pk2(o[8 * c + 4] * rl, o[8 * c + 5] * rl); w.w = pk2(o[8 * c + 6] * rl, o[8 * c + 7] * rl);
        *(v4u*)(ao + rowq * D + h * 64 + 8 * c) = w; }
}

__device__ __forceinline__ void hgrn_gate(Frame& F, const Args& a, int j) {
    LANE_IDS();
    unsigned char* ws = a.ws; const bf16* __restrict__ O = (const bf16*)(ws + WS_HO); const bf16* __restrict__ G = (const bf16*)(ws + WS_HG); bf16* __restrict__ AOP = (bf16*)(ws + WS_HQ); const float* __restrict__ hn = a.in[10] + (size_t)j * D;
    const int gw = F.vcu * NWAVES + F.wave, NGW = F.G * NWAVES; (void)TID;
#pragma unroll 4
    for (int m = gw; m < M; m += NGW) {
#pragma unroll
        for (int jj = 0; jj < 2; ++jj) { const int c = (4 * jj + (LANE >> 4)) * HGD + 8 * (LANE & 15); const size_t off = (size_t)m * D + c;
            const v4u ow = *(const v4u*)(O + off), gv = *(const v4u*)(G + off); float o[8], g[8];
#pragma unroll
            for (int q = 0; q < 4; ++q) { o[2 * q] = bf_lo(ow[q]); o[2 * q + 1] = bf_hi(ow[q]); g[2 * q] = bf_lo(gv[q]); g[2 * q + 1] = bf_hi(gv[q]); }
            float s = 0.f;
#pragma unroll
            for (int q = 0; q < 8; ++q) s += o[q] * o[q];
            s += __shfl_xor(s, 1); s += __shfl_xor(s, 2); s += __shfl_xor(s, 4); s += __shfl_xor(s, 8);
            const float r = __builtin_amdgcn_rsqf(s * (1.0f / HGD) + EPS); const f32x4 h0 = *(const f32x4*)(hn + c), h1 = *(const f32x4*)(hn + c + 4);
            v4u w; w.x = pk2(o[0] * r * h0[0] * g[0], o[1] * r * h0[1] * g[1]); w.y = pk2(o[2] * r * h0[2] * g[2], o[3] * r * h0[3] * g[3]);
            w.z = pk2(o[4] * r * h1[0] * g[4], o[5] * r * h1[1] * g[5]); w.w = pk2(o[6] * r * h1[2] * g[6], o[7] * r * h1[3] * g[7]);
            *(v4u*)(AOP + off) = w; }
    }
}
__device__ __forceinline__ void final_norm(Frame& F, const Args& a) {
    LANE_IDS(); (void)TID;
    const int gw = F.vcu * NWAVES + F.wave, NGW = F.G * NWAVES; const float* __restrict__ g = a.in[3]; const bf16* __restrict__ xb = (const bf16*)(a.ws + WS_XB); float* __restrict__ outp = a.out;
    f32x4 gv[4];
#pragma unroll
    for (int q = 0; q < 4; ++q) gv[q] = *(const f32x4*)(g + (q >> 1) * 512 + 8 * LANE + 4 * (q & 1));
#pragma unroll 4
    for (int m = gw; m < M; m += NGW) { const v4u* xr = (const v4u*)(xb + (size_t)m * D) + LANE; const v4u v0 = xr[0], v1 = xr[64]; f32x4 x[4]; float s = 0.f;
#pragma unroll
        for (int q = 0; q < 4; ++q) { const unsigned a0 = (q >> 1) ? v1[2 * (q & 1)] : v0[2 * (q & 1)], a1 = (q >> 1) ? v1[2 * (q & 1) + 1] : v0[2 * (q & 1) + 1];
            x[q] = (f32x4){bf_lo(a0), bf_hi(a0), bf_lo(a1), bf_hi(a1)}; s += (x[q][0] * x[q][0] + x[q][1] * x[q][1]) + (x[q][2] * x[q][2] + x[q][3] * x[q][3]); }
        const float r = __builtin_amdgcn_rsqf(wave_sum(s) * (1.0f / D) + EPS); float* orow = outp + (size_t)m * D;
#pragma unroll
        for (int q = 0; q < 4; ++q) { f32x4 ov = x[q] * r * gv[q]; if ((TS_PHASE != -1 || TS_P0) && m == 0 && LANE == 0 && q == 0) ov[0] += (float)__hip_atomic_load((unsigned*)(F.ctl + 16), __ATOMIC_RELAXED, __HIP_MEMORY_SCOPE_AGENT) * (1.0f / TS_DIV);
            *(f32x4*)(orow + (q >> 1) * 512 + 8 * LANE + 4 * (q & 1)) = ov; } }
}

constexpr int N_PHASES = 26;
#ifndef WCONV_IN_FFN_TAIL
#define WCONV_IN_FFN_TAIL 1
#endif
#ifndef PROBE_MASK
#define PROBE_MASK 0
#endif
#ifndef HGRN_NAIVE
#define HGRN_NAIVE 0
#endif
#ifndef ATTN_NAIVE
#define ATTN_NAIVE 0
#endif
#ifndef MK_PER_PHASE
#define MK_PER_PHASE 0
#endif
__global__ void __launch_bounds__(NWAVES * 64, 2) trunk_fwd(Args args) {
    extern __shared__ __attribute__((aligned(16))) unsigned char lds[];
    Frame F_;
    if (TS_PHASE == -2 && blockIdx.x == 0 && threadIdx.x == 0) __hip_atomic_store((unsigned*)(args.ws + WS_CTL) + 17, (unsigned)__builtin_amdgcn_s_memrealtime(), __ATOMIC_RELAXED, __HIP_MEMORY_SCOPE_AGENT);
    F_.lds = (LAS unsigned char*)lds; F_.MISC = (volatile LAS unsigned*)(F_.lds + MISC_OFF);
    F_.wave = __builtin_amdgcn_readfirstlane((int)threadIdx.x >> 6);
    F_.G = gridDim.x; { const int bx = blockIdx.x; F_.vcu = (F_.G % 8 == 0) ? (bx % 8) * (F_.G / 8) + bx / 8 : bx; }
    unsigned char* ws = args.ws; F_.ctl = (gu32*)(ws + WS_CTL);
    for (int u = threadIdx.x; u < (LDS_BYTES - LDSCTL_OFF) / 4; u += NWAVES * 64) ((LAS unsigned*)(F_.lds + LDSCTL_OFF))[u] = 0u;
    __syncthreads();
    const int lo = args.ph_lo, hi = args.ph_hi;
    XcdBarrier bar; bar.bar = (unsigned*)(F_.ctl + CW_BAR); bar.x = 0; bar.st = nullptr;
    if (hi - lo > 1) bar = xcd_barrier_post((unsigned*)(F_.ctl + CW_BAR), F_.MISC + 8);
#pragma unroll 1
    for (int p = lo; p < hi; ++p) {
        const int l = (p - 1) / 6, s = (p - 1) - 6 * l, j = l >> 1; const bool even = (l & 1) == 0, mid = (p >= 1 && p <= 24);
#if defined(__HIP_DEVICE_COMPILE__)
        KArgP ap = (KArgP)__builtin_amdgcn_kernarg_segment_ptr(); asm volatile("" : "+s"(ap));
        Args A2; for (int q_ = 0; q_ < 14; ++q_) A2.in[q_] = (const float*)(const GAS float*)ap->in[q_]; A2.out = (float*)(GAS float*)ap->out; A2.ws = (unsigned char*)(GAS unsigned char*)ap->ws;     A2.ph_lo = lo; A2.ph_hi = hi; A2.li = 0; A2.pad = 0;
#else
        Args A2 = args;
#endif
        Frame FL = F_; { int w_ = F_.wave, v_ = F_.vcu, g_ = F_.G; asm volatile("" : "+s"(w_), "+s"(v_), "+s"(g_)); FL.wave = w_; FL.vcu = v_; FL.G = g_; }
        int bx = blockIdx.x; asm volatile("" : "+s"(bx));
        Frame& F = FL;
        GAS unsigned char* wsg = (GAS unsigned char*)A2.ws; asm volatile("" : "+s"(wsg)); unsigned char* ws = (unsigned char*)wsg; A2.ws = ws;
        bf16* const wb = (bf16*)(ws + WS_W); bf16* const XB = (bf16*)(ws + WS_XB); float* const SSQ = (float*)(ws + WS_SSQ);
        const int cls = p == 0 ? 1 : p == 25 ? 11 : (s == 0 ? (even ? 2 : 3) : s == 1 ? (even ? 4 : 5) : s == 2 ? 6 : s == 3 ? 7 : s == 4 ? 8 : 9);
        if (mid && s == 2 && even) continue;
        const int nrep = ((PROBE_MASK >> cls) & 1) ? 2 : 1;
        if (TS_PHASE == -2 && p == 0 && bx == 0 && threadIdx.x == 0) __hip_atomic_store((unsigned*)(F.ctl + 16), (unsigned)__builtin_amdgcn_s_memrealtime() - __hip_atomic_load((unsigned*)(F.ctl + 17), __ATOMIC_RELAXED, __HIP_MEMORY_SCOPE_AGENT), __ATOMIC_RELAXED, __HIP_MEMORY_SCOPE_AGENT);
        if (TS_PHASE >= 0 && (p == TS_PHASE || p == TS_PHASE_END) && bx == 0 && threadIdx.x == 0) { const unsigned now_ = TS_CLOCK ? (unsigned)__builtin_amdgcn_s_memtime() : (unsigned)__builtin_amdgcn_s_memrealtime();
            if (p == TS_PHASE) __hip_atomic_store((unsigned*)(F.ctl + 17), now_, __ATOMIC_RELAXED, __HIP_MEMORY_SCOPE_AGENT);
            else __hip_atomic_store((unsigned*)(F.ctl + 16), now_ - __hip_atomic_load((unsigned*)(F.ctl + 17), __ATOMIC_RELAXED, __HIP_MEMORY_SCOPE_AGENT), __ATOMIC_RELAXED, __HIP_MEMORY_SCOPE_AGENT); }
#define GRID_BARRIER() do { XcdBarrier b2 = bar; GAS unsigned* bg = (GAS unsigned*)bar.bar; asm volatile("" : "+s"(bg), "+s"(b2.x)); b2.bar = (unsigned*)bg; xcd_barrier(b2); } while (0)
#pragma unroll 1
        for (int rp = 0; rp < nrep; ++rp) { const bool dummy = rp + 1 < nrep; (void)dummy;
        if (p == 0) p0_prologue(F, A2);
        else if (p == 25) { if (!(FUSE_FINAL_NORM && F.G == 256)) final_norm(F, A2); }
        else if (s == 0 && even) {
            pg8::Gemm g{XB, (const bf16*)((unsigned char*)wb + W_ABIN + j * SZ_ABIN), M, AB_N, D}; pg8::StaticOrder S; S.init(M, AB_N, F.G, bx);
            pg8::EpiAB E{(bf16*)(ws + WS_QKVU), (size_t)M * 512, SSQ, QSCALE};
            pg8::gemm_phase<pg8::EpiAB, pg8::StaticOrder, true, true>(F.lds + RING_OFF, g, S, E);
            for (int jb = F.vcu; jb < M / 64; jb += F.G) fgate_job(F, A2, j, jb);
        } else if (s == 0) {
            pg8::Gemm g{XB, (const bf16*)((unsigned char*)wb + W_CIN + j * SZ_CIN), M, C_COLS, D}; pg8::StaticOrder S; S.init(M, C_COLS, F.G, bx);
            pg8::EpiHG E{(bf16*)(ws + WS_HQ), (bf16*)(ws + WS_KD), (bf16*)(ws + WS_KT), (bf16*)(ws + WS_HV), (size_t)M * D, (float*)(ws + WS_DEC), (const float*)(ws + WS_LB) + (size_t)j * D, SSQ, j == 0};
            static_assert(WS_HG == WS_HV + (size_t)M * D * 2, "V | G consecutive");
            pg8::gemm_phase<pg8::EpiHG, pg8::StaticOrder, true, true>(F.lds + RING_OFF, g, S, E);
        } else if (s == 1 && even) {
            if (F.vcu & 1) for (int jb = F.vcu; jb < M / 64; jb += F.G) conv_job(F, A2, j, jb);
#if ATTN_NAIVE
            for (int u = F.vcu; u < 256; u += F.G) attn_naive_unit(F, A2, u);
#else
            { const attn_body::AttnTensors AT{(const attn_body::bf16*)(ws + WS_QKVU), (const attn_body::bf16*)(ws + WS_QKVU + T512), (const attn_body::bf16*)(ws + WS_QKVU + 2 * T512), (attn_body::bf16*)(ws + WS_AO),
                                               (const float*)(ws + WS_CL), (const float*)(ws + WS_BT)};
              const attn_body::StaticOrder S((int)F.G, bx);
              attn_body::attn_phase<attn_body::StaticOrder>((char*)lds + RING_OFF, AT, S); }
#endif
            if (!(F.vcu & 1)) for (int jb = F.vcu; jb < M / 64; jb += F.G) conv_job(F, A2, j, jb);
        } else if (s == 1) {
            for (int u = F.vcu; u < 256; u += F.G) hg::hgrn_unit(F.lds + RING_OFF, (const unsigned short*)(ws + WS_HQ), (const unsigned short*)(ws + WS_KD), (const unsigned short*)(ws + WS_KT), (const float*)(ws + WS_DEC), (const unsigned short*)(ws + WS_HV), (unsigned short*)(ws + WS_HO), u);
        } else if (s == 2) {
            hgrn_gate(F, A2, j);
        } else if (s == 4) {
            pg8::Gemm g{XB, (const bf16*)((unsigned char*)wb + W_FIN + l * SZ_FIN), M, FF2, D}; pg8::StaticOrder S; S.init(M, FF2, F.G, bx);
            pg8::EpiSwi E{(bf16*)(ws + WS_H), SSQ};
            pg8::gemm_phase<pg8::EpiSwi, pg8::StaticOrder, true, true>(F.lds + RING_OFF, g, S, E, (TS_EPI && p == TS_PHASE) ? (unsigned*)(F.ctl + 16) : (unsigned*)(F.ctl + 20));
#if WCONV_IN_FFN_TAIL
            { const int nfull = (M / 256) * (FF2 / 256) - (((M / 256) * (FF2 / 256)) / F.G) * F.G;
              if (l + 1 < DEPTH && !dummy && bx >= nfull) convert_layer_weights(F, A2, l + 1, (bx - nfull) * NWAVES + F.wave, (F.G - nfull) * NWAVES); }
#endif
        } else {
            const bool dn = (s == 5);
            const bf16* A = dn ? (const bf16*)(ws + WS_H) : (even ? (const bf16*)(ws + WS_AO) : (const bf16*)(ws + WS_HQ));
            const size_t wo = dn ? (W_FOUT + l * SZ_FOUT) : (even ? (W_ABOUT + j * SZ_ABOUT) : (W_COUT + j * SZ_COUT));
            pg8::Gemm g{A, (const bf16*)((unsigned char*)wb + wo), M, D, dn ? FFH : D}; pg8::StaticOrder S; S.init(M, D, F.G, bx);
#if FUSE_FINAL_NORM
            if (p == 24 && !dummy && F.G == 256) {
                pg8::EpiResFinal E{XB, A2.out, (float*)(ws + WS_XS), (unsigned*)(F.ctl + CW_FIN), A2.in[3]};
                pg8::gemm_phase<pg8::EpiResFinal, pg8::StaticOrder, true, true>(F.lds + RING_OFF, g, S, E);
            } else
#endif
            { pg8::EpiRes E{XB, dummy ? (bf16*)(ws + WS_MIX + (dn ? 96 * MiB : 0)) : XB, SSQ};
              pg8::gemm_phase<pg8::EpiRes, pg8::StaticOrder, true, true>(F.lds + RING_OFF, g, S, E); }
        }
        if (dummy) GRID_BARRIER();
        }
        if (TS_PHASE_END < 0 && TS_PHASE >= 0 && p == TS_PHASE && bx == 0 && threadIdx.x == 0) { const unsigned dt_ = (unsigned)__builtin_amdgcn_s_memrealtime() - __hip_atomic_load((unsigned*)(F.ctl + 17), __ATOMIC_RELAXED, __HIP_MEMORY_SCOPE_AGENT); __hip_atomic_store((unsigned*)(F.ctl + 16), dt_, __ATOMIC_RELAXED, __HIP_MEMORY_SCOPE_AGENT); }
        if (p + 1 < hi && !(FUSE_FINAL_NORM && F.G == 256 && p >= 24)) { GRID_BARRIER(); if ((PROBE_MASK >> 10) & 1) GRID_BARRIER(); }
    }
}

extern "C" void kernel_launch(void* const* d_in, const int* in_sizes, int n_in, void* d_out, int out_size, void* d_ws, size_t ws_size, hipStream_t stream) {
    static int grid = 0;
    if (grid == 0) {
        if (n_in != 14 || in_sizes[0] != M * D || out_size != M * D || ws_size < WS_END) { fprintf(stderr, "kernel_launch: unexpected shapes / workspace (n_in %d, ws %zu, need %zu)\n", n_in, ws_size, (size_t)WS_END); grid = -1; return; }
        int dev = 0, cus = 0;
        if (hipGetDevice(&dev) != hipSuccess || hipDeviceGetAttribute(&cus, hipDeviceAttributeMultiprocessorCount, dev) != hipSuccess) { grid = -1; return; }
        if (hipFuncSetAttribute((const void*)trunk_fwd, hipFuncAttributeMaxDynamicSharedMemorySize, LDS_BYTES) != hipSuccess) { fprintf(stderr, "kernel_launch: hipFuncSetAttribute failed\n"); grid = -1; return; }
        int per_cu = 0; (void)hipOccupancyMaxActiveBlocksPerMultiprocessor(&per_cu, (const void*)trunk_fwd, NWAVES * 64, LDS_BYTES); (void)hipGetLastError();
        grid = cus;
    }
    if (grid < 0) return;
    (void)hipMemsetAsync((char*)d_ws + WS_CTL, 0, CTL_ZERO_BYTES, stream);
    Args a{};
    for (int i = 0; i < 14; ++i) a.in[i] = (const float*)d_in[i];
    a.out = (float*)d_out; a.ws = (unsigned char*)d_ws;
#if MK_PER_PHASE
    for (int p = 0; p < N_PHASES; ++p) { const int l = (p - 1) / 6, s = (p - 1) % 6; if (p >= 1 && p <= 24 && s == 2 && (l & 1) == 0) continue;
        a.ph_lo = p; a.ph_hi = p + 1; a.li = 0; hipLaunchKernelGGL(trunk_fwd, dim3(grid), dim3(NWAVES * 64), LDS_BYTES, stream, a); }
#else
    a.ph_lo = 0; a.ph_hi = N_PHASES; a.li = 0;
    hipLaunchKernelGGL(trunk_fwd, dim3(grid), dim3(NWAVES * 64), LDS_BYTES, stream, a);
#endif
}
```

```cpp
#include <hip/hip_runtime.h>
#include <cstdio>
#include <cstdint>
#include <cmath>
#ifndef TS_EPI
#define TS_EPI 0
#endif
namespace pg8 {
#define PG8_LAS __attribute__((address_space(3)))
typedef unsigned short bf16_t;
typedef short bf16x8 __attribute__((ext_vector_type(8)));
typedef float f32x4 __attribute__((ext_vector_type(4)));
typedef unsigned u32x4 __attribute__((ext_vector_type(4)));
constexpr int BM = 256, BK = 64, HALF = 128, HTB = HALF * BK * 2  , STAGE_BYTES = 8 * HTB, NXCD = 8, WGM = 8;

__host__ __device__ __forceinline__ int lds_byte(int r, int c) { const int st = (r >> 4) * 2 + (c >> 5), rr = r & 15, cc = c & 31, ob = rr * 64 + cc * 2; return st * 1024 + (ob ^ (((ob >> 9) & 1) << 5)); }
__host__ __device__ __forceinline__ void stage_rc(int b, int& R, int& C) { const int st = b / 1024, sb = b % 1024, swz = sb ^ (((sb >> 9) & 1) << 5); R = (st >> 1) * 16 + swz / 64; C = (st & 1) * 32 + (swz % 64) / 2; }
__host__ __device__ __forceinline__ int perm32(int rho) { const int n = rho >> 4, i = rho & 15; return 8 * (i >> 2) + 4 * n + (i & 3); }

struct Unit { int pm, pn; };
struct Gemm { const bf16_t* A; const bf16_t* Bt; int M, N, K; };

struct StaticOrder {
    int nM, nN, nwg, G, c;
    __host__ __device__ void init(int M, int N, int G_, int c_) { nM = M / BM; nN = N / BM; nwg = nM * nN; G = G_; c = c_; }
    __host__ __device__ bool next(int i, Unit& u) const {
        const long L = (long)i * G + c; if (L >= nwg) return false;
        int wgid = (int)L; { const int q = nwg / NXCD, r = nwg % NXCD, xcd = wgid % NXCD, off = wgid / NXCD; wgid = (xcd < r ? xcd * (q + 1) : r * (q + 1) + (xcd - r) * q) + off; }
        const int nig = WGM * nN, gid = wgid / nig, fm = gid * WGM, gsz = (nM - fm) < WGM ? (nM - fm) : WGM;
        u.pm = fm + ((wgid % nig) % gsz); u.pn = (wgid % nig) / gsz; return true;
    }
    __device__ __forceinline__ void a_ready(const Unit&) const {}
    __device__ __forceinline__ void done(const Unit&) const {}
};


__device__ __forceinline__ unsigned cvt_pk_bf16(float lo, float hi) { unsigned r; asm volatile("v_cvt_pk_bf16_f32 %0, %1, %2" : "=v"(r) : "v"(lo), "v"(hi)); return r; }
typedef unsigned u32x2 __attribute__((ext_vector_type(2)));
constexpr float RMS_EPS = 1e-6f;
__device__ __forceinline__ float row_rstd(const float* ssq, int row) {
    const f32x4* p = (const f32x4*)(ssq + (size_t)row * 16);
    const f32x4 a = p[0], b = p[1], c = p[2], d = p[3];
    const float s = (((a[0] + a[1]) + (a[2] + a[3])) + ((b[0] + b[1]) + (b[2] + b[3]))) + (((c[0] + c[1]) + (c[2] + c[3])) + ((d[0] + d[1]) + (d[2] + d[3])));
    return __builtin_amdgcn_rsqf(s * (1.0f / 1024.0f) + RMS_EPS);
}
__device__ __forceinline__ float row_rstd_q(const float* ssq, int row, int fq) {
    const f32x4 a = *((const f32x4*)(ssq + (size_t)row * 16) + fq);
    float s = (a[0] + a[1]) + (a[2] + a[3]);
    s += __shfl_xor(s, 16); s += __shfl_xor(s, 32);
    return __builtin_amdgcn_rsqf(s * (1.0f / 1024.0f) + RMS_EPS);
}
__device__ __forceinline__ void row_rstd_half(const float* ssq, int rowh, int fq, float (&rs)[4]) {
    f32x4 a[4];
#pragma unroll
    for (int m = 0; m < 4; ++m) a[m] = *((const f32x4*)(ssq + (size_t)(rowh + m * 16) * 16) + fq);
#pragma unroll
    for (int m = 0; m < 4; ++m) { float s = (a[m][0] + a[m][1]) + (a[m][2] + a[m][3]); s += __shfl_xor(s, 16); s += __shfl_xor(s, 32); rs[m] = __builtin_amdgcn_rsqf(s * (1.0f / 1024.0f) + RMS_EPS); }
}
__device__ __forceinline__ float sigmoid_f(float z) { return __builtin_amdgcn_rcpf(1.0f + __expf(-z)); }

struct EpiAB {
    static constexpr bool PERM = true, AFTER_DRAIN = false; static constexpr int NS_MIN = 16;
    bf16_t* O; size_t tstride; const float* ssq; float qscale;
    __device__ __forceinline__ void operator()(const f32x4 (&acc)[2][2][4][2], const Unit& u, int wr, int wc, int fr, int fq) const {
        const int t = u.pn >> 1; bf16_t* base = O + (size_t)t * tstride;
        const int col0 = (u.pn & 1) * 256 + wc * 32 + 8 * fq, row0 = u.pm * BM + wr * 64 + fr;
        const float sc0 = (t == 0) ? qscale : 1.0f;
#pragma unroll
        for (int ai = 0; ai < 2; ++ai) { float rsv[4]; row_rstd_half(ssq, row0 + ai * HALF, fq, rsv);
#pragma unroll
            for (int m = 0; m < 4; ++m) { const int row = row0 + ai * HALF + m * 16; const float rs = rsv[m] * sc0; bf16_t* rowp = base + (size_t)row * 512 + col0;
#pragma unroll
                for (int bj = 0; bj < 2; ++bj) { const f32x4 v0 = acc[ai][bj][m][0] * rs, v1 = acc[ai][bj][m][1] * rs;
                    u32x4 w; w.x = cvt_pk_bf16(v0[0], v0[1]); w.y = cvt_pk_bf16(v0[2], v0[3]); w.z = cvt_pk_bf16(v1[0], v1[1]); w.w = cvt_pk_bf16(v1[2], v1[3]);
                    *(u32x4*)(rowp + bj * HALF) = w; } } }
    }
};
struct EpiRes {
    static constexpr bool PERM = true, AFTER_DRAIN = false; static constexpr int NS_MIN = 16;
    const bf16_t* base; bf16_t* out; float* ssq;
    __device__ __forceinline__ void operator()(const f32x4 (&acc)[2][2][4][2], const Unit& u, int wr, int wc, int fr, int fq) const {
        const int col0 = u.pn * BM + wc * 32 + 8 * fq;
#pragma unroll
        for (int ai = 0; ai < 2; ++ai) {
            u32x4 b[4][2];
#pragma unroll
            for (int m = 0; m < 4; ++m)
#pragma unroll
                for (int bj = 0; bj < 2; ++bj) b[m][bj] = *(const u32x4*)(base + (size_t)(u.pm * BM + ai * HALF + wr * 64 + m * 16 + fr) * 1024 + col0 + bj * HALF);
#pragma unroll
            for (int m = 0; m < 4; ++m) { const int row = u.pm * BM + ai * HALF + wr * 64 + m * 16 + fr; const size_t off = (size_t)row * 1024 + col0; float s = 0.f;
#pragma unroll
                for (int bj = 0; bj < 2; ++bj) { const u32x4 bb = b[m][bj]; f32x4 x0 = acc[ai][bj][m][0], x1 = acc[ai][bj][m][1];
                    x0[0] += __uint_as_float(bb.x << 16); x0[1] += __uint_as_float(bb.x & 0xffff0000u); x0[2] += __uint_as_float(bb.y << 16); x0[3] += __uint_as_float(bb.y & 0xffff0000u);
                    x1[0] += __uint_as_float(bb.z << 16); x1[1] += __uint_as_float(bb.z & 0xffff0000u); x1[2] += __uint_as_float(bb.w << 16); x1[3] += __uint_as_float(bb.w & 0xffff0000u);
                    u32x4 w; w.x = cvt_pk_bf16(x0[0], x0[1]); w.y = cvt_pk_bf16(x0[2], x0[3]); w.z = cvt_pk_bf16(x1[0], x1[1]); w.w = cvt_pk_bf16(x1[2], x1[3]);
                    *(u32x4*)(out + off + bj * HALF) = w;
                    const float r0 = __uint_as_float(w.x << 16), r1 = __uint_as_float(w.x & 0xffff0000u), r2 = __uint_as_float(w.y << 16), r3 = __uint_as_float(w.y & 0xffff0000u);
                    const float r4 = __uint_as_float(w.z << 16), r5 = __uint_as_float(w.z & 0xffff0000u), r6 = __uint_as_float(w.w << 16), r7 = __uint_as_float(w.w & 0xffff0000u);
                    s += ((r0 * r0 + r1 * r1) + (r2 * r2 + r3 * r3)) + ((r4 * r4 + r5 * r5) + (r6 * r6 + r7 * r7)); }
                s += __shfl_xor(s, 16); s += __shfl_xor(s, 32);
                if (fq == 0) ssq[(size_t)row * 16 + u.pn * 4 + wc] = s; }
        }
    }
};
struct EpiResFinal {
    static constexpr bool PERM = true, AFTER_DRAIN = false; static constexpr int NS_MIN = 0;
    const bf16_t* base; float* out; float* xs; unsigned* cnt; const float* gain;
    __device__ __forceinline__ void operator()(const f32x4 (&acc)[2][2][4][2], const Unit& u, int wr, int wc, int fr, int fq) const {
        const int col0 = u.pn * BM + wc * 32 + 8 * fq, rowb = u.pm * BM + wr * 64 + fr;
#pragma unroll
        for (int ai = 0; ai < 2; ++ai) { u32x4 b[4][2];
#pragma unroll
            for (int m = 0; m < 4; ++m)
#pragma unroll
                for (int bj = 0; bj < 2; ++bj) b[m][bj] = *(const u32x4*)(base + (size_t)(rowb + ai * HALF + m * 16) * 1024 + col0 + bj * HALF);
#pragma unroll
            for (int m = 0; m < 4; ++m) { const int row = rowb + ai * HALF + m * 16; float s = 0.f;
#pragma unroll
                for (int bj = 0; bj < 2; ++bj) { const u32x4 bb = b[m][bj]; const f32x4 a0 = acc[ai][bj][m][0], a1 = acc[ai][bj][m][1];
                    const float x0 = a0[0] + __uint_as_float(bb.x << 16), x1 = a0[1] + __uint_as_float(bb.x & 0xffff0000u), x2 = a0[2] + __uint_as_float(bb.y << 16), x3 = a0[3] + __uint_as_float(bb.y & 0xffff0000u);
                    const float x4 = a1[0] + __uint_as_float(bb.z << 16), x5 = a1[1] + __uint_as_float(bb.z & 0xffff0000u), x6 = a1[2] + __uint_as_float(bb.w << 16), x7 = a1[3] + __uint_as_float(bb.w & 0xffff0000u);
                    s += ((x0 * x0 + x1 * x1) + (x2 * x2 + x3 * x3)) + ((x4 * x4 + x5 * x5) + (x6 * x6 + x7 * x7)); }
                s += __shfl_xor(s, 16); s += __shfl_xor(s, 32);
                if (fq == 0) __hip_atomic_store(xs + (size_t)row * 16 + u.pn * 4 + wc, s, __ATOMIC_RELAXED, __HIP_MEMORY_SCOPE_AGENT); } }
        asm volatile("s_waitcnt vmcnt(0)" ::: "memory");
        unsigned* const pc = cnt + 64 * u.pm;
        if ((threadIdx.x & 63) == 0) __hip_atomic_fetch_add(pc, 1u, __ATOMIC_RELAXED, __HIP_MEMORY_SCOPE_AGENT);
        { const unsigned long long t0 = __builtin_amdgcn_s_memrealtime();
          while ((unsigned)__builtin_amdgcn_readfirstlane(__hip_atomic_load(pc, __ATOMIC_RELAXED, __HIP_MEMORY_SCOPE_AGENT)) < 32u) {
              if (__builtin_amdgcn_s_memrealtime() - t0 > 2000000ull) break;
              __builtin_amdgcn_s_sleep(2); } }
        asm volatile("" ::: "memory");
        const f32x4 g0 = *(const f32x4*)(gain + col0), g1 = *(const f32x4*)(gain + col0 + 4), g2 = *(const f32x4*)(gain + col0 + HALF), g3 = *(const f32x4*)(gain + col0 + HALF + 4);
#pragma unroll
        for (int ai = 0; ai < 2; ++ai) { u32x4 b[4][2]; float rs[4];
#pragma unroll
            for (int m = 0; m < 4; ++m) { const int row = rowb + ai * HALF + m * 16; const float* xp = xs + (size_t)row * 16 + 4 * fq;
                float s = (__hip_atomic_load(xp, __ATOMIC_RELAXED, __HIP_MEMORY_SCOPE_AGENT) + __hip_atomic_load(xp + 1, __ATOMIC_RELAXED, __HIP_MEMORY_SCOPE_AGENT))
                        + (__hip_atomic_load(xp + 2, __ATOMIC_RELAXED, __HIP_MEMORY_SCOPE_AGENT) + __hip_atomic_load(xp + 3, __ATOMIC_RELAXED, __HIP_MEMORY_SCOPE_AGENT));
                s += __shfl_xor(s, 16); s += __shfl_xor(s, 32); rs[m] = __builtin_amdgcn_rsqf(s * (1.0f / 1024.0f) + RMS_EPS);
#pragma unroll
                for (int bj = 0; bj < 2; ++bj) b[m][bj] = *(const u32x4*)(base + (size_t)row * 1024 + col0 + bj * HALF); }
#pragma unroll
            for (int m = 0; m < 4; ++m) { const int row = rowb + ai * HALF + m * 16; const float r = rs[m]; float* op = out + (size_t)row * 1024 + col0;
#pragma unroll
                for (int bj = 0; bj < 2; ++bj) { const u32x4 bb = b[m][bj]; const f32x4 a0 = acc[ai][bj][m][0], a1 = acc[ai][bj][m][1]; const f32x4 ga = bj ? g2 : g0, gb = bj ? g3 : g1;
                    f32x4 o0, o1;
                    o0[0] = (a0[0] + __uint_as_float(bb.x << 16)) * r * ga[0]; o0[1] = (a0[1] + __uint_as_float(bb.x & 0xffff0000u)) * r * ga[1];
                    o0[2] = (a0[2] + __uint_as_float(bb.y << 16)) * r * ga[2]; o0[3] = (a0[3] + __uint_as_float(bb.y & 0xffff0000u)) * r * ga[3];
                    o1[0] = (a1[0] + __uint_as_float(bb.z << 16)) * r * gb[0]; o1[1] = (a1[1] + __uint_as_float(bb.z & 0xffff0000u)) * r * gb[1];
                    o1[2] = (a1[2] + __uint_as_float(bb.w << 16)) * r * gb[2]; o1[3] = (a1[3] + __uint_as_float(bb.w & 0xffff0000u)) * r * gb[3];
                    *(f32x4*)(op + bj * HALF) = o0; *(f32x4*)(op + bj * HALF + 4) = o1; } } }
    }
};
template <int SH> __device__ __forceinline__ float row_shr(float v) { return __builtin_bit_cast(float, __builtin_amdgcn_update_dpp(0, __builtin_bit_cast(int, v), 0x110 + SH, 0xf, 0xf, true)); }
__device__ __forceinline__ float rowscan16(float v) { v += row_shr<1>(v); v += row_shr<2>(v); v += row_shr<4>(v); v += row_shr<8>(v); return v; }
__device__ __forceinline__ float rowlast16(float v) { return __shfl(v, 15, 16); }
struct EpiHG {
    static constexpr bool PERM = true, AFTER_DRAIN = false; static constexpr int NS_MIN = 16;
    bf16_t* QA; bf16_t* KD; bf16_t* KT; bf16_t* V; size_t tstride; float* DEC; const float* lb; const float* ssq; bool lbzero;
    __device__ __forceinline__ void operator()(const f32x4 (&acc)[2][2][4][2], const Unit& u, int wr, int wc, int fr, int fq) const {
        const int row0 = u.pm * BM + wr * 64 + fr;
        if (u.pn >= 8) {
            const int tt = (u.pn >= 12) ? 1 : 0; const int col0 = ((u.pn - 8) & 3) * 256 + wc * 32 + 8 * fq; bf16_t* const dbase = V + (size_t)tt * tstride;
#pragma unroll
            for (int ai = 0; ai < 2; ++ai) { float rsv[4]; row_rstd_half(ssq, row0 + ai * HALF, fq, rsv);
#pragma unroll
                for (int m = 0; m < 4; ++m) { const int row = row0 + ai * HALF + m * 16; const float rs = rsv[m]; const size_t off = (size_t)row * 1024 + col0;
#pragma unroll
                    for (int bj = 0; bj < 2; ++bj) { f32x4 v0 = acc[ai][bj][m][0] * rs, v1 = acc[ai][bj][m][1] * rs;
                        if (tt == 1) {
#pragma unroll
                            for (int i = 0; i < 4; ++i) { v0[i] = v0[i] * sigmoid_f(v0[i]); v1[i] = v1[i] * sigmoid_f(v1[i]); } }
                        u32x4 w; w.x = cvt_pk_bf16(v0[0], v0[1]); w.y = cvt_pk_bf16(v0[2], v0[3]); w.z = cvt_pk_bf16(v1[0], v1[1]); w.w = cvt_pk_bf16(v1[2], v1[3]);
                        *(u32x4*)(dbase + off + bj * HALF) = w; } } }
            return;
        }
        const int colh = u.pn * HALF + wc * 32 + 8 * fq;
        f32x4 lbv[2];
#pragma unroll
        for (int n = 0; n < 2; ++n) lbv[n] = *(const f32x4*)(lb + colh + 4 * n);
#pragma unroll
        for (int ai = 0; ai < 2; ++ai) { float rsv[4]; row_rstd_half(ssq, row0 + ai * HALF, fq, rsv);
#pragma unroll
            for (int c2 = 0; c2 < 2; ++c2) {
                const int rowE = row0 + ai * HALF + (2 * c2) * 16, rowO = rowE + 16;
                const float rsE = rsv[2 * c2], rsO = rsv[2 * c2 + 1];
#pragma unroll
                for (int n = 0; n < 2; ++n) { float oq[2][4], od[2][4], ot[2][4]; f32x4 dec;
#pragma unroll
                    for (int i = 0; i < 4; ++i) {
                        float lf[2], kk[2], qq[2];
#pragma unroll
                        for (int eo = 0; eo < 2; ++eo) { const float rs = eo ? rsO : rsE; const float z = acc[ai][1][2 * c2 + eo][n][i] * rs; qq[eo] = acc[ai][0][2 * c2 + eo][n][i] * rs;
                            const float e = __builtin_amdgcn_exp2f(-fabsf(z) * 1.4426950408889634f), d = __builtin_amdgcn_rcpf(1.0f + e), sg = z >= 0.f ? d : e * d; float f;
                            if (lbzero) { f = sg; lf[eo] = fminf(z, 0.f) * 1.4426950408889634f - __builtin_amdgcn_logf(1.0f + e); }
                            else { const float l = lbv[n][i]; f = l + (1.0f - l) * sg; lf[eo] = __builtin_amdgcn_logf(f); }
                            kk[eo] = 1.0f - f; }
                        const float bE = rowscan16(lf[0]); const float totE = rowlast16(bE); const float bO = rowscan16(lf[1]) + totE; const float bl = rowlast16(bO);
                        oq[0][i] = qq[0] * __builtin_amdgcn_exp2f(bE); oq[1][i] = qq[1] * __builtin_amdgcn_exp2f(bO);
                        od[0][i] = kk[0] * __builtin_amdgcn_exp2f(fminf(-bE, 100.f)); od[1][i] = kk[1] * __builtin_amdgcn_exp2f(fminf(-bO, 100.f));
                        ot[0][i] = kk[0] * __builtin_amdgcn_exp2f(bl - bE); ot[1][i] = kk[1] * __builtin_amdgcn_exp2f(bl - bO);
                        dec[i] = __builtin_amdgcn_exp2f(bl); }
#pragma unroll
                    for (int eo = 0; eo < 2; ++eo) { const size_t off = (size_t)(eo ? rowO : rowE) * 1024 + colh + 4 * n; u32x2 w;
                        w.x = cvt_pk_bf16(oq[eo][0], oq[eo][1]); w.y = cvt_pk_bf16(oq[eo][2], oq[eo][3]); *(u32x2*)(QA + off) = w;
                        w.x = cvt_pk_bf16(od[eo][0], od[eo][1]); w.y = cvt_pk_bf16(od[eo][2], od[eo][3]); *(u32x2*)(KD + off) = w;
                        w.x = cvt_pk_bf16(ot[eo][0], ot[eo][1]); w.y = cvt_pk_bf16(ot[eo][2], ot[eo][3]); *(u32x2*)(KT + off) = w; }
                    if (fr == 0) *(f32x4*)(DEC + (size_t)(rowE >> 5) * 1024 + colh + 4 * n) = dec;
                    asm volatile("" ::: "memory"); }
            } }
    }
};
struct EpiSwi {
    static constexpr bool PERM = true, AFTER_DRAIN = false; static constexpr int NS_MIN = 8;
    bf16_t* H; const float* ssq;
    __device__ __forceinline__ void operator()(const f32x4 (&acc)[2][2][4][2], const Unit& u, int wr, int wc, int fr, int fq) const {
        const int col0 = u.pn * HALF + wc * 32 + 8 * fq, row0 = u.pm * BM + wr * 64 + fr;
#pragma unroll
        for (int ai = 0; ai < 2; ++ai) { float rsv[4]; row_rstd_half(ssq, row0 + ai * HALF, fq, rsv);
#pragma unroll
            for (int m = 0; m < 4; ++m) { const int row = row0 + ai * HALF + m * 16; const float rs = rsv[m];
                f32x4 h[2];
#pragma unroll
                for (int n = 0; n < 2; ++n) { const f32x4 g = acc[ai][0][m][n] * rs, uu = acc[ai][1][m][n] * rs;
#pragma unroll
                    for (int i = 0; i < 4; ++i) h[n][i] = g[i] * sigmoid_f(g[i]) * uu[i]; }
                u32x4 w; w.x = cvt_pk_bf16(h[0][0], h[0][1]); w.y = cvt_pk_bf16(h[0][2], h[0][3]); w.z = cvt_pk_bf16(h[1][0], h[1][1]); w.w = cvt_pk_bf16(h[1][2], h[1][3]);
                *(u32x4*)(H + (size_t)row * 2816 + col0) = w; } }
    }
};
template <class Epi, class Sched, bool ALIGN_EPI = false, bool SP2 = false>
__device__ __forceinline__ void gemm_phase(PG8_LAS unsigned char* lds, const Gemm g, const Sched& S, const Epi& E, unsigned* ts_out = nullptr) {
    int tid_ = threadIdx.x; asm volatile("" : "+v"(tid_));
    const int tid = tid_, wid = __builtin_amdgcn_readfirstlane(tid >> 6), lane = tid & 63, wr = wid >> 2, wc = wid & 3, fr = lane & 15, fq = lane >> 4;
    const int K = g.K, nt = K / BK;
    unsigned voffA[2], voffB[2];
#pragma unroll
    for (int i = 0; i < 2; ++i) { int R, C; stage_rc(tid * 16 + i * 8192, R, C); const int Rb = Epi::PERM ? ((R & ~31) + perm32(R & 31)) : R;
        voffA[i] = (unsigned)(R * K + C) * 2u; voffB[i] = (unsigned)(Rb * K + C) * 2u; }
    const size_t kstep = (size_t)(BK * 2);
    const size_t hstep = (size_t)HALF * K * 2;
    const size_t tstep = 2 * hstep;
    const unsigned ldsw = (unsigned)wid * 1024u;
    const int aoff = lds_byte(wr * 64 + fr, fq * 8), boff = lds_byte(wc * 32 + fr, fq * 8);
#define PG8_SA(b, h) (((b) * 2 + (h)) * HTB)
#define PG8_SB(b, h) ((4 + (b) * 2 + (h)) * HTB)
#define PG8_STAGE(bufoff, gbase, voff) do { _Pragma("unroll") for (int _i = 0; _i < 2; ++_i) \
        __builtin_amdgcn_global_load_lds((const unsigned*)((const char*)(gbase) + (voff)[_i]), (PG8_LAS unsigned*)(lds + (bufoff) + ldsw + _i * 8192), 16, 0, 0); } while (0)
#define PG8_LDA(dst, b, h) do { _Pragma("unroll") for (int m = 0; m < 4; ++m) _Pragma("unroll") for (int k = 0; k < 2; ++k) dst[m][k] = *(const PG8_LAS bf16x8*)(lds + PG8_SA(b, h) + aoff + m * 2048 + k * 1024); } while (0)
#define PG8_LDB(dst, b, h) do { _Pragma("unroll") for (int n = 0; n < 2; ++n) _Pragma("unroll") for (int k = 0; k < 2; ++k) dst[n][k] = *(const PG8_LAS bf16x8*)(lds + PG8_SB(b, h) + boff + n * 2048 + k * 1024); } while (0)
#define PG8_MMA(ai, bj, At, Bt) do { __builtin_amdgcn_s_setprio(1); _Pragma("unroll") for (int m = 0; m < 4; ++m) _Pragma("unroll") for (int n = 0; n < 2; ++n) _Pragma("unroll") for (int k = 0; k < 2; ++k) \
        acc[ai][bj][m][n] = __builtin_amdgcn_mfma_f32_16x16x32_bf16(Bt[n][k], At[m][k], acc[ai][bj][m][n], 0, 0, 0); __builtin_amdgcn_s_setprio(0); } while (0)
#define PG8_WAIT_V(n) asm volatile("s_waitcnt vmcnt(" #n ")" ::: "memory")
#define PG8_WAIT_V8_SEL(rlx, n) asm volatile("s_cmp_lg_u32 %0, 0\n\ts_cbranch_scc1 .Lpg8_rlx_%=\n\ts_waitcnt vmcnt(8)\n\ts_branch .Lpg8_end_%=\n.Lpg8_rlx_%=:\n\ts_waitcnt vmcnt(" #n ")\n.Lpg8_end_%=:" :: "s"(rlx) : "scc", "memory")
#define PG8_WAIT_V8_FIRST(rlx) do { if constexpr (Epi::NS_MIN >= 16) PG8_WAIT_V8_SEL(rlx, 24); else if constexpr (Epi::NS_MIN >= 8) PG8_WAIT_V8_SEL(rlx, 16); else PG8_WAIT_V(8); } while (0)
#define PG8_WAIT_L(n) asm volatile("s_waitcnt lgkmcnt(" #n ")" ::: "memory")
#define PG8_BAR __builtin_amdgcn_s_barrier()
#define PG8_SCHED __builtin_amdgcn_sched_barrier(0)
    Unit cur, nxt; int ui = 0;
#if TS_EPI
    unsigned ts_epi_ = 0;
#endif
    if (!S.next(0, cur)) return;
    f32x4 acc[2][2][4][2];
#pragma unroll
    for (int a = 0; a < 2; ++a)
#pragma unroll
        for (int b = 0; b < 2; ++b)
#pragma unroll
            for (int m = 0; m < 4; ++m)
#pragma unroll
                for (int n = 0; n < 2; ++n) acc[a][b][m][n] = (f32x4){0.f, 0.f, 0.f, 0.f};
    bf16x8 At[4][2], B0[2][2], B1[2][2];
    const char* cA = (const char*)g.A + (size_t)cur.pm * tstep; const char* cB = (const char*)g.Bt + (size_t)cur.pn * tstep;
    S.a_ready(cur);
    if constexpr (SP2) {
        PG8_STAGE(PG8_SB(0, 0), cB, voffB); PG8_STAGE(PG8_SB(0, 1), cB + hstep, voffB); PG8_STAGE(PG8_SA(0, 0), cA, voffA); PG8_STAGE(PG8_SA(0, 1), cA + hstep, voffA);
        if (wr == 1) PG8_BAR;
        PG8_WAIT_V(2); PG8_BAR;
        PG8_STAGE(PG8_SB(1, 0), cB + kstep, voffB); PG8_STAGE(PG8_SA(1, 0), cA + kstep, voffA); PG8_STAGE(PG8_SB(1, 1), cB + hstep + kstep, voffB);
        PG8_WAIT_V(6); PG8_BAR;
    } else {
        PG8_STAGE(PG8_SB(0, 0), cB, voffB); PG8_STAGE(PG8_SA(0, 0), cA, voffA); PG8_STAGE(PG8_SB(0, 1), cB + hstep, voffB); PG8_STAGE(PG8_SA(0, 1), cA + hstep, voffA);
        if (wr == 1) PG8_BAR;
        PG8_WAIT_V(4); PG8_BAR;
        PG8_STAGE(PG8_SB(1, 0), cB + kstep, voffB); PG8_STAGE(PG8_SA(1, 0), cA + kstep, voffA); PG8_STAGE(PG8_SB(1, 1), cB + hstep + kstep, voffB);
        PG8_WAIT_V(6); PG8_BAR;
    }
    for (;;) {
        const bool has_next = S.next(ui + 1, nxt);
        const char* nA = has_next ? (const char*)g.A + (size_t)nxt.pm * tstep : cA; const char* nB = has_next ? (const char*)g.Bt + (size_t)nxt.pn * tstep : cB;
#if TS_EPI == 2
        const unsigned long long tk0_ = __builtin_amdgcn_s_memtime();
#endif
        for (int t = 0; t < nt; t += 2) {
            const bool last = (t == nt - 2);
            const char* a1 = cA + (size_t)(t + 1) * kstep;
            const char* a2 = last ? nA : cA + (size_t)(t + 2) * kstep; const char* b2 = last ? nB : cB + (size_t)(t + 2) * kstep;
            const char* a3 = a2 + kstep; const char* b3 = b2 + kstep;
            if (last && has_next) S.a_ready(nxt);
            const int relax_ = __builtin_amdgcn_readfirstlane(((t == 0) && (ui > 0)) ? 1 : 0);
            if constexpr (SP2) {
            PG8_LDB(B0, 0, 0); PG8_LDB(B1, 0, 1); PG8_SCHED; PG8_LDA(At, 0, 0); PG8_STAGE(PG8_SA(1, 1), a1 + hstep, voffA);
            PG8_WAIT_V8_FIRST(relax_); PG8_WAIT_L(0); PG8_BAR; PG8_MMA(0, 0, At, B0); PG8_MMA(0, 1, At, B1); PG8_BAR; PG8_SCHED;
            PG8_LDA(At, 0, 1); PG8_STAGE(PG8_SB(0, 0), b2, voffB); PG8_STAGE(PG8_SB(0, 1), b2 + hstep, voffB); PG8_STAGE(PG8_SA(0, 0), a2, voffA);
            PG8_WAIT_V8_FIRST(relax_); PG8_WAIT_L(0); PG8_BAR; PG8_MMA(1, 0, At, B0); PG8_MMA(1, 1, At, B1); PG8_BAR; PG8_SCHED;
            PG8_LDB(B0, 1, 0); PG8_LDB(B1, 1, 1); PG8_SCHED; PG8_LDA(At, 1, 0); PG8_STAGE(PG8_SA(0, 1), a2 + hstep, voffA);
            PG8_WAIT_V(8); PG8_WAIT_L(0); PG8_BAR; PG8_MMA(0, 0, At, B0); PG8_MMA(0, 1, At, B1); PG8_BAR; PG8_SCHED;
            PG8_LDA(At, 1, 1); PG8_STAGE(PG8_SB(1, 0), b3, voffB); PG8_STAGE(PG8_SB(1, 1), b3 + hstep, voffB); PG8_STAGE(PG8_SA(1, 0), a3, voffA);
            PG8_WAIT_V(8); PG8_WAIT_L(0); PG8_BAR; PG8_MMA(1, 0, At, B0); PG8_MMA(1, 1, At, B1); PG8_BAR; PG8_SCHED;
            } else {
            PG8_LDB(B0, 0, 0); PG8_SCHED; PG8_LDA(At, 0, 0); PG8_STAGE(PG8_SA(1, 1), a1 + hstep, voffA);
            PG8_WAIT_L(8); PG8_BAR; PG8_WAIT_L(0); PG8_MMA(0, 0, At, B0); PG8_BAR; PG8_SCHED;
            PG8_LDB(B1, 0, 1); PG8_STAGE(PG8_SB(0, 0), b2, voffB);
            PG8_BAR; PG8_WAIT_L(0); PG8_MMA(0, 1, At, B1); PG8_BAR;
            PG8_LDA(At, 0, 1); PG8_STAGE(PG8_SA(0, 0), a2, voffA);
            PG8_BAR; PG8_WAIT_L(0); PG8_MMA(1, 0, At, B0); PG8_BAR; PG8_SCHED;
            PG8_STAGE(PG8_SB(0, 1), b2 + hstep, voffB);
            PG8_WAIT_V(6); PG8_BAR; PG8_MMA(1, 1, At, B1); PG8_BAR;
            PG8_LDB(B0, 1, 0); PG8_SCHED; PG8_LDA(At, 1, 0); PG8_STAGE(PG8_SA(0, 1), a2 + hstep, voffA);
            PG8_WAIT_L(8); PG8_BAR; PG8_WAIT_L(0); PG8_MMA(0, 0, At, B0); PG8_BAR; PG8_SCHED;
            PG8_LDB(B1, 1, 1); PG8_STAGE(PG8_SB(1, 0), b3, voffB);
            PG8_BAR; PG8_WAIT_L(0); PG8_MMA(0, 1, At, B1); PG8_BAR;
            PG8_LDA(At, 1, 1); PG8_STAGE(PG8_SA(1, 0), a3, voffA);
            PG8_BAR; PG8_WAIT_L(0); PG8_MMA(1, 0, At, B0); PG8_BAR; PG8_SCHED;
            PG8_STAGE(PG8_SB(1, 1), b3 + hstep, voffB);
            PG8_WAIT_V(6); PG8_BAR; PG8_MMA(1, 1, At, B1); PG8_BAR;
            }
        }
#if TS_EPI == 2
        ts_epi_ += (unsigned)(__builtin_amdgcn_s_memtime() - tk0_);
#endif
        if constexpr (ALIGN_EPI) { if (wr == 0) PG8_BAR; }
#if TS_EPI == 1
        const unsigned long long te0_ = __builtin_amdgcn_s_memrealtime();
#endif
        if constexpr (!Epi::AFTER_DRAIN) { E(acc, cur, wr, wc, fr, fq); S.done(cur); }
#if TS_EPI == 1
        asm volatile("s_waitcnt vmcnt(0)" ::: "memory");
        ts_epi_ += (unsigned)(__builtin_amdgcn_s_memrealtime() - te0_);
#endif
        if (!has_next) break;
#pragma unroll
        for (int a = 0; a < 2; ++a)
#pragma unroll
            for (int b = 0; b < 2; ++b)
#pragma unroll
                for (int m = 0; m < 4; ++m)
#pragma unroll
                    for (int n = 0; n < 2; ++n) acc[a][b][m][n] = (f32x4){0.f, 0.f, 0.f, 0.f};
        cur = nxt; cA = nA; cB = nB; ++ui;
        if constexpr (ALIGN_EPI) { if (wr == 1) PG8_BAR; }
    }
#if TS_EPI
    if (blockIdx.x == 0 && threadIdx.x == 0) *ts_out = ts_epi_;
#endif
    PG8_WAIT_V(0);
    if constexpr (!ALIGN_EPI) { if (wr == 0) PG8_BAR; }
    PG8_BAR;
    if constexpr (Epi::AFTER_DRAIN) { E.fused(acc, cur, wr, wc, fr, fq, lds, wid, lane); S.done(cur); }
#undef PG8_SA
#undef PG8_SB
#undef PG8_STAGE
#undef PG8_LDA
#undef PG8_LDB
#undef PG8_MMA
#undef PG8_WAIT_V
#undef PG8_WAIT_V8_FIRST
#undef PG8_WAIT_V8_SEL
#undef PG8_WAIT_L
#undef PG8_BAR
#undef PG8_SCHED
}
}

#include <hip/hip_bf16.h>
#include <cmath>
namespace attn_body {
using bf16=__hip_bfloat16;
using bf16x8=__attribute__((ext_vector_type(8)))short;
using s16x4=__attribute__((ext_vector_type(4)))short;
using f32x16=__attribute__((ext_vector_type(16)))float;
using u32x4=__attribute__((ext_vector_type(4)))unsigned;
using f32x4_t=__attribute__((ext_vector_type(4)))float;
constexpr int BATCH=8,NHEAD=8,SEQ=2048,D=64,DM=NHEAD*D,OPITCH=1024;
constexpr int NW=8,QBLK=32,QB=QBLK*NW,KVBLK=64,NQB=SEQ/QB;
constexpr int ATTN_PITCH=DM, ATTN_UNIT_ROWS=QB;
constexpr float ATT_LOG2E=1.4426950408889634f;
__device__ __forceinline__ int crow(int r,int hi){return (r&3)+8*(r>>2)+4*hi;}
#define SBAR() __builtin_amdgcn_sched_barrier(0)
__device__ __forceinline__ void cmask(f32x16&p0,f32x16&p1,int jb,int qrel,int hi){
  const float NEG=-INFINITY; int kb=64*jb+4*hi;
  #pragma unroll
  for(int r=0;r<16;++r){int kv=kb+(r&3)+8*(r>>2); if(kv>qrel)p0[r]=NEG; if(kv+32>qrel)p1[r]=NEG;}
}

constexpr int NSLOT=3, SLOTB=8192;
constexpr int LDS_K=0, LDS_V=NSLOT*SLOTB, LDS_WS=2*NSLOT*SLOTB, LDS_OST=LDS_WS+NW*64*4, LDS_BETA=LDS_OST+NW*4096, LDS_PRE=LDS_BETA+SEQ*4, LDS_BYTES=LDS_PRE+256;
constexpr float C2=0.125f*1.4426950408889634f;
__device__ __forceinline__ void glds16(const void*gsrc,unsigned lds_dst){unsigned keep;
  asm volatile("s_mov_b32 %0, m0\n\ts_mov_b32 m0, %2\n\ts_nop 0\n\tglobal_load_lds_dwordx4 %1, off\n\ts_mov_b32 m0, %0":"=&s"(keep):"v"(gsrc),"s"(lds_dst):"memory");}
__device__ __forceinline__ float max3f(float a,float b,float c){float r;asm("v_max3_f32 %0, %1, %2, %3":"=v"(r):"v"(a),"v"(b),"v"(c));return r;}
__device__ __forceinline__ float max2f(float a,float b){float r;asm("v_max_f32_e32 %0, %1, %2":"=v"(r):"v"(a),"v"(b));return r;}
__device__ __forceinline__ float fadd_s(float a,float b){float r;asm("v_add_f32_e32 %0, %1, %2":"=v"(r):"v"(a),"v"(b));return r;}
__device__ __forceinline__ float fsub_s(float a,float b){float r;asm("v_sub_f32_e32 %0, %1, %2":"=v"(r):"v"(a),"v"(b));return r;}
typedef float f32x2_t __attribute__((ext_vector_type(2))); typedef __bf16 bf16x2_t __attribute__((ext_vector_type(2)));
__device__ __forceinline__ unsigned cvtpk_s(float lo,float hi){f32x2_t v={lo,hi};bf16x2_t b=__builtin_convertvector(v,bf16x2_t);return __builtin_bit_cast(unsigned,b);}
#define WAIT_BAR(N) asm volatile("s_waitcnt vmcnt(" #N ") lgkmcnt(0)\n\ts_barrier":::"memory")

__device__ __forceinline__ void qkt(f32x16&p0,f32x16&p1,const char*Kslot,const bf16x8*qr,const f32x16&negm,int r32,int hi){
  const char*kb=Kslot+hi*1024+r32*16;
  #pragma unroll
  for(int d0=0;d0<4;++d0){
    const bf16x8 b0=*reinterpret_cast<const bf16x8*>(kb+d0*2048);
    const bf16x8 b1=*reinterpret_cast<const bf16x8*>(kb+d0*2048+512);
    if(d0==0){p0=__builtin_amdgcn_mfma_f32_32x32x16_bf16(b0,qr[0],negm,0,0,0);p1=__builtin_amdgcn_mfma_f32_32x32x16_bf16(b1,qr[0],negm,0,0,0);}
    else{p0=__builtin_amdgcn_mfma_f32_32x32x16_bf16(b0,qr[d0],p0,0,0,0);p1=__builtin_amdgcn_mfma_f32_32x32x16_bf16(b1,qr[d0],p1,0,0,0);}}
}
typedef __attribute__((address_space(3))) const char* lds_cptr;
typedef short v4i16_t __attribute__((ext_vector_type(4)));
__device__ __forceinline__ void kload8(bf16x8*kf,lds_cptr kp){
  kf[0]=*(const __attribute__((address_space(3))) bf16x8*)(kp);      kf[1]=*(const __attribute__((address_space(3))) bf16x8*)(kp+512);
  kf[2]=*(const __attribute__((address_space(3))) bf16x8*)(kp+2048); kf[3]=*(const __attribute__((address_space(3))) bf16x8*)(kp+2560);
  kf[4]=*(const __attribute__((address_space(3))) bf16x8*)(kp+4096); kf[5]=*(const __attribute__((address_space(3))) bf16x8*)(kp+4608);
  kf[6]=*(const __attribute__((address_space(3))) bf16x8*)(kp+6144); kf[7]=*(const __attribute__((address_space(3))) bf16x8*)(kp+6656);
}
__device__ __forceinline__ void kload2(bf16x8*kf,lds_cptr kp,int j){ kf[2*j]=*(const __attribute__((address_space(3))) bf16x8*)(kp+j*2048); kf[2*j+1]=*(const __attribute__((address_space(3))) bf16x8*)(kp+j*2048+512); }
__device__ __forceinline__ s16x4 vtr(lds_cptr p){ return __builtin_bit_cast(s16x4,__builtin_amdgcn_ds_read_tr16_b64_v4i16((__attribute__((address_space(3))) v4i16_t*)p)); }
__device__ __forceinline__ float rowmax(const f32x16&p0,const f32x16&p1){
  float a=max3f(p0[0],p0[1],p1[0]),b=max3f(p0[2],p0[3],p1[1]);a=max3f(a,p1[2],p1[3]);
  #pragma unroll
  for(int r=4;r<16;r+=4){a=max3f(a,p0[r],p0[r+1]);b=max3f(b,p0[r+2],p0[r+3]);a=max3f(a,p1[r],p1[r+1]);b=max3f(b,p1[r+2],p1[r+3]);}
  const float m=max2f(a,b);
  auto rr=__builtin_amdgcn_permlane32_swap(__float_as_uint(m),__float_as_uint(m),false,false);
  return max2f(__uint_as_float(rr[0]),__uint_as_float(rr[1]));
}
__device__ __forceinline__ void pv(f32x16*o,int vb,bf16x8 pa0,bf16x8 pa1,bf16x8 pa2,bf16x8 pa3){
  #pragma unroll
  for(int d0=0;d0<2;++d0){s16x4 lo[4],hi[4];
    #pragma unroll
    for(int ks=0;ks<4;++ks){
      asm volatile("ds_read_b64_tr_b16 %0,%1 offset:%c2":"=&v"(lo[ks]):"v"(vb),"i"(d0*4096+ks*1024):"memory");
      asm volatile("ds_read_b64_tr_b16 %0,%1 offset:%c2":"=&v"(hi[ks]):"v"(vb),"i"(d0*4096+ks*1024+512):"memory");}
    asm volatile("s_waitcnt lgkmcnt(0)":::"memory");SBAR();
    #define PK(k) (bf16x8){lo[k][0],lo[k][1],lo[k][2],lo[k][3],hi[k][0],hi[k][1],hi[k][2],hi[k][3]}
    o[d0]=__builtin_amdgcn_mfma_f32_32x32x16_bf16(pa0,PK(0),o[d0],0,0,0);
    o[d0]=__builtin_amdgcn_mfma_f32_32x32x16_bf16(pa1,PK(1),o[d0],0,0,0);
    o[d0]=__builtin_amdgcn_mfma_f32_32x32x16_bf16(pa2,PK(2),o[d0],0,0,0);
    o[d0]=__builtin_amdgcn_mfma_f32_32x32x16_bf16(pa3,PK(3),o[d0],0,0,0);
    #undef PK
  }
}

#ifndef ATTN_STORE16
#define ATTN_STORE16(p,v) (*(u32x4*)(p)=(v))
#endif
template<int THRL> __device__ __forceinline__ void attn_unit(int b,int h,int qb,const bf16*Q,const bf16*__restrict__ K,const bf16*__restrict__ V,bf16*O,char*shm){
  int tid_o=threadIdx.x; asm volatile("":"+v"(tid_o));
  const int tid=tid_o,lane=tid&63,r32=lane&31,hi=lane>>5; const int wid=__builtin_amdgcn_readfirstlane(tid>>6);
  const long rowbase=(long)b*SEQ; const int q0=qb*QB;
  const bf16*Qw=Q+(rowbase+q0+wid*QBLK)*DM+h*D;
  const bf16*Kh=K+rowbase*DM+h*D,*Vh=V+rowbase*DM+h*D;
  const unsigned lds0=(unsigned)(uintptr_t)shm;
  float*wsf=(float*)(shm+LDS_WS)+wid*64;
  const bf16*ksrc=Kh+(long)lane*DM+wid*8;
  const bf16*vsrc=Vh+(long)(16*(wid&3)+(lane>>2))*DM+(wid>>2)*32+(lane&3)*8;
  const unsigned kdst=lds0+LDS_K+wid*1024, vdst=lds0+LDS_V+wid*1024;
  #define DMA_K(t,slot) glds16(ksrc+(long)(t)*KVBLK*DM,(unsigned)__builtin_amdgcn_readfirstlane(kdst+(slot)))
  #define DMA_V(t,slot) glds16(vsrc+(long)(t)*KVBLK*DM,(unsigned)__builtin_amdgcn_readfirstlane(vdst+(slot)))
  const int vb0=(int)(lds0+LDS_V)+((lane>>4)&1)*32+(lane&3)*8+(4*hi+((lane&15)>>2))*64;
  const char*Kbase=shm+LDS_K; bf16x8 kf[8];
  const lds_cptr shm3=(lds_cptr)shm; const lds_cptr kp0=shm3+LDS_K+hi*1024+r32*16; const lds_cptr vp0=shm3+LDS_V+((lane>>4)&1)*32+(lane&3)*8+(4*hi+((lane&15)>>2))*64;
  const int NT=(q0+QB)/KVBLK;
  DMA_K(0,0);DMA_V(0,0);DMA_K(1,SLOTB);
  bf16x8 qr[4];
  #pragma unroll
  for(int d0=0;d0<4;++d0)qr[d0]=*reinterpret_cast<const bf16x8*>(&Qw[(long)r32*DM+d0*16+hi*8]);
  float m0;
  { const bf16*Kd=Kh+(long)(q0+wid*QBLK+r32)*DM+hi*8; float acc_=0.f;
    #pragma unroll
    for(int d0=0;d0<4;++d0){ const bf16x8 kd=*reinterpret_cast<const bf16x8*>(&Kd[d0*16]);
      #pragma unroll
      for(int j_=0;j_<8;++j_) acc_+=__uint_as_float((unsigned)(unsigned short)qr[d0][j_]<<16)*__uint_as_float((unsigned)(unsigned short)kd[j_]<<16); }
    auto rr_=__builtin_amdgcn_permlane32_swap(__float_as_uint(acc_),__float_as_uint(acc_),false,false);
    m0=__uint_as_float(rr_[0])+__uint_as_float(rr_[1])+((__attribute__((address_space(3))) const float*)((lds_cptr)shm+LDS_BETA))[q0+wid*QBLK+r32]; }
  float mhat=0.f,l_reg=0.f;f32x16 o[2];o[0]=f32x16{};o[1]=f32x16{};f32x16 negm=f32x16{};asm volatile("":"+v"(negm));
  const int qrel=wid*QBLK+r32;
  #define CMASK(P0,P1,t) do{int jb_=(t)-(NT-4); if(jb_>=0)cmask(P0,P1,jb_,qrel,hi);}while(0)
  typedef __attribute__((address_space(3))) const f32x4_t* lds_f4ptr;
  const lds_f4ptr betab=(lds_f4ptr)((lds_cptr)shm+LDS_BETA+16*hi);
  #define BIAS(P0,P1,t) do{ const lds_f4ptr bp_=betab+16*(t); \
    _Pragma("unroll") for(int g_=0;g_<4;++g_){ const f32x4_t b0_=bp_[2*g_], b1_=bp_[8+2*g_]; \
      _Pragma("unroll") for(int i_=0;i_<4;++i_){ P0[4*g_+i_]+=b0_[i_]; P1[4*g_+i_]+=b1_[i_]; } if(g_&1)SBAR(); } }while(0)
  bool resc=false;
  #define START(P0,P1) do{ const float rm=rowmax(P0,P1); resc=false; \
    { const float dl=max2f(rm,m0); mhat=fadd_s(mhat,dl); \
      _Pragma("unroll") for(int r=0;r<16;++r){P0[r]=fsub_s(P0[r],dl);P1[r]=fsub_s(P1[r],dl);} \
      _Pragma("unroll") for(int r=0;r<16;++r)negm[r]=-mhat; asm volatile("":"+v"(negm)); } \
    _Pragma("unroll") for(int r=0;r<16;++r)P0[r]=__builtin_amdgcn_exp2f(P0[r]); }while(0)
  #define RESC() do{ if(resc){ asm volatile("s_waitcnt lgkmcnt(0)":::"memory"); \
      _Pragma("unroll") for(int d_=0;d_<2;++d_) _Pragma("unroll") for(int r=0;r<16;++r)o[d_][r]*=wsf[crow(r,hi)]; } }while(0)
  f32x16 pA0,pA1,pB0,pB1;
  int sl_prev=0,sl_cur=0,sl_next=SLOTB;
  #define ROT() do{sl_prev=sl_cur;sl_cur=sl_next;sl_next=(sl_next==(NSLOT-1)*SLOTB)?0:sl_next+SLOTB;}while(0)
  DMA_K(2,2*SLOTB);
  WAIT_BAR(3);
  qkt(pA0,pA1,Kbase,qr,negm,r32,hi);asm volatile("s_nop 15\n\ts_nop 7":"+v"(pA0),"+v"(pA1));BIAS(pA0,pA1,0);CMASK(pA0,pA1,0);
  START(pA0,pA1);
  _Pragma("unroll") for(int r=0;r<16;++r)pA1[r]=__builtin_amdgcn_exp2f(pA1[r]);
  WAIT_BAR(0);
  DMA_K(3,0);DMA_V(1,SLOTB);
  ROT();
  kload8(kf,kp0+sl_cur);
  WAIT_BAR(2);
  s16x4 vlo[8],vhi[8]; u32x4 pw0,pw1,pw2,pw3;
  #define PKW(P,B) cvtpk_s(P[B],P[B+1])
  #define PAF(k) __builtin_bit_cast(bf16x8,pw##k)
  #define VFR(i) (bf16x8){vlo[i][0],vlo[i][1],vlo[i][2],vlo[i][3],vhi[i][0],vhi[i][1],vhi[i][2],vhi[i][3]}
  #define PIN(x) asm volatile("":"+v"(x))
  #define MX3(a,b,c) __builtin_fmaxf(__builtin_fmaxf((a),(b)),(c))
  #define GAPA(MF,A0,A1,A2,A3,W0,W1,PW) do{ MF; sacc+=A0; sacc+=A1; sacc+=A2; sacc+=A3; PIN(sacc); W0; W1; PIN(PW); SBAR(); }while(0)
  #define EX(v) __builtin_amdgcn_exp2f(v)
  #define GAPB(MF,X,B) do{ MF; X[B]=EX(X[B]); X[B+1]=EX(X[B+1]); X[B+2]=EX(X[B+2]); X[B+3]=EX(X[B+3]); PIN(X); SBAR(); }while(0)
  #define VRD(i) do{ vlo[i]=vtr(vp_+(((i)>>2)*4096+((i)&3)*1024)); vhi[i]=vtr(vp_+(((i)>>2)*4096+((i)&3)*1024+512)); }while(0)
  #define KRD(G,j) do{ if(G){ kload2(kf,kp0+sl_next,j); SBAR(); } }while(0)
  #define STEP(C0,C1,P0,P1,t,GK,GV,GL) do{ SBAR(); \
    const lds_cptr vp_=vp0+sl_prev; \
    VRD(0); SBAR(); float sacc=(P0[0]+P0[1]); \
    GAPA(C0=__builtin_amdgcn_mfma_f32_32x32x16_bf16(kf[0],qr[0],negm,0,0,0), P0[2],P0[3],P0[4],P0[5],     pw0[0]=PKW(P0,0), pw0[1]=PKW(P0,2), pw0); \
    VRD(4); SBAR(); GAPA(C1=__builtin_amdgcn_mfma_f32_32x32x16_bf16(kf[1],qr[0],negm,0,0,0), P0[6],P0[7],P0[8],P0[9],     pw0[2]=PKW(P0,4), pw0[3]=PKW(P0,6), pw0); \
    VRD(1); SBAR(); GAPA(C0=__builtin_amdgcn_mfma_f32_32x32x16_bf16(kf[2],qr[1],C0,0,0,0),   P0[10],P0[11],P0[12],P0[13], pw1[0]=PKW(P0,8), pw1[1]=PKW(P0,10), pw1); \
    VRD(5); SBAR(); GAPA(C1=__builtin_amdgcn_mfma_f32_32x32x16_bf16(kf[3],qr[1],C1,0,0,0),   P0[14],P0[15],P1[0],P1[1],   pw1[2]=PKW(P0,12),pw1[3]=PKW(P0,14), pw1); \
    VRD(2); SBAR(); GAPA(C0=__builtin_amdgcn_mfma_f32_32x32x16_bf16(kf[4],qr[2],C0,0,0,0),   P1[2],P1[3],P1[4],P1[5],     pw2[0]=PKW(P1,0), pw2[1]=PKW(P1,2), pw2); \
    VRD(6); SBAR(); GAPA(C1=__builtin_amdgcn_mfma_f32_32x32x16_bf16(kf[5],qr[2],C1,0,0,0),   P1[6],P1[7],P1[8],P1[9],     pw2[2]=PKW(P1,4), pw2[3]=PKW(P1,6), pw2); \
    VRD(3); SBAR(); GAPA(C0=__builtin_amdgcn_mfma_f32_32x32x16_bf16(kf[6],qr[3],C0,0,0,0),   P1[10],P1[11],P1[12],P1[13], pw3[0]=PKW(P1,8), pw3[1]=PKW(P1,10), pw3); \
    VRD(7); SBAR(); GAPA(C1=__builtin_amdgcn_mfma_f32_32x32x16_bf16(kf[7],qr[3],C1,0,0,0),   P1[14],P1[15],0.f,0.f,       pw3[2]=PKW(P1,12),pw3[3]=PKW(P1,14), pw3); \
    l_reg+=sacc; \
    if(GK){DMA_K((t)+3,sl_cur);} if(GV){DMA_V((t)+1,sl_next);} \
    BIAS(C0,C1,t); CMASK(C0,C1,t); \
    { float a=MX3(C0[0],C0[1],C1[0]),b=MX3(C0[2],C0[3],C1[1]); a=MX3(a,C1[2],C1[3]); \
      _Pragma("unroll") for(int r=4;r<16;r+=4){a=MX3(a,C0[r],C0[r+1]);b=MX3(b,C0[r+2],C0[r+3]);a=MX3(a,C1[r],C1[r+1]);b=MX3(b,C1[r+2],C1[r+3]);} \
      float rm=__builtin_fmaxf(a,b); { auto rr=__builtin_amdgcn_permlane32_swap(__float_as_uint(rm),__float_as_uint(rm),false,false); rm=__builtin_fmaxf(__uint_as_float(rr[0]),__uint_as_float(rr[1])); } \
      resc=false; \
      if(__builtin_expect(__any(rm>(float)THRL),0)){ const float dl=__builtin_fmaxf(rm,0.f); mhat+=dl; \
        _Pragma("unroll") for(int r=0;r<16;++r){C0[r]-=dl;C1[r]-=dl;} \
        _Pragma("unroll") for(int r=0;r<16;++r)negm[r]=-mhat; asm volatile("":"+v"(negm)); \
        const float f=__builtin_amdgcn_exp2f(-dl); l_reg*=f; if(hi==0)wsf[r32]=f; resc=true; } } \
    SBAR(); \
    GAPB(o[0]=__builtin_amdgcn_mfma_f32_32x32x16_bf16(PAF(0),VFR(0),o[0],0,0,0), C0,0); \
    GAPB(o[1]=__builtin_amdgcn_mfma_f32_32x32x16_bf16(PAF(0),VFR(4),o[1],0,0,0), C0,4); \
    KRD(GL,0); GAPB(o[0]=__builtin_amdgcn_mfma_f32_32x32x16_bf16(PAF(1),VFR(1),o[0],0,0,0), C0,8); \
    KRD(GL,1); GAPB(o[1]=__builtin_amdgcn_mfma_f32_32x32x16_bf16(PAF(1),VFR(5),o[1],0,0,0), C0,12); \
    KRD(GL,2); GAPB(o[0]=__builtin_amdgcn_mfma_f32_32x32x16_bf16(PAF(2),VFR(2),o[0],0,0,0), C1,0); \
    KRD(GL,3); GAPB(o[1]=__builtin_amdgcn_mfma_f32_32x32x16_bf16(PAF(2),VFR(6),o[1],0,0,0), C1,4); \
    GAPB(o[0]=__builtin_amdgcn_mfma_f32_32x32x16_bf16(PAF(3),VFR(3),o[0],0,0,0), C1,8); \
    GAPB(o[1]=__builtin_amdgcn_mfma_f32_32x32x16_bf16(PAF(3),VFR(7),o[1],0,0,0), C1,12); \
    }while(0)
  int t=1;
  #undef CMASK
  #define CMASK(P0,P1,t) do{}while(0)
  for(;t+5<NT;t+=2){
    STEP(pB0,pB1,pA0,pA1,t,true,true,true);     WAIT_BAR(2); RESC(); ROT();
    STEP(pA0,pA1,pB0,pB1,t+1,true,true,true);   WAIT_BAR(2); RESC(); ROT();
  }
  #undef CMASK
  #define CMASK(P0,P1,t) do{int jb_=(t)-(NT-4); if(jb_>=0)cmask(P0,P1,jb_,qrel,hi);}while(0)
  #define ENDW(tt) do{ if((tt)+3<NT){WAIT_BAR(2);} else if((tt)+2<NT){WAIT_BAR(1);} else {WAIT_BAR(0);} }while(0)
  for(;t+1<NT;t+=2){
    STEP(pB0,pB1,pA0,pA1,t,(t+3<NT),(t+1<NT),(t+1<NT));       ENDW(t);   RESC(); ROT();
    STEP(pA0,pA1,pB0,pB1,t+1,(t+4<NT),(t+2<NT),(t+2<NT));     ENDW(t+1); RESC(); ROT();
  }
  STEP(pB0,pB1,pA0,pA1,NT-1,false,false,false); RESC();
  { float sacc=pB0[0]+pB0[1]; _Pragma("unroll") for(int r=2;r<16;++r)sacc+=pB0[r]; _Pragma("unroll") for(int r=0;r<16;++r)sacc+=pB1[r]; l_reg+=sacc;
    pw0=(u32x4){PKW(pB0,0),PKW(pB0,2),PKW(pB0,4),PKW(pB0,6)};pw1=(u32x4){PKW(pB0,8),PKW(pB0,10),PKW(pB0,12),PKW(pB0,14)};pw2=(u32x4){PKW(pB1,0),PKW(pB1,2),PKW(pB1,4),PKW(pB1,6)};pw3=(u32x4){PKW(pB1,8),PKW(pB1,10),PKW(pB1,12),PKW(pB1,14)};
    SBAR(); pv(o,vb0+sl_cur,PAF(0),PAF(1),PAF(2),PAF(3)); }
  #undef PKW
  #undef PAF
  #undef VFR
  #undef PIN
  #undef MX3
  #undef GAPA
  #undef GAPB
  #undef EX
  #undef VRD
  #undef KRD
  #undef STEP
  #undef ENDW
  {auto rr=__builtin_amdgcn_permlane32_swap(__float_as_uint(l_reg),__float_as_uint(l_reg),false,false);l_reg=__uint_as_float(rr[0])+__uint_as_float(rr[1]);}
  if(hi==0)wsf[32+r32]=l_reg;asm volatile("s_waitcnt lgkmcnt(0)":::"memory");
  float rli[16];
  #pragma unroll
  for(int r=0;r<16;++r)rli[r]=__builtin_amdgcn_rcpf(wsf[32+crow(r,hi)]);
  bf16*Ow=O+(rowbase+q0+wid*QBLK)*OPITCH+h*D;
  { bf16*stg=(bf16*)(shm+LDS_OST)+wid*2048;
    #pragma unroll
    for(int r=0;r<16;++r){const int orow=crow(r,hi);
      #pragma unroll
      for(int d0=0;d0<2;++d0)stg[orow*64+d0*32+r32]=__float2bfloat16(o[d0][r]*rli[r]);}
    asm volatile("s_waitcnt lgkmcnt(0)":::"memory");
    #pragma unroll
    for(int i=0;i<4;++i){const int row=i*8+(lane>>3),ch=lane&7; const u32x4 v=*(const u32x4*)(stg+row*64+ch*8); ATTN_STORE16(Ow+(long)row*OPITCH+ch*8,v);} }
  asm volatile("s_waitcnt lgkmcnt(0)\n\ts_barrier":::"memory");
  #undef DMA_K
  #undef DMA_V
  #undef CMASK
  #undef BIAS
  #undef START
  #undef RESC
  #undef ROT
}
constexpr int ATTN_LDS_BYTES=LDS_BYTES;
struct AttnTensors { const bf16* Q; const bf16* K; const bf16* V; bf16* O; const float* cl; const float* bt; };
struct AttnUnit { int bh; int qb; };
struct StaticOrder {
  int vcu,grid;
  __device__ __forceinline__ explicit StaticOrder(int grid_,int block):vcu((grid_%8==0)?(block%8)*(grid_/8)+block/8:block),grid(grid_){}
  __device__ __forceinline__ bool next(int i,AttnUnit&u)const{ const int v=vcu+(i>>1)*grid; if(v>=BATCH*NHEAD*4)return false; const int s=v&3; u.bh=v>>2; u.qb=((i&1)==0)?7-s:s; return true; }
  __device__ __forceinline__ void a_ready(const AttnUnit&)const{}
  __device__ __forceinline__ void done(const AttnUnit&)const{}
};
__device__ __forceinline__ void build_beta(char*lds,const float*cl,const float*bt,int bh){
  int tid_o=threadIdx.x; asm volatile("":"+v"(tid_o)); const int tid=tid_o,b=bh/NHEAD,h=bh%NHEAD;
  __attribute__((address_space(3))) float*beta=(__attribute__((address_space(3))) float*)((lds_cptr)lds+LDS_BETA);
  __attribute__((address_space(3))) float*pre=(__attribute__((address_space(3))) float*)((lds_cptr)lds+LDS_PRE);
  if(tid<64){ float v=(tid<32)?bt[(b*32+tid)*8+h]:0.f; const float own=v;
    #pragma unroll
    for(int o=1;o<32;o<<=1){ const float n=__shfl_up(v,o); if((tid&63)>=o)v+=n; }
    if(tid<32)pre[tid]=v-own; }
  asm volatile("s_waitcnt lgkmcnt(0)":::"memory"); __syncthreads();
  for(int s=tid;s<SEQ;s+=NW*64) beta[s]=-(pre[s>>6]+cl[(long)(b*SEQ+s)*8+h])*ATT_LOG2E;
  asm volatile("s_waitcnt lgkmcnt(0)":::"memory"); __syncthreads();
}
template<class Sched,int THRL=8> __device__ __forceinline__ void attn_phase(char*lds,const AttnTensors&T,const Sched&S){
  AttnUnit u;
  for(int i=0;S.next(i,u);++i){ if((i&1)==0) build_beta(lds,T.cl,T.bt,u.bh);
    S.a_ready(u); attn_unit<THRL>(u.bh/NHEAD,u.bh%NHEAD,u.qb,T.Q,T.K,T.V,T.O,lds); S.done(u); }
}
#undef SBAR
#undef WAIT_BAR
}

namespace hg {
typedef short bf16x8 __attribute__((ext_vector_type(8)));
typedef short s16x4 __attribute__((ext_vector_type(4)));
typedef float f32x16 __attribute__((ext_vector_type(16)));
typedef float f32x4 __attribute__((ext_vector_type(4)));
typedef unsigned u32x4 __attribute__((ext_vector_type(4)));
typedef unsigned u32x2 __attribute__((ext_vector_type(2)));
#define HG_LAS __attribute__((address_space(3)))
#define HG_BAR() do { asm volatile("s_waitcnt lgkmcnt(0)" ::: "memory"); __builtin_amdgcn_s_barrier(); asm volatile("" ::: "memory"); } while (0)
constexpr int CH = 32, NCH = 2048 / CH;
constexpr int S_QA = 0, S_KD = 8192, S_KT = 16384, S_V = 24576, S_DEC = 26624, SLOT_BYTES = 27136;
constexpr int OFF_OPART = 2 * SLOT_BYTES, OPART_BYTES = 4 * 4096, LDS_BYTES = OFF_OPART + 2 * OPART_BYTES;
__device__ __forceinline__ int qa_off(int t, int d) { return t * 256 + ((((d >> 3) ^ (t & 15))) << 4) + (d & 7) * 2; }
__device__ __forceinline__ int kt_off(int s, int d) { return s * 256 + ((((d >> 3) ^ ((s & 3) << 2))) << 4) + (d & 7) * 2; }
__device__ __forceinline__ int v_off(int s, int e) { return s * 64 + e * 2; }
typedef short v4i16_t __attribute__((ext_vector_type(4)));
__device__ __forceinline__ s16x4 trd(const HG_LAS unsigned char* p) { return __builtin_bit_cast(s16x4, __builtin_amdgcn_ds_read_tr16_b64_v4i16((HG_LAS v4i16_t*)p)); }
__device__ __forceinline__ unsigned cvtpk(float lo, float hi) { typedef float f2 __attribute__((ext_vector_type(2))); typedef __bf16 b2 __attribute__((ext_vector_type(2))); f2 v = {lo, hi}; b2 b = __builtin_convertvector(v, b2); return __builtin_bit_cast(unsigned, b); }
__device__ __forceinline__ int crow(int r, int hi) { return (r & 3) + 8 * (r >> 2) + 4 * hi; }
__device__ __forceinline__ bf16x8 pack8(const f32x16& x, int base) {
    u32x4 w; w.x = cvtpk(x[base], x[base + 1]); w.y = cvtpk(x[base + 2], x[base + 3]); w.z = cvtpk(x[base + 4], x[base + 5]); w.w = cvtpk(x[base + 6], x[base + 7]); return __builtin_bit_cast(bf16x8, w); }
__device__ __forceinline__ bf16x8 cat64(s16x4 a, s16x4 b) { return (bf16x8){a[0], a[1], a[2], a[3], b[0], b[1], b[2], b[3]}; }

__device__ __forceinline__ void hgrn_unit(HG_LAS unsigned char* lds, const unsigned short* QA, const unsigned short* KD, const unsigned short* KT, const float* DEC, const unsigned short* V, unsigned short* O, int unit) {
    int tid_o = threadIdx.x; asm volatile("" : "+v"(tid_o));
    const int tid = tid_o, lane = tid & 63, wid = __builtin_amdgcn_readfirstlane(tid >> 6), r32 = lane & 31, hi = lane >> 5;
    const int b = unit >> 5, h = (unit >> 2) & 7, eq = unit & 3;
    const size_t gbase = (size_t)b * 2048 * 1024 + h * 128;
    __syncthreads();
    if (wid < 4) {
        const int w = wid;
        const int tq = (lane & 15) >> 2, tc = 16 * ((lane >> 4) & 1) + 4 * (lane & 3);
        f32x16 S = {};
#pragma unroll 1
        for (int i = -1; i <= NCH; ++i) {
            if (i >= 0 && i < NCH) {
                HG_LAS unsigned char* sl = lds + (i & 1) * SLOT_BYTES;
                bf16x8 kdf[2], qaf[2]; s16x4 qp[2][2], vp[2][2], ktf[2][2], vf[2][2]; f32x4 dcv[4];
#pragma unroll
                for (int ks = 0; ks < 2; ++ks) { const int o = qa_off(r32, 32 * w + 16 * ks + 8 * hi), d0 = 32 * w + 16 * ks + 4 * hi, sp = 16 * ks + 4 * hi, sn = 16 * ks + 8 * hi;
                    kdf[ks] = *(const HG_LAS bf16x8*)(sl + S_KD + o); qaf[ks] = *(const HG_LAS bf16x8*)(sl + S_QA + o);
                    qp[ks][0] = *(const HG_LAS s16x4*)(sl + S_QA + qa_off(r32, d0)); qp[ks][1] = *(const HG_LAS s16x4*)(sl + S_QA + qa_off(r32, d0 + 8));
                    vp[ks][0] = trd(sl + S_V + v_off(sp + tq, tc)); vp[ks][1] = trd(sl + S_V + v_off(sp + 8 + tq, tc));
                    ktf[ks][0] = trd(sl + S_KT + kt_off(sn + tq, 32 * w + tc)); ktf[ks][1] = trd(sl + S_KT + kt_off(sn + 4 + tq, 32 * w + tc));
                    vf[ks][0] = trd(sl + S_V + v_off(sn + tq, tc)); vf[ks][1] = trd(sl + S_V + v_off(sn + 4 + tq, tc)); }
#pragma unroll
                for (int g = 0; g < 4; ++g) dcv[g] = *(const HG_LAS f32x4*)(sl + S_DEC + (32 * w + 8 * g + 4 * hi) * 4);
                __builtin_amdgcn_sched_barrier(0);
                const bf16x8 sb0 = pack8(S, 0), sb1 = pack8(S, 8);
                f32x16 X = {}, ow = {};
#pragma unroll
                for (int g = 0; g < 4; ++g)
#pragma unroll
                    for (int q = 0; q < 4; ++q) S[4 * g + q] *= dcv[g][q];
                X = __builtin_amdgcn_mfma_f32_32x32x16_bf16(kdf[0], qaf[0], X, 0, 0, 0);
                ow = __builtin_amdgcn_mfma_f32_32x32x16_bf16(cat64(qp[0][0], qp[0][1]), sb0, ow, 0, 0, 0);
                S = __builtin_amdgcn_mfma_f32_32x32x16_bf16(cat64(ktf[0][0], ktf[0][1]), cat64(vf[0][0], vf[0][1]), S, 0, 0, 0);
                X = __builtin_amdgcn_mfma_f32_32x32x16_bf16(kdf[1], qaf[1], X, 0, 0, 0);
                ow = __builtin_amdgcn_mfma_f32_32x32x16_bf16(cat64(qp[1][0], qp[1][1]), sb1, ow, 0, 0, 0);
                S = __builtin_amdgcn_mfma_f32_32x32x16_bf16(cat64(ktf[1][0], ktf[1][1]), cat64(vf[1][0], vf[1][1]), S, 0, 0, 0);
#pragma unroll
                for (int r = 0; r < 16; ++r) X[r] = (crow(r, hi) <= r32) ? X[r] : 0.f;
                ow = __builtin_amdgcn_mfma_f32_32x32x16_bf16(pack8(X, 0), cat64(vp[0][0], vp[0][1]), ow, 0, 0, 0);
                ow = __builtin_amdgcn_mfma_f32_32x32x16_bf16(pack8(X, 8), cat64(vp[1][0], vp[1][1]), ow, 0, 0, 0);
                { HG_LAS float* op = (HG_LAS float*)(lds + OFF_OPART + (i & 1) * OPART_BYTES + w * 4096) + lane;
#pragma unroll
                  for (int r = 0; r < 16; ++r) op[r * 64] = ow[r]; }
            }
            HG_BAR();
        }
    } else {
        const int pt = tid - 256;
        const int t0 = pt >> 4, d0 = (pt & 15) * 8;
        const int vs = pt >> 3, ve = (pt & 7) * 4;
        u32x4 qaA[2], kdA[2], ktA[2], qaB[2], kdB[2], ktB[2]; u32x2 vA, vB; float dcA = 0.f, dcB = 0.f;
#define HG_LOAD(qa, kd, kt, vr, dc, c) do { const int c_ = (c) < NCH ? (c) : NCH - 1;      \
            const size_t ro_ = gbase + (size_t)c_ * CH * 1024; \
            _Pragma("unroll") for (int k_ = 0; k_ < 2; ++k_) { const size_t o_ = ro_ + (size_t)(t0 + 16 * k_) * 1024 + d0; \
                qa[k_] = *(const u32x4*)(QA + o_); kd[k_] = *(const u32x4*)(KD + o_); kt[k_] = *(const u32x4*)(KT + o_); } \
            vr = *(const u32x2*)(V + ro_ + (size_t)vs * 1024 + eq * 32 + ve); \
            dc = DEC[(size_t)(b * NCH + c_) * 1024 + h * 128 + (pt & 127)]; } while (0)
#define HG_PSTEP(i, RED, PREP, qa, kd, kt, vr, dc) do { \
            if (PREP) { \
                HG_LAS unsigned char* sl = lds + (((i) + 1) & 1) * SLOT_BYTES; \
                _Pragma("unroll") for (int k_ = 0; k_ < 2; ++k_) { const int t_ = t0 + 16 * k_; \
                    *(HG_LAS u32x4*)(sl + S_QA + qa_off(t_, d0)) = qa[k_]; *(HG_LAS u32x4*)(sl + S_KD + qa_off(t_, d0)) = kd[k_]; \
                    *(HG_LAS u32x4*)(sl + S_KT + kt_off(t_, d0)) = kt[k_]; } \
                *(HG_LAS u32x2*)(sl + S_V + v_off(vs, ve)) = vr; \
                *(HG_LAS float*)(sl + S_DEC + (pt & 127) * 4) = dc; \
                HG_LOAD(qa, kd, kt, vr, dc, (i) + 3); } \
            if (RED) { const HG_LAS float* op = (const HG_LAS float*)(lds + OFF_OPART + (((i) - 1) & 1) * OPART_BYTES); \
                const int idx = 4 * pt, reg = idx >> 6, ln = idx & 63; const HG_LAS f32x4* op4 = (const HG_LAS f32x4*)(op + idx); \
                const f32x4 v = (op4[0] + op4[256]) + (op4[512] + op4[768]);              \
                const int t = crow(reg, ln >> 5), e = ln & 31; u32x2 wv; wv.x = cvtpk(v[0], v[1]); wv.y = cvtpk(v[2], v[3]); \
                *(u32x2*)(O + gbase + (size_t)(((i) - 1) * CH + t) * 1024 + eq * 32 + e) = wv; } \
            HG_BAR(); } while (0)
        HG_LOAD(qaA, kdA, ktA, vA, dcA, 0); HG_LOAD(qaB, kdB, ktB, vB, dcB, 1);
        HG_PSTEP(-1, false, true, qaA, kdA, ktA, vA, dcA); HG_PSTEP(0, false, true, qaB, kdB, ktB, vB, dcB);
#pragma unroll 1
        for (int i = 1; i + 1 < NCH; i += 2) { HG_PSTEP(i, true, true, qaA, kdA, ktA, vA, dcA); HG_PSTEP(i + 1, true, true, qaB, kdB, ktB, vB, dcB); }
        HG_PSTEP(NCH - 1, true, false, qaA, kdA, ktA, vA, dcA); HG_PSTEP(NCH, true, false, qaB, kdB, ktB, vB, dcB);
#undef HG_PSTEP
#undef HG_LOAD
    }
}
#undef HG_LAS
#undef HG_BAR
}

#define GAS __attribute__((address_space(1)))
#define LAS __attribute__((address_space(3)))
typedef unsigned short bf16;
typedef unsigned v4u __attribute__((ext_vector_type(4)));
typedef float f32x4 __attribute__((ext_vector_type(4)));
typedef short bf16x8 __attribute__((ext_vector_type(8)));
typedef GAS unsigned gu32;
typedef GAS unsigned long long gu64;
#define RLX_AGENT __ATOMIC_RELAXED, __HIP_MEMORY_SCOPE_AGENT
#define LDS_WAIT() asm volatile("s_waitcnt lgkmcnt(0)" ::: "memory")
#define VM_WAIT() asm volatile("s_waitcnt vmcnt(0)" ::: "memory")
__device__ __forceinline__ unsigned long long rt() { return __builtin_amdgcn_s_memrealtime(); }
__device__ __forceinline__ unsigned f2bf(float f) { unsigned u = __builtin_bit_cast(unsigned, f); return (u + 0x7fffu + ((u >> 16) & 1u)) >> 16; }
__device__ __forceinline__ unsigned pk2(float lo, float hi) { return f2bf(lo) | (f2bf(hi) << 16); }

#define XB_TMO      128
#define XB_XCNT(j)  (256  + 64 * (j))
#define XB_XSUB(j)  (1280 + 64 * (j))
#define XB_XGEN(j)  (2304 + 64 * (j))
#define XB_TOP      3328
#define XB_TOPGEN   3392
#define XCD_BAR_WORDS 3456
#define XB_SPIN_CAP (1u << 18)

__device__ __forceinline__ unsigned xb_ld(unsigned* p)              { return __hip_atomic_load(p, __ATOMIC_RELAXED, __HIP_MEMORY_SCOPE_AGENT); }
__device__ __forceinline__ unsigned xb_add(unsigned* p, unsigned v) { return __hip_atomic_fetch_add(p, v, __ATOMIC_RELAXED, __HIP_MEMORY_SCOPE_AGENT); }
__device__ __forceinline__ unsigned xb_xcc_id() { return (unsigned)__builtin_amdgcn_s_getreg((3 << 11) | 20) & 0xFu; }
#define XB_SPIN(cond, bar) do { unsigned _sp = 0; while (cond) { __builtin_amdgcn_s_sleep(1); \
    if ((++_sp & 255u) == 0u) { if (xb_ld(&(bar)[XB_TMO])) break; if (_sp > XB_SPIN_CAP) { atomicAdd(&(bar)[XB_TMO], 1u); break; } } } } while (0)

struct XcdBarrier {
    unsigned* bar; unsigned x;
    volatile LAS unsigned* st;
};

__device__ __forceinline__ XcdBarrier xcd_barrier_post(unsigned* bar, volatile LAS unsigned* st) {
    XcdBarrier b; b.bar = bar; b.x = xb_xcc_id(); b.st = st;
    if (threadIdx.x == 0) (void)xb_add(&bar[XB_XCNT(b.x)], 1u);
    return b;
}
__device__ __forceinline__ void xcd_barrier_complete(unsigned* bar, unsigned x, unsigned& nloc, unsigned& nx) {
    const unsigned G = gridDim.x * gridDim.y * gridDim.z;
    unsigned sum, cnt, mine, sp = 0u;
    for (;;) {
        sum = 0u; cnt = 0u; mine = 0u;
#pragma unroll
        for (unsigned j = 0; j < 16; ++j) { const unsigned c = xb_ld(&bar[XB_XCNT(j)]); sum += c; cnt += (c > 0u) ? 1u : 0u; mine = (j == x) ? c : mine; }
        if (sum == G) break;
        __builtin_amdgcn_s_sleep(1);
        if ((++sp & 255u) == 0u) { if (xb_ld(&bar[XB_TMO])) break; if (sp > XB_SPIN_CAP) { atomicAdd(&bar[XB_TMO], 1u); break; } }
    }
    nloc = mine > 0u ? mine : 1u; nx = cnt > 0u ? cnt : 1u;
}

__device__ __forceinline__ void xcd_barrier(const XcdBarrier& b) {
    asm volatile("s_waitcnt vmcnt(0)" ::: "memory");
    __syncthreads();
    if (threadIdx.x == 0) {
        unsigned* bar = b.bar;
        __builtin_amdgcn_s_waitcnt(0);
        unsigned nloc = b.st[0], nx = b.st[1];
        if (nloc == 0u) { xcd_barrier_complete(bar, b.x, nloc, nx); b.st[0] = nloc; b.st[1] = nx; }
        const unsigned old = xb_add(&bar[XB_XSUB(b.x)], 1u);
        const unsigned gen = old / nloc;
        if (old + 1u == (gen + 1u) * nloc) {
            __builtin_amdgcn_fence(__ATOMIC_RELEASE, "agent");
            asm volatile("s_waitcnt vmcnt(0)" ::: "memory");
            const unsigned og = xb_add(&bar[XB_TOP], 1u);
            const unsigned tg = og / nx;
            if (og + 1u == (tg + 1u) * nx) xb_add(&bar[XB_TOPGEN], 1u);
            else XB_SPIN(xb_ld(&bar[XB_TOPGEN]) == tg, bar);
            __builtin_amdgcn_fence(__ATOMIC_ACQUIRE, "agent");
            xb_add(&bar[XB_XGEN(b.x)], 1u);
            asm volatile("s_waitcnt vmcnt(0)" ::: "memory");
        } else {
            XB_SPIN(xb_ld(&bar[XB_XGEN(b.x)]) == gen, bar);
            __builtin_amdgcn_fence(__ATOMIC_ACQUIRE, "agent");
            asm volatile("s_waitcnt vmcnt(0)" ::: "memory");
        }
    }
    __syncthreads();
}

#ifndef L0_SPLIT
#define L0_SPLIT 1
#endif

#ifndef TS_P0
#define TS_P0 0
#endif

#ifndef FUSE_FINAL_NORM
#define FUSE_FINAL_NORM 0
#endif

#ifndef TS_CLOCK
#define TS_CLOCK 0
#endif

#ifndef TS_PHASE_END
#define TS_PHASE_END -1
#endif

#ifndef TS_AFTER_BAR
#define TS_AFTER_BAR 0
#endif

#ifndef TS_PHASE
#define TS_PHASE -1
#endif
#ifndef TS_DIV
#define TS_DIV 1000.0f
#endif

#ifndef PROBE_P0
#define PROBE_P0 0
#endif

constexpr int NWAVES = 8;
constexpr int BATCH = 8, SEQ = 2048, D = 1024, DEPTH = 4, M = BATCH * SEQ;
constexpr int FOXH = 8, FOXD = 64, FOXW = 512, CONVW = 512, AB_COLS = 3080, AB_N = 3072;
constexpr int HGH = 8, HGD = 128, C_COLS = 4096;
constexpr int FFH = 2816, FF2 = 5632;
constexpr float EPS = 1e-6f;
constexpr float LOG2E = 1.4426950408889634f;
constexpr float QSCALE = 0.125f * LOG2E;

constexpr size_t MiB = 1u << 20;
constexpr size_t WS_CTL = 0, CTL_ZERO_BYTES = 64 * 1024;
constexpr size_t WS_SSQ = 1 * MiB;
constexpr size_t WS_CL = 2 * MiB;
constexpr size_t WS_BT = WS_CL + 512 * 1024;
constexpr size_t WS_WF = WS_BT + 64 * 1024;
constexpr size_t WS_LB = WS_WF + 64 * 1024;
constexpr size_t WS_W = 4 * MiB;
constexpr size_t W_ABIN = 0, SZ_ABIN = (size_t)AB_N * D * 2;
constexpr size_t W_ABOUT = W_ABIN + 2 * SZ_ABIN, SZ_ABOUT = (size_t)D * D * 2;
constexpr size_t W_CIN = W_ABOUT + 2 * SZ_ABOUT, SZ_CIN = (size_t)C_COLS * D * 2;
constexpr size_t W_COUT = W_CIN + 2 * SZ_CIN, SZ_COUT = (size_t)D * D * 2;
constexpr size_t W_FIN = W_COUT + 2 * SZ_COUT, SZ_FIN = (size_t)FF2 * D * 2;
constexpr size_t W_FOUT = W_FIN + 4 * SZ_FIN, SZ_FOUT = (size_t)D * FFH * 2;
constexpr size_t W_END = W_FOUT + 4 * SZ_FOUT;
static_assert(WS_W + W_END <= 108 * MiB, "weights region");
constexpr size_t WS_XB = 108 * MiB;
constexpr size_t WS_MIX = 140 * MiB;
constexpr size_t WS_H = WS_MIX;
constexpr size_t WS_QKVU = WS_MIX, T512 = (size_t)M * 512 * 2, WS_AO = WS_MIX + 6 * T512;
constexpr size_t WS_KD = WS_MIX, WS_KT = WS_MIX + 32 * MiB, WS_HQ = WS_MIX + 64 * MiB, WS_HV = WS_HQ + 32 * MiB, WS_HG = WS_HV + 32 * MiB, WS_HO = WS_HG + 32 * MiB, WS_DEC = WS_HO + 32 * MiB, WS_END = WS_DEC + 2 * MiB;
static_assert(WS_END <= 352 * MiB, "workspace budget");
constexpr int CW_TMO = 0, CW_BAR = 4096, CW_FIN = 8192;
constexpr size_t WS_XS = 3 * MiB;

constexpr int RING_OFF = 0, RING_BYTES = 131072;
constexpr int LDSCTL_OFF = RING_BYTES, MISC_OFF = LDSCTL_OFF + 320;
constexpr int LDS_BYTES = 147456;
static_assert(MISC_OFF + 128 <= LDS_BYTES, "LDS map");
static_assert(attn_body::ATTN_LDS_BYTES <= RING_BYTES && hg::LDS_BYTES <= RING_BYTES, "mixer LDS inside the ring region");

struct Args { const float* in[14]; float* out; unsigned char* ws; int ph_lo, ph_hi, li, pad; };
typedef const __attribute__((address_space(4))) Args* KArgP;

struct Frame {
    LAS unsigned char* lds; volatile LAS unsigned* MISC; gu32* ctl;
    int wave, vcu, G;
};
#define LANE_IDS() int tid_l = threadIdx.x; asm volatile("" : "+v"(tid_l)); const int TID = tid_l, LANE = tid_l & 63
__device__ __forceinline__ float wave_sum(float v) {
#pragma unroll
    for (int o = 1; o < 64; o <<= 1) v += __shfl_xor(v, o);
    return v;
}
__device__ __forceinline__ float bf_lo(unsigned w) { return __uint_as_float(w << 16); }
__device__ __forceinline__ float bf_hi(unsigned w) { return __uint_as_float(w & 0xffff0000u); }

struct WItem { const float* W; const float* gain; bf16* WT; int ldn, ksrc0, nsrc0, K, drow0; };
constexpr int I_ABIN = 16 * (AB_N / 32), I_SQ = 16 * (D / 32), I_CIN = 16 * (C_COLS / 32), I_FIN = 16 * (FF2 / 32), I_FOUT = (FFH / 64) * (D / 32);
__host__ __device__ constexpr int layer_items(int l) { return ((l & 1) ? I_CIN : I_ABIN) + I_SQ + I_FIN + I_FOUT; }
__device__ __forceinline__ WItem layer_item(const Args& a, int l, int it) {
    unsigned char* wb = a.ws + WS_W; const int j = l >> 1; WItem w;
    const int n_in = (l & 1) ? I_CIN : I_ABIN;
    if (it < n_in) {
        if (l & 1) { const int nb = it % 128, kb = it / 128, c0 = 32 * nb;
            const int drow = c0 < 1024 ? 256 * (c0 / 128) + (c0 % 128) : (c0 < 2048 ? 256 * ((c0 - 1024) / 128) + 128 + ((c0 - 1024) % 128) : c0);
            w = WItem{a.in[8] + (size_t)j * D * C_COLS, a.in[1] + (size_t)l * D, (bf16*)(wb + W_CIN + j * SZ_CIN), C_COLS, 64 * kb, c0, D, drow}; }
        else { const int nb = it % (AB_N / 32), kb = it / (AB_N / 32), n0 = 32 * nb;
            w = WItem{a.in[4] + (size_t)j * D * AB_COLS, a.in[1] + (size_t)l * D, (bf16*)(wb + W_ABIN + j * SZ_ABIN), AB_COLS, 64 * kb, n0 + (n0 >= 1536 ? 8 : 0), D, n0}; }
        return w; }
    it -= n_in;
    if (it < I_SQ) { const int nb = it % 32, kb = it / 32;
        w = WItem{((l & 1) ? a.in[11] : a.in[7]) + (size_t)j * D * D, nullptr, (bf16*)(wb + ((l & 1) ? W_COUT + j * SZ_COUT : W_ABOUT + j * SZ_ABOUT)), D, 64 * kb, 32 * nb, D, 32 * nb}; return w; }
    it -= I_SQ;
    if (it < I_FIN) { const int nb = it % (FF2 / 32), kb = it / (FF2 / 32), c0 = 32 * nb;
        const int drow = c0 < FFH ? 256 * (c0 / 128) + (c0 % 128) : 256 * ((c0 - FFH) / 128) + 128 + ((c0 - FFH) % 128);
        w = WItem{a.in[12] + (size_t)l * D * FF2, a.in[2] + (size_t)l * D, (bf16*)(wb + W_FIN + l * SZ_FIN), FF2, 64 * kb, c0, D, drow}; return w; }
    it -= I_FIN;
    { const int nb = it % 32, kb = it / 32;
      w = WItem{a.in[13] + (size_t)l * FFH * D, nullptr, (bf16*)(wb + W_FOUT + l * SZ_FOUT), D, 64 * kb, 32 * nb, FFH, 32 * nb}; }
    return w;
}
__device__ __forceinline__ void witem_load(const WItem& w, f32x4 (&r)[8], int lane) {
    const int n4 = (lane & 7) * 4;
#pragma unroll
    for (int i = 0; i < 8; ++i) { const int kk = 8 * i + (lane >> 3); r[i] = *(const f32x4*)(w.W + (size_t)(w.ksrc0 + kk) * w.ldn + w.nsrc0 + n4); }
}
__device__ __forceinline__ void witem_finish(const WItem& w, const f32x4 (&r)[8], LAS float* scr, int lane) {
    const int n4 = (lane & 7) * 4;
#pragma unroll
    for (int i = 0; i < 8; ++i) { const int kk = 8 * i + (lane >> 3); f32x4 v = r[i]; if (w.gain) v = v * w.gain[w.ksrc0 + kk];
        LAS float* s = scr + kk * 33 + n4; s[0] = v[0]; s[1] = v[1]; s[2] = v[2]; s[3] = v[3]; }
    LDS_WAIT(); asm volatile("" ::: "memory");
    const int c = lane & 7;
#pragma unroll
    for (int j = 0; j < 4; ++j) { const int n = (lane >> 3) + 8 * j; const LAS float* s = scr + (8 * c) * 33 + n;
        v4u o; o.x = pk2(s[0 * 33], s[1 * 33]); o.y = pk2(s[2 * 33], s[3 * 33]); o.z = pk2(s[4 * 33], s[5 * 33]); o.w = pk2(s[6 * 33], s[7 * 33]);
        *(v4u*)(w.WT + (size_t)(w.drow0 + n) * w.K + w.ksrc0 + 8 * c) = o; }
    LDS_WAIT(); asm volatile("" ::: "memory");
}
__device__ __forceinline__ void convert_layer_weights(Frame& F, const Args& a, int l, int gw, int ngw, int it_lo = 0, int it_hi = 1 << 30) {
    LANE_IDS(); (void)TID;
    LAS float* scr = (LAS float*)(F.lds + RING_OFF + F.wave * 16384);
    const int n = layer_items(l) < it_hi ? layer_items(l) : it_hi; int it = it_lo + gw; if (it >= n) return;
    WItem cur = layer_item(a, l, it); f32x4 rc[8], rn[8]; witem_load(cur, rc, LANE);
    for (;;) { const int itn = it + ngw; const bool more = itn < n; WItem nxt = cur;
        if (more) { nxt = layer_item(a, l, itn); witem_load(nxt, rn, LANE); }
        witem_finish(cur, rc, scr, LANE);
        if (!more) break;
#pragma unroll
        for (int i = 0; i < 8; ++i) rc[i] = rn[i];
        cur = nxt; it = itn; }
}
__device__ __forceinline__ void p0_prologue(Frame& F, const Args& a) {
    LANE_IDS();
    const int gw = F.vcu * NWAVES + F.wave, NGW = F.G * NWAVES;
    unsigned char* ws = a.ws;
    if (TS_P0 && blockIdx.x == 0 && TID == 0) __hip_atomic_store((unsigned*)(a.ws + WS_CTL) + 17, (unsigned)__builtin_amdgcn_s_memrealtime(), __ATOMIC_RELAXED, __HIP_MEMORY_SCOPE_AGENT);
    for (int r_ = 0; r_ < ((PROBE_P0 & 1) ? 2 : 1); ++r_)
    convert_layer_weights(F, a, 0, gw, NGW, 0, L0_SPLIT ? I_ABIN : (1 << 30));
#if !WCONV_IN_FFN_TAIL
    for (int l = 1; l < DEPTH; ++l) convert_layer_weights(F, a, l, gw, NGW);
#endif
    if (TS_P0 == 1 && blockIdx.x == 0 && TID == 0) __hip_atomic_store((unsigned*)(a.ws + WS_CTL) + 16, (unsigned)__builtin_amdgcn_s_memrealtime() - __hip_atomic_load((unsigned*)(a.ws + WS_CTL) + 17, __ATOMIC_RELAXED, __HIP_MEMORY_SCOPE_AGENT), __ATOMIC_RELAXED, __HIP_MEMORY_SCOPE_AGENT);
    for (int r_ = 0; r_ < ((PROBE_P0 & 2) ? 2 : 1); ++r_)
    { const float* __restrict__ x = a.in[0]; bf16* __restrict__ xb = (bf16*)(ws + WS_XB); float* __restrict__ ssq = (float*)(ws + WS_SSQ);
      f32x4 v[2][4], vn[2][4];
#pragma unroll
      for (int h = 0; h < 2; ++h) { const int m0 = gw + h * NGW; const int mr = m0 < M ? m0 : gw; const f32x4* xr = (const f32x4*)(x + (size_t)mr * D) + LANE;
#pragma unroll
        for (int j = 0; j < 4; ++j) v[h][j] = xr[64 * j]; }
      for (int m = gw; m < M; m += 2 * NGW) {
#pragma unroll
        for (int h = 0; h < 2; ++h) { const int mn0 = m + (2 + h) * NGW; const int mn = mn0 < M ? mn0 : gw; const f32x4* xr = (const f32x4*)(x + (size_t)mn * D) + LANE;
#pragma unroll
          for (int j = 0; j < 4; ++j) vn[h][j] = xr[64 * j]; }
#pragma unroll
        for (int h = 0; h < 2; ++h) { const int mm = m + h * NGW; if (mm < M) { float s = 0.f;
          unsigned long long* o8 = (unsigned long long*)(xb + (size_t)mm * D) + LANE;
#pragma unroll
          for (int j = 0; j < 4; ++j) { const unsigned w0 = pk2(v[h][j][0], v[h][j][1]), w1 = pk2(v[h][j][2], v[h][j][3]); o8[64 * j] = (unsigned long long)w0 | ((unsigned long long)w1 << 32);
              const float r0 = bf_lo(w0), r1 = bf_hi(w0), r2 = bf_lo(w1), r3 = bf_hi(w1); s += (r0 * r0 + r1 * r1) + (r2 * r2 + r3 * r3); }
          s = wave_sum(s);
          if (LANE < 16) ssq[(size_t)mm * 16 + LANE] = LANE == 0 ? s : 0.f; } }
#pragma unroll
        for (int h = 0; h < 2; ++h)
#pragma unroll
          for (int j = 0; j < 4; ++j) v[h][j] = vn[h][j];
      } }
    if (TS_P0 == 2 && blockIdx.x == 0 && TID == 0) __hip_atomic_store((unsigned*)(a.ws + WS_CTL) + 16, (unsigned)__builtin_amdgcn_s_memrealtime() - __hip_atomic_load((unsigned*)(a.ws + WS_CTL) + 17, __ATOMIC_RELAXED, __HIP_MEMORY_SCOPE_AGENT), __ATOMIC_RELAXED, __HIP_MEMORY_SCOPE_AGENT);
    for (int r_ = 0; r_ < ((PROBE_P0 & 4) ? 2 : 1); ++r_)
    { const int gt = (F.vcu * NWAVES + F.wave) * 64 + LANE, NGT = NGW * 64; float* wf = (float*)(ws + WS_WF); float* lb = (float*)(ws + WS_LB);
      for (int i = gt; i < 2 * 8 * D; i += NGT) { const int j = i / (8 * D), h = (i / D) % 8, k = i % D; wf[i] = a.in[4][(size_t)j * D * AB_COLS + (size_t)k * AB_COLS + 1536 + h] * a.in[1][(2 * j) * D + k]; }
      for (int i = gt; i < D; i += NGT) { const float c0 = a.in[9][i], c1 = a.in[9][D + i]; lb[i] = 0.f; lb[D + i] = 1.0f / (1.0f + expf(c0 - c1)); } }
}

__device__ __forceinline__ void fgate_job(Frame& F, const Args& a, int j, int jb) {
    LANE_IDS();
    unsigned char* ws = a.ws; const float* wf = (const float*)(ws + WS_WF) + (size_t)j * 8 * D; const float* ssq = (const float*)(ws + WS_SSQ); const bf16* xb = (const bf16*)(ws + WS_XB);
    float* cl = (float*)(ws + WS_CL); float* bt = (float*)(ws + WS_BT); const float* bias = a.in[5] + j * 8;
    LAS float* tmp = (LAS float*)(F.lds + RING_OFF);
    f32x4 w[8][4];
#pragma unroll
    for (int h = 0; h < 8; ++h)
#pragma unroll
        for (int q = 0; q < 4; ++q) w[h][q] = *(const f32x4*)(wf + (size_t)h * D + (q >> 1) * 512 + 8 * LANE + 4 * (q & 1));
    v4u v[2], vn[2];
    { const v4u* xr = (const v4u*)(xb + (size_t)(jb * 64 + F.wave * 8) * D) + LANE; v[0] = xr[0]; v[1] = xr[64]; }
#pragma unroll 1
    for (int i = 0; i < 8; ++i) { const int rl = F.wave * 8 + i, row = jb * 64 + rl;
        { const v4u* xr = (const v4u*)(xb + (size_t)(row + (i < 7 ? 1 : 0)) * D) + LANE; vn[0] = xr[0]; vn[1] = xr[64]; }
        const float rs = pg8::row_rstd(ssq, row); float s8[8]; f32x4 xf[4];
#pragma unroll
        for (int q = 0; q < 4; ++q) { const unsigned a0 = v[q >> 1][2 * (q & 1)], a1 = v[q >> 1][2 * (q & 1) + 1]; xf[q] = (f32x4){bf_lo(a0), bf_hi(a0), bf_lo(a1), bf_hi(a1)}; }
#pragma unroll
        for (int h = 0; h < 8; ++h) { float s = 0.f;
#pragma unroll
            for (int q = 0; q < 4; ++q) s += (xf[q][0] * w[h][q][0] + xf[q][1] * w[h][q][1]) + (xf[q][2] * w[h][q][2] + xf[q][3] * w[h][q][3]);
            s8[h] = s; }
#pragma unroll
        for (int h = 0; h < 4; ++h) { const float a = s8[2 * h], b = s8[2 * h + 1]; const bool up = (LANE & 1) != 0; const float send = up ? a : b, keep = up ? b : a; s8[h] = keep + __shfl_xor(send, 1); }
#pragma unroll
        for (int h = 0; h < 2; ++h) { const float a = s8[2 * h], b = s8[2 * h + 1]; const bool up = (LANE & 2) != 0; const float send = up ? a : b, keep = up ? b : a; s8[h] = keep + __shfl_xor(send, 2); }
        { const float a = s8[0], b = s8[1]; const bool up = (LANE & 4) != 0; const float send = up ? a : b, keep = up ? b : a; s8[0] = keep + __shfl_xor(send, 4); }
        float mine = s8[0]; mine += __shfl_xor(mine, 8); mine += __shfl_xor(mine, 16); mine += __shfl_xor(mine, 32);
        const int hd = LANE & 7;
        if (LANE < 8) { const float z = mine * rs + bias[hd]; tmp[rl * 8 + hd] = fminf(z, 0.f) - log1pf(expf(-fabsf(z))); }
        v[0] = vn[0]; v[1] = vn[1];
    }
    LDS_WAIT(); __syncthreads();
    { const int h = F.wave; float c = tmp[LANE * 8 + h];
#pragma unroll
      for (int o = 1; o < 64; o <<= 1) { const float n = __shfl_up(c, o); if (LANE >= o) c += n; }
      cl[(size_t)(jb * 64 + LANE) * 8 + h] = c; if (LANE == 63) bt[jb * 8 + h] = c; }
    __syncthreads();
}

__device__ __forceinline__ void conv_job(Frame& F, const Args& a, int j, int jb) {
    LANE_IDS();
    unsigned char* ws = a.ws; const bf16* __restrict__ ub = (const bf16*)(ws + WS_QKVU + 3 * T512); const bf16* __restrict__ uc = (const bf16*)(ws + WS_QKVU + 4 * T512); const bf16* __restrict__ ux = (const bf16*)(ws + WS_QKVU + 5 * T512);
    bf16* __restrict__ ao = (bf16*)(ws + WS_AO); const float* __restrict__ cw = a.in[6] + (size_t)j * 3 * CONVW;
#pragma unroll 4
    for (int it = TID; it < 64 * 64; it += NWAVES * 64) { const int rl = it >> 6, ch = (it & 63) * 8, row = jb * 64 + rl, t = row & (SEQ - 1);
        float z[3][8];
#pragma unroll
        for (int d = 0; d < 3; ++d) { const int tt = t - 2 + d;
            if (tt >= 0) { const v4u cv = *(const v4u*)(uc + (size_t)(row - 2 + d) * 512 + ch), xv = *(const v4u*)(ux + (size_t)(row - 2 + d) * 512 + ch);
#pragma unroll
                for (int q = 0; q < 4; ++q) { z[d][2 * q] = bf_lo(cv[q]) * bf_lo(xv[q]); z[d][2 * q + 1] = bf_hi(cv[q]) * bf_hi(xv[q]); } }
            else {
#pragma unroll
                for (int q = 0; q < 8; ++q) z[d][q] = 0.f; } }
        const v4u bv = *(const v4u*)(ub + (size_t)row * 512 + ch); float y[8];
#pragma unroll
        for (int q = 0; q < 8; ++q) { const float b = (q & 1) ? bf_hi(bv[q >> 1]) : bf_lo(bv[q >> 1]);
            y[q] = b * (cw[ch + q] * z[0][q] + cw[CONVW + ch + q] * z[1][q] + cw[2 * CONVW + ch + q] * z[2][q]); }
        v4u o; o.x = pk2(y[0], y[1]); o.y = pk2(y[2], y[3]); o.z = pk2(y[4], y[5]); o.w = pk2(y[6], y[7]);
        *(v4u*)(ao + (size_t)row * D + 512 + ch) = o; }
}

__device__ __forceinline__ void attn_naive_unit(Frame& F, const Args& a, int unit) {
    LANE_IDS();
    unsigned char* ws = a.ws; const bf16* Q = (const bf16*)(ws + WS_QKVU); const bf16* K = (const bf16*)(ws + WS_QKVU + T512); const bf16* V = (const bf16*)(ws + WS_QKVU + 2 * T512);
    bf16* ao = (bf16*)(ws + WS_AO); const float* cl = (const float*)(ws + WS_CL); const float* bt = (const float*)(ws + WS_BT);
    const int b = unit >> 5, h = (unit >> 2) & 7, blk = unit & 3;
    LAS float* beta = (LAS float*)(F.lds + RING_OFF);
    LAS float* pre = beta + 2048;
    __syncthreads();
    if (TID == 0) { float c = 0.f; for (int i = 0; i < 32; ++i) { pre[i] = c; c += bt[(b * 32 + i) * 8 + h]; } }
    LDS_WAIT(); __syncthreads();
    for (int s = TID; s < SEQ; s += NWAVES * 64) beta[s] = -(pre[s >> 6] + cl[(size_t)(b * SEQ + s) * 8 + h]) * LOG2E;
    LDS_WAIT(); __syncthreads();
    const int t = blk * 512 + TID; const size_t rowq = (size_t)(b * SEQ + t);
    float q[64], o[64];
#pragma unroll
    for (int c = 0; c < 8; ++c) { const v4u w = *(const v4u*)(Q + rowq * 512 + h * 64 + 8 * c);
#pragma unroll
        for (int i = 0; i < 4; ++i) { q[8 * c + 2 * i] = bf_lo(w[i]); q[8 * c + 2 * i + 1] = bf_hi(w[i]); } }
#pragma unroll
    for (int d = 0; d < 64; ++d) o[d] = 0.f;
    float mx = -INFINITY, l = 0.f;
    const int send = blk * 512 + 511;
    for (int s = 0; s <= send; ++s) {
        const bf16* kr = K + (size_t)(b * SEQ + s) * 512 + h * 64; const bf16* vr = V + (size_t)(b * SEQ + s) * 512 + h * 64;
        float sc = 0.f;
#pragma unroll
        for (int c = 0; c < 8; ++c) { const v4u w = *(const v4u*)(kr + 8 * c);
#pragma unroll
            for (int i = 0; i < 4; ++i) sc += q[8 * c + 2 * i] * bf_lo(w[i]) + q[8 * c + 2 * i + 1] * bf_hi(w[i]); }
        sc += beta[s];
        if (s <= t) {
            const float mn = fmaxf(mx, sc), f = exp2f(mx - mn), p = exp2f(sc - mn); mx = mn; l = l * f + p;
#pragma unroll
            for (int c = 0; c < 8; ++c) { const v4u w = *(const v4u*)(vr + 8 * c);
#pragma unroll
                for (int i = 0; i < 4; ++i) { o[8 * c + 2 * i] = o[8 * c + 2 * i] * f + p * bf_lo(w[i]); o[8 * c + 2 * i + 1] = o[8 * c + 2 * i + 1] * f + p * bf_hi(w[i]); } }
        }
    }
    const float rl = 1.0f / l;
#pragma unroll
    for (int c = 0; c < 8; ++c) { v4u w; w.x = pk2(o[8 * c] * rl, o[8 * c + 1] * rl); w.y = pk2(o[8 * c + 2] * rl, o[8 * c + 3] * rl); w.z = pk2(o[8 * c + 4] * rl, o[8 * c + 5] * rl); w.w = pk2(o[8 * c + 6] * rl, o[8 * c + 7] * rl);
        *(v4u*)(ao + rowq * D + h * 64 + 8 * c) = w; }
}

__device__ __forceinline__ void hgrn_gate(Frame& F, const Args& a, int j) {
    LANE_IDS();
    unsigned char* ws = a.ws; const bf16* __restrict__ O = (const bf16*)(ws + WS_HO); const bf16* __restrict__ G = (const bf16*)(ws + WS_HG); bf16* __restrict__ AOP = (bf16*)(ws + WS_HQ); const float* __restrict__ hn = a.in[10] + (size_t)j * D;
    const int gw = F.vcu * NWAVES + F.wave, NGW = F.G * NWAVES; (void)TID;
#pragma unroll 4
    for (int m = gw; m < M; m += NGW) {
#pragma unroll
        for (int jj = 0; jj < 2; ++jj) { const int c = (4 * jj + (LANE >> 4)) * HGD + 8 * (LANE & 15); const size_t off = (size_t)m * D + c;
            const v4u ow = *(const v4u*)(O + off), gv = *(const v4u*)(G + off); float o[8], g[8];
#pragma unroll
            for (int q = 0; q < 4; ++q) { o[2 * q] = bf_lo(ow[q]); o[2 * q + 1] = bf_hi(ow[q]); g[2 * q] = bf_lo(gv[q]); g[2 * q + 1] = bf_hi(gv[q]); }
            float s = 0.f;
#pragma unroll
            for (int q = 0; q < 8; ++q) s += o[q] * o[q];
            s += __shfl_xor(s, 1); s += __shfl_xor(s, 2); s += __shfl_xor(s, 4); s += __shfl_xor(s, 8);
            const float r = __builtin_amdgcn_rsqf(s * (1.0f / HGD) + EPS); const f32x4 h0 = *(const f32x4*)(hn + c), h1 = *(const f32x4*)(hn + c + 4);
            v4u w; w.x = pk2(o[0] * r * h0[0] * g[0], o[1] * r * h0[1] * g[1]); w.y = pk2(o[2] * r * h0[2] * g[2], o[3] * r * h0[3] * g[3]);
            w.z = pk2(o[4] * r * h1[0] * g[4], o[5] * r * h1[1] * g[5]); w.w = pk2(o[6] * r * h1[2] * g[6], o[7] * r * h1[3] * g[7]);
            *(v4u*)(AOP + off) = w; }
    }
}
__device__ __forceinline__ void final_norm(Frame& F, const Args& a) {
    LANE_IDS(); (void)TID;
    const int gw = F.vcu * NWAVES + F.wave, NGW = F.G * NWAVES; const float* __restrict__ g = a.in[3]; const bf16* __restrict__ xb = (const bf16*)(a.ws + WS_XB); float* __restrict__ outp = a.out;
    f32x4 gv[4];
#pragma unroll
    for (int q = 0; q < 4; ++q) gv[q] = *(const f32x4*)(g + (q >> 1) * 512 + 8 * LANE + 4 * (q & 1));
#pragma unroll 4
    for (int m = gw; m < M; m += NGW) { const v4u* xr = (const v4u*)(xb + (size_t)m * D) + LANE; const v4u v0 = xr[0], v1 = xr[64]; f32x4 x[4]; float s = 0.f;
#pragma unroll
        for (int q = 0; q < 4; ++q) { const unsigned a0 = (q >> 1) ? v1[2 * (q & 1)] : v0[2 * (q & 1)], a1 = (q >> 1) ? v1[2 * (q & 1) + 1] : v0[2 * (q & 1) + 1];
            x[q] = (f32x4){bf_lo(a0), bf_hi(a0), bf_lo(a1), bf_hi(a1)}; s += (x[q][0] * x[q][0] + x[q][1] * x[q][1]) + (x[q][2] * x[q][2] + x[q][3] * x[q][3]); }
        const float r = __builtin_amdgcn_rsqf(wave_sum(s) * (1.0f / D) + EPS); float* orow = outp + (size_t)m * D;
#pragma unroll
        for (int q = 0; q < 4; ++q) { f32x4 ov = x[q] * r * gv[q]; if ((TS_PHASE != -1 || TS_P0) && m == 0 && LANE == 0 && q == 0) ov[0] += (float)__hip_atomic_load((unsigned*)(F.ctl + 16), __ATOMIC_RELAXED, __HIP_MEMORY_SCOPE_AGENT) * (1.0f / TS_DIV);
            *(f32x4*)(orow + (q >> 1) * 512 + 8 * LANE + 4 * (q & 1)) = ov; } }
}

constexpr int N_PHASES = 26;
#ifndef WCONV_IN_FFN_TAIL
#define WCONV_IN_FFN_TAIL 1
#endif
#ifndef PROBE_MASK
#define PROBE_MASK 0
#endif
#ifndef HGRN_NAIVE
#define HGRN_NAIVE 0
#endif
#ifndef ATTN_NAIVE
#define ATTN_NAIVE 0
#endif
#ifndef MK_PER_PHASE
#define MK_PER_PHASE 0
#endif
__global__ void __launch_bounds__(NWAVES * 64, 2) trunk_fwd(Args args) {
    extern __shared__ __attribute__((aligned(16))) unsigned char lds[];
    Frame F_;
    if (TS_PHASE == -2 && blockIdx.x == 0 && threadIdx.x == 0) __hip_atomic_store((unsigned*)(args.ws + WS_CTL) + 17, (unsigned)__builtin_amdgcn_s_memrealtime(), __ATOMIC_RELAXED, __HIP_MEMORY_SCOPE_AGENT);
    F_.lds = (LAS unsigned char*)lds; F_.MISC = (volatile LAS unsigned*)(F_.lds + MISC_OFF);
    F_.wave = __builtin_amdgcn_readfirstlane((int)threadIdx.x >> 6);
    F_.G = gridDim.x; { const int bx = blockIdx.x; F_.vcu = (F_.G % 8 == 0) ? (bx % 8) * (F_.G / 8) + bx / 8 : bx; }
    unsigned char* ws = args.ws; F_.ctl = (gu32*)(ws + WS_CTL);
    for (int u = threadIdx.x; u < (LDS_BYTES - LDSCTL_OFF) / 4; u += NWAVES * 64) ((LAS unsigned*)(F_.lds + LDSCTL_OFF))[u] = 0u;
    __syncthreads();
    const int lo = args.ph_lo, hi = args.ph_hi;
    XcdBarrier bar; bar.bar = (unsigned*)(F_.ctl + CW_BAR); bar.x = 0; bar.st = nullptr;
    if (hi - lo > 1) bar = xcd_barrier_post((unsigned*)(F_.ctl + CW_BAR), F_.MISC + 8);
#pragma unroll 1
    for (int p = lo; p < hi; ++p) {
        const int l = (p - 1) / 6, s = (p - 1) - 6 * l, j = l >> 1; const bool even = (l & 1) == 0, mid = (p >= 1 && p <= 24);
#if defined(__HIP_DEVICE_COMPILE__)
        KArgP ap = (KArgP)__builtin_amdgcn_kernarg_segment_ptr(); asm volatile("" : "+s"(ap));
        Args A2; for (int q_ = 0; q_ < 14; ++q_) A2.in[q_] = (const float*)(const GAS float*)ap->in[q_]; A2.out = (float*)(GAS float*)ap->out; A2.ws = (unsigned char*)(GAS unsigned char*)ap->ws;     A2.ph_lo = lo; A2.ph_hi = hi; A2.li = 0; A2.pad = 0;
#else
        Args A2 = args;
#endif
        Frame FL = F_; { int w_ = F_.wave, v_ = F_.vcu, g_ = F_.G; asm volatile("" : "+s"(w_), "+s"(v_), "+s"(g_)); FL.wave = w_; FL.vcu = v_; FL.G = g_; }
        int bx = blockIdx.x; asm volatile("" : "+s"(bx));
        Frame& F = FL;
        GAS unsigned char* wsg = (GAS unsigned char*)A2.ws; asm volatile("" : "+s"(wsg)); unsigned char* ws = (unsigned char*)wsg; A2.ws = ws;
        bf16* const wb = (bf16*)(ws + WS_W); bf16* const XB = (bf16*)(ws + WS_XB); float* const SSQ = (float*)(ws + WS_SSQ);
        const int cls = p == 0 ? 1 : p == 25 ? 11 : (s == 0 ? (even ? 2 : 3) : s == 1 ? (even ? 4 : 5) : s == 2 ? 6 : s == 3 ? 7 : s == 4 ? 8 : 9);
        if (mid && s == 2 && even) continue;
        const int nrep = ((PROBE_MASK >> cls) & 1) ? 2 : 1;
        if (TS_PHASE == -2 && p == 0 && bx == 0 && threadIdx.x == 0) __hip_atomic_store((unsigned*)(F.ctl + 16), (unsigned)__builtin_amdgcn_s_memrealtime() - __hip_atomic_load((unsigned*)(F.ctl + 17), __ATOMIC_RELAXED, __HIP_MEMORY_SCOPE_AGENT), __ATOMIC_RELAXED, __HIP_MEMORY_SCOPE_AGENT);
        if (TS_PHASE >= 0 && (p == TS_PHASE || p == TS_PHASE_END) && bx == 0 && threadIdx.x == 0) { const unsigned now_ = TS_CLOCK ? (unsigned)__builtin_amdgcn_s_memtime() : (unsigned)__builtin_amdgcn_s_memrealtime();
            if (p == TS_PHASE) __hip_atomic_store((unsigned*)(F.ctl + 17), now_, __ATOMIC_RELAXED, __HIP_MEMORY_SCOPE_AGENT);
            else __hip_atomic_store((unsigned*)(F.ctl + 16), now_ - __hip_atomic_load((unsigned*)(F.ctl + 17), __ATOMIC_RELAXED, __HIP_MEMORY_SCOPE_AGENT), __ATOMIC_RELAXED, __HIP_MEMORY_SCOPE_AGENT); }
#define GRID_BARRIER() do { XcdBarrier b2 = bar; GAS unsigned* bg = (GAS unsigned*)bar.bar; asm volatile("" : "+s"(bg), "+s"(b2.x)); b2.bar = (unsigned*)bg; xcd_barrier(b2); } while (0)
#pragma unroll 1
        for (int rp = 0; rp < nrep; ++rp) { const bool dummy = rp + 1 < nrep; (void)dummy;
        if (p == 0) p0_prologue(F, A2);
        else if (p == 25) { if (!(FUSE_FINAL_NORM && F.G == 256)) final_norm(F, A2); }
        else if (s == 0 && even) {
            pg8::Gemm g{XB, (const bf16*)((unsigned char*)wb + W_ABIN + j * SZ_ABIN), M, AB_N, D}; pg8::StaticOrder S; S.init(M, AB_N, F.G, bx);
            pg8::EpiAB E{(bf16*)(ws + WS_QKVU), (size_t)M * 512, SSQ, QSCALE};
            pg8::gemm_phase<pg8::EpiAB, pg8::StaticOrder, true, true>(F.lds + RING_OFF, g, S, E);
            for (int jb = F.vcu; jb < M / 64; jb += F.G) fgate_job(F, A2, j, jb);
            if (L0_SPLIT && l == 0 && !dummy) convert_layer_weights(F, A2, 0, F.vcu * NWAVES + F.wave, F.G * NWAVES, I_ABIN, I_ABIN + I_SQ + I_FIN);
        } else if (s == 0) {
            pg8::Gemm g{XB, (const bf16*)((unsigned char*)wb + W_CIN + j * SZ_CIN), M, C_COLS, D}; pg8::StaticOrder S; S.init(M, C_COLS, F.G, bx);
            pg8::EpiHG E{(bf16*)(ws + WS_HQ), (bf16*)(ws + WS_KD), (bf16*)(ws + WS_KT), (bf16*)(ws + WS_HV), (size_t)M * D, (float*)(ws + WS_DEC), (const float*)(ws + WS_LB) + (size_t)j * D, SSQ, j == 0};
            static_assert(WS_HG == WS_HV + (size_t)M * D * 2, "V | G consecutive");
            pg8::gemm_phase<pg8::EpiHG, pg8::StaticOrder, true, true>(F.lds + RING_OFF, g, S, E);
        } else if (s == 1 && even) {
            if (F.vcu & 1) for (int jb = F.vcu; jb < M / 64; jb += F.G) conv_job(F, A2, j, jb);
#if ATTN_NAIVE
            for (int u = F.vcu; u < 256; u += F.G) attn_naive_unit(F, A2, u);
#else
            { const attn_body::AttnTensors AT{(const attn_body::bf16*)(ws + WS_QKVU), (const attn_body::bf16*)(ws + WS_QKVU + T512), (const attn_body::bf16*)(ws + WS_QKVU + 2 * T512), (attn_body::bf16*)(ws + WS_AO),
                                               (const float*)(ws + WS_CL), (const float*)(ws + WS_BT)};
              const attn_body::StaticOrder S((int)F.G, bx);
              attn_body::attn_phase<attn_body::StaticOrder>((char*)lds + RING_OFF, AT, S); }
#endif
            if (!(F.vcu & 1)) for (int jb = F.vcu; jb < M / 64; jb += F.G) conv_job(F, A2, j, jb);
            if (L0_SPLIT && l == 0 && !dummy) { __syncthreads(); convert_layer_weights(F, A2, 0, F.vcu * NWAVES + F.wave, F.G * NWAVES, I_ABIN + I_SQ + I_FIN, 1 << 30); }
        } else if (s == 1) {
            for (int u = F.vcu; u < 256; u += F.G) hg::hgrn_unit(F.lds + RING_OFF, (const unsigned short*)(ws + WS_HQ), (const unsigned short*)(ws + WS_KD), (const unsigned short*)(ws + WS_KT), (const float*)(ws + WS_DEC), (const unsigned short*)(ws + WS_HV), (unsigned short*)(ws + WS_HO), u);
        } else if (s == 2) {
            hgrn_gate(F, A2, j);
        } else if (s == 4) {
            pg8::Gemm g{XB, (const bf16*)((unsigned char*)wb + W_FIN + l * SZ_FIN), M, FF2, D}; pg8::StaticOrder S; S.init(M, FF2, F.G, bx);
            pg8::EpiSwi E{(bf16*)(ws + WS_H), SSQ};
            pg8::gemm_phase<pg8::EpiSwi, pg8::StaticOrder, true, true>(F.lds + RING_OFF, g, S, E, (TS_EPI && p == TS_PHASE) ? (unsigned*)(F.ctl + 16) : (unsigned*)(F.ctl + 20));
#if WCONV_IN_FFN_TAIL
            { const int nfull = (M / 256) * (FF2 / 256) - (((M / 256) * (FF2 / 256)) / F.G) * F.G;
              if (l + 1 < DEPTH && !dummy && bx >= nfull) convert_layer_weights(F, A2, l + 1, (bx - nfull) * NWAVES + F.wave, (F.G - nfull) * NWAVES); }
#endif
        } else {
            const bool dn = (s == 5);
            const bf16* A = dn ? (const bf16*)(ws + WS_H) : (even ? (const bf16*)(ws + WS_AO) : (const bf16*)(ws + WS_HQ));
            const size_t wo = dn ? (W_FOUT + l * SZ_FOUT) : (even ? (W_ABOUT + j * SZ_ABOUT) : (W_COUT + j * SZ_COUT));
            pg8::Gemm g{A, (const bf16*)((unsigned char*)wb + wo), M, D, dn ? FFH : D}; pg8::StaticOrder S; S.init(M, D, F.G, bx);
#if FUSE_FINAL_NORM
            if (p == 24 && !dummy && F.G == 256) {
                pg8::EpiResFinal E{XB, A2.out, (float*)(ws + WS_XS), (unsigned*)(F.ctl + CW_FIN), A2.in[3]};
                pg8::gemm_phase<pg8::EpiResFinal, pg8::StaticOrder, true, true>(F.lds + RING_OFF, g, S, E);
            } else
#endif
            { pg8::EpiRes E{XB, dummy ? (bf16*)(ws + WS_MIX + (dn ? 96 * MiB : 0)) : XB, SSQ};
              pg8::gemm_phase<pg8::EpiRes, pg8::StaticOrder, true, true>(F.lds + RING_OFF, g, S, E); }
        }
        if (dummy) GRID_BARRIER();
        }
        if (TS_PHASE_END < 0 && TS_PHASE >= 0 && p == TS_PHASE && bx == 0 && threadIdx.x == 0) { const unsigned dt_ = (unsigned)__builtin_amdgcn_s_memrealtime() - __hip_atomic_load((unsigned*)(F.ctl + 17), __ATOMIC_RELAXED, __HIP_MEMORY_SCOPE_AGENT); __hip_atomic_store((unsigned*)(F.ctl + 16), dt_, __ATOMIC_RELAXED, __HIP_MEMORY_SCOPE_AGENT); }
        if (p + 1 < hi && !(FUSE_FINAL_NORM && F.G == 256 && p >= 24)) { GRID_BARRIER(); if ((PROBE_MASK >> 10) & 1) GRID_BARRIER(); }
    }
}

extern "C" void kernel_launch(void* const* d_in, const int* in_sizes, int n_in, void* d_out, int out_size, void* d_ws, size_t ws_size, hipStream_t stream) {
    static int grid = 0;
    if (grid == 0) {
        if (n_in != 14 || in_sizes[0] != M * D || out_size != M * D || ws_size < WS_END) { fprintf(stderr, "kernel_launch: unexpected shapes / workspace (n_in %d, ws %zu, need %zu)\n", n_in, ws_size, (size_t)WS_END); grid = -1; return; }
        int dev = 0, cus = 0;
        if (hipGetDevice(&dev) != hipSuccess || hipDeviceGetAttribute(&cus, hipDeviceAttributeMultiprocessorCount, dev) != hipSuccess) { grid = -1; return; }
        if (hipFuncSetAttribute((const void*)trunk_fwd, hipFuncAttributeMaxDynamicSharedMemorySize, LDS_BYTES) != hipSuccess) { fprintf(stderr, "kernel_launch: hipFuncSetAttribute failed\n"); grid = -1; return; }
        int per_cu = 0; (void)hipOccupancyMaxActiveBlocksPerMultiprocessor(&per_cu, (const void*)trunk_fwd, NWAVES * 64, LDS_BYTES); (void)hipGetLastError();
        grid = cus;
    }
    if (grid < 0) return;
    (void)hipMemsetAsync((char*)d_ws + WS_CTL, 0, CTL_ZERO_BYTES, stream);
    Args a{};
    for (int i = 0; i < 14; ++i) a.in[i] = (const float*)d_in[i];
    a.out = (float*)d_out; a.ws = (unsigned char*)d_ws;
#if MK_PER_PHASE
    for (int p = 0; p < N_PHASES; ++p) { const int l = (p - 1) / 6, s = (p - 1) % 6; if (p >= 1 && p <= 24 && s == 2 && (l & 1) == 0) continue;
        a.ph_lo = p; a.ph_hi = p + 1; a.li = 0; hipLaunchKernelGGL(trunk_fwd, dim3(grid), dim3(NWAVES * 64), LDS_BYTES, stream, a); }
#else
    a.ph_lo = 0; a.ph_hi = N_PHASES; a.li = 0;
    hipLaunchKernelGGL(trunk_fwd, dim3(grid), dim3(NWAVES * 64), LDS_BYTES, stream, a);
#endif
}
```

```cpp
#include <hip/hip_runtime.h>
#include <cstdio>
#include <cstdint>
#include <cmath>
#ifndef TS_EPI
#define TS_EPI 0
#endif
namespace pg8 {
#define PG8_LAS __attribute__((address_space(3)))
typedef unsigned short bf16_t;
typedef short bf16x8 __attribute__((ext_vector_type(8)));
typedef float f32x4 __attribute__((ext_vector_type(4)));
typedef unsigned u32x4 __attribute__((ext_vector_type(4)));
constexpr int BM = 256, BK = 64, HALF = 128, HTB = HALF * BK * 2  , STAGE_BYTES = 8 * HTB, NXCD = 8, WGM = 4;

__host__ __device__ __forceinline__ int lds_byte(int r, int c) { const int st = (r >> 4) * 2 + (c >> 5), rr = r & 15, cc = c & 31, ob = rr * 64 + cc * 2; return st * 1024 + (ob ^ (((ob >> 9) & 1) << 5)); }
__host__ __device__ __forceinline__ void stage_rc(int b, int& R, int& C) { const int st = b / 1024, sb = b % 1024, swz = sb ^ (((sb >> 9) & 1) << 5); R = (st >> 1) * 16 + swz / 64; C = (st & 1) * 32 + (swz % 64) / 2; }
__host__ __device__ __forceinline__ int perm32(int rho) { const int n = rho >> 4, i = rho & 15; return 8 * (i >> 2) + 4 * n + (i & 3); }

struct Unit { int pm, pn; };
struct Gemm { const bf16_t* A; const bf16_t* Bt; int M, N, K; };

struct StaticOrder {
    int nM, nN, nwg, G, c;
    __host__ __device__ void init(int M, int N, int G_, int c_) { nM = M / BM; nN = N / BM; nwg = nM * nN; G = G_; c = c_; }
    __host__ __device__ bool next(int i, Unit& u) const {
        const long L = (long)i * G + c; if (L >= nwg) return false;
        int wgid = (int)L; { const int q = nwg / NXCD, r = nwg % NXCD, xcd = wgid % NXCD, off = wgid / NXCD; wgid = (xcd < r ? xcd * (q + 1) : r * (q + 1) + (xcd - r) * q) + off; }
        const int nig = WGM * nN, gid = wgid / nig, fm = gid * WGM, gsz = (nM - fm) < WGM ? (nM - fm) : WGM;
        u.pm = fm + ((wgid % nig) % gsz); u.pn = (wgid % nig) / gsz; return true;
    }
    __device__ __forceinline__ void a_ready(const Unit&) const {}
    __device__ __forceinline__ void done(const Unit&) const {}
};


__device__ __forceinline__ unsigned cvt_pk_bf16(float lo, float hi) { unsigned r; asm volatile("v_cvt_pk_bf16_f32 %0, %1, %2" : "=v"(r) : "v"(lo), "v"(hi)); return r; }
typedef unsigned u32x2 __attribute__((ext_vector_type(2)));
constexpr float RMS_EPS = 1e-6f;
__device__ __forceinline__ float row_rstd(const float* ssq, int row) {
    const f32x4* p = (const f32x4*)(ssq + (size_t)row * 16);
    const f32x4 a = p[0], b = p[1], c = p[2], d = p[3];
    const float s = (((a[0] + a[1]) + (a[2] + a[3])) + ((b[0] + b[1]) + (b[2] + b[3]))) + (((c[0] + c[1]) + (c[2] + c[3])) + ((d[0] + d[1]) + (d[2] + d[3])));
    return __builtin_amdgcn_rsqf(s * (1.0f / 1024.0f) + RMS_EPS);
}
__device__ __forceinline__ float row_rstd_q(const float* ssq, int row, int fq) {
    const f32x4 a = *((const f32x4*)(ssq + (size_t)row * 16) + fq);
    float s = (a[0] + a[1]) + (a[2] + a[3]);
    s += __shfl_xor(s, 16); s += __shfl_xor(s, 32);
    return __builtin_amdgcn_rsqf(s * (1.0f / 1024.0f) + RMS_EPS);
}
__device__ __forceinline__ void row_rstd_half(const float* ssq, int rowh, int fq, float (&rs)[4]) {
    f32x4 a[4];
#pragma unroll
    for (int m = 0; m < 4; ++m) a[m] = *((const f32x4*)(ssq + (size_t)(rowh + m * 16) * 16) + fq);
#pragma unroll
    for (int m = 0; m < 4; ++m) { float s = (a[m][0] + a[m][1]) + (a[m][2] + a[m][3]); s += __shfl_xor(s, 16); s += __shfl_xor(s, 32); rs[m] = __builtin_amdgcn_rsqf(s * (1.0f / 1024.0f) + RMS_EPS); }
}
__device__ __forceinline__ float sigmoid_f(float z) { return __builtin_amdgcn_rcpf(1.0f + __expf(-z)); }

struct EpiAB {
    static constexpr bool PERM = true, AFTER_DRAIN = false; static constexpr int NS_MIN = 16;
    bf16_t* O; size_t tstride; const float* ssq; float qscale;
    __device__ __forceinline__ void operator()(const f32x4 (&acc)[2][2][4][2], const Unit& u, int wr, int wc, int fr, int fq) const {
        const int t = u.pn >> 1; bf16_t* base = O + (size_t)t * tstride;
        const int col0 = (u.pn & 1) * 256 + wc * 32 + 8 * fq, row0 = u.pm * BM + wr * 64 + fr;
        const float sc0 = (t == 0) ? qscale : 1.0f;
#pragma unroll
        for (int ai = 0; ai < 2; ++ai) { float rsv[4]; row_rstd_half(ssq, row0 + ai * HALF, fq, rsv);
#pragma unroll
            for (int m = 0; m < 4; ++m) { const int row = row0 + ai * HALF + m * 16; const float rs = rsv[m] * sc0; bf16_t* rowp = base + (size_t)row * 512 + col0;
#pragma unroll
                for (int bj = 0; bj < 2; ++bj) { const f32x4 v0 = acc[ai][bj][m][0] * rs, v1 = acc[ai][bj][m][1] * rs;
                    u32x4 w; w.x = cvt_pk_bf16(v0[0], v0[1]); w.y = cvt_pk_bf16(v0[2], v0[3]); w.z = cvt_pk_bf16(v1[0], v1[1]); w.w = cvt_pk_bf16(v1[2], v1[3]);
                    *(u32x4*)(rowp + bj * HALF) = w; } } }
    }
};
struct EpiRes {
    static constexpr bool PERM = true, AFTER_DRAIN = false; static constexpr int NS_MIN = 16;
    const bf16_t* base; bf16_t* out; float* ssq;
    __device__ __forceinline__ void operator()(const f32x4 (&acc)[2][2][4][2], const Unit& u, int wr, int wc, int fr, int fq) const {
        const int col0 = u.pn * BM + wc * 32 + 8 * fq;
#pragma unroll
        for (int ai = 0; ai < 2; ++ai) {
            u32x4 b[4][2];
#pragma unroll
            for (int m = 0; m < 4; ++m)
#pragma unroll
                for (int bj = 0; bj < 2; ++bj) b[m][bj] = *(const u32x4*)(base + (size_t)(u.pm * BM + ai * HALF + wr * 64 + m * 16 + fr) * 1024 + col0 + bj * HALF);
#pragma unroll
            for (int m = 0; m < 4; ++m) { const int row = u.pm * BM + ai * HALF + wr * 64 + m * 16 + fr; const size_t off = (size_t)row * 1024 + col0; float s = 0.f;
#pragma unroll
                for (int bj = 0; bj < 2; ++bj) { const u32x4 bb = b[m][bj]; f32x4 x0 = acc[ai][bj][m][0], x1 = acc[ai][bj][m][1];
                    x0[0] += __uint_as_float(bb.x << 16); x0[1] += __uint_as_float(bb.x & 0xffff0000u); x0[2] += __uint_as_float(bb.y << 16); x0[3] += __uint_as_float(bb.y & 0xffff0000u);
                    x1[0] += __uint_as_float(bb.z << 16); x1[1] += __uint_as_float(bb.z & 0xffff0000u); x1[2] += __uint_as_float(bb.w << 16); x1[3] += __uint_as_float(bb.w & 0xffff0000u);
                    u32x4 w; w.x = cvt_pk_bf16(x0[0], x0[1]); w.y = cvt_pk_bf16(x0[2], x0[3]); w.z = cvt_pk_bf16(x1[0], x1[1]); w.w = cvt_pk_bf16(x1[2], x1[3]);
                    *(u32x4*)(out + off + bj * HALF) = w;
                    const float r0 = __uint_as_float(w.x << 16), r1 = __uint_as_float(w.x & 0xffff0000u), r2 = __uint_as_float(w.y << 16), r3 = __uint_as_float(w.y & 0xffff0000u);
                    const float r4 = __uint_as_float(w.z << 16), r5 = __uint_as_float(w.z & 0xffff0000u), r6 = __uint_as_float(w.w << 16), r7 = __uint_as_float(w.w & 0xffff0000u);
                    s += ((r0 * r0 + r1 * r1) + (r2 * r2 + r3 * r3)) + ((r4 * r4 + r5 * r5) + (r6 * r6 + r7 * r7)); }
                s += __shfl_xor(s, 16); s += __shfl_xor(s, 32);
                if (fq == 0) ssq[(size_t)row * 16 + u.pn * 4 + wc] = s; }
        }
    }
};
struct EpiResFinal {
    static constexpr bool PERM = true, AFTER_DRAIN = false; static constexpr int NS_MIN = 0;
    const bf16_t* base; float* out; float* xs; unsigned* cnt; const float* gain;
    __device__ __forceinline__ void operator()(const f32x4 (&acc)[2][2][4][2], const Unit& u, int wr, int wc, int fr, int fq) const {
        const int col0 = u.pn * BM + wc * 32 + 8 * fq, rowb = u.pm * BM + wr * 64 + fr;
#pragma unroll
        for (int ai = 0; ai < 2; ++ai) { u32x4 b[4][2];
#pragma unroll
            for (int m = 0; m < 4; ++m)
#pragma unroll
                for (int bj = 0; bj < 2; ++bj) b[m][bj] = *(const u32x4*)(base + (size_t)(rowb + ai * HALF + m * 16) * 1024 + col0 + bj * HALF);
#pragma unroll
            for (int m = 0; m < 4; ++m) { const int row = rowb + ai * HALF + m * 16; float s = 0.f;
#pragma unroll
                for (int bj = 0; bj < 2; ++bj) { const u32x4 bb = b[m][bj]; const f32x4 a0 = acc[ai][bj][m][0], a1 = acc[ai][bj][m][1];
                    const float x0 = a0[0] + __uint_as_float(bb.x << 16), x1 = a0[1] + __uint_as_float(bb.x & 0xffff0000u), x2 = a0[2] + __uint_as_float(bb.y << 16), x3 = a0[3] + __uint_as_float(bb.y & 0xffff0000u);
                    const float x4 = a1[0] + __uint_as_float(bb.z << 16), x5 = a1[1] + __uint_as_float(bb.z & 0xffff0000u), x6 = a1[2] + __uint_as_float(bb.w << 16), x7 = a1[3] + __uint_as_float(bb.w & 0xffff0000u);
                    s += ((x0 * x0 + x1 * x1) + (x2 * x2 + x3 * x3)) + ((x4 * x4 + x5 * x5) + (x6 * x6 + x7 * x7)); }
                s += __shfl_xor(s, 16); s += __shfl_xor(s, 32);
                if (fq == 0) __hip_atomic_store(xs + (size_t)row * 16 + u.pn * 4 + wc, s, __ATOMIC_RELAXED, __HIP_MEMORY_SCOPE_AGENT); } }
        asm volatile("s_waitcnt vmcnt(0)" ::: "memory");
        unsigned* const pc = cnt + 64 * u.pm;
        if ((threadIdx.x & 63) == 0) __hip_atomic_fetch_add(pc, 1u, __ATOMIC_RELAXED, __HIP_MEMORY_SCOPE_AGENT);
        { const unsigned long long t0 = __builtin_amdgcn_s_memrealtime();
          while ((unsigned)__builtin_amdgcn_readfirstlane(__hip_atomic_load(pc, __ATOMIC_RELAXED, __HIP_MEMORY_SCOPE_AGENT)) < 32u) {
              if (__builtin_amdgcn_s_memrealtime() - t0 > 2000000ull) break;
              __builtin_amdgcn_s_sleep(2); } }
        asm volatile("" ::: "memory");
        const f32x4 g0 = *(const f32x4*)(gain + col0), g1 = *(const f32x4*)(gain + col0 + 4), g2 = *(const f32x4*)(gain + col0 + HALF), g3 = *(const f32x4*)(gain + col0 + HALF + 4);
#pragma unroll
        for (int ai = 0; ai < 2; ++ai) { u32x4 b[4][2]; float rs[4];
#pragma unroll
            for (int m = 0; m < 4; ++m) { const int row = rowb + ai * HALF + m * 16; const float* xp = xs + (size_t)row * 16 + 4 * fq;
                float s = (__hip_atomic_load(xp, __ATOMIC_RELAXED, __HIP_MEMORY_SCOPE_AGENT) + __hip_atomic_load(xp + 1, __ATOMIC_RELAXED, __HIP_MEMORY_SCOPE_AGENT))
                        + (__hip_atomic_load(xp + 2, __ATOMIC_RELAXED, __HIP_MEMORY_SCOPE_AGENT) + __hip_atomic_load(xp + 3, __ATOMIC_RELAXED, __HIP_MEMORY_SCOPE_AGENT));
                s += __shfl_xor(s, 16); s += __shfl_xor(s, 32); rs[m] = __builtin_amdgcn_rsqf(s * (1.0f / 1024.0f) + RMS_EPS);
#pragma unroll
                for (int bj = 0; bj < 2; ++bj) b[m][bj] = *(const u32x4*)(base + (size_t)row * 1024 + col0 + bj * HALF); }
#pragma unroll
            for (int m = 0; m < 4; ++m) { const int row = rowb + ai * HALF + m * 16; const float r = rs[m]; float* op = out + (size_t)row * 1024 + col0;
#pragma unroll
                for (int bj = 0; bj < 2; ++bj) { const u32x4 bb = b[m][bj]; const f32x4 a0 = acc[ai][bj][m][0], a1 = acc[ai][bj][m][1]; const f32x4 ga = bj ? g2 : g0, gb = bj ? g3 : g1;
                    f32x4 o0, o1;
                    o0[0] = (a0[0] + __uint_as_float(bb.x << 16)) * r * ga[0]; o0[1] = (a0[1] + __uint_as_float(bb.x & 0xffff0000u)) * r * ga[1];
                    o0[2] = (a0[2] + __uint_as_float(bb.y << 16)) * r * ga[2]; o0[3] = (a0[3] + __uint_as_float(bb.y & 0xffff0000u)) * r * ga[3];
                    o1[0] = (a1[0] + __uint_as_float(bb.z << 16)) * r * gb[0]; o1[1] = (a1[1] + __uint_as_float(bb.z & 0xffff0000u)) * r * gb[1];
                    o1[2] = (a1[2] + __uint_as_float(bb.w << 16)) * r * gb[2]; o1[3] = (a1[3] + __uint_as_float(bb.w & 0xffff0000u)) * r * gb[3];
                    *(f32x4*)(op + bj * HALF) = o0; *(f32x4*)(op + bj * HALF + 4) = o1; } } }
    }
};
template <int SH> __device__ __forceinline__ float row_shr(float v) { return __builtin_bit_cast(float, __builtin_amdgcn_update_dpp(0, __builtin_bit_cast(int, v), 0x110 + SH, 0xf, 0xf, true)); }
__device__ __forceinline__ float rowscan16(float v) { v += row_shr<1>(v); v += row_shr<2>(v); v += row_shr<4>(v); v += row_shr<8>(v); return v; }
__device__ __forceinline__ float rowlast16(float v) { return __shfl(v, 15, 16); }
struct EpiHG {
    static constexpr bool PERM = true, AFTER_DRAIN = false; static constexpr int NS_MIN = 16;
    bf16_t* QA; bf16_t* KD; bf16_t* KT; bf16_t* V; size_t tstride; float* DEC; const float* lb; const float* ssq; bool lbzero;
    __device__ __forceinline__ void operator()(const f32x4 (&acc)[2][2][4][2], const Unit& u, int wr, int wc, int fr, int fq) const {
        const int row0 = u.pm * BM + wr * 64 + fr;
        if (u.pn >= 8) {
            const int tt = (u.pn >= 12) ? 1 : 0; const int col0 = ((u.pn - 8) & 3) * 256 + wc * 32 + 8 * fq; bf16_t* const dbase = V + (size_t)tt * tstride;
#pragma unroll
            for (int ai = 0; ai < 2; ++ai) { float rsv[4]; row_rstd_half(ssq, row0 + ai * HALF, fq, rsv);
#pragma unroll
                for (int m = 0; m < 4; ++m) { const int row = row0 + ai * HALF + m * 16; const float rs = rsv[m]; const size_t off = (size_t)row * 1024 + col0;
#pragma unroll
                    for (int bj = 0; bj < 2; ++bj) { f32x4 v0 = acc[ai][bj][m][0] * rs, v1 = acc[ai][bj][m][1] * rs;
                        if (tt == 1) {
#pragma unroll
                            for (int i = 0; i < 4; ++i) { v0[i] = v0[i] * sigmoid_f(v0[i]); v1[i] = v1[i] * sigmoid_f(v1[i]); } }
                        u32x4 w; w.x = cvt_pk_bf16(v0[0], v0[1]); w.y = cvt_pk_bf16(v0[2], v0[3]); w.z = cvt_pk_bf16(v1[0], v1[1]); w.w = cvt_pk_bf16(v1[2], v1[3]);
                        *(u32x4*)(dbase + off + bj * HALF) = w; } } }
            return;
        }
        const int colh = u.pn * HALF + wc * 32 + 8 * fq;
        f32x4 lbv[2];
#pragma unroll
        for (int n = 0; n < 2; ++n) lbv[n] = *(const f32x4*)(lb + colh + 4 * n);
#pragma unroll
        for (int ai = 0; ai < 2; ++ai) { float rsv[4]; row_rstd_half(ssq, row0 + ai * HALF, fq, rsv);
#pragma unroll
            for (int c2 = 0; c2 < 2; ++c2) {
                const int rowE = row0 + ai * HALF + (2 * c2) * 16, rowO = rowE + 16;
                const float rsE = rsv[2 * c2], rsO = rsv[2 * c2 + 1];
#pragma unroll
                for (int n = 0; n < 2; ++n) { float oq[2][4], od[2][4], ot[2][4]; f32x4 dec;
#pragma unroll
                    for (int i = 0; i < 4; ++i) {
                        float lf[2], kk[2], qq[2];
#pragma unroll
                        for (int eo = 0; eo < 2; ++eo) { const float rs = eo ? rsO : rsE; const float z = acc[ai][1][2 * c2 + eo][n][i] * rs; qq[eo] = acc[ai][0][2 * c2 + eo][n][i] * rs;
                            const float e = __builtin_amdgcn_exp2f(-fabsf(z) * 1.4426950408889634f), d = __builtin_amdgcn_rcpf(1.0f + e), sg = z >= 0.f ? d : e * d; float f;
                            if (lbzero) { f = sg; lf[eo] = fminf(z, 0.f) * 1.4426950408889634f - __builtin_amdgcn_logf(1.0f + e); }
                            else { const float l = lbv[n][i]; f = l + (1.0f - l) * sg; lf[eo] = __builtin_amdgcn_logf(f); }
                            kk[eo] = 1.0f - f; }
                        const float bE = rowscan16(lf[0]); const float totE = rowlast16(bE); const float bO = rowscan16(lf[1]) + totE; const float bl = rowlast16(bO);
                        oq[0][i] = qq[0] * __builtin_amdgcn_exp2f(bE); oq[1][i] = qq[1] * __builtin_amdgcn_exp2f(bO);
                        od[0][i] = kk[0] * __builtin_amdgcn_exp2f(fminf(-bE, 100.f)); od[1][i] = kk[1] * __builtin_amdgcn_exp2f(fminf(-bO, 100.f));
                        ot[0][i] = kk[0] * __builtin_amdgcn_exp2f(bl - bE); ot[1][i] = kk[1] * __builtin_amdgcn_exp2f(bl - bO);
                        dec[i] = __builtin_amdgcn_exp2f(bl); }
#pragma unroll
                    for (int eo = 0; eo < 2; ++eo) { const size_t off = (size_t)(eo ? rowO : rowE) * 1024 + colh + 4 * n; u32x2 w;
                        w.x = cvt_pk_bf16(oq[eo][0], oq[eo][1]); w.y = cvt_pk_bf16(oq[eo][2], oq[eo][3]); *(u32x2*)(QA + off) = w;
                        w.x = cvt_pk_bf16(od[eo][0], od[eo][1]); w.y = cvt_pk_bf16(od[eo][2], od[eo][3]); *(u32x2*)(KD + off) = w;
                        w.x = cvt_pk_bf16(ot[eo][0], ot[eo][1]); w.y = cvt_pk_bf16(ot[eo][2], ot[eo][3]); *(u32x2*)(KT + off) = w; }
                    if (fr == 0) *(f32x4*)(DEC + (size_t)(rowE >> 5) * 1024 + colh + 4 * n) = dec;
                    asm volatile("" ::: "memory"); }
            } }
    }
};
struct EpiSwi {
    static constexpr bool PERM = true, AFTER_DRAIN = false; static constexpr int NS_MIN = 8;
    bf16_t* H; const float* ssq;
    __device__ __forceinline__ void operator()(const f32x4 (&acc)[2][2][4][2], const Unit& u, int wr, int wc, int fr, int fq) const {
        const int col0 = u.pn * HALF + wc * 32 + 8 * fq, row0 = u.pm * BM + wr * 64 + fr;
#pragma unroll
        for (int ai = 0; ai < 2; ++ai) { float rsv[4]; row_rstd_half(ssq, row0 + ai * HALF, fq, rsv);
#pragma unroll
            for (int m = 0; m < 4; ++m) { const int row = row0 + ai * HALF + m * 16; const float rs = rsv[m];
                f32x4 h[2];
#pragma unroll
                for (int n = 0; n < 2; ++n) { const f32x4 g = acc[ai][0][m][n] * rs, uu = acc[ai][1][m][n] * rs;
#pragma unroll
                    for (int i = 0; i < 4; ++i) h[n][i] = g[i] * sigmoid_f(g[i]) * uu[i]; }
                u32x4 w; w.x = cvt_pk_bf16(h[0][0], h[0][1]); w.y = cvt_pk_bf16(h[0][2], h[0][3]); w.z = cvt_pk_bf16(h[1][0], h[1][1]); w.w = cvt_pk_bf16(h[1][2], h[1][3]);
                *(u32x4*)(H + (size_t)row * 2816 + col0) = w; } }
    }
};
template <class Epi, class Sched, bool ALIGN_EPI = false, bool SP2 = false>
__device__ __forceinline__ void gemm_phase(PG8_LAS unsigned char* lds, const Gemm g, const Sched& S, const Epi& E, unsigned* ts_out = nullptr) {
    int tid_ = threadIdx.x; asm volatile("" : "+v"(tid_));
    const int tid = tid_, wid = __builtin_amdgcn_readfirstlane(tid >> 6), lane = tid & 63, wr = wid >> 2, wc = wid & 3, fr = lane & 15, fq = lane >> 4;
    const int K = g.K, nt = K / BK;
    unsigned voffA[2], voffB[2];
#pragma unroll
    for (int i = 0; i < 2; ++i) { int R, C; stage_rc(tid * 16 + i * 8192, R, C); const int Rb = Epi::PERM ? ((R & ~31) + perm32(R & 31)) : R;
        voffA[i] = (unsigned)(R * K + C) * 2u; voffB[i] = (unsigned)(Rb * K + C) * 2u; }
    const size_t kstep = (size_t)(BK * 2);
    const size_t hstep = (size_t)HALF * K * 2;
    const size_t tstep = 2 * hstep;
    const unsigned ldsw = (unsigned)wid * 1024u;
    const int aoff = lds_byte(wr * 64 + fr, fq * 8), boff = lds_byte(wc * 32 + fr, fq * 8);
#define PG8_SA(b, h) (((b) * 2 + (h)) * HTB)
#define PG8_SB(b, h) ((4 + (b) * 2 + (h)) * HTB)
#define PG8_STAGE(bufoff, gbase, voff) do { _Pragma("unroll") for (int _i = 0; _i < 2; ++_i) \
        __builtin_amdgcn_global_load_lds((const unsigned*)((const char*)(gbase) + (voff)[_i]), (PG8_LAS unsigned*)(lds + (bufoff) + ldsw + _i * 8192), 16, 0, 0); } while (0)
#define PG8_LDA(dst, b, h) do { _Pragma("unroll") for (int m = 0; m < 4; ++m) _Pragma("unroll") for (int k = 0; k < 2; ++k) dst[m][k] = *(const PG8_LAS bf16x8*)(lds + PG8_SA(b, h) + aoff + m * 2048 + k * 1024); } while (0)
#define PG8_LDB(dst, b, h) do { _Pragma("unroll") for (int n = 0; n < 2; ++n) _Pragma("unroll") for (int k = 0; k < 2; ++k) dst[n][k] = *(const PG8_LAS bf16x8*)(lds + PG8_SB(b, h) + boff + n * 2048 + k * 1024); } while (0)
#define PG8_MMA(ai, bj, At, Bt) do { __builtin_amdgcn_s_setprio(1); _Pragma("unroll") for (int m = 0; m < 4; ++m) _Pragma("unroll") for (int n = 0; n < 2; ++n) _Pragma("unroll") for (int k = 0; k < 2; ++k) \
        acc[ai][bj][m][n] = __builtin_amdgcn_mfma_f32_16x16x32_bf16(Bt[n][k], At[m][k], acc[ai][bj][m][n], 0, 0, 0); __builtin_amdgcn_s_setprio(0); } while (0)
#define PG8_WAIT_V(n) asm volatile("s_waitcnt vmcnt(" #n ")" ::: "memory")
#define PG8_WAIT_V8_SEL(rlx, n) asm volatile("s_cmp_lg_u32 %0, 0\n\ts_cbranch_scc1 .Lpg8_rlx_%=\n\ts_waitcnt vmcnt(8)\n\ts_branch .Lpg8_end_%=\n.Lpg8_rlx_%=:\n\ts_waitcnt vmcnt(" #n ")\n.Lpg8_end_%=:" :: "s"(rlx) : "scc", "memory")
#define PG8_WAIT_V8_FIRST(rlx) do { if constexpr (Epi::NS_MIN >= 16) PG8_WAIT_V8_SEL(rlx, 24); else if constexpr (Epi::NS_MIN >= 8) PG8_WAIT_V8_SEL(rlx, 16); else PG8_WAIT_V(8); } while (0)
#define PG8_WAIT_L(n) asm volatile("s_waitcnt lgkmcnt(" #n ")" ::: "memory")
#define PG8_BAR __builtin_amdgcn_s_barrier()
#define PG8_SCHED __builtin_amdgcn_sched_barrier(0)
    Unit cur, nxt; int ui = 0;
#if TS_EPI
    unsigned ts_epi_ = 0;
#endif
    if (!S.next(0, cur)) return;
    f32x4 acc[2][2][4][2];
#pragma unroll
    for (int a = 0; a < 2; ++a)
#pragma unroll
        for (int b = 0; b < 2; ++b)
#pragma unroll
            for (int m = 0; m < 4; ++m)
#pragma unroll
                for (int n = 0; n < 2; ++n) acc[a][b][m][n] = (f32x4){0.f, 0.f, 0.f, 0.f};
    bf16x8 At[4][2], B0[2][2], B1[2][2];
    const char* cA = (const char*)g.A + (size_t)cur.pm * tstep; const char* cB = (const char*)g.Bt + (size_t)cur.pn * tstep;
    S.a_ready(cur);
    if constexpr (SP2) {
        PG8_STAGE(PG8_SB(0, 0), cB, voffB); PG8_STAGE(PG8_SB(0, 1), cB + hstep, voffB); PG8_STAGE(PG8_SA(0, 0), cA, voffA); PG8_STAGE(PG8_SA(0, 1), cA + hstep, voffA);
        if (wr == 1) PG8_BAR;
        PG8_WAIT_V(2); PG8_BAR;
        PG8_STAGE(PG8_SB(1, 0), cB + kstep, voffB); PG8_STAGE(PG8_SA(1, 0), cA + kstep, voffA); PG8_STAGE(PG8_SB(1, 1), cB + hstep + kstep, voffB);
        PG8_WAIT_V(6); PG8_BAR;
    } else {
        PG8_STAGE(PG8_SB(0, 0), cB, voffB); PG8_STAGE(PG8_SA(0, 0), cA, voffA); PG8_STAGE(PG8_SB(0, 1), cB + hstep, voffB); PG8_STAGE(PG8_SA(0, 1), cA + hstep, voffA);
        if (wr == 1) PG8_BAR;
        PG8_WAIT_V(4); PG8_BAR;
        PG8_STAGE(PG8_SB(1, 0), cB + kstep, voffB); PG8_STAGE(PG8_SA(1, 0), cA + kstep, voffA); PG8_STAGE(PG8_SB(1, 1), cB + hstep + kstep, voffB);
        PG8_WAIT_V(6); PG8_BAR;
    }
    for (;;) {
        const bool has_next = S.next(ui + 1, nxt);
        const char* nA = has_next ? (const char*)g.A + (size_t)nxt.pm * tstep : cA; const char* nB = has_next ? (const char*)g.Bt + (size_t)nxt.pn * tstep : cB;
#if TS_EPI == 2
        const unsigned long long tk0_ = __builtin_amdgcn_s_memtime();
#endif
        for (int t = 0; t < nt; t += 2) {
            const bool last = (t == nt - 2);
            const char* a1 = cA + (size_t)(t + 1) * kstep;
            const char* a2 = last ? nA : cA + (size_t)(t + 2) * kstep; const char* b2 = last ? nB : cB + (size_t)(t + 2) * kstep;
            const char* a3 = a2 + kstep; const char* b3 = b2 + kstep;
            if (last && has_next) S.a_ready(nxt);
            const int relax_ = __builtin_amdgcn_readfirstlane(((t == 0) && (ui > 0)) ? 1 : 0);
            if constexpr (SP2) {
            PG8_LDB(B0, 0, 0); PG8_LDB(B1, 0, 1); PG8_SCHED; PG8_LDA(At, 0, 0); PG8_STAGE(PG8_SA(1, 1), a1 + hstep, voffA);
            PG8_WAIT_V8_FIRST(relax_); PG8_WAIT_L(0); PG8_BAR; PG8_MMA(0, 0, At, B0); PG8_MMA(0, 1, At, B1); PG8_BAR; PG8_SCHED;
            PG8_LDA(At, 0, 1); PG8_STAGE(PG8_SB(0, 0), b2, voffB); PG8_STAGE(PG8_SB(0, 1), b2 + hstep, voffB); PG8_STAGE(PG8_SA(0, 0), a2, voffA);
            PG8_WAIT_V8_FIRST(relax_); PG8_WAIT_L(0); PG8_BAR; PG8_MMA(1, 0, At, B0); PG8_MMA(1, 1, At, B1); PG8_BAR; PG8_SCHED;
            PG8_LDB(B0, 1, 0); PG8_LDB(B1, 1, 1); PG8_SCHED; PG8_LDA(At, 1, 0); PG8_STAGE(PG8_SA(0, 1), a2 + hstep, voffA);
            PG8_WAIT_V(8); PG8_WAIT_L(0); PG8_BAR; PG8_MMA(0, 0, At, B0); PG8_MMA(0, 1, At, B1); PG8_BAR; PG8_SCHED;
            PG8_LDA(At, 1, 1); PG8_STAGE(PG8_SB(1, 0), b3, voffB); PG8_STAGE(PG8_SB(1, 1), b3 + hstep, voffB); PG8_STAGE(PG8_SA(1, 0), a3, voffA);
            PG8_WAIT_V(8); PG8_WAIT_L(0); PG8_BAR; PG8_MMA(1, 0, At, B0); PG8_MMA(1, 1, At, B1); PG8_BAR; PG8_SCHED;
            } else {
            PG8_LDB(B0, 0, 0); PG8_SCHED; PG8_LDA(At, 0, 0); PG8_STAGE(PG8_SA(1, 1), a1 + hstep, voffA);
            PG8_WAIT_L(8); PG8_BAR; PG8_WAIT_L(0); PG8_MMA(0, 0, At, B0); PG8_BAR; PG8_SCHED;
            PG8_LDB(B1, 0, 1); PG8_STAGE(PG8_SB(0, 0), b2, voffB);
            PG8_BAR; PG8_WAIT_L(0); PG8_MMA(0, 1, At, B1); PG8_BAR;
            PG8_LDA(At, 0, 1); PG8_STAGE(PG8_SA(0, 0), a2, voffA);
            PG8_BAR; PG8_WAIT_L(0); PG8_MMA(1, 0, At, B0); PG8_BAR; PG8_SCHED;
            PG8_STAGE(PG8_SB(0, 1), b2 + hstep, voffB);
            PG8_WAIT_V(6); PG8_BAR; PG8_MMA(1, 1, At, B1); PG8_BAR;
            PG8_LDB(B0, 1, 0); PG8_SCHED; PG8_LDA(At, 1, 0); PG8_STAGE(PG8_SA(0, 1), a2 + hstep, voffA);
            PG8_WAIT_L(8); PG8_BAR; PG8_WAIT_L(0); PG8_MMA(0, 0, At, B0); PG8_BAR; PG8_SCHED;
            PG8_LDB(B1, 1, 1); PG8_STAGE(PG8_SB(1, 0), b3, voffB);
            PG8_BAR; PG8_WAIT_L(0); PG8_MMA(0, 1, At, B1); PG8_BAR;
            PG8_LDA(At, 1, 1); PG8_STAGE(PG8_SA(1, 0), a3, voffA);
            PG8_BAR; PG8_WAIT_L(0); PG8_MMA(1, 0, At, B0); PG8_BAR; PG8_SCHED;
            PG8_STAGE(PG8_SB(1, 1), b3 + hstep, voffB);
            PG8_WAIT_V(6); PG8_BAR; PG8_MMA(1, 1, At, B1); PG8_BAR;
            }
        }
#if TS_EPI == 2
        ts_epi_ += (unsigned)(__builtin_amdgcn_s_memtime() - tk0_);
#endif
        if constexpr (ALIGN_EPI) { if (wr == 0) PG8_BAR; }
#if TS_EPI == 1
        const unsigned long long te0_ = __builtin_amdgcn_s_memrealtime();
#endif
        if constexpr (!Epi::AFTER_DRAIN) { E(acc, cur, wr, wc, fr, fq); S.done(cur); }
#if TS_EPI == 1
        asm volatile("s_waitcnt vmcnt(0)" ::: "memory");
        ts_epi_ += (unsigned)(__builtin_amdgcn_s_memrealtime() - te0_);
#endif
        if (!has_next) break;
#pragma unroll
        for (int a = 0; a < 2; ++a)
#pragma unroll
            for (int b = 0; b < 2; ++b)
#pragma unroll
                for (int m = 0; m < 4; ++m)
#pragma unroll
                    for (int n = 0; n < 2; ++n) acc[a][b][m][n] = (f32x4){0.f, 0.f, 0.f, 0.f};
        cur = nxt; cA = nA; cB = nB; ++ui;
        if constexpr (ALIGN_EPI) { if (wr == 1) PG8_BAR; }
    }
#if TS_EPI
    if (blockIdx.x == 0 && threadIdx.x == 0) *ts_out = ts_epi_;
#endif
    PG8_WAIT_V(0);
    if constexpr (!ALIGN_EPI) { if (wr == 0) PG8_BAR; }
    PG8_BAR;
    if constexpr (Epi::AFTER_DRAIN) { E.fused(acc, cur, wr, wc, fr, fq, lds, wid, lane); S.done(cur); }
#undef PG8_SA
#undef PG8_SB
#undef PG8_STAGE
#undef PG8_LDA
#undef PG8_LDB
#undef PG8_MMA
#undef PG8_WAIT_V
#undef PG8_WAIT_V8_FIRST
#undef PG8_WAIT_V8_SEL
#undef PG8_WAIT_L
#undef PG8_BAR
#undef PG8_SCHED
}
}

#include <hip/hip_bf16.h>
#include <cmath>
namespace attn_body {
using bf16=__hip_bfloat16;
using bf16x8=__attribute__((ext_vector_type(8)))short;
using s16x4=__attribute__((ext_vector_type(4)))short;
using f32x16=__attribute__((ext_vector_type(16)))float;
using u32x4=__attribute__((ext_vector_type(4)))unsigned;
using f32x4_t=__attribute__((ext_vector_type(4)))float;
constexpr int BATCH=8,NHEAD=8,SEQ=2048,D=64,DM=NHEAD*D,OPITCH=1024;
constexpr int NW=8,QBLK=32,QB=QBLK*NW,KVBLK=64,NQB=SEQ/QB;
constexpr int ATTN_PITCH=DM, ATTN_UNIT_ROWS=QB;
constexpr float ATT_LOG2E=1.4426950408889634f;
__device__ __forceinline__ int crow(int r,int hi){return (r&3)+8*(r>>2)+4*hi;}
#define SBAR() __builtin_amdgcn_sched_barrier(0)
__device__ __forceinline__ void cmask(f32x16&p0,f32x16&p1,int jb,int qrel,int hi){
  const float NEG=-INFINITY; int kb=64*jb+4*hi;
  #pragma unroll
  for(int r=0;r<16;++r){int kv=kb+(r&3)+8*(r>>2); if(kv>qrel)p0[r]=NEG; if(kv+32>qrel)p1[r]=NEG;}
}

constexpr int NSLOT=3, SLOTB=8192;
constexpr int LDS_K=0, LDS_V=NSLOT*SLOTB, LDS_WS=2*NSLOT*SLOTB, LDS_OST=LDS_WS+NW*64*4, LDS_BETA=LDS_OST+NW*4096, LDS_PRE=LDS_BETA+SEQ*4, LDS_BYTES=LDS_PRE+256;
constexpr float C2=0.125f*1.4426950408889634f;
__device__ __forceinline__ void glds16(const void*gsrc,unsigned lds_dst){unsigned keep;
  asm volatile("s_mov_b32 %0, m0\n\ts_mov_b32 m0, %2\n\ts_nop 0\n\tglobal_load_lds_dwordx4 %1, off\n\ts_mov_b32 m0, %0":"=&s"(keep):"v"(gsrc),"s"(lds_dst):"memory");}
__device__ __forceinline__ float max3f(float a,float b,float c){float r;asm("v_max3_f32 %0, %1, %2, %3":"=v"(r):"v"(a),"v"(b),"v"(c));return r;}
__device__ __forceinline__ float max2f(float a,float b){float r;asm("v_max_f32_e32 %0, %1, %2":"=v"(r):"v"(a),"v"(b));return r;}
__device__ __forceinline__ float fadd_s(float a,float b){float r;asm("v_add_f32_e32 %0, %1, %2":"=v"(r):"v"(a),"v"(b));return r;}
__device__ __forceinline__ float fsub_s(float a,float b){float r;asm("v_sub_f32_e32 %0, %1, %2":"=v"(r):"v"(a),"v"(b));return r;}
typedef float f32x2_t __attribute__((ext_vector_type(2))); typedef __bf16 bf16x2_t __attribute__((ext_vector_type(2)));
__device__ __forceinline__ unsigned cvtpk_s(float lo,float hi){f32x2_t v={lo,hi};bf16x2_t b=__builtin_convertvector(v,bf16x2_t);return __builtin_bit_cast(unsigned,b);}
#define WAIT_BAR(N) asm volatile("s_waitcnt vmcnt(" #N ") lgkmcnt(0)\n\ts_barrier":::"memory")

__device__ __forceinline__ void qkt(f32x16&p0,f32x16&p1,const char*Kslot,const bf16x8*qr,const f32x16&negm,int r32,int hi){
  const char*kb=Kslot+hi*1024+r32*16;
  #pragma unroll
  for(int d0=0;d0<4;++d0){
    const bf16x8 b0=*reinterpret_cast<const bf16x8*>(kb+d0*2048);
    const bf16x8 b1=*reinterpret_cast<const bf16x8*>(kb+d0*2048+512);
    if(d0==0){p0=__builtin_amdgcn_mfma_f32_32x32x16_bf16(b0,qr[0],negm,0,0,0);p1=__builtin_amdgcn_mfma_f32_32x32x16_bf16(b1,qr[0],negm,0,0,0);}
    else{p0=__builtin_amdgcn_mfma_f32_32x32x16_bf16(b0,qr[d0],p0,0,0,0);p1=__builtin_amdgcn_mfma_f32_32x32x16_bf16(b1,qr[d0],p1,0,0,0);}}
}
typedef __attribute__((address_space(3))) const char* lds_cptr;
typedef short v4i16_t __attribute__((ext_vector_type(4)));
__device__ __forceinline__ void kload8(bf16x8*kf,lds_cptr kp){
  kf[0]=*(const __attribute__((address_space(3))) bf16x8*)(kp);      kf[1]=*(const __attribute__((address_space(3))) bf16x8*)(kp+512);
  kf[2]=*(const __attribute__((address_space(3))) bf16x8*)(kp+2048); kf[3]=*(const __attribute__((address_space(3))) bf16x8*)(kp+2560);
  kf[4]=*(const __attribute__((address_space(3))) bf16x8*)(kp+4096); kf[5]=*(const __attribute__((address_space(3))) bf16x8*)(kp+4608);
  kf[6]=*(const __attribute__((address_space(3))) bf16x8*)(kp+6144); kf[7]=*(const __attribute__((address_space(3))) bf16x8*)(kp+6656);
}
__device__ __forceinline__ void kload2(bf16x8*kf,lds_cptr kp,int j){ kf[2*j]=*(const __attribute__((address_space(3))) bf16x8*)(kp+j*2048); kf[2*j+1]=*(const __attribute__((address_space(3))) bf16x8*)(kp+j*2048+512); }
__device__ __forceinline__ s16x4 vtr(lds_cptr p){ return __builtin_bit_cast(s16x4,__builtin_amdgcn_ds_read_tr16_b64_v4i16((__attribute__((address_space(3))) v4i16_t*)p)); }
__device__ __forceinline__ float rowmax(const f32x16&p0,const f32x16&p1){
  float a=max3f(p0[0],p0[1],p1[0]),b=max3f(p0[2],p0[3],p1[1]);a=max3f(a,p1[2],p1[3]);
  #pragma unroll
  for(int r=4;r<16;r+=4){a=max3f(a,p0[r],p0[r+1]);b=max3f(b,p0[r+2],p0[r+3]);a=max3f(a,p1[r],p1[r+1]);b=max3f(b,p1[r+2],p1[r+3]);}
  const float m=max2f(a,b);
  auto rr=__builtin_amdgcn_permlane32_swap(__float_as_uint(m),__float_as_uint(m),false,false);
  return max2f(__uint_as_float(rr[0]),__uint_as_float(rr[1]));
}
__device__ __forceinline__ void pv(f32x16*o,int vb,bf16x8 pa0,bf16x8 pa1,bf16x8 pa2,bf16x8 pa3){
  #pragma unroll
  for(int d0=0;d0<2;++d0){s16x4 lo[4],hi[4];
    #pragma unroll
    for(int ks=0;ks<4;++ks){
      asm volatile("ds_read_b64_tr_b16 %0,%1 offset:%c2":"=&v"(lo[ks]):"v"(vb),"i"(d0*4096+ks*1024):"memory");
      asm volatile("ds_read_b64_tr_b16 %0,%1 offset:%c2":"=&v"(hi[ks]):"v"(vb),"i"(d0*4096+ks*1024+512):"memory");}
    asm volatile("s_waitcnt lgkmcnt(0)":::"memory");SBAR();
    #define PK(k) (bf16x8){lo[k][0],lo[k][1],lo[k][2],lo[k][3],hi[k][0],hi[k][1],hi[k][2],hi[k][3]}
    o[d0]=__builtin_amdgcn_mfma_f32_32x32x16_bf16(pa0,PK(0),o[d0],0,0,0);
    o[d0]=__builtin_amdgcn_mfma_f32_32x32x16_bf16(pa1,PK(1),o[d0],0,0,0);
    o[d0]=__builtin_amdgcn_mfma_f32_32x32x16_bf16(pa2,PK(2),o[d0],0,0,0);
    o[d0]=__builtin_amdgcn_mfma_f32_32x32x16_bf16(pa3,PK(3),o[d0],0,0,0);
    #undef PK
  }
}

#ifndef ATTN_STORE16
#define ATTN_STORE16(p,v) (*(u32x4*)(p)=(v))
#endif
template<int THRL> __device__ __forceinline__ void attn_unit(int b,int h,int qb,const bf16*Q,const bf16*__restrict__ K,const bf16*__restrict__ V,bf16*O,char*shm){
  int tid_o=threadIdx.x; asm volatile("":"+v"(tid_o));
  const int tid=tid_o,lane=tid&63,r32=lane&31,hi=lane>>5; const int wid=__builtin_amdgcn_readfirstlane(tid>>6);
  const long rowbase=(long)b*SEQ; const int q0=qb*QB;
  const bf16*Qw=Q+(rowbase+q0+wid*QBLK)*DM+h*D;
  const bf16*Kh=K+rowbase*DM+h*D,*Vh=V+rowbase*DM+h*D;
  const unsigned lds0=(unsigned)(uintptr_t)shm;
  float*wsf=(float*)(shm+LDS_WS)+wid*64;
  const bf16*ksrc=Kh+(long)lane*DM+wid*8;
  const bf16*vsrc=Vh+(long)(16*(wid&3)+(lane>>2))*DM+(wid>>2)*32+(lane&3)*8;
  const unsigned kdst=lds0+LDS_K+wid*1024, vdst=lds0+LDS_V+wid*1024;
  #define DMA_K(t,slot) glds16(ksrc+(long)(t)*KVBLK*DM,(unsigned)__builtin_amdgcn_readfirstlane(kdst+(slot)))
  #define DMA_V(t,slot) glds16(vsrc+(long)(t)*KVBLK*DM,(unsigned)__builtin_amdgcn_readfirstlane(vdst+(slot)))
  const int vb0=(int)(lds0+LDS_V)+((lane>>4)&1)*32+(lane&3)*8+(4*hi+((lane&15)>>2))*64;
  const char*Kbase=shm+LDS_K; bf16x8 kf[8];
  const lds_cptr shm3=(lds_cptr)shm; const lds_cptr kp0=shm3+LDS_K+hi*1024+r32*16; const lds_cptr vp0=shm3+LDS_V+((lane>>4)&1)*32+(lane&3)*8+(4*hi+((lane&15)>>2))*64;
  const int NT=(q0+QB)/KVBLK;
  DMA_K(0,0);DMA_V(0,0);DMA_K(1,SLOTB);
  bf16x8 qr[4];
  #pragma unroll
  for(int d0=0;d0<4;++d0)qr[d0]=*reinterpret_cast<const bf16x8*>(&Qw[(long)r32*DM+d0*16+hi*8]);
  float m0;
  { const bf16*Kd=Kh+(long)(q0+wid*QBLK+r32)*DM+hi*8; float acc_=0.f;
    #pragma unroll
    for(int d0=0;d0<4;++d0){ const bf16x8 kd=*reinterpret_cast<const bf16x8*>(&Kd[d0*16]);
      #pragma unroll
      for(int j_=0;j_<8;++j_) acc_+=__uint_as_float((unsigned)(unsigned short)qr[d0][j_]<<16)*__uint_as_float((unsigned)(unsigned short)kd[j_]<<16); }
    auto rr_=__builtin_amdgcn_permlane32_swap(__float_as_uint(acc_),__float_as_uint(acc_),false,false);
    m0=__uint_as_float(rr_[0])+__uint_as_float(rr_[1])+((__attribute__((address_space(3))) const float*)((lds_cptr)shm+LDS_BETA))[q0+wid*QBLK+r32]; }
  float mhat=0.f,l_reg=0.f;f32x16 o[2];o[0]=f32x16{};o[1]=f32x16{};f32x16 negm=f32x16{};asm volatile("":"+v"(negm));
  const int qrel=wid*QBLK+r32;
  #define CMASK(P0,P1,t) do{int jb_=(t)-(NT-4); if(jb_>=0)cmask(P0,P1,jb_,qrel,hi);}while(0)
  typedef __attribute__((address_space(3))) const f32x4_t* lds_f4ptr;
  const lds_f4ptr betab=(lds_f4ptr)((lds_cptr)shm+LDS_BETA+16*hi);
  #define BIAS(P0,P1,t) do{ const lds_f4ptr bp_=betab+16*(t); \
    _Pragma("unroll") for(int g_=0;g_<4;++g_){ const f32x4_t b0_=bp_[2*g_], b1_=bp_[8+2*g_]; \
      _Pragma("unroll") for(int i_=0;i_<4;++i_){ P0[4*g_+i_]+=b0_[i_]; P1[4*g_+i_]+=b1_[i_]; } if(g_&1)SBAR(); } }while(0)
  bool resc=false;
  #define START(P0,P1) do{ const float rm=rowmax(P0,P1); resc=false; \
    { const float dl=max2f(rm,m0); mhat=fadd_s(mhat,dl); \
      _Pragma("unroll") for(int r=0;r<16;++r){P0[r]=fsub_s(P0[r],dl);P1[r]=fsub_s(P1[r],dl);} \
      _Pragma("unroll") for(int r=0;r<16;++r)negm[r]=-mhat; asm volatile("":"+v"(negm)); } \
    _Pragma("unroll") for(int r=0;r<16;++r)P0[r]=__builtin_amdgcn_exp2f(P0[r]); }while(0)
  #define RESC() do{ if(resc){ asm volatile("s_waitcnt lgkmcnt(0)":::"memory"); \
      _Pragma("unroll") for(int d_=0;d_<2;++d_) _Pragma("unroll") for(int r=0;r<16;++r)o[d_][r]*=wsf[crow(r,hi)]; } }while(0)
  f32x16 pA0,pA1,pB0,pB1;
  int sl_prev=0,sl_cur=0,sl_next=SLOTB;
  #define ROT() do{sl_prev=sl_cur;sl_cur=sl_next;sl_next=(sl_next==(NSLOT-1)*SLOTB)?0:sl_next+SLOTB;}while(0)
  DMA_K(2,2*SLOTB);
  WAIT_BAR(3);
  qkt(pA0,pA1,Kbase,qr,negm,r32,hi);asm volatile("s_nop 15\n\ts_nop 7":"+v"(pA0),"+v"(pA1));BIAS(pA0,pA1,0);CMASK(pA0,pA1,0);
  START(pA0,pA1);
  _Pragma("unroll") for(int r=0;r<16;++r)pA1[r]=__builtin_amdgcn_exp2f(pA1[r]);
  WAIT_BAR(0);
  DMA_K(3,0);DMA_V(1,SLOTB);
  ROT();
  kload8(kf,kp0+sl_cur);
  WAIT_BAR(2);
  s16x4 vlo[8],vhi[8]; u32x4 pw0,pw1,pw2,pw3;
  #define PKW(P,B) cvtpk_s(P[B],P[B+1])
  #define PAF(k) __builtin_bit_cast(bf16x8,pw##k)
  #define VFR(i) (bf16x8){vlo[i][0],vlo[i][1],vlo[i][2],vlo[i][3],vhi[i][0],vhi[i][1],vhi[i][2],vhi[i][3]}
  #define PIN(x) asm volatile("":"+v"(x))
  #define MX3(a,b,c) __builtin_fmaxf(__builtin_fmaxf((a),(b)),(c))
  #define GAPA(MF,A0,A1,A2,A3,W0,W1,PW) do{ MF; sacc+=A0; sacc+=A1; sacc+=A2; sacc+=A3; PIN(sacc); W0; W1; PIN(PW); SBAR(); }while(0)
  #define EX(v) __builtin_amdgcn_exp2f(v)
  #define GAPB(MF,X,B) do{ MF; X[B]=EX(X[B]); X[B+1]=EX(X[B+1]); X[B+2]=EX(X[B+2]); X[B+3]=EX(X[B+3]); PIN(X); SBAR(); }while(0)
  #define VRD(i) do{ vlo[i]=vtr(vp_+(((i)>>2)*4096+((i)&3)*1024)); vhi[i]=vtr(vp_+(((i)>>2)*4096+((i)&3)*1024+512)); }while(0)
  #define KRD(G,j) do{ if(G){ kload2(kf,kp0+sl_next,j); SBAR(); } }while(0)
  #define STEP(C0,C1,P0,P1,t,GK,GV,GL) do{ SBAR(); \
    const lds_cptr vp_=vp0+sl_prev; \
    VRD(0); SBAR(); float sacc=(P0[0]+P0[1]); \
    GAPA(C0=__builtin_amdgcn_mfma_f32_32x32x16_bf16(kf[0],qr[0],negm,0,0,0), P0[2],P0[3],P0[4],P0[5],     pw0[0]=PKW(P0,0), pw0[1]=PKW(P0,2), pw0); \
    VRD(4); SBAR(); GAPA(C1=__builtin_amdgcn_mfma_f32_32x32x16_bf16(kf[1],qr[0],negm,0,0,0), P0[6],P0[7],P0[8],P0[9],     pw0[2]=PKW(P0,4), pw0[3]=PKW(P0,6), pw0); \
    VRD(1); SBAR(); GAPA(C0=__builtin_amdgcn_mfma_f32_32x32x16_bf16(kf[2],qr[1],C0,0,0,0),   P0[10],P0[11],P0[12],P0[13], pw1[0]=PKW(P0,8), pw1[1]=PKW(P0,10), pw1); \
    VRD(5); SBAR(); GAPA(C1=__builtin_amdgcn_mfma_f32_32x32x16_bf16(kf[3],qr[1],C1,0,0,0),   P0[14],P0[15],P1[0],P1[1],   pw1[2]=PKW(P0,12),pw1[3]=PKW(P0,14), pw1); \
    VRD(2); SBAR(); GAPA(C0=__builtin_amdgcn_mfma_f32_32x32x16_bf16(kf[4],qr[2],C0,0,0,0),   P1[2],P1[3],P1[4],P1[5],     pw2[0]=PKW(P1,0), pw2[1]=PKW(P1,2), pw2); \
    VRD(6); SBAR(); GAPA(C1=__builtin_amdgcn_mfma_f32_32x32x16_bf16(kf[5],qr[2],C1,0,0,0),   P1[6],P1[7],P1[8],P1[9],     pw2[2]=PKW(P1,4), pw2[3]=PKW(P1,6), pw2); \
    VRD(3); SBAR(); GAPA(C0=__builtin_amdgcn_mfma_f32_32x32x16_bf16(kf[6],qr[3],C0,0,0,0),   P1[10],P1[11],P1[12],P1[13], pw3[0]=PKW(P1,8), pw3[1]=PKW(P1,10), pw3); \
    VRD(7); SBAR(); GAPA(C1=__builtin_amdgcn_mfma_f32_32x32x16_bf16(kf[7],qr[3],C1,0,0,0),   P1[14],P1[15],0.f,0.f,       pw3[2]=PKW(P1,12),pw3[3]=PKW(P1,14), pw3); \
    l_reg+=sacc; \
    if(GK){DMA_K((t)+3,sl_cur);} if(GV){DMA_V((t)+1,sl_next);} \
    BIAS(C0,C1,t); CMASK(C0,C1,t); \
    { float a=MX3(C0[0],C0[1],C1[0]),b=MX3(C0[2],C0[3],C1[1]); a=MX3(a,C1[2],C1[3]); \
      _Pragma("unroll") for(int r=4;r<16;r+=4){a=MX3(a,C0[r],C0[r+1]);b=MX3(b,C0[r+2],C0[r+3]);a=MX3(a,C1[r],C1[r+1]);b=MX3(b,C1[r+2],C1[r+3]);} \
      float rm=__builtin_fmaxf(a,b); { auto rr=__builtin_amdgcn_permlane32_swap(__float_as_uint(rm),__float_as_uint(rm),false,false); rm=__builtin_fmaxf(__uint_as_float(rr[0]),__uint_as_float(rr[1])); } \
      resc=false; \
      if(__builtin_expect(__any(rm>(float)THRL),0)){ const float dl=__builtin_fmaxf(rm,0.f); mhat+=dl; \
        _Pragma("unroll") for(int r=0;r<16;++r){C0[r]-=dl;C1[r]-=dl;} \
        _Pragma("unroll") for(int r=0;r<16;++r)negm[r]=-mhat; asm volatile("":"+v"(negm)); \
        const float f=__builtin_amdgcn_exp2f(-dl); l_reg*=f; if(hi==0)wsf[r32]=f; resc=true; } } \
    SBAR(); \
    GAPB(o[0]=__builtin_amdgcn_mfma_f32_32x32x16_bf16(PAF(0),VFR(0),o[0],0,0,0), C0,0); \
    GAPB(o[1]=__builtin_amdgcn_mfma_f32_32x32x16_bf16(PAF(0),VFR(4),o[1],0,0,0), C0,4); \
    KRD(GL,0); GAPB(o[0]=__builtin_amdgcn_mfma_f32_32x32x16_bf16(PAF(1),VFR(1),o[0],0,0,0), C0,8); \
    KRD(GL,1); GAPB(o[1]=__builtin_amdgcn_mfma_f32_32x32x16_bf16(PAF(1),VFR(5),o[1],0,0,0), C0,12); \
    KRD(GL,2); GAPB(o[0]=__builtin_amdgcn_mfma_f32_32x32x16_bf16(PAF(2),VFR(2),o[0],0,0,0), C1,0); \
    KRD(GL,3); GAPB(o[1]=__builtin_amdgcn_mfma_f32_32x32x16_bf16(PAF(2),VFR(6),o[1],0,0,0), C1,4); \
    GAPB(o[0]=__builtin_amdgcn_mfma_f32_32x32x16_bf16(PAF(3),VFR(3),o[0],0,0,0), C1,8); \
    GAPB(o[1]=__builtin_amdgcn_mfma_f32_32x32x16_bf16(PAF(3),VFR(7),o[1],0,0,0), C1,12); \
    }while(0)
  int t=1;
  #undef CMASK
  #define CMASK(P0,P1,t) do{}while(0)
  for(;t+5<NT;t+=2){
    STEP(pB0,pB1,pA0,pA1,t,true,true,true);     WAIT_BAR(2); RESC(); ROT();
    STEP(pA0,pA1,pB0,pB1,t+1,true,true,true);   WAIT_BAR(2); RESC(); ROT();
  }
  #undef CMASK
  #define CMASK(P0,P1,t) do{int jb_=(t)-(NT-4); if(jb_>=0)cmask(P0,P1,jb_,qrel,hi);}while(0)
  #define ENDW(tt) do{ if((tt)+3<NT){WAIT_BAR(2);} else if((tt)+2<NT){WAIT_BAR(1);} else {WAIT_BAR(0);} }while(0)
  for(;t+1<NT;t+=2){
    STEP(pB0,pB1,pA0,pA1,t,(t+3<NT),(t+1<NT),(t+1<NT));       ENDW(t);   RESC(); ROT();
    STEP(pA0,pA1,pB0,pB1,t+1,(t+4<NT),(t+2<NT),(t+2<NT));     ENDW(t+1); RESC(); ROT();
  }
  STEP(pB0,pB1,pA0,pA1,NT-1,false,false,false); RESC();
  { float sacc=pB0[0]+pB0[1]; _Pragma("unroll") for(int r=2;r<16;++r)sacc+=pB0[r]; _Pragma("unroll") for(int r=0;r<16;++r)sacc+=pB1[r]; l_reg+=sacc;
    pw0=(u32x4){PKW(pB0,0),PKW(pB0,2),PKW(pB0,4),PKW(pB0,6)};pw1=(u32x4){PKW(pB0,8),PKW(pB0,10),PKW(pB0,12),PKW(pB0,14)};pw2=(u32x4){PKW(pB1,0),PKW(pB1,2),PKW(pB1,4),PKW(pB1,6)};pw3=(u32x4){PKW(pB1,8),PKW(pB1,10),PKW(pB1,12),PKW(pB1,14)};
    SBAR(); pv(o,vb0+sl_cur,PAF(0),PAF(1),PAF(2),PAF(3)); }
  #undef PKW
  #undef PAF
  #undef VFR
  #undef PIN
  #undef MX3
  #undef GAPA
  #undef GAPB
  #undef EX
  #undef VRD
  #undef KRD
  #undef STEP
  #undef ENDW
  {auto rr=__builtin_amdgcn_permlane32_swap(__float_as_uint(l_reg),__float_as_uint(l_reg),false,false);l_reg=__uint_as_float(rr[0])+__uint_as_float(rr[1]);}
  if(hi==0)wsf[32+r32]=l_reg;asm volatile("s_waitcnt lgkmcnt(0)":::"memory");
  float rli[16];
  #pragma unroll
  for(int r=0;r<16;++r)rli[r]=__builtin_amdgcn_rcpf(wsf[32+crow(r,hi)]);
  bf16*Ow=O+(rowbase+q0+wid*QBLK)*OPITCH+h*D;
  { bf16*stg=(bf16*)(shm+LDS_OST)+wid*2048;
    #pragma unroll
    for(int r=0;r<16;++r){const int orow=crow(r,hi);
      #pragma unroll
      for(int d0=0;d0<2;++d0)stg[orow*64+d0*32+r32]=__float2bfloat16(o[d0][r]*rli[r]);}
    asm volatile("s_waitcnt lgkmcnt(0)":::"memory");
    #pragma unroll
    for(int i=0;i<4;++i){const int row=i*8+(lane>>3),ch=lane&7; const u32x4 v=*(const u32x4*)(stg+row*64+ch*8); ATTN_STORE16(Ow+(long)row*OPITCH+ch*8,v);} }
  asm volatile("s_waitcnt lgkmcnt(0)\n\ts_barrier":::"memory");
  #undef DMA_K
  #undef DMA_V
  #undef CMASK
  #undef BIAS
  #undef START
  #undef RESC
  #undef ROT
}
constexpr int ATTN_LDS_BYTES=LDS_BYTES;
struct AttnTensors { const bf16* Q; const bf16* K; const bf16* V; bf16* O; const float* cl; const float* bt; };
struct AttnUnit { int bh; int qb; };
struct StaticOrder {
  int vcu,grid;
  __device__ __forceinline__ explicit StaticOrder(int grid_,int block):vcu((grid_%8==0)?(block%8)*(grid_/8)+block/8:block),grid(grid_){}
  __device__ __forceinline__ bool next(int i,AttnUnit&u)const{ const int v=vcu+(i>>1)*grid; if(v>=BATCH*NHEAD*4)return false; const int s=v&3; u.bh=v>>2; u.qb=((i&1)==0)?7-s:s; return true; }
  __device__ __forceinline__ void a_ready(const AttnUnit&)const{}
  __device__ __forceinline__ void done(const AttnUnit&)const{}
};
__device__ __forceinline__ void build_beta(char*lds,const float*cl,const float*bt,int bh){
  int tid_o=threadIdx.x; asm volatile("":"+v"(tid_o)); const int tid=tid_o,b=bh/NHEAD,h=bh%NHEAD;
  __attribute__((address_space(3))) float*beta=(__attribute__((address_space(3))) float*)((lds_cptr)lds+LDS_BETA);
  __attribute__((address_space(3))) float*pre=(__attribute__((address_space(3))) float*)((lds_cptr)lds+LDS_PRE);
  if(tid<64){ float v=(tid<32)?bt[(b*32+tid)*8+h]:0.f; const float own=v;
    #pragma unroll
    for(int o=1;o<32;o<<=1){ const float n=__shfl_up(v,o); if((tid&63)>=o)v+=n; }
    if(tid<32)pre[tid]=v-own; }
  asm volatile("s_waitcnt lgkmcnt(0)":::"memory"); __syncthreads();
  for(int s=tid;s<SEQ;s+=NW*64) beta[s]=-(pre[s>>6]+cl[(long)(b*SEQ+s)*8+h])*ATT_LOG2E;
  asm volatile("s_waitcnt lgkmcnt(0)":::"memory"); __syncthreads();
}
template<class Sched,int THRL=8> __device__ __forceinline__ void attn_phase(char*lds,const AttnTensors&T,const Sched&S){
  AttnUnit u;
  for(int i=0;S.next(i,u);++i){ if((i&1)==0) build_beta(lds,T.cl,T.bt,u.bh);
    S.a_ready(u); attn_unit<THRL>(u.bh/NHEAD,u.bh%NHEAD,u.qb,T.Q,T.K,T.V,T.O,lds); S.done(u); }
}
#undef SBAR
#undef WAIT_BAR
}

namespace hg {
typedef short bf16x8 __attribute__((ext_vector_type(8)));
typedef short s16x4 __attribute__((ext_vector_type(4)));
typedef float f32x16 __attribute__((ext_vector_type(16)));
typedef float f32x4 __attribute__((ext_vector_type(4)));
typedef unsigned u32x4 __attribute__((ext_vector_type(4)));
typedef unsigned u32x2 __attribute__((ext_vector_type(2)));
#define HG_LAS __attribute__((address_space(3)))
#define HG_BAR() do { asm volatile("s_waitcnt lgkmcnt(0)" ::: "memory"); __builtin_amdgcn_s_barrier(); asm volatile("" ::: "memory"); } while (0)
constexpr int CH = 32, NCH = 2048 / CH;
constexpr int S_QA = 0, S_KD = 8192, S_KT = 16384, S_V = 24576, S_DEC = 26624, SLOT_BYTES = 27136;
constexpr int OFF_OPART = 2 * SLOT_BYTES, OPART_BYTES = 4 * 4096, LDS_BYTES = OFF_OPART + 2 * OPART_BYTES;
__device__ __forceinline__ int qa_off(int t, int d) { return t * 256 + ((((d >> 3) ^ (t & 15))) << 4) + (d & 7) * 2; }
__device__ __forceinline__ int kt_off(int s, int d) { return s * 256 + ((((d >> 3) ^ ((s & 3) << 2))) << 4) + (d & 7) * 2; }
__device__ __forceinline__ int v_off(int s, int e) { return s * 64 + e * 2; }
typedef short v4i16_t __attribute__((ext_vector_type(4)));
__device__ __forceinline__ s16x4 trd(const HG_LAS unsigned char* p) { return __builtin_bit_cast(s16x4, __builtin_amdgcn_ds_read_tr16_b64_v4i16((HG_LAS v4i16_t*)p)); }
__device__ __forceinline__ unsigned cvtpk(float lo, float hi) { typedef float f2 __attribute__((ext_vector_type(2))); typedef __bf16 b2 __attribute__((ext_vector_type(2))); f2 v = {lo, hi}; b2 b = __builtin_convertvector(v, b2); return __builtin_bit_cast(unsigned, b); }
__device__ __forceinline__ int crow(int r, int hi) { return (r & 3) + 8 * (r >> 2) + 4 * hi; }
__device__ __forceinline__ bf16x8 pack8(const f32x16& x, int base) {
    u32x4 w; w.x = cvtpk(x[base], x[base + 1]); w.y = cvtpk(x[base + 2], x[base + 3]); w.z = cvtpk(x[base + 4], x[base + 5]); w.w = cvtpk(x[base + 6], x[base + 7]); return __builtin_bit_cast(bf16x8, w); }
__device__ __forceinline__ bf16x8 cat64(s16x4 a, s16x4 b) { return (bf16x8){a[0], a[1], a[2], a[3], b[0], b[1], b[2], b[3]}; }

__device__ __forceinline__ void hgrn_unit(HG_LAS unsigned char* lds, const unsigned short* QA, const unsigned short* KD, const unsigned short* KT, const float* DEC, const unsigned short* V, unsigned short* O, int unit) {
    int tid_o = threadIdx.x; asm volatile("" : "+v"(tid_o));
    const int tid = tid_o, lane = tid & 63, wid = __builtin_amdgcn_readfirstlane(tid >> 6), r32 = lane & 31, hi = lane >> 5;
    const int b = unit >> 5, h = (unit >> 2) & 7, eq = unit & 3;
    const size_t gbase = (size_t)b * 2048 * 1024 + h * 128;
    __syncthreads();
    if (wid < 4) {
        const int w = wid;
        const int tq = (lane & 15) >> 2, tc = 16 * ((lane >> 4) & 1) + 4 * (lane & 3);
        f32x16 S = {};
#pragma unroll 1
        for (int i = -1; i <= NCH; ++i) {
            if (i >= 0 && i < NCH) {
                HG_LAS unsigned char* sl = lds + (i & 1) * SLOT_BYTES;
                bf16x8 kdf[2], qaf[2]; s16x4 qp[2][2], vp[2][2], ktf[2][2], vf[2][2]; f32x4 dcv[4];
#pragma unroll
                for (int ks = 0; ks < 2; ++ks) { const int o = qa_off(r32, 32 * w + 16 * ks + 8 * hi), d0 = 32 * w + 16 * ks + 4 * hi, sp = 16 * ks + 4 * hi, sn = 16 * ks + 8 * hi;
                    kdf[ks] = *(const HG_LAS bf16x8*)(sl + S_KD + o); qaf[ks] = *(const HG_LAS bf16x8*)(sl + S_QA + o);
                    qp[ks][0] = *(const HG_LAS s16x4*)(sl + S_QA + qa_off(r32, d0)); qp[ks][1] = *(const HG_LAS s16x4*)(sl + S_QA + qa_off(r32, d0 + 8));
                    vp[ks][0] = trd(sl + S_V + v_off(sp + tq, tc)); vp[ks][1] = trd(sl + S_V + v_off(sp + 8 + tq, tc));
                    ktf[ks][0] = trd(sl + S_KT + kt_off(sn + tq, 32 * w + tc)); ktf[ks][1] = trd(sl + S_KT + kt_off(sn + 4 + tq, 32 * w + tc));
                    vf[ks][0] = trd(sl + S_V + v_off(sn + tq, tc)); vf[ks][1] = trd(sl + S_V + v_off(sn + 4 + tq, tc)); }
#pragma unroll
                for (int g = 0; g < 4; ++g) dcv[g] = *(const HG_LAS f32x4*)(sl + S_DEC + (32 * w + 8 * g + 4 * hi) * 4);
                __builtin_amdgcn_sched_barrier(0);
                const bf16x8 sb0 = pack8(S, 0), sb1 = pack8(S, 8);
                f32x16 X = {}, ow = {};
#pragma unroll
                for (int g = 0; g < 4; ++g)
#pragma unroll
                    for (int q = 0; q < 4; ++q) S[4 * g + q] *= dcv[g][q];
                X = __builtin_amdgcn_mfma_f32_32x32x16_bf16(kdf[0], qaf[0], X, 0, 0, 0);
                ow = __builtin_amdgcn_mfma_f32_32x32x16_bf16(cat64(qp[0][0], qp[0][1]), sb0, ow, 0, 0, 0);
                S = __builtin_amdgcn_mfma_f32_32x32x16_bf16(cat64(ktf[0][0], ktf[0][1]), cat64(vf[0][0], vf[0][1]), S, 0, 0, 0);
                X = __builtin_amdgcn_mfma_f32_32x32x16_bf16(kdf[1], qaf[1], X, 0, 0, 0);
                ow = __builtin_amdgcn_mfma_f32_32x32x16_bf16(cat64(qp[1][0], qp[1][1]), sb1, ow, 0, 0, 0);
                S = __builtin_amdgcn_mfma_f32_32x32x16_bf16(cat64(ktf[1][0], ktf[1][1]), cat64(vf[1][0], vf[1][1]), S, 0, 0, 0);
#pragma unroll
                for (int r = 0; r < 16; ++r) X[r] = (crow(r, hi) <= r32) ? X[r] : 0.f;
                ow = __builtin_amdgcn_mfma_f32_32x32x16_bf16(pack8(X, 0), cat64(vp[0][0], vp[0][1]), ow, 0, 0, 0);
                ow = __builtin_amdgcn_mfma_f32_32x32x16_bf16(pack8(X, 8), cat64(vp[1][0], vp[1][1]), ow, 0, 0, 0);
                { HG_LAS float* op = (HG_LAS float*)(lds + OFF_OPART + (i & 1) * OPART_BYTES + w * 4096) + lane;
#pragma unroll
                  for (int r = 0; r < 16; ++r) op[r * 64] = ow[r]; }
            }
            HG_BAR();
        }
    } else {
        const int pt = tid - 256;
        const int t0 = pt >> 4, d0 = (pt & 15) * 8;
        const int vs = pt >> 3, ve = (pt & 7) * 4;
        u32x4 qaA[2], kdA[2], ktA[2], qaB[2], kdB[2], ktB[2]; u32x2 vA, vB; float dcA = 0.f, dcB = 0.f;
#define HG_LOAD(qa, kd, kt, vr, dc, c) do { const int c_ = (c) < NCH ? (c) : NCH - 1;      \
            const size_t ro_ = gbase + (size_t)c_ * CH * 1024; \
            _Pragma("unroll") for (int k_ = 0; k_ < 2; ++k_) { const size_t o_ = ro_ + (size_t)(t0 + 16 * k_) * 1024 + d0; \
                qa[k_] = *(const u32x4*)(QA + o_); kd[k_] = *(const u32x4*)(KD + o_); kt[k_] = *(const u32x4*)(KT + o_); } \
            vr = *(const u32x2*)(V + ro_ + (size_t)vs * 1024 + eq * 32 + ve); \
            dc = DEC[(size_t)(b * NCH + c_) * 1024 + h * 128 + (pt & 127)]; } while (0)
#define HG_PSTEP(i, RED, PREP, qa, kd, kt, vr, dc) do { \
            if (PREP) { \
                HG_LAS unsigned char* sl = lds + (((i) + 1) & 1) * SLOT_BYTES; \
                _Pragma("unroll") for (int k_ = 0; k_ < 2; ++k_) { const int t_ = t0 + 16 * k_; \
                    *(HG_LAS u32x4*)(sl + S_QA + qa_off(t_, d0)) = qa[k_]; *(HG_LAS u32x4*)(sl + S_KD + qa_off(t_, d0)) = kd[k_]; \
                    *(HG_LAS u32x4*)(sl + S_KT + kt_off(t_, d0)) = kt[k_]; } \
                *(HG_LAS u32x2*)(sl + S_V + v_off(vs, ve)) = vr; \
                *(HG_LAS float*)(sl + S_DEC + (pt & 127) * 4) = dc; \
                HG_LOAD(qa, kd, kt, vr, dc, (i) + 3); } \
            if (RED) { const HG_LAS float* op = (const HG_LAS float*)(lds + OFF_OPART + (((i) - 1) & 1) * OPART_BYTES); \
                const int idx = 4 * pt, reg = idx >> 6, ln = idx & 63; const HG_LAS f32x4* op4 = (const HG_LAS f32x4*)(op + idx); \
                const f32x4 v = (op4[0] + op4[256]) + (op4[512] + op4[768]);              \
                const int t = crow(reg, ln >> 5), e = ln & 31; u32x2 wv; wv.x = cvtpk(v[0], v[1]); wv.y = cvtpk(v[2], v[3]); \
                *(u32x2*)(O + gbase + (size_t)(((i) - 1) * CH + t) * 1024 + eq * 32 + e) = wv; } \
            HG_BAR(); } while (0)
        HG_LOAD(qaA, kdA, ktA, vA, dcA, 0); HG_LOAD(qaB, kdB, ktB, vB, dcB, 1);
        HG_PSTEP(-1, false, true, qaA, kdA, ktA, vA, dcA); HG_PSTEP(0, false, true, qaB, kdB, ktB, vB, dcB);
#pragma unroll 1
        for (int i = 1; i + 1 < NCH; i += 2) { HG_PSTEP(i, true, true, qaA, kdA, ktA, vA, dcA); HG_PSTEP(i + 1, true, true, qaB, kdB, ktB, vB, dcB); }
        HG_PSTEP(NCH - 1, true, false, qaA, kdA, ktA, vA, dcA); HG_PSTEP(NCH, true, false, qaB, kdB, ktB, vB, dcB);
#undef HG_PSTEP
#undef HG_LOAD
    }
}
#undef HG_LAS
#undef HG_BAR
}

#define GAS __attribute__((address_space(1)))
#define LAS __attribute__((address_space(3)))
typedef unsigned short bf16;
typedef unsigned v4u __attribute__((ext_vector_type(4)));
typedef float f32x4 __attribute__((ext_vector_type(4)));
typedef short bf16x8 __attribute__((ext_vector_type(8)));
typedef GAS unsigned gu32;
typedef GAS unsigned long long gu64;
#define RLX_AGENT __ATOMIC_RELAXED, __HIP_MEMORY_SCOPE_AGENT
#define LDS_WAIT() asm volatile("s_waitcnt lgkmcnt(0)" ::: "memory")
#define VM_WAIT() asm volatile("s_waitcnt vmcnt(0)" ::: "memory")
__device__ __forceinline__ unsigned long long rt() { return __builtin_amdgcn_s_memrealtime(); }
__device__ __forceinline__ unsigned f2bf(float f) { unsigned u = __builtin_bit_cast(unsigned, f); return (u + 0x7fffu + ((u >> 16) & 1u)) >> 16; }
__device__ __forceinline__ unsigned pk2(float lo, float hi) { return f2bf(lo) | (f2bf(hi) << 16); }

#define XB_TMO      128
#define XB_XCNT(j)  (256  + 64 * (j))
#define XB_XSUB(j)  (1280 + 64 * (j))
#define XB_XGEN(j)  (2304 + 64 * (j))
#define XB_TOP      3328
#define XB_TOPGEN   3392
#define XCD_BAR_WORDS 3456
#define XB_SPIN_CAP (1u << 18)

__device__ __forceinline__ unsigned xb_ld(unsigned* p)              { return __hip_atomic_load(p, __ATOMIC_RELAXED, __HIP_MEMORY_SCOPE_AGENT); }
__device__ __forceinline__ unsigned xb_add(unsigned* p, unsigned v) { return __hip_atomic_fetch_add(p, v, __ATOMIC_RELAXED, __HIP_MEMORY_SCOPE_AGENT); }
__device__ __forceinline__ unsigned xb_xcc_id() { return (unsigned)__builtin_amdgcn_s_getreg((3 << 11) | 20) & 0xFu; }
#define XB_SPIN(cond, bar) do { unsigned _sp = 0; while (cond) { __builtin_amdgcn_s_sleep(1); \
    if ((++_sp & 255u) == 0u) { if (xb_ld(&(bar)[XB_TMO])) break; if (_sp > XB_SPIN_CAP) { atomicAdd(&(bar)[XB_TMO], 1u); break; } } } } while (0)

struct XcdBarrier {
    unsigned* bar; unsigned x;
    volatile LAS unsigned* st;
};

__device__ __forceinline__ XcdBarrier xcd_barrier_post(unsigned* bar, volatile LAS unsigned* st) {
    XcdBarrier b; b.bar = bar; b.x = xb_xcc_id(); b.st = st;
    if (threadIdx.x == 0) (void)xb_add(&bar[XB_XCNT(b.x)], 1u);
    return b;
}
__device__ __forceinline__ void xcd_barrier_complete(unsigned* bar, unsigned x, unsigned& nloc, unsigned& nx) {
    const unsigned G = gridDim.x * gridDim.y * gridDim.z;
    unsigned sum, cnt, mine, sp = 0u;
    for (;;) {
        sum = 0u; cnt = 0u; mine = 0u;
#pragma unroll
        for (unsigned j = 0; j < 16; ++j) { const unsigned c = xb_ld(&bar[XB_XCNT(j)]); sum += c; cnt += (c > 0u) ? 1u : 0u; mine = (j == x) ? c : mine; }
        if (sum == G) break;
        __builtin_amdgcn_s_sleep(1);
        if ((++sp & 255u) == 0u) { if (xb_ld(&bar[XB_TMO])) break; if (sp > XB_SPIN_CAP) { atomicAdd(&bar[XB_TMO], 1u); break; } }
    }
    nloc = mine > 0u ? mine : 1u; nx = cnt > 0u ? cnt : 1u;
}

__device__ __forceinline__ void xcd_barrier(const XcdBarrier& b) {
    asm volatile("s_waitcnt vmcnt(0)" ::: "memory");
    __syncthreads();
    if (threadIdx.x == 0) {
        unsigned* bar = b.bar;
        __builtin_amdgcn_s_waitcnt(0);
        unsigned nloc = b.st[0], nx = b.st[1];
        if (nloc == 0u) { xcd_barrier_complete(bar, b.x, nloc, nx); b.st[0] = nloc; b.st[1] = nx; }
        const unsigned old = xb_add(&bar[XB_XSUB(b.x)], 1u);
        const unsigned gen = old / nloc;
        if (old + 1u == (gen + 1u) * nloc) {
            __builtin_amdgcn_fence(__ATOMIC_RELEASE, "agent");
            asm volatile("s_waitcnt vmcnt(0)" ::: "memory");
            const unsigned og = xb_add(&bar[XB_TOP], 1u);
            const unsigned tg = og / nx;
            if (og + 1u == (tg + 1u) * nx) xb_add(&bar[XB_TOPGEN], 1u);
            else XB_SPIN(xb_ld(&bar[XB_TOPGEN]) == tg, bar);
            __builtin_amdgcn_fence(__ATOMIC_ACQUIRE, "agent");
            xb_add(&bar[XB_XGEN(b.x)], 1u);
            asm volatile("s_waitcnt vmcnt(0)" ::: "memory");
        } else {
            XB_SPIN(xb_ld(&bar[XB_XGEN(b.x)]) == gen, bar);
            __builtin_amdgcn_fence(__ATOMIC_ACQUIRE, "agent");
            asm volatile("s_waitcnt vmcnt(0)" ::: "memory");
        }
    }
    __syncthreads();
}

#ifndef L0_SPLIT
#define L0_SPLIT 1
#endif

#ifndef TS_P0
#define TS_P0 0
#endif

#ifndef FUSE_FINAL_NORM
#define FUSE_FINAL_NORM 0
#endif

#ifndef TS_CLOCK
#define TS_CLOCK 0
#endif

#ifndef TS_PHASE_END
#define TS_PHASE_END -1
#endif

#ifndef TS_AFTER_BAR
#define TS_AFTER_BAR 0
#endif

#ifndef TS_PHASE
#define TS_PHASE -1
#endif
#ifndef TS_DIV
#define TS_DIV 1000.0f
#endif

#ifndef PROBE_P0
#define PROBE_P0 0
#endif

constexpr int NWAVES = 8;
constexpr int BATCH = 8, SEQ = 2048, D = 1024, DEPTH = 4, M = BATCH * SEQ;
constexpr int FOXH = 8, FOXD = 64, FOXW = 512, CONVW = 512, AB_COLS = 3080, AB_N = 3072;
constexpr int HGH = 8, HGD = 128, C_COLS = 4096;
constexpr int FFH = 2816, FF2 = 5632;
constexpr float EPS = 1e-6f;
constexpr float LOG2E = 1.4426950408889634f;
constexpr float QSCALE = 0.125f * LOG2E;

constexpr size_t MiB = 1u << 20;
constexpr size_t WS_CTL = 0, CTL_ZERO_BYTES = 64 * 1024;
constexpr size_t WS_SSQ = 1 * MiB;
constexpr size_t WS_CL = 2 * MiB;
constexpr size_t WS_BT = WS_CL + 512 * 1024;
constexpr size_t WS_WF = WS_BT + 64 * 1024;
constexpr size_t WS_LB = WS_WF + 64 * 1024;
constexpr size_t WS_W = 4 * MiB;
constexpr size_t W_ABIN = 0, SZ_ABIN = (size_t)AB_N * D * 2;
constexpr size_t W_ABOUT = W_ABIN + 2 * SZ_ABIN, SZ_ABOUT = (size_t)D * D * 2;
constexpr size_t W_CIN = W_ABOUT + 2 * SZ_ABOUT, SZ_CIN = (size_t)C_COLS * D * 2;
constexpr size_t W_COUT = W_CIN + 2 * SZ_CIN, SZ_COUT = (size_t)D * D * 2;
constexpr size_t W_FIN = W_COUT + 2 * SZ_COUT, SZ_FIN = (size_t)FF2 * D * 2;
constexpr size_t W_FOUT = W_FIN + 4 * SZ_FIN, SZ_FOUT = (size_t)D * FFH * 2;
constexpr size_t W_END = W_FOUT + 4 * SZ_FOUT;
static_assert(WS_W + W_END <= 108 * MiB, "weights region");
constexpr size_t WS_XB = 108 * MiB;
constexpr size_t WS_MIX = 140 * MiB;
constexpr size_t WS_H = WS_MIX;
constexpr size_t WS_QKVU = WS_MIX, T512 = (size_t)M * 512 * 2, WS_AO = WS_MIX + 6 * T512;
constexpr size_t WS_KD = WS_MIX, WS_KT = WS_MIX + 32 * MiB, WS_HQ = WS_MIX + 64 * MiB, WS_HV = WS_HQ + 32 * MiB, WS_HG = WS_HV + 32 * MiB, WS_HO = WS_HG + 32 * MiB, WS_DEC = WS_HO + 32 * MiB, WS_END = WS_DEC + 2 * MiB;
static_assert(WS_END <= 352 * MiB, "workspace budget");
constexpr int CW_TMO = 0, CW_BAR = 4096, CW_FIN = 8192;
constexpr size_t WS_XS = 3 * MiB;

constexpr int RING_OFF = 0, RING_BYTES = 131072;
constexpr int LDSCTL_OFF = RING_BYTES, MISC_OFF = LDSCTL_OFF + 320;
constexpr int LDS_BYTES = 147456;
static_assert(MISC_OFF + 128 <= LDS_BYTES, "LDS map");
static_assert(attn_body::ATTN_LDS_BYTES <= RING_BYTES && hg::LDS_BYTES <= RING_BYTES, "mixer LDS inside the ring region");

struct Args { const float* in[14]; float* out; unsigned char* ws; int ph_lo, ph_hi, li, pad; };
typedef const __attribute__((address_space(4))) Args* KArgP;

struct Frame {
    LAS unsigned char* lds; volatile LAS unsigned* MISC; gu32* ctl;
    int wave, vcu, G;
};
#define LANE_IDS() int tid_l = threadIdx.x; asm volatile("" : "+v"(tid_l)); const int TID = tid_l, LANE = tid_l & 63
__device__ __forceinline__ float wave_sum(float v) {
#pragma unroll
    for (int o = 1; o < 64; o <<= 1) v += __shfl_xor(v, o);
    return v;
}
__device__ __forceinline__ float bf_lo(unsigned w) { return __uint_as_float(w << 16); }
__device__ __forceinline__ float bf_hi(unsigned w) { return __uint_as_float(w & 0xffff0000u); }

struct WItem { const float* W; const float* gain; bf16* WT; int ldn, ksrc0, nsrc0, K, drow0; };
constexpr int I_ABIN = 16 * (AB_N / 32), I_SQ = 16 * (D / 32), I_CIN = 16 * (C_COLS / 32), I_FIN = 16 * (FF2 / 32), I_FOUT = (FFH / 64) * (D / 32);
__host__ __device__ constexpr int layer_items(int l) { return ((l & 1) ? I_CIN : I_ABIN) + I_SQ + I_FIN + I_FOUT; }
__device__ __forceinline__ WItem layer_item(const Args& a, int l, int it) {
    unsigned char* wb = a.ws + WS_W; const int j = l >> 1; WItem w;
    const int n_in = (l & 1) ? I_CIN : I_ABIN;
    if (it < n_in) {
        if (l & 1) { const int nb = it % 128, kb = it / 128, c0 = 32 * nb;
            const int drow = c0 < 1024 ? 256 * (c0 / 128) + (c0 % 128) : (c0 < 2048 ? 256 * ((c0 - 1024) / 128) + 128 + ((c0 - 1024) % 128) : c0);
            w = WItem{a.in[8] + (size_t)j * D * C_COLS, a.in[1] + (size_t)l * D, (bf16*)(wb + W_CIN + j * SZ_CIN), C_COLS, 64 * kb, c0, D, drow}; }
        else { const int nb = it % (AB_N / 32), kb = it / (AB_N / 32), n0 = 32 * nb;
            w = WItem{a.in[4] + (size_t)j * D * AB_COLS, a.in[1] + (size_t)l * D, (bf16*)(wb + W_ABIN + j * SZ_ABIN), AB_COLS, 64 * kb, n0 + (n0 >= 1536 ? 8 : 0), D, n0}; }
        return w; }
    it -= n_in;
    if (it < I_SQ) { const int nb = it % 32, kb = it / 32;
        w = WItem{((l & 1) ? a.in[11] : a.in[7]) + (size_t)j * D * D, nullptr, (bf16*)(wb + ((l & 1) ? W_COUT + j * SZ_COUT : W_ABOUT + j * SZ_ABOUT)), D, 64 * kb, 32 * nb, D, 32 * nb}; return w; }
    it -= I_SQ;
    if (it < I_FIN) { const int nb = it % (FF2 / 32), kb = it / (FF2 / 32), c0 = 32 * nb;
        const int drow = c0 < FFH ? 256 * (c0 / 128) + (c0 % 128) : 256 * ((c0 - FFH) / 128) + 128 + ((c0 - FFH) % 128);
        w = WItem{a.in[12] + (size_t)l * D * FF2, a.in[2] + (size_t)l * D, (bf16*)(wb + W_FIN + l * SZ_FIN), FF2, 64 * kb, c0, D, drow}; return w; }
    it -= I_FIN;
    { const int nb = it % 32, kb = it / 32;
      w = WItem{a.in[13] + (size_t)l * FFH * D, nullptr, (bf16*)(wb + W_FOUT + l * SZ_FOUT), D, 64 * kb, 32 * nb, FFH, 32 * nb}; }
    return w;
}
__device__ __forceinline__ void witem_load(const WItem& w, f32x4 (&r)[8], int lane) {
    const int n4 = (lane & 7) * 4;
#pragma unroll
    for (int i = 0; i < 8; ++i) { const int kk = 8 * i + (lane >> 3); r[i] = *(const f32x4*)(w.W + (size_t)(w.ksrc0 + kk) * w.ldn + w.nsrc0 + n4); }
}
__device__ __forceinline__ void witem_finish(const WItem& w, const f32x4 (&r)[8], LAS float* scr, int lane) {
    const int n4 = (lane & 7) * 4;
#pragma unroll
    for (int i = 0; i < 8; ++i) { const int kk = 8 * i + (lane >> 3); f32x4 v = r[i]; if (w.gain) v = v * w.gain[w.ksrc0 + kk];
        LAS float* s = scr + kk * 33 + n4; s[0] = v[0]; s[1] = v[1]; s[2] = v[2]; s[3] = v[3]; }
    LDS_WAIT(); asm volatile("" ::: "memory");
    const int c = lane & 7;
#pragma unroll
    for (int j = 0; j < 4; ++j) { const int n = (lane >> 3) + 8 * j; const LAS float* s = scr + (8 * c) * 33 + n;
        v4u o; o.x = pk2(s[0 * 33], s[1 * 33]); o.y = pk2(s[2 * 33], s[3 * 33]); o.z = pk2(s[4 * 33], s[5 * 33]); o.w = pk2(s[6 * 33], s[7 * 33]);
        *(v4u*)(w.WT + (size_t)(w.drow0 + n) * w.K + w.ksrc0 + 8 * c) = o; }
    LDS_WAIT(); asm volatile("" ::: "memory");
}
__device__ __forceinline__ void convert_layer_weights(Frame& F, const Args& a, int l, int gw, int ngw, int it_lo = 0, int it_hi = 1 << 30) {
    LANE_IDS(); (void)TID;
    LAS float* scr = (LAS float*)(F.lds + RING_OFF + F.wave * 16384);
    const int n = layer_items(l) < it_hi ? layer_items(l) : it_hi; int it = it_lo + gw; if (it >= n) return;
    WItem cur = layer_item(a, l, it); f32x4 rc[8], rn[8]; witem_load(cur, rc, LANE);
    for (;;) { const int itn = it + ngw; const bool more = itn < n; WItem nxt = cur;
        if (more) { nxt = layer_item(a, l, itn); witem_load(nxt, rn, LANE); }
        witem_finish(cur, rc, scr, LANE);
        if (!more) break;
#pragma unroll
        for (int i = 0; i < 8; ++i) rc[i] = rn[i];
        cur = nxt; it = itn; }
}
__device__ __forceinline__ void p0_prologue(Frame& F, const Args& a) {
    LANE_IDS();
    const int gw = F.vcu * NWAVES + F.wave, NGW = F.G * NWAVES;
    unsigned char* ws = a.ws;
    if (TS_P0 && blockIdx.x == 0 && TID == 0) __hip_atomic_store((unsigned*)(a.ws + WS_CTL) + 17, (unsigned)__builtin_amdgcn_s_memrealtime(), __ATOMIC_RELAXED, __HIP_MEMORY_SCOPE_AGENT);
    for (int r_ = 0; r_ < ((PROBE_P0 & 1) ? 2 : 1); ++r_)
    convert_layer_weights(F, a, 0, gw, NGW, 0, L0_SPLIT ? I_ABIN : (1 << 30));
#if !WCONV_IN_FFN_TAIL
    for (int l = 1; l < DEPTH; ++l) convert_layer_weights(F, a, l, gw, NGW);
#endif
    if (TS_P0 == 1 && blockIdx.x == 0 && TID == 0) __hip_atomic_store((unsigned*)(a.ws + WS_CTL) + 16, (unsigned)__builtin_amdgcn_s_memrealtime() - __hip_atomic_load((unsigned*)(a.ws + WS_CTL) + 17, __ATOMIC_RELAXED, __HIP_MEMORY_SCOPE_AGENT), __ATOMIC_RELAXED, __HIP_MEMORY_SCOPE_AGENT);
    for (int r_ = 0; r_ < ((PROBE_P0 & 2) ? 2 : 1); ++r_)
    { const float* __restrict__ x = a.in[0]; bf16* __restrict__ xb = (bf16*)(ws + WS_XB); float* __restrict__ ssq = (float*)(ws + WS_SSQ);
      f32x4 v[2][4], vn[2][4];
#pragma unroll
      for (int h = 0; h < 2; ++h) { const int m0 = gw + h * NGW; const int mr = m0 < M ? m0 : gw; const f32x4* xr = (const f32x4*)(x + (size_t)mr * D) + LANE;
#pragma unroll
        for (int j = 0; j < 4; ++j) v[h][j] = xr[64 * j]; }
      for (int m = gw; m < M; m += 2 * NGW) {
#pragma unroll
        for (int h = 0; h < 2; ++h) { const int mn0 = m + (2 + h) * NGW; const int mn = mn0 < M ? mn0 : gw; const f32x4* xr = (const f32x4*)(x + (size_t)mn * D) + LANE;
#pragma unroll
          for (int j = 0; j < 4; ++j) vn[h][j] = xr[64 * j]; }
#pragma unroll
        for (int h = 0; h < 2; ++h) { const int mm = m + h * NGW; if (mm < M) { float s = 0.f;
          unsigned long long* o8 = (unsigned long long*)(xb + (size_t)mm * D) + LANE;
#pragma unroll
          for (int j = 0; j < 4; ++j) { const unsigned w0 = pk2(v[h][j][0], v[h][j][1]), w1 = pk2(v[h][j][2], v[h][j][3]); o8[64 * j] = (unsigned long long)w0 | ((unsigned long long)w1 << 32);
              const float r0 = bf_lo(w0), r1 = bf_hi(w0), r2 = bf_lo(w1), r3 = bf_hi(w1); s += (r0 * r0 + r1 * r1) + (r2 * r2 + r3 * r3); }
          s = wave_sum(s);
          if (LANE < 16) ssq[(size_t)mm * 16 + LANE] = LANE == 0 ? s : 0.f; } }
#pragma unroll
        for (int h = 0; h < 2; ++h)
#pragma unroll
          for (int j = 0; j < 4; ++j) v[h][j] = vn[h][j];
      } }
    if (TS_P0 == 2 && blockIdx.x == 0 && TID == 0) __hip_atomic_store((unsigned*)(a.ws + WS_CTL) + 16, (unsigned)__builtin_amdgcn_s_memrealtime() - __hip_atomic_load((unsigned*)(a.ws + WS_CTL) + 17, __ATOMIC_RELAXED, __HIP_MEMORY_SCOPE_AGENT), __ATOMIC_RELAXED, __HIP_MEMORY_SCOPE_AGENT);
    for (int r_ = 0; r_ < ((PROBE_P0 & 4) ? 2 : 1); ++r_)
    { const int gt = (F.vcu * NWAVES + F.wave) * 64 + LANE, NGT = NGW * 64; float* wf = (float*)(ws + WS_WF); float* lb = (float*)(ws + WS_LB);
      for (int i = gt; i < 2 * 8 * D; i += NGT) { const int j = i / (8 * D), h = (i / D) % 8, k = i % D; wf[i] = a.in[4][(size_t)j * D * AB_COLS + (size_t)k * AB_COLS + 1536 + h] * a.in[1][(2 * j) * D + k]; }
      for (int i = gt; i < D; i += NGT) { const float c0 = a.in[9][i], c1 = a.in[9][D + i]; lb[i] = 0.f; lb[D + i] = 1.0f / (1.0f + expf(c0 - c1)); } }
}

__device__ __forceinline__ void fgate_job(Frame& F, const Args& a, int j, int jb) {
    LANE_IDS();
    unsigned char* ws = a.ws; const float* wf = (const float*)(ws + WS_WF) + (size_t)j * 8 * D; const float* ssq = (const float*)(ws + WS_SSQ); const bf16* xb = (const bf16*)(ws + WS_XB);
    float* cl = (float*)(ws + WS_CL); float* bt = (float*)(ws + WS_BT); const float* bias = a.in[5] + j * 8;
    LAS float* tmp = (LAS float*)(F.lds + RING_OFF);
    f32x4 w[8][4];
#pragma unroll
    for (int h = 0; h < 8; ++h)
#pragma unroll
        for (int q = 0; q < 4; ++q) w[h][q] = *(const f32x4*)(wf + (size_t)h * D + (q >> 1) * 512 + 8 * LANE + 4 * (q & 1));
    v4u v[2], vn[2];
    { const v4u* xr = (const v4u*)(xb + (size_t)(jb * 64 + F.wave * 8) * D) + LANE; v[0] = xr[0]; v[1] = xr[64]; }
#pragma unroll 1
    for (int i = 0; i < 8; ++i) { const int rl = F.wave * 8 + i, row = jb * 64 + rl;
        { const v4u* xr = (const v4u*)(xb + (size_t)(row + (i < 7 ? 1 : 0)) * D) + LANE; vn[0] = xr[0]; vn[1] = xr[64]; }
        const float rs = pg8::row_rstd(ssq, row); float s8[8]; f32x4 xf[4];
#pragma unroll
        for (int q = 0; q < 4; ++q) { const unsigned a0 = v[q >> 1][2 * (q & 1)], a1 = v[q >> 1][2 * (q & 1) + 1]; xf[q] = (f32x4){bf_lo(a0), bf_hi(a0), bf_lo(a1), bf_hi(a1)}; }
#pragma unroll
        for (int h = 0; h < 8; ++h) { float s = 0.f;
#pragma unroll
            for (int q = 0; q < 4; ++q) s += (xf[q][0] * w[h][q][0] + xf[q][1] * w[h][q][1]) + (xf[q][2] * w[h][q][2] + xf[q][3] * w[h][q][3]);
            s8[h] = s; }
#pragma unroll
        for (int h = 0; h < 4; ++h) { const float a = s8[2 * h], b = s8[2 * h + 1]; const bool up = (LANE & 1) != 0; const float send = up ? a : b, keep = up ? b : a; s8[h] = keep + __shfl_xor(send, 1); }
#pragma unroll
        for (int h = 0; h < 2; ++h) { const float a = s8[2 * h], b = s8[2 * h + 1]; const bool up = (LANE & 2) != 0; const float send = up ? a : b, keep = up ? b : a; s8[h] = keep + __shfl_xor(send, 2); }
        { const float a = s8[0], b = s8[1]; const bool up = (LANE & 4) != 0; const float send = up ? a : b, keep = up ? b : a; s8[0] = keep + __shfl_xor(send, 4); }
        float mine = s8[0]; mine += __shfl_xor(mine, 8); mine += __shfl_xor(mine, 16); mine += __shfl_xor(mine, 32);
        const int hd = LANE & 7;
        if (LANE < 8) { const float z = mine * rs + bias[hd]; tmp[rl * 8 + hd] = fminf(z, 0.f) - log1pf(expf(-fabsf(z))); }
        v[0] = vn[0]; v[1] = vn[1];
    }
    LDS_WAIT(); __syncthreads();
    { const int h = F.wave; float c = tmp[LANE * 8 + h];
#pragma unroll
      for (int o = 1; o < 64; o <<= 1) { const float n = __shfl_up(c, o); if (LANE >= o) c += n; }
      cl[(size_t)(jb * 64 + LANE) * 8 + h] = c; if (LANE == 63) bt[jb * 8 + h] = c; }
    __syncthreads();
}

__device__ __forceinline__ void conv_job(Frame& F, const Args& a, int j, int jb) {
    LANE_IDS();
    unsigned char* ws = a.ws; const bf16* __restrict__ ub = (const bf16*)(ws + WS_QKVU + 3 * T512); const bf16* __restrict__ uc = (const bf16*)(ws + WS_QKVU + 4 * T512); const bf16* __restrict__ ux = (const bf16*)(ws + WS_QKVU + 5 * T512);
    bf16* __restrict__ ao = (bf16*)(ws + WS_AO); const float* __restrict__ cw = a.in[6] + (size_t)j * 3 * CONVW;
#pragma unroll 4
    for (int it = TID; it < 64 * 64; it += NWAVES * 64) { const int rl = it >> 6, ch = (it & 63) * 8, row = jb * 64 + rl, t = row & (SEQ - 1);
        float z[3][8];
#pragma unroll
        for (int d = 0; d < 3; ++d) { const int tt = t - 2 + d;
            if (tt >= 0) { const v4u cv = *(const v4u*)(uc + (size_t)(row - 2 + d) * 512 + ch), xv = *(const v4u*)(ux + (size_t)(row - 2 + d) * 512 + ch);
#pragma unroll
                for (int q = 0; q < 4; ++q) { z[d][2 * q] = bf_lo(cv[q]) * bf_lo(xv[q]); z[d][2 * q + 1] = bf_hi(cv[q]) * bf_hi(xv[q]); } }
            else {
#pragma unroll
                for (int q = 0; q < 8; ++q) z[d][q] = 0.f; } }
        const v4u bv = *(const v4u*)(ub + (size_t)row * 512 + ch); float y[8];
#pragma unroll
        for (int q = 0; q < 8; ++q) { const float b = (q & 1) ? bf_hi(bv[q >> 1]) : bf_lo(bv[q >> 1]);
            y[q] = b * (cw[ch + q] * z[0][q] + cw[CONVW + ch + q] * z[1][q] + cw[2 * CONVW + ch + q] * z[2][q]); }
        v4u o; o.x = pk2(y[0], y[1]); o.y = pk2(y[2], y[3]); o.z = pk2(y[4], y[5]); o.w = pk2(y[6], y[7]);
        *(v4u*)(ao + (size_t)row * D + 512 + ch) = o; }
}

__device__ __forceinline__ void attn_naive_unit(Frame& F, const Args& a, int unit) {
    LANE_IDS();
    unsigned char* ws = a.ws; const bf16* Q = (const bf16*)(ws + WS_QKVU); const bf16* K = (const bf16*)(ws + WS_QKVU + T512); const bf16* V = (const bf16*)(ws + WS_QKVU + 2 * T512);
    bf16* ao = (bf16*)(ws + WS_AO); const float* cl = (const float*)(ws + WS_CL); const float* bt = (const float*)(ws + WS_BT);
    const int b = unit >> 5, h = (unit >> 2) & 7, blk = unit & 3;
    LAS float* beta = (LAS float*)(F.lds + RING_OFF);
    LAS float* pre = beta + 2048;
    __syncthreads();
    if (TID == 0) { float c = 0.f; for (int i = 0; i < 32; ++i) { pre[i] = c; c += bt[(b * 32 + i) * 8 + h]; } }
    LDS_WAIT(); __syncthreads();
    for (int s = TID; s < SEQ; s += NWAVES * 64) beta[s] = -(pre[s >> 6] + cl[(size_t)(b * SEQ + s) * 8 + h]) * LOG2E;
    LDS_WAIT(); __syncthreads();
    const int t = blk * 512 + TID; const size_t rowq = (size_t)(b * SEQ + t);
    float q[64], o[64];
#pragma unroll
    for (int c = 0; c < 8; ++c) { const v4u w = *(const v4u*)(Q + rowq * 512 + h * 64 + 8 * c);
#pragma unroll
        for (int i = 0; i < 4; ++i) { q[8 * c + 2 * i] = bf_lo(w[i]); q[8 * c + 2 * i + 1] = bf_hi(w[i]); } }
#pragma unroll
    for (int d = 0; d < 64; ++d) o[d] = 0.f;
    float mx = -INFINITY, l = 0.f;
    const int send = blk * 512 + 511;
    for (int s = 0; s <= send; ++s) {
        const bf16* kr = K + (size_t)(b * SEQ + s) * 512 + h * 64; const bf16* vr = V + (size_t)(b * SEQ + s) * 512 + h * 64;
        float sc = 0.f;
#pragma unroll
        for (int c = 0; c < 8; ++c) { const v4u w = *(const v4u*)(kr + 8 * c);
#pragma unroll
            for (int i = 0; i < 4; ++i) sc += q[8 * c + 2 * i] * bf_lo(w[i]) + q[8 * c + 2 * i + 1] * bf_hi(w[i]); }
        sc += beta[s];
        if (s <= t) {
            const float mn = fmaxf(mx, sc), f = exp2f(mx - mn), p = exp2f(sc - mn); mx = mn; l = l * f + p;
#pragma unroll
            for (int c = 0; c < 8; ++c) { const v4u w = *(const v4u*)(vr + 8 * c);
#pragma unroll
                for (int i = 0; i < 4; ++i) { o[8 * c + 2 * i] = o[8 * c + 2 * i] * f + p * bf_lo(w[i]); o[8 * c + 2 * i + 1] = o[8 * c + 2 * i + 1] * f + p * bf_hi(w[i]); } }
        }
    }
    const float rl = 1.0f / l;
#pragma unroll
    for (int c = 0; c < 8; ++c) { v4u w; w.x = pk2(o[8 * c] * rl, o[8 * c + 1] * rl); w.y = pk2(o[8 * c + 2] * rl, o[8 * c + 3] * rl); w.z = pk2(o[8 * c + 4] * rl, o[8 * c + 5] * rl); w.w = pk2(o[8 * c + 6] * rl, o[8 * c + 7] * rl);
        *(v4u*)(ao + rowq * D + h * 64 + 8 * c) = w; }
}

__device__ __forceinline__ void hgrn_gate(Frame& F, const Args& a, int j) {
    LANE_IDS();
    unsigned char* ws = a.ws; const bf16* __restrict__ O = (const bf16*)(ws + WS_HO); const bf16* __restrict__ G = (const bf16*)(ws + WS_HG); bf16* __restrict__ AOP = (bf16*)(ws + WS_HQ); const float* __restrict__ hn = a.in[10] + (size_t)j * D;
    const int gw = F.vcu * NWAVES + F.wave, NGW = F.G * NWAVES; (void)TID;
#pragma unroll 4
    for (int m = gw; m < M; m += NGW) {
#pragma unroll
        for (int jj = 0; jj < 2; ++jj) { const int c = (4 * jj + (LANE >> 4)) * HGD + 8 * (LANE & 15); const size_t off = (size_t)m * D + c;
            const v4u ow = *(const v4u*)(O + off), gv = *(const v4u*)(G + off); float o[8], g[8];
#pragma unroll
            for (int q = 0; q < 4; ++q) { o[2 * q] = bf_lo(ow[q]); o[2 * q + 1] = bf_hi(ow[q]); g[2 * q] = bf_lo(gv[q]); g[2 * q + 1] = bf_hi(gv[q]); }
            float s = 0.f;
#pragma unroll
            for (int q = 0; q < 8; ++q) s += o[q] * o[q];
            s += __shfl_xor(s, 1); s += __shfl_xor(s, 2); s += __shfl_xor(s, 4); s += __shfl_xor(s, 8);
            const float r = __builtin_amdgcn_rsqf(s * (1.0f / HGD) + EPS); const f32x4 h0 = *(const f32x4*)(hn + c), h1 = *(const f32x4*)(hn + c + 4);
            v4u w; w.x = pk2(o[0] * r * h0[0] * g[0], o[1] * r * h0[1] * g[1]); w.y = pk2(o[2] * r * h0[2] * g[2], o[3] * r * h0[3] * g[3]);
            w.z = pk2(o[4] * r * h1[0] * g[4], o[5] * r * h1[1] * g[5]); w.w = pk2(o[6] * r * h1[2] * g[6], o[7] * r * h1[3] * g[7]);
            *(v4u*)(AOP + off) = w; }
    }
}
__device__ __forceinline__ void final_norm(Frame& F, const Args& a) {
    LANE_IDS(); (void)TID;
    const int gw = F.vcu * NWAVES + F.wave, NGW = F.G * NWAVES; const float* __restrict__ g = a.in[3]; const bf16* __restrict__ xb = (const bf16*)(a.ws + WS_XB); float* __restrict__ outp = a.out;
    f32x4 gv[4];
#pragma unroll
    for (int q = 0; q < 4; ++q) gv[q] = *(const f32x4*)(g + (q >> 1) * 512 + 8 * LANE + 4 * (q & 1));
#pragma unroll 4
    for (int m = gw; m < M; m += NGW) { const v4u* xr = (const v4u*)(xb + (size_t)m * D) + LANE; const v4u v0 = xr[0], v1 = xr[64]; f32x4 x[4]; float s = 0.f;
#pragma unroll
        for (int q = 0; q < 4; ++q) { const unsigned a0 = (q >> 1) ? v1[2 * (q & 1)] : v0[2 * (q & 1)], a1 = (q >> 1) ? v1[2 * (q & 1) + 1] : v0[2 * (q & 1) + 1];
            x[q] = (f32x4){bf_lo(a0), bf_hi(a0), bf_lo(a1), bf_hi(a1)}; s += (x[q][0] * x[q][0] + x[q][1] * x[q][1]) + (x[q][2] * x[q][2] + x[q][3] * x[q][3]); }
        const float r = __builtin_amdgcn_rsqf(wave_sum(s) * (1.0f / D) + EPS); float* orow = outp + (size_t)m * D;
#pragma unroll
        for (int q = 0; q < 4; ++q) { f32x4 ov = x[q] * r * gv[q]; if ((TS_PHASE != -1 || TS_P0) && m == 0 && LANE == 0 && q == 0) ov[0] += (float)__hip_atomic_load((unsigned*)(F.ctl + 16), __ATOMIC_RELAXED, __HIP_MEMORY_SCOPE_AGENT) * (1.0f / TS_DIV);
            *(f32x4*)(orow + (q >> 1) * 512 + 8 * LANE + 4 * (q & 1)) = ov; } }
}

constexpr int N_PHASES = 26;
#ifndef WCONV_IN_FFN_TAIL
#define WCONV_IN_FFN_TAIL 1
#endif
#ifndef PROBE_MASK
#define PROBE_MASK 0
#endif
#ifndef HGRN_NAIVE
#define HGRN_NAIVE 0
#endif
#ifndef ATTN_NAIVE
#define ATTN_NAIVE 0
#endif
#ifndef MK_PER_PHASE
#define MK_PER_PHASE 0
#endif
__global__ void __launch_bounds__(NWAVES * 64, 2) trunk_fwd(Args args) {
    extern __shared__ __attribute__((aligned(16))) unsigned char lds[];
    Frame F_;
    if (TS_PHASE == -2 && blockIdx.x == 0 && threadIdx.x == 0) __hip_atomic_store((unsigned*)(args.ws + WS_CTL) + 17, (unsigned)__builtin_amdgcn_s_memrealtime(), __ATOMIC_RELAXED, __HIP_MEMORY_SCOPE_AGENT);
    F_.lds = (LAS unsigned char*)lds; F_.MISC = (volatile LAS unsigned*)(F_.lds + MISC_OFF);
    F_.wave = __builtin_amdgcn_readfirstlane((int)threadIdx.x >> 6);
    F_.G = gridDim.x; { const int bx = blockIdx.x; F_.vcu = (F_.G % 8 == 0) ? (bx % 8) * (F_.G / 8) + bx / 8 : bx; }
    unsigned char* ws = args.ws; F_.ctl = (gu32*)(ws + WS_CTL);
    for (int u = threadIdx.x; u < (LDS_BYTES - LDSCTL_OFF) / 4; u += NWAVES * 64) ((LAS unsigned*)(F_.lds + LDSCTL_OFF))[u] = 0u;
    __syncthreads();
    const int lo = args.ph_lo, hi = args.ph_hi;
    XcdBarrier bar; bar.bar = (unsigned*)(F_.ctl + CW_BAR); bar.x = 0; bar.st = nullptr;
    if (hi - lo > 1) bar = xcd_barrier_post((unsigned*)(F_.ctl + CW_BAR), F_.MISC + 8);
#pragma unroll 1
    for (int p = lo; p < hi; ++p) {
        const int l = (p - 1) / 6, s = (p - 1) - 6 * l, j = l >> 1; const bool even = (l & 1) == 0, mid = (p >= 1 && p <= 24);
#if defined(__HIP_DEVICE_COMPILE__)
        KArgP ap = (KArgP)__builtin_amdgcn_kernarg_segment_ptr(); asm volatile("" : "+s"(ap));
        Args A2; for (int q_ = 0; q_ < 14; ++q_) A2.in[q_] = (const float*)(const GAS float*)ap->in[q_]; A2.out = (float*)(GAS float*)ap->out; A2.ws = (unsigned char*)(GAS unsigned char*)ap->ws;     A2.ph_lo = lo; A2.ph_hi = hi; A2.li = 0; A2.pad = 0;
#else
        Args A2 = args;
#endif
        Frame FL = F_; { int w_ = F_.wave, v_ = F_.vcu, g_ = F_.G; asm volatile("" : "+s"(w_), "+s"(v_), "+s"(g_)); FL.wave = w_; FL.vcu = v_; FL.G = g_; }
        int bx = blockIdx.x; asm volatile("" : "+s"(bx));
        Frame& F = FL;
        GAS unsigned char* wsg = (GAS unsigned char*)A2.ws; asm volatile("" : "+s"(wsg)); unsigned char* ws = (unsigned char*)wsg; A2.ws = ws;
        bf16* const wb = (bf16*)(ws + WS_W); bf16* const XB = (bf16*)(ws + WS_XB); float* const SSQ = (float*)(ws + WS_SSQ);
        const int cls = p == 0 ? 1 : p == 25 ? 11 : (s == 0 ? (even ? 2 : 3) : s == 1 ? (even ? 4 : 5) : s == 2 ? 6 : s == 3 ? 7 : s == 4 ? 8 : 9);
        if (mid && s == 2 && even) continue;
        const int nrep = ((PROBE_MASK >> cls) & 1) ? 2 : 1;
        if (TS_PHASE == -2 && p == 0 && bx == 0 && threadIdx.x == 0) __hip_atomic_store((unsigned*)(F.ctl + 16), (unsigned)__builtin_amdgcn_s_memrealtime() - __hip_atomic_load((unsigned*)(F.ctl + 17), __ATOMIC_RELAXED, __HIP_MEMORY_SCOPE_AGENT), __ATOMIC_RELAXED, __HIP_MEMORY_SCOPE_AGENT);
        if (TS_PHASE >= 0 && (p == TS_PHASE || p == TS_PHASE_END) && bx == 0 && threadIdx.x == 0) { const unsigned now_ = TS_CLOCK ? (unsigned)__builtin_amdgcn_s_memtime() : (unsigned)__builtin_amdgcn_s_memrealtime();
            if (p == TS_PHASE) __hip_atomic_store((unsigned*)(F.ctl + 17), now_, __ATOMIC_RELAXED, __HIP_MEMORY_SCOPE_AGENT);
            else __hip_atomic_store((unsigned*)(F.ctl + 16), now_ - __hip_atomic_load((unsigned*)(F.ctl + 17), __ATOMIC_RELAXED, __HIP_MEMORY_SCOPE_AGENT), __ATOMIC_RELAXED, __HIP_MEMORY_SCOPE_AGENT); }
#define GRID_BARRIER() do { XcdBarrier b2 = bar; GAS unsigned* bg = (GAS unsigned*)bar.bar; asm volatile("" : "+s"(bg), "+s"(b2.x)); b2.bar = (unsigned*)bg; xcd_barrier(b2); } while (0)
#pragma unroll 1
        for (int rp = 0; rp < nrep; ++rp) { const bool dummy = rp + 1 < nrep; (void)dummy;
        if (p == 0) p0_prologue(F, A2);
        else if (p == 25) { if (!(FUSE_FINAL_NORM && F.G == 256)) final_norm(F, A2); }
        else if (s == 0 && even) {
            pg8::Gemm g{XB, (const bf16*)((unsigned char*)wb + W_ABIN + j * SZ_ABIN), M, AB_N, D}; pg8::StaticOrder S; S.init(M, AB_N, F.G, bx);
            pg8::EpiAB E{(bf16*)(ws + WS_QKVU), (size_t)M * 512, SSQ, QSCALE};
            pg8::gemm_phase<pg8::EpiAB, pg8::StaticOrder, true, true>(F.lds + RING_OFF, g, S, E);
            for (int jb = F.vcu; jb < M / 64; jb += F.G) fgate_job(F, A2, j, jb);
            if (L0_SPLIT && l == 0 && !dummy) convert_layer_weights(F, A2, 0, F.vcu * NWAVES + F.wave, F.G * NWAVES, I_ABIN, I_ABIN + I_SQ + I_FIN);
        } else if (s == 0) {
            pg8::Gemm g{XB, (const bf16*)((unsigned char*)wb + W_CIN + j * SZ_CIN), M, C_COLS, D}; pg8::StaticOrder S; S.init(M, C_COLS, F.G, bx);
            pg8::EpiHG E{(bf16*)(ws + WS_HQ), (bf16*)(ws + WS_KD), (bf16*)(ws + WS_KT), (bf16*)(ws + WS_HV), (size_t)M * D, (float*)(ws + WS_DEC), (const float*)(ws + WS_LB) + (size_t)j * D, SSQ, j == 0};
            static_assert(WS_HG == WS_HV + (size_t)M * D * 2, "V | G consecutive");
            pg8::gemm_phase<pg8::EpiHG, pg8::StaticOrder, true, true>(F.lds + RING_OFF, g, S, E);
        } else if (s == 1 && even) {
            if (F.vcu & 1) for (int jb = F.vcu; jb < M / 64; jb += F.G) conv_job(F, A2, j, jb);
#if ATTN_NAIVE
            for (int u = F.vcu; u < 256; u += F.G) attn_naive_unit(F, A2, u);
#else
            { const attn_body::AttnTensors AT{(const attn_body::bf16*)(ws + WS_QKVU), (const attn_body::bf16*)(ws + WS_QKVU + T512), (const attn_body::bf16*)(ws + WS_QKVU + 2 * T512), (attn_body::bf16*)(ws + WS_AO),
                                               (const float*)(ws + WS_CL), (const float*)(ws + WS_BT)};
              const attn_body::StaticOrder S((int)F.G, bx);
              attn_body::attn_phase<attn_body::StaticOrder>((char*)lds + RING_OFF, AT, S); }
#endif
            if (!(F.vcu & 1)) for (int jb = F.vcu; jb < M / 64; jb += F.G) conv_job(F, A2, j, jb);
            if (L0_SPLIT && l == 0 && !dummy) { __syncthreads(); convert_layer_weights(F, A2, 0, F.vcu * NWAVES + F.wave, F.G * NWAVES, I_ABIN + I_SQ + I_FIN, 1 << 30); }
        } else if (s == 1) {
            for (int u = F.vcu; u < 256; u += F.G) hg::hgrn_unit(F.lds + RING_OFF, (const unsigned short*)(ws + WS_HQ), (const unsigned short*)(ws + WS_KD), (const unsigned short*)(ws + WS_KT), (const float*)(ws + WS_DEC), (const unsigned short*)(ws + WS_HV), (unsigned short*)(ws + WS_HO), u);
        } else if (s == 2) {
            hgrn_gate(F, A2, j);
        } else if (s == 4) {
            pg8::Gemm g{XB, (const bf16*)((unsigned char*)wb + W_FIN + l * SZ_FIN), M, FF2, D}; pg8::StaticOrder S; S.init(M, FF2, F.G, bx);
            pg8::EpiSwi E{(bf16*)(ws + WS_H), SSQ};
            pg8::gemm_phase<pg8::EpiSwi, pg8::StaticOrder, true, true>(F.lds + RING_OFF, g, S, E, (TS_EPI && p == TS_PHASE) ? (unsigned*)(F.ctl + 16) : (unsigned*)(F.ctl + 20));
#if WCONV_IN_FFN_TAIL
            { const int nfull = (M / 256) * (FF2 / 256) - (((M / 256) * (FF2 / 256)) / F.G) * F.G;
              if (l + 1 < DEPTH && !dummy && bx >= nfull) convert_layer_weights(F, A2, l + 1, (bx - nfull) * NWAVES + F.wave, (F.G - nfull) * NWAVES); }
#endif
        } else {
            const bool dn = (s == 5);
            const bf16* A = dn ? (const bf16*)(ws + WS_H) : (even ? (const bf16*)(ws + WS_AO) : (const bf16*)(ws + WS_HQ));
            const size_t wo = dn ? (W_FOUT + l * SZ_FOUT) : (even ? (W_ABOUT + j * SZ_ABOUT) : (W_COUT + j * SZ_COUT));
            pg8::Gemm g{A, (const bf16*)((unsigned char*)wb + wo), M, D, dn ? FFH : D}; pg8::StaticOrder S; S.init(M, D, F.G, bx);
#if FUSE_FINAL_NORM
            if (p == 24 && !dummy && F.G == 256) {
                pg8::EpiResFinal E{XB, A2.out, (float*)(ws + WS_XS), (unsigned*)(F.ctl + CW_FIN), A2.in[3]};
                pg8::gemm_phase<pg8::EpiResFinal, pg8::StaticOrder, true, true>(F.lds + RING_OFF, g, S, E);
            } else
#endif
            { pg8::EpiRes E{XB, dummy ? (bf16*)(ws + WS_MIX + (dn ? 96 * MiB : 0)) : XB, SSQ};
              pg8::gemm_phase<pg8::EpiRes, pg8::StaticOrder, true, true>(F.lds + RING_OFF, g, S, E); }
        }
        if (dummy) GRID_BARRIER();
        }
        if (TS_PHASE_END < 0 && TS_PHASE >= 0 && p == TS_PHASE && bx == 0 && threadIdx.x == 0) { const unsigned dt_ = (unsigned)__builtin_amdgcn_s_memrealtime() - __hip_atomic_load((unsigned*)(F.ctl + 17), __ATOMIC_RELAXED, __HIP_MEMORY_SCOPE_AGENT); __hip_atomic_store((unsigned*)(F.ctl + 16), dt_, __ATOMIC_RELAXED, __HIP_MEMORY_SCOPE_AGENT); }
        if (p + 1 < hi && !(FUSE_FINAL_NORM && F.G == 256 && p >= 24)) { GRID_BARRIER(); if ((PROBE_MASK >> 10) & 1) GRID_BARRIER(); }
    }
}

extern "C" void kernel_launch(void* const* d_in, const int* in_sizes, int n_in, void* d_out, int out_size, void* d_ws, size_t ws_size, hipStream_t stream) {
    static int grid = 0;
    if (grid == 0) {
        if (n_in != 14 || in_sizes[0] != M * D || out_size != M * D || ws_size < WS_END) { fprintf(stderr, "kernel_launch: unexpected shapes / workspace (n_in %d, ws %zu, need %zu)\n", n_in, ws_size, (size_t)WS_END); grid = -1; return; }
        int dev = 0, cus = 0;
        if (hipGetDevice(&dev) != hipSuccess || hipDeviceGetAttribute(&cus, hipDeviceAttributeMultiprocessorCount, dev) != hipSuccess) { grid = -1; return; }
        if (hipFuncSetAttribute((const void*)trunk_fwd, hipFuncAttributeMaxDynamicSharedMemorySize, LDS_BYTES) != hipSuccess) { fprintf(stderr, "kernel_launch: hipFuncSetAttribute failed\n"); grid = -1; return; }
        int per_cu = 0; (void)hipOccupancyMaxActiveBlocksPerMultiprocessor(&per_cu, (const void*)trunk_fwd, NWAVES * 64, LDS_BYTES); (void)hipGetLastError();
        grid = cus;
    }
    if (grid < 0) return;
    (void)hipMemsetAsync((char*)d_ws + WS_CTL, 0, CTL_ZERO_BYTES, stream);
    Args a{};
    for (int i = 0; i < 14; ++i) a.in[i] = (const float*)d_in[i];
    a.out = (float*)d_out; a.ws = (unsigned char*)d_ws;
#if MK_PER_PHASE
    for (int p = 0; p < N_PHASES; ++p) { const int l = (p - 1) / 6, s = (p - 1) % 6; if (p >= 1 && p <= 24 && s == 2 && (l & 1) == 0) continue;
        a.ph_lo = p; a.ph_hi = p + 1; a.li = 0; hipLaunchKernelGGL(trunk_fwd, dim3(grid), dim3(NWAVES * 64), LDS_BYTES, stream, a); }
#else
    a.ph_lo = 0; a.ph_hi = N_PHASES; a.li = 0;
    hipLaunchKernelGGL(trunk_fwd, dim3(grid), dim3(NWAVES * 64), LDS_BYTES, stream, a);
#endif
}
```

```cpp
#include <hip/hip_runtime.h>
#include <cstdio>
#include <cstdint>
#include <cmath>
#ifndef TS_EPI
#define TS_EPI 0
#endif
namespace pg8 {
#define PG8_LAS __attribute__((address_space(3)))
typedef unsigned short bf16_t;
typedef short bf16x8 __attribute__((ext_vector_type(8)));
typedef float f32x4 __attribute__((ext_vector_type(4)));
typedef unsigned u32x4 __attribute__((ext_vector_type(4)));
constexpr int BM = 256, BK = 64, HALF = 128, HTB = HALF * BK * 2  , STAGE_BYTES = 8 * HTB, NXCD = 8, WGM = 4;

__host__ __device__ __forceinline__ int lds_byte(int r, int c) { const int st = (r >> 4) * 2 + (c >> 5), rr = r & 15, cc = c & 31, ob = rr * 64 + cc * 2; return st * 1024 + (ob ^ (((ob >> 9) & 1) << 5)); }
__host__ __device__ __forceinline__ void stage_rc(int b, int& R, int& C) { const int st = b / 1024, sb = b % 1024, swz = sb ^ (((sb >> 9) & 1) << 5); R = (st >> 1) * 16 + swz / 64; C = (st & 1) * 32 + (swz % 64) / 2; }
__host__ __device__ __forceinline__ int perm32(int rho) { const int n = rho >> 4, i = rho & 15; return 8 * (i >> 2) + 4 * n + (i & 3); }

struct Unit { int pm, pn; };
struct Gemm { const bf16_t* A; const bf16_t* Bt; int M, N, K; };

struct StaticOrder {
    int nM, nN, nwg, G, c;
    __host__ __device__ void init(int M, int N, int G_, int c_) { nM = M / BM; nN = N / BM; nwg = nM * nN; G = G_; c = c_; }
    __host__ __device__ bool next(int i, Unit& u) const {
        const long L = (long)i * G + c; if (L >= nwg) return false;
        int wgid = (int)L; { const int q = nwg / NXCD, r = nwg % NXCD, xcd = wgid % NXCD, off = wgid / NXCD; wgid = (xcd < r ? xcd * (q + 1) : r * (q + 1) + (xcd - r) * q) + off; }
        const int nig = WGM * nN, gid = wgid / nig, fm = gid * WGM, gsz = (nM - fm) < WGM ? (nM - fm) : WGM;
        u.pm = fm + ((wgid % nig) % gsz); u.pn = (wgid % nig) / gsz; return true;
    }
    __device__ __forceinline__ void a_ready(const Unit&) const {}
    __device__ __forceinline__ void done(const Unit&) const {}
};


__device__ __forceinline__ unsigned cvt_pk_bf16(float lo, float hi) { typedef float f2_ __attribute__((ext_vector_type(2))); typedef __bf16 b2_ __attribute__((ext_vector_type(2))); f2_ v = {lo, hi}; b2_ b = __builtin_convertvector(v, b2_); return __builtin_bit_cast(unsigned, b); }
typedef unsigned u32x2 __attribute__((ext_vector_type(2)));
constexpr float RMS_EPS = 1e-6f;
__device__ __forceinline__ float row_rstd(const float* ssq, int row) {
    const f32x4* p = (const f32x4*)(ssq + (size_t)row * 16);
    const f32x4 a = p[0], b = p[1], c = p[2], d = p[3];
    const float s = (((a[0] + a[1]) + (a[2] + a[3])) + ((b[0] + b[1]) + (b[2] + b[3]))) + (((c[0] + c[1]) + (c[2] + c[3])) + ((d[0] + d[1]) + (d[2] + d[3])));
    return __builtin_amdgcn_rsqf(s * (1.0f / 1024.0f) + RMS_EPS);
}
__device__ __forceinline__ float row_rstd_q(const float* ssq, int row, int fq) {
    const f32x4 a = *((const f32x4*)(ssq + (size_t)row * 16) + fq);
    float s = (a[0] + a[1]) + (a[2] + a[3]);
    s += __shfl_xor(s, 16); s += __shfl_xor(s, 32);
    return __builtin_amdgcn_rsqf(s * (1.0f / 1024.0f) + RMS_EPS);
}
__device__ __forceinline__ void row_rstd_half(const float* ssq, int rowh, int fq, float (&rs)[4]) {
    f32x4 a[4];
#pragma unroll
    for (int m = 0; m < 4; ++m) a[m] = *((const f32x4*)(ssq + (size_t)(rowh + m * 16) * 16) + fq);
#pragma unroll
    for (int m = 0; m < 4; ++m) { float s = (a[m][0] + a[m][1]) + (a[m][2] + a[m][3]); s += __shfl_xor(s, 16); s += __shfl_xor(s, 32); rs[m] = __builtin_amdgcn_rsqf(s * (1.0f / 1024.0f) + RMS_EPS); }
}
__device__ __forceinline__ float sigmoid_f(float z) { return __builtin_amdgcn_rcpf(1.0f + __expf(-z)); }

struct EpiAB {
    static constexpr bool PERM = true, AFTER_DRAIN = false; static constexpr int NS_MIN = 16;
    bf16_t* O; size_t tstride; const float* ssq; float qscale;
    __device__ __forceinline__ void operator()(const f32x4 (&acc)[2][2][4][2], const Unit& u, int wr, int wc, int fr, int fq) const {
        const int t = u.pn >> 1; bf16_t* base = O + (size_t)t * tstride;
        const int col0 = (u.pn & 1) * 256 + wc * 32 + 8 * fq, row0 = u.pm * BM + wr * 64 + fr;
        const float sc0 = (t == 0) ? qscale : 1.0f;
#pragma unroll
        for (int ai = 0; ai < 2; ++ai) { float rsv[4]; row_rstd_half(ssq, row0 + ai * HALF, fq, rsv);
#pragma unroll
            for (int m = 0; m < 4; ++m) { const int row = row0 + ai * HALF + m * 16; const float rs = rsv[m] * sc0; bf16_t* rowp = base + (size_t)row * 512 + col0;
#pragma unroll
                for (int bj = 0; bj < 2; ++bj) { const f32x4 v0 = acc[ai][bj][m][0] * rs, v1 = acc[ai][bj][m][1] * rs;
                    u32x4 w; w.x = cvt_pk_bf16(v0[0], v0[1]); w.y = cvt_pk_bf16(v0[2], v0[3]); w.z = cvt_pk_bf16(v1[0], v1[1]); w.w = cvt_pk_bf16(v1[2], v1[3]);
                    *(u32x4*)(rowp + bj * HALF) = w; } } }
    }
};
struct EpiRes {
    static constexpr bool PERM = true, AFTER_DRAIN = false; static constexpr int NS_MIN = 16;
    const bf16_t* base; bf16_t* out; float* ssq;
    __device__ __forceinline__ void operator()(const f32x4 (&acc)[2][2][4][2], const Unit& u, int wr, int wc, int fr, int fq) const {
        const int col0 = u.pn * BM + wc * 32 + 8 * fq;
#pragma unroll
        for (int ai = 0; ai < 2; ++ai) {
            u32x4 b[4][2];
#pragma unroll
            for (int m = 0; m < 4; ++m)
#pragma unroll
                for (int bj = 0; bj < 2; ++bj) b[m][bj] = *(const u32x4*)(base + (size_t)(u.pm * BM + ai * HALF + wr * 64 + m * 16 + fr) * 1024 + col0 + bj * HALF);
#pragma unroll
            for (int m = 0; m < 4; ++m) { const int row = u.pm * BM + ai * HALF + wr * 64 + m * 16 + fr; const size_t off = (size_t)row * 1024 + col0; float s = 0.f;
#pragma unroll
                for (int bj = 0; bj < 2; ++bj) { const u32x4 bb = b[m][bj]; f32x4 x0 = acc[ai][bj][m][0], x1 = acc[ai][bj][m][1];
                    x0[0] += __uint_as_float(bb.x << 16); x0[1] += __uint_as_float(bb.x & 0xffff0000u); x0[2] += __uint_as_float(bb.y << 16); x0[3] += __uint_as_float(bb.y & 0xffff0000u);
                    x1[0] += __uint_as_float(bb.z << 16); x1[1] += __uint_as_float(bb.z & 0xffff0000u); x1[2] += __uint_as_float(bb.w << 16); x1[3] += __uint_as_float(bb.w & 0xffff0000u);
                    u32x4 w; w.x = cvt_pk_bf16(x0[0], x0[1]); w.y = cvt_pk_bf16(x0[2], x0[3]); w.z = cvt_pk_bf16(x1[0], x1[1]); w.w = cvt_pk_bf16(x1[2], x1[3]);
                    *(u32x4*)(out + off + bj * HALF) = w;
                    const float r0 = __uint_as_float(w.x << 16), r1 = __uint_as_float(w.x & 0xffff0000u), r2 = __uint_as_float(w.y << 16), r3 = __uint_as_float(w.y & 0xffff0000u);
                    const float r4 = __uint_as_float(w.z << 16), r5 = __uint_as_float(w.z & 0xffff0000u), r6 = __uint_as_float(w.w << 16), r7 = __uint_as_float(w.w & 0xffff0000u);
                    s += ((r0 * r0 + r1 * r1) + (r2 * r2 + r3 * r3)) + ((r4 * r4 + r5 * r5) + (r6 * r6 + r7 * r7)); }
                s += __shfl_xor(s, 16); s += __shfl_xor(s, 32);
                if (fq == 0) ssq[(size_t)row * 16 + u.pn * 4 + wc] = s; }
        }
    }
};
struct EpiResFinal {
    static constexpr bool PERM = true, AFTER_DRAIN = false; static constexpr int NS_MIN = 0;
    const bf16_t* base; float* out; float* xs; unsigned* cnt; const float* gain;
    __device__ __forceinline__ void operator()(const f32x4 (&acc)[2][2][4][2], const Unit& u, int wr, int wc, int fr, int fq) const {
        const int col0 = u.pn * BM + wc * 32 + 8 * fq, rowb = u.pm * BM + wr * 64 + fr;
#pragma unroll
        for (int ai = 0; ai < 2; ++ai) { u32x4 b[4][2];
#pragma unroll
            for (int m = 0; m < 4; ++m)
#pragma unroll
                for (int bj = 0; bj < 2; ++bj) b[m][bj] = *(const u32x4*)(base + (size_t)(rowb + ai * HALF + m * 16) * 1024 + col0 + bj * HALF);
#pragma unroll
            for (int m = 0; m < 4; ++m) { const int row = rowb + ai * HALF + m * 16; float s = 0.f;
#pragma unroll
                for (int bj = 0; bj < 2; ++bj) { const u32x4 bb = b[m][bj]; const f32x4 a0 = acc[ai][bj][m][0], a1 = acc[ai][bj][m][1];
                    const float x0 = a0[0] + __uint_as_float(bb.x << 16), x1 = a0[1] + __uint_as_float(bb.x & 0xffff0000u), x2 = a0[2] + __uint_as_float(bb.y << 16), x3 = a0[3] + __uint_as_float(bb.y & 0xffff0000u);
                    const float x4 = a1[0] + __uint_as_float(bb.z << 16), x5 = a1[1] + __uint_as_float(bb.z & 0xffff0000u), x6 = a1[2] + __uint_as_float(bb.w << 16), x7 = a1[3] + __uint_as_float(bb.w & 0xffff0000u);
                    s += ((x0 * x0 + x1 * x1) + (x2 * x2 + x3 * x3)) + ((x4 * x4 + x5 * x5) + (x6 * x6 + x7 * x7)); }
                s += __shfl_xor(s, 16); s += __shfl_xor(s, 32);
                if (fq == 0) __hip_atomic_store(xs + (size_t)row * 16 + u.pn * 4 + wc, s, __ATOMIC_RELAXED, __HIP_MEMORY_SCOPE_AGENT); } }
        asm volatile("s_waitcnt vmcnt(0)" ::: "memory");
        unsigned* const pc = cnt + 64 * u.pm;
        if ((threadIdx.x & 63) == 0) __hip_atomic_fetch_add(pc, 1u, __ATOMIC_RELAXED, __HIP_MEMORY_SCOPE_AGENT);
        { const unsigned long long t0 = __builtin_amdgcn_s_memrealtime();
          while ((unsigned)__builtin_amdgcn_readfirstlane(__hip_atomic_load(pc, __ATOMIC_RELAXED, __HIP_MEMORY_SCOPE_AGENT)) < 32u) {
              if (__builtin_amdgcn_s_memrealtime() - t0 > 2000000ull) break;
              __builtin_amdgcn_s_sleep(2); } }
        asm volatile("" ::: "memory");
        const f32x4 g0 = *(const f32x4*)(gain + col0), g1 = *(const f32x4*)(gain + col0 + 4), g2 = *(const f32x4*)(gain + col0 + HALF), g3 = *(const f32x4*)(gain + col0 + HALF + 4);
#pragma unroll
        for (int ai = 0; ai < 2; ++ai) { u32x4 b[4][2]; float rs[4];
#pragma unroll
            for (int m = 0; m < 4; ++m) { const int row = rowb + ai * HALF + m * 16; const float* xp = xs + (size_t)row * 16 + 4 * fq;
                float s = (__hip_atomic_load(xp, __ATOMIC_RELAXED, __HIP_MEMORY_SCOPE_AGENT) + __hip_atomic_load(xp + 1, __ATOMIC_RELAXED, __HIP_MEMORY_SCOPE_AGENT))
                        + (__hip_atomic_load(xp + 2, __ATOMIC_RELAXED, __HIP_MEMORY_SCOPE_AGENT) + __hip_atomic_load(xp + 3, __ATOMIC_RELAXED, __HIP_MEMORY_SCOPE_AGENT));
                s += __shfl_xor(s, 16); s += __shfl_xor(s, 32); rs[m] = __builtin_amdgcn_rsqf(s * (1.0f / 1024.0f) + RMS_EPS);
#pragma unroll
                for (int bj = 0; bj < 2; ++bj) b[m][bj] = *(const u32x4*)(base + (size_t)row * 1024 + col0 + bj * HALF); }
#pragma unroll
            for (int m = 0; m < 4; ++m) { const int row = rowb + ai * HALF + m * 16; const float r = rs[m]; float* op = out + (size_t)row * 1024 + col0;
#pragma unroll
                for (int bj = 0; bj < 2; ++bj) { const u32x4 bb = b[m][bj]; const f32x4 a0 = acc[ai][bj][m][0], a1 = acc[ai][bj][m][1]; const f32x4 ga = bj ? g2 : g0, gb = bj ? g3 : g1;
                    f32x4 o0, o1;
                    o0[0] = (a0[0] + __uint_as_float(bb.x << 16)) * r * ga[0]; o0[1] = (a0[1] + __uint_as_float(bb.x & 0xffff0000u)) * r * ga[1];
                    o0[2] = (a0[2] + __uint_as_float(bb.y << 16)) * r * ga[2]; o0[3] = (a0[3] + __uint_as_float(bb.y & 0xffff0000u)) * r * ga[3];
                    o1[0] = (a1[0] + __uint_as_float(bb.z << 16)) * r * gb[0]; o1[1] = (a1[1] + __uint_as_float(bb.z & 0xffff0000u)) * r * gb[1];
                    o1[2] = (a1[2] + __uint_as_float(bb.w << 16)) * r * gb[2]; o1[3] = (a1[3] + __uint_as_float(bb.w & 0xffff0000u)) * r * gb[3];
                    *(f32x4*)(op + bj * HALF) = o0; *(f32x4*)(op + bj * HALF + 4) = o1; } } }
    }
};
template <int SH> __device__ __forceinline__ float row_shr(float v) { return __builtin_bit_cast(float, __builtin_amdgcn_update_dpp(0, __builtin_bit_cast(int, v), 0x110 + SH, 0xf, 0xf, true)); }
__device__ __forceinline__ float rowscan16(float v) { v += row_shr<1>(v); v += row_shr<2>(v); v += row_shr<4>(v); v += row_shr<8>(v); return v; }
__device__ __forceinline__ float rowlast16(float v) { return __shfl(v, 15, 16); }
struct EpiHG {
    static constexpr bool PERM = true, AFTER_DRAIN = false; static constexpr int NS_MIN = 16;
    bf16_t* QA; bf16_t* KD; bf16_t* KT; bf16_t* V; size_t tstride; float* DEC; const float* lb; const float* ssq; bool lbzero;
    __device__ __forceinline__ void operator()(const f32x4 (&acc)[2][2][4][2], const Unit& u, int wr, int wc, int fr, int fq) const {
        const int row0 = u.pm * BM + wr * 64 + fr;
        if (u.pn >= 8) {
            const int tt = (u.pn >= 12) ? 1 : 0; const int col0 = ((u.pn - 8) & 3) * 256 + wc * 32 + 8 * fq; bf16_t* const dbase = V + (size_t)tt * tstride;
#pragma unroll
            for (int ai = 0; ai < 2; ++ai) { float rsv[4]; row_rstd_half(ssq, row0 + ai * HALF, fq, rsv);
#pragma unroll
                for (int m = 0; m < 4; ++m) { const int row = row0 + ai * HALF + m * 16; const float rs = rsv[m]; const size_t off = (size_t)row * 1024 + col0;
#pragma unroll
                    for (int bj = 0; bj < 2; ++bj) { f32x4 v0 = acc[ai][bj][m][0] * rs, v1 = acc[ai][bj][m][1] * rs;
                        if (tt == 1) {
#pragma unroll
                            for (int i = 0; i < 4; ++i) { v0[i] = v0[i] * sigmoid_f(v0[i]); v1[i] = v1[i] * sigmoid_f(v1[i]); } }
                        u32x4 w; w.x = cvt_pk_bf16(v0[0], v0[1]); w.y = cvt_pk_bf16(v0[2], v0[3]); w.z = cvt_pk_bf16(v1[0], v1[1]); w.w = cvt_pk_bf16(v1[2], v1[3]);
                        *(u32x4*)(dbase + off + bj * HALF) = w; } } }
            return;
        }
        const int colh = u.pn * HALF + wc * 32 + 8 * fq;
        f32x4 lbv[2];
#pragma unroll
        for (int n = 0; n < 2; ++n) lbv[n] = *(const f32x4*)(lb + colh + 4 * n);
#pragma unroll
        for (int ai = 0; ai < 2; ++ai) { float rsv[4]; row_rstd_half(ssq, row0 + ai * HALF, fq, rsv);
#pragma unroll
            for (int c2 = 0; c2 < 2; ++c2) {
                const int rowE = row0 + ai * HALF + (2 * c2) * 16, rowO = rowE + 16;
                const float rsE = rsv[2 * c2], rsO = rsv[2 * c2 + 1];
#pragma unroll
                for (int n = 0; n < 2; ++n) { float oq[2][4], od[2][4], ot[2][4]; f32x4 dec;
#pragma unroll
                    for (int i = 0; i < 4; ++i) {
                        float lf[2], kk[2], qq[2];
#pragma unroll
                        for (int eo = 0; eo < 2; ++eo) { const float rs = eo ? rsO : rsE; const float z = acc[ai][1][2 * c2 + eo][n][i] * rs; qq[eo] = acc[ai][0][2 * c2 + eo][n][i] * rs;
                            const float e = __builtin_amdgcn_exp2f(-fabsf(z) * 1.4426950408889634f), d = __builtin_amdgcn_rcpf(1.0f + e), sg = z >= 0.f ? d : e * d; float f;
                            if (lbzero) { f = sg; lf[eo] = fminf(z, 0.f) * 1.4426950408889634f - __builtin_amdgcn_logf(1.0f + e); }
                            else { const float l = lbv[n][i]; f = l + (1.0f - l) * sg; lf[eo] = __builtin_amdgcn_logf(f); }
                            kk[eo] = 1.0f - f; }
                        const float bE = rowscan16(lf[0]); const float totE = rowlast16(bE); const float bO = rowscan16(lf[1]) + totE; const float bl = rowlast16(bO);
                        oq[0][i] = qq[0] * __builtin_amdgcn_exp2f(bE); oq[1][i] = qq[1] * __builtin_amdgcn_exp2f(bO);
                        od[0][i] = kk[0] * __builtin_amdgcn_exp2f(fminf(-bE, 100.f)); od[1][i] = kk[1] * __builtin_amdgcn_exp2f(fminf(-bO, 100.f));
                        ot[0][i] = kk[0] * __builtin_amdgcn_exp2f(bl - bE); ot[1][i] = kk[1] * __builtin_amdgcn_exp2f(bl - bO);
                        dec[i] = __builtin_amdgcn_exp2f(bl); }
#pragma unroll
                    for (int eo = 0; eo < 2; ++eo) { const size_t off = (size_t)(eo ? rowO : rowE) * 1024 + colh + 4 * n; u32x2 w;
                        w.x = cvt_pk_bf16(oq[eo][0], oq[eo][1]); w.y = cvt_pk_bf16(oq[eo][2], oq[eo][3]); *(u32x2*)(QA + off) = w;
                        w.x = cvt_pk_bf16(od[eo][0], od[eo][1]); w.y = cvt_pk_bf16(od[eo][2], od[eo][3]); *(u32x2*)(KD + off) = w;
                        w.x = cvt_pk_bf16(ot[eo][0], ot[eo][1]); w.y = cvt_pk_bf16(ot[eo][2], ot[eo][3]); *(u32x2*)(KT + off) = w; }
                    if (fr == 0) *(f32x4*)(DEC + (size_t)(rowE >> 5) * 1024 + colh + 4 * n) = dec;
                    asm volatile("" ::: "memory"); }
            } }
    }
};
struct EpiSwi {
    static constexpr bool PERM = true, AFTER_DRAIN = false; static constexpr int NS_MIN = 8;
    bf16_t* H; const float* ssq;
    __device__ __forceinline__ void operator()(const f32x4 (&acc)[2][2][4][2], const Unit& u, int wr, int wc, int fr, int fq) const {
        const int col0 = u.pn * HALF + wc * 32 + 8 * fq, row0 = u.pm * BM + wr * 64 + fr;
#pragma unroll
        for (int ai = 0; ai < 2; ++ai) { float rsv[4]; row_rstd_half(ssq, row0 + ai * HALF, fq, rsv);
#pragma unroll
            for (int m = 0; m < 4; ++m) { const int row = row0 + ai * HALF + m * 16; const float rs = rsv[m];
                f32x4 h[2];
#pragma unroll
                for (int n = 0; n < 2; ++n) { const f32x4 g = acc[ai][0][m][n] * rs, uu = acc[ai][1][m][n] * rs;
#pragma unroll
                    for (int i = 0; i < 4; ++i) h[n][i] = g[i] * sigmoid_f(g[i]) * uu[i]; }
                u32x4 w; w.x = cvt_pk_bf16(h[0][0], h[0][1]); w.y = cvt_pk_bf16(h[0][2], h[0][3]); w.z = cvt_pk_bf16(h[1][0], h[1][1]); w.w = cvt_pk_bf16(h[1][2], h[1][3]);
                *(u32x4*)(H + (size_t)row * 2816 + col0) = w; } }
    }
};
template <class Epi, class Sched, bool ALIGN_EPI = false, bool SP2 = false>
__device__ __forceinline__ void gemm_phase(PG8_LAS unsigned char* lds, const Gemm g, const Sched& S, const Epi& E, unsigned* ts_out = nullptr) {
    int tid_ = threadIdx.x; asm volatile("" : "+v"(tid_));
    const int tid = tid_, wid = __builtin_amdgcn_readfirstlane(tid >> 6), lane = tid & 63, wr = wid >> 2, wc = wid & 3, fr = lane & 15, fq = lane >> 4;
    const int K = g.K, nt = K / BK;
    unsigned voffA[2], voffB[2];
#pragma unroll
    for (int i = 0; i < 2; ++i) { int R, C; stage_rc(tid * 16 + i * 8192, R, C); const int Rb = Epi::PERM ? ((R & ~31) + perm32(R & 31)) : R;
        voffA[i] = (unsigned)(R * K + C) * 2u; voffB[i] = (unsigned)(Rb * K + C) * 2u; }
    const size_t kstep = (size_t)(BK * 2);
    const size_t hstep = (size_t)HALF * K * 2;
    const size_t tstep = 2 * hstep;
    const unsigned ldsw = (unsigned)wid * 1024u;
    const int aoff = lds_byte(wr * 64 + fr, fq * 8), boff = lds_byte(wc * 32 + fr, fq * 8);
#define PG8_SA(b, h) (((b) * 2 + (h)) * HTB)
#define PG8_SB(b, h) ((4 + (b) * 2 + (h)) * HTB)
#define PG8_STAGE(bufoff, gbase, voff) do { _Pragma("unroll") for (int _i = 0; _i < 2; ++_i) \
        __builtin_amdgcn_global_load_lds((const unsigned*)((const char*)(gbase) + (voff)[_i]), (PG8_LAS unsigned*)(lds + (bufoff) + ldsw + _i * 8192), 16, 0, 0); } while (0)
#define PG8_LDA(dst, b, h) do { _Pragma("unroll") for (int m = 0; m < 4; ++m) _Pragma("unroll") for (int k = 0; k < 2; ++k) dst[m][k] = *(const PG8_LAS bf16x8*)(lds + PG8_SA(b, h) + aoff + m * 2048 + k * 1024); } while (0)
#define PG8_LDB(dst, b, h) do { _Pragma("unroll") for (int n = 0; n < 2; ++n) _Pragma("unroll") for (int k = 0; k < 2; ++k) dst[n][k] = *(const PG8_LAS bf16x8*)(lds + PG8_SB(b, h) + boff + n * 2048 + k * 1024); } while (0)
#define PG8_MMA(ai, bj, At, Bt) do { __builtin_amdgcn_s_setprio(1); _Pragma("unroll") for (int m = 0; m < 4; ++m) _Pragma("unroll") for (int n = 0; n < 2; ++n) _Pragma("unroll") for (int k = 0; k < 2; ++k) \
        acc[ai][bj][m][n] = __builtin_amdgcn_mfma_f32_16x16x32_bf16(Bt[n][k], At[m][k], acc[ai][bj][m][n], 0, 0, 0); __builtin_amdgcn_s_setprio(0); } while (0)
#define PG8_WAIT_V(n) asm volatile("s_waitcnt vmcnt(" #n ")" ::: "memory")
#define PG8_WAIT_V8_SEL(rlx, n) asm volatile("s_cmp_lg_u32 %0, 0\n\ts_cbranch_scc1 .Lpg8_rlx_%=\n\ts_waitcnt vmcnt(8)\n\ts_branch .Lpg8_end_%=\n.Lpg8_rlx_%=:\n\ts_waitcnt vmcnt(" #n ")\n.Lpg8_end_%=:" :: "s"(rlx) : "scc", "memory")
#define PG8_WAIT_V8_FIRST(rlx) do { if constexpr (Epi::NS_MIN >= 16) PG8_WAIT_V8_SEL(rlx, 24); else if constexpr (Epi::NS_MIN >= 8) PG8_WAIT_V8_SEL(rlx, 16); else PG8_WAIT_V(8); } while (0)
#define PG8_WAIT_L(n) asm volatile("s_waitcnt lgkmcnt(" #n ")" ::: "memory")
#define PG8_BAR __builtin_amdgcn_s_barrier()
#define PG8_SCHED __builtin_amdgcn_sched_barrier(0)
    Unit cur, nxt; int ui = 0;
#if TS_EPI
    unsigned ts_epi_ = 0;
#endif
    if (!S.next(0, cur)) return;
    f32x4 acc[2][2][4][2];
#pragma unroll
    for (int a = 0; a < 2; ++a)
#pragma unroll
        for (int b = 0; b < 2; ++b)
#pragma unroll
            for (int m = 0; m < 4; ++m)
#pragma unroll
                for (int n = 0; n < 2; ++n) acc[a][b][m][n] = (f32x4){0.f, 0.f, 0.f, 0.f};
    bf16x8 At[4][2], B0[2][2], B1[2][2];
    const char* cA = (const char*)g.A + (size_t)cur.pm * tstep; const char* cB = (const char*)g.Bt + (size_t)cur.pn * tstep;
    S.a_ready(cur);
    if constexpr (SP2) {
        PG8_STAGE(PG8_SB(0, 0), cB, voffB); PG8_STAGE(PG8_SB(0, 1), cB + hstep, voffB); PG8_STAGE(PG8_SA(0, 0), cA, voffA); PG8_STAGE(PG8_SA(0, 1), cA + hstep, voffA);
        if (wr == 1) PG8_BAR;
        PG8_WAIT_V(2); PG8_BAR;
        PG8_STAGE(PG8_SB(1, 0), cB + kstep, voffB); PG8_STAGE(PG8_SA(1, 0), cA + kstep, voffA); PG8_STAGE(PG8_SB(1, 1), cB + hstep + kstep, voffB);
        PG8_WAIT_V(6); PG8_BAR;
    } else {
        PG8_STAGE(PG8_SB(0, 0), cB, voffB); PG8_STAGE(PG8_SA(0, 0), cA, voffA); PG8_STAGE(PG8_SB(0, 1), cB + hstep, voffB); PG8_STAGE(PG8_SA(0, 1), cA + hstep, voffA);
        if (wr == 1) PG8_BAR;
        PG8_WAIT_V(4); PG8_BAR;
        PG8_STAGE(PG8_SB(1, 0), cB + kstep, voffB); PG8_STAGE(PG8_SA(1, 0), cA + kstep, voffA); PG8_STAGE(PG8_SB(1, 1), cB + hstep + kstep, voffB);
        PG8_WAIT_V(6); PG8_BAR;
    }
    for (;;) {
        const bool has_next = S.next(ui + 1, nxt);
        const char* nA = has_next ? (const char*)g.A + (size_t)nxt.pm * tstep : cA; const char* nB = has_next ? (const char*)g.Bt + (size_t)nxt.pn * tstep : cB;
#if TS_EPI == 2
        const unsigned long long tk0_ = __builtin_amdgcn_s_memtime();
#endif
        for (int t = 0; t < nt; t += 2) {
            const bool last = (t == nt - 2);
            const char* a1 = cA + (size_t)(t + 1) * kstep;
            const char* a2 = last ? nA : cA + (size_t)(t + 2) * kstep; const char* b2 = last ? nB : cB + (size_t)(t + 2) * kstep;
            const char* a3 = a2 + kstep; const char* b3 = b2 + kstep;
            if (last && has_next) S.a_ready(nxt);
            const int relax_ = __builtin_amdgcn_readfirstlane(((t == 0) && (ui > 0)) ? 1 : 0);
            if constexpr (SP2) {
            PG8_LDB(B0, 0, 0); PG8_LDB(B1, 0, 1); PG8_SCHED; PG8_LDA(At, 0, 0); PG8_STAGE(PG8_SA(1, 1), a1 + hstep, voffA);
            PG8_WAIT_V8_FIRST(relax_); PG8_WAIT_L(0); PG8_BAR; PG8_MMA(0, 0, At, B0); PG8_MMA(0, 1, At, B1); PG8_BAR; PG8_SCHED;
            PG8_LDA(At, 0, 1); PG8_STAGE(PG8_SB(0, 0), b2, voffB); PG8_STAGE(PG8_SB(0, 1), b2 + hstep, voffB); PG8_STAGE(PG8_SA(0, 0), a2, voffA);
            PG8_WAIT_V8_FIRST(relax_); PG8_WAIT_L(0); PG8_BAR; PG8_MMA(1, 0, At, B0); PG8_MMA(1, 1, At, B1); PG8_BAR; PG8_SCHED;
            PG8_LDB(B0, 1, 0); PG8_LDB(B1, 1, 1); PG8_SCHED; PG8_LDA(At, 1, 0); PG8_STAGE(PG8_SA(0, 1), a2 + hstep, voffA);
            PG8_WAIT_V(8); PG8_WAIT_L(0); PG8_BAR; PG8_MMA(0, 0, At, B0); PG8_MMA(0, 1, At, B1); PG8_BAR; PG8_SCHED;
            PG8_LDA(At, 1, 1); PG8_STAGE(PG8_SB(1, 0), b3, voffB); PG8_STAGE(PG8_SB(1, 1), b3 + hstep, voffB); PG8_STAGE(PG8_SA(1, 0), a3, voffA);
            PG8_WAIT_V(8); PG8_WAIT_L(0); PG8_BAR; PG8_MMA(1, 0, At, B0); PG8_MMA(1, 1, At, B1); PG8_BAR; PG8_SCHED;
            } else {
            PG8_LDB(B0, 0, 0); PG8_SCHED; PG8_LDA(At, 0, 0); PG8_STAGE(PG8_SA(1, 1), a1 + hstep, voffA);
            PG8_WAIT_L(8); PG8_BAR; PG8_WAIT_L(0); PG8_MMA(0, 0, At, B0); PG8_BAR; PG8_SCHED;
            PG8_LDB(B1, 0, 1); PG8_STAGE(PG8_SB(0, 0), b2, voffB);
            PG8_BAR; PG8_WAIT_L(0); PG8_MMA(0, 1, At, B1); PG8_BAR;
            PG8_LDA(At, 0, 1); PG8_STAGE(PG8_SA(0, 0), a2, voffA);
            PG8_BAR; PG8_WAIT_L(0); PG8_MMA(1, 0, At, B0); PG8_BAR; PG8_SCHED;
            PG8_STAGE(PG8_SB(0, 1), b2 + hstep, voffB);
            PG8_WAIT_V(6); PG8_BAR; PG8_MMA(1, 1, At, B1); PG8_BAR;
            PG8_LDB(B0, 1, 0); PG8_SCHED; PG8_LDA(At, 1, 0); PG8_STAGE(PG8_SA(0, 1), a2 + hstep, voffA);
            PG8_WAIT_L(8); PG8_BAR; PG8_WAIT_L(0); PG8_MMA(0, 0, At, B0); PG8_BAR; PG8_SCHED;
            PG8_LDB(B1, 1, 1); PG8_STAGE(PG8_SB(1, 0), b3, voffB);
            PG8_BAR; PG8_WAIT_L(0); PG8_MMA(0, 1, At, B1); PG8_BAR;
            PG8_LDA(At, 1, 1); PG8_STAGE(PG8_SA(1, 0), a3, voffA);
            PG8_BAR; PG8_WAIT_L(0); PG8_MMA(1, 0, At, B0); PG8_BAR; PG8_SCHED;
            PG8_STAGE(PG8_SB(1, 1), b3 + hstep, voffB);
            PG8_WAIT_V(6); PG8_BAR; PG8_MMA(1, 1, At, B1); PG8_BAR;
            }
        }
#if TS_EPI == 2
        ts_epi_ += (unsigned)(__builtin_amdgcn_s_memtime() - tk0_);
#endif
        if constexpr (ALIGN_EPI) { if (wr == 0) PG8_BAR; }
#if TS_EPI == 1
        const unsigned long long te0_ = __builtin_amdgcn_s_memrealtime();
#endif
        if constexpr (!Epi::AFTER_DRAIN) { E(acc, cur, wr, wc, fr, fq); S.done(cur); }
#if TS_EPI == 1
        asm volatile("s_waitcnt vmcnt(0)" ::: "memory");
        ts_epi_ += (unsigned)(__builtin_amdgcn_s_memrealtime() - te0_);
#endif
        if (!has_next) break;
#pragma unroll
        for (int a = 0; a < 2; ++a)
#pragma unroll
            for (int b = 0; b < 2; ++b)
#pragma unroll
                for (int m = 0; m < 4; ++m)
#pragma unroll
                    for (int n = 0; n < 2; ++n) acc[a][b][m][n] = (f32x4){0.f, 0.f, 0.f, 0.f};
        cur = nxt; cA = nA; cB = nB; ++ui;
        if constexpr (ALIGN_EPI) { if (wr == 1) PG8_BAR; }
    }
#if TS_EPI
    if (blockIdx.x == 0 && threadIdx.x == 0) *ts_out = ts_epi_;
#endif
    PG8_WAIT_V(0);
    if constexpr (!ALIGN_EPI) { if (wr == 0) PG8_BAR; }
    PG8_BAR;
    if constexpr (Epi::AFTER_DRAIN) { E.fused(acc, cur, wr, wc, fr, fq, lds, wid, lane); S.done(cur); }
#undef PG8_SA
#undef PG8_SB
#undef PG8_STAGE
#undef PG8_LDA
#undef PG8_LDB
#undef PG8_MMA
#undef PG8_WAIT_V
#undef PG8_WAIT_V8_FIRST
#undef PG8_WAIT_V8_SEL
#undef PG8_WAIT_L
#undef PG8_BAR
#undef PG8_SCHED
}
}

#include <hip/hip_bf16.h>
#include <cmath>
namespace attn_body {
using bf16=__hip_bfloat16;
using bf16x8=__attribute__((ext_vector_type(8)))short;
using s16x4=__attribute__((ext_vector_type(4)))short;
using f32x16=__attribute__((ext_vector_type(16)))float;
using u32x4=__attribute__((ext_vector_type(4)))unsigned;
using f32x4_t=__attribute__((ext_vector_type(4)))float;
constexpr int BATCH=8,NHEAD=8,SEQ=2048,D=64,DM=NHEAD*D,OPITCH=1024;
constexpr int NW=8,QBLK=32,QB=QBLK*NW,KVBLK=64,NQB=SEQ/QB;
constexpr int ATTN_PITCH=DM, ATTN_UNIT_ROWS=QB;
constexpr float ATT_LOG2E=1.4426950408889634f;
__device__ __forceinline__ int crow(int r,int hi){return (r&3)+8*(r>>2)+4*hi;}
#define SBAR() __builtin_amdgcn_sched_barrier(0)
__device__ __forceinline__ void cmask(f32x16&p0,f32x16&p1,int jb,int qrel,int hi){
  const float NEG=-INFINITY; int kb=64*jb+4*hi;
  #pragma unroll
  for(int r=0;r<16;++r){int kv=kb+(r&3)+8*(r>>2); if(kv>qrel)p0[r]=NEG; if(kv+32>qrel)p1[r]=NEG;}
}

constexpr int NSLOT=3, SLOTB=8192;
constexpr int LDS_K=0, LDS_V=NSLOT*SLOTB, LDS_WS=2*NSLOT*SLOTB, LDS_OST=LDS_WS+NW*64*4, LDS_BETA=LDS_OST+NW*4096, LDS_PRE=LDS_BETA+SEQ*4, LDS_BYTES=LDS_PRE+256;
constexpr float C2=0.125f*1.4426950408889634f;
__device__ __forceinline__ void glds16(const void*gsrc,unsigned lds_dst){unsigned keep;
  asm volatile("s_mov_b32 %0, m0\n\ts_mov_b32 m0, %2\n\ts_nop 0\n\tglobal_load_lds_dwordx4 %1, off\n\ts_mov_b32 m0, %0":"=&s"(keep):"v"(gsrc),"s"(lds_dst):"memory");}
__device__ __forceinline__ float max3f(float a,float b,float c){float r;asm("v_max3_f32 %0, %1, %2, %3":"=v"(r):"v"(a),"v"(b),"v"(c));return r;}
__device__ __forceinline__ float max2f(float a,float b){float r;asm("v_max_f32_e32 %0, %1, %2":"=v"(r):"v"(a),"v"(b));return r;}
__device__ __forceinline__ float fadd_s(float a,float b){float r;asm("v_add_f32_e32 %0, %1, %2":"=v"(r):"v"(a),"v"(b));return r;}
__device__ __forceinline__ float fsub_s(float a,float b){float r;asm("v_sub_f32_e32 %0, %1, %2":"=v"(r):"v"(a),"v"(b));return r;}
typedef float f32x2_t __attribute__((ext_vector_type(2))); typedef __bf16 bf16x2_t __attribute__((ext_vector_type(2)));
__device__ __forceinline__ unsigned cvtpk_s(float lo,float hi){f32x2_t v={lo,hi};bf16x2_t b=__builtin_convertvector(v,bf16x2_t);return __builtin_bit_cast(unsigned,b);}
#define WAIT_BAR(N) asm volatile("s_waitcnt vmcnt(" #N ") lgkmcnt(0)\n\ts_barrier":::"memory")

__device__ __forceinline__ void qkt(f32x16&p0,f32x16&p1,const char*Kslot,const bf16x8*qr,const f32x16&negm,int r32,int hi){
  const char*kb=Kslot+hi*1024+r32*16;
  #pragma unroll
  for(int d0=0;d0<4;++d0){
    const bf16x8 b0=*reinterpret_cast<const bf16x8*>(kb+d0*2048);
    const bf16x8 b1=*reinterpret_cast<const bf16x8*>(kb+d0*2048+512);
    if(d0==0){p0=__builtin_amdgcn_mfma_f32_32x32x16_bf16(b0,qr[0],negm,0,0,0);p1=__builtin_amdgcn_mfma_f32_32x32x16_bf16(b1,qr[0],negm,0,0,0);}
    else{p0=__builtin_amdgcn_mfma_f32_32x32x16_bf16(b0,qr[d0],p0,0,0,0);p1=__builtin_amdgcn_mfma_f32_32x32x16_bf16(b1,qr[d0],p1,0,0,0);}}
}
typedef __attribute__((address_space(3))) const char* lds_cptr;
typedef short v4i16_t __attribute__((ext_vector_type(4)));
__device__ __forceinline__ void kload8(bf16x8*kf,lds_cptr kp){
  kf[0]=*(const __attribute__((address_space(3))) bf16x8*)(kp);      kf[1]=*(const __attribute__((address_space(3))) bf16x8*)(kp+512);
  kf[2]=*(const __attribute__((address_space(3))) bf16x8*)(kp+2048); kf[3]=*(const __attribute__((address_space(3))) bf16x8*)(kp+2560);
  kf[4]=*(const __attribute__((address_space(3))) bf16x8*)(kp+4096); kf[5]=*(const __attribute__((address_space(3))) bf16x8*)(kp+4608);
  kf[6]=*(const __attribute__((address_space(3))) bf16x8*)(kp+6144); kf[7]=*(const __attribute__((address_space(3))) bf16x8*)(kp+6656);
}
__device__ __forceinline__ void kload2(bf16x8*kf,lds_cptr kp,int j){ kf[2*j]=*(const __attribute__((address_space(3))) bf16x8*)(kp+j*2048); kf[2*j+1]=*(const __attribute__((address_space(3))) bf16x8*)(kp+j*2048+512); }
__device__ __forceinline__ s16x4 vtr(lds_cptr p){ return __builtin_bit_cast(s16x4,__builtin_amdgcn_ds_read_tr16_b64_v4i16((__attribute__((address_space(3))) v4i16_t*)p)); }
__device__ __forceinline__ float rowmax(const f32x16&p0,const f32x16&p1){
  float a=max3f(p0[0],p0[1],p1[0]),b=max3f(p0[2],p0[3],p1[1]);a=max3f(a,p1[2],p1[3]);
  #pragma unroll
  for(int r=4;r<16;r+=4){a=max3f(a,p0[r],p0[r+1]);b=max3f(b,p0[r+2],p0[r+3]);a=max3f(a,p1[r],p1[r+1]);b=max3f(b,p1[r+2],p1[r+3]);}
  const float m=max2f(a,b);
  auto rr=__builtin_amdgcn_permlane32_swap(__float_as_uint(m),__float_as_uint(m),false,false);
  return max2f(__uint_as_float(rr[0]),__uint_as_float(rr[1]));
}
__device__ __forceinline__ void pv(f32x16*o,int vb,bf16x8 pa0,bf16x8 pa1,bf16x8 pa2,bf16x8 pa3){
  #pragma unroll
  for(int d0=0;d0<2;++d0){s16x4 lo[4],hi[4];
    #pragma unroll
    for(int ks=0;ks<4;++ks){
      asm volatile("ds_read_b64_tr_b16 %0,%1 offset:%c2":"=&v"(lo[ks]):"v"(vb),"i"(d0*4096+ks*1024):"memory");
      asm volatile("ds_read_b64_tr_b16 %0,%1 offset:%c2":"=&v"(hi[ks]):"v"(vb),"i"(d0*4096+ks*1024+512):"memory");}
    asm volatile("s_waitcnt lgkmcnt(0)":::"memory");SBAR();
    #define PK(k) (bf16x8){lo[k][0],lo[k][1],lo[k][2],lo[k][3],hi[k][0],hi[k][1],hi[k][2],hi[k][3]}
    o[d0]=__builtin_amdgcn_mfma_f32_32x32x16_bf16(pa0,PK(0),o[d0],0,0,0);
    o[d0]=__builtin_amdgcn_mfma_f32_32x32x16_bf16(pa1,PK(1),o[d0],0,0,0);
    o[d0]=__builtin_amdgcn_mfma_f32_32x32x16_bf16(pa2,PK(2),o[d0],0,0,0);
    o[d0]=__builtin_amdgcn_mfma_f32_32x32x16_bf16(pa3,PK(3),o[d0],0,0,0);
    #undef PK
  }
}

#ifndef ATTN_STORE16
#define ATTN_STORE16(p,v) (*(u32x4*)(p)=(v))
#endif
template<int THRL> __device__ __forceinline__ void attn_unit(int b,int h,int qb,const bf16*Q,const bf16*__restrict__ K,const bf16*__restrict__ V,bf16*O,char*shm){
  int tid_o=threadIdx.x; asm volatile("":"+v"(tid_o));
  const int tid=tid_o,lane=tid&63,r32=lane&31,hi=lane>>5; const int wid=__builtin_amdgcn_readfirstlane(tid>>6);
  const long rowbase=(long)b*SEQ; const int q0=qb*QB;
  const bf16*Qw=Q+(rowbase+q0+wid*QBLK)*DM+h*D;
  const bf16*Kh=K+rowbase*DM+h*D,*Vh=V+rowbase*DM+h*D;
  const unsigned lds0=(unsigned)(uintptr_t)shm;
  float*wsf=(float*)(shm+LDS_WS)+wid*64;
  const bf16*ksrc=Kh+(long)lane*DM+wid*8;
  const bf16*vsrc=Vh+(long)(16*(wid&3)+(lane>>2))*DM+(wid>>2)*32+(lane&3)*8;
  const unsigned kdst=lds0+LDS_K+wid*1024, vdst=lds0+LDS_V+wid*1024;
  #define DMA_K(t,slot) glds16(ksrc+(long)(t)*KVBLK*DM,(unsigned)__builtin_amdgcn_readfirstlane(kdst+(slot)))
  #define DMA_V(t,slot) glds16(vsrc+(long)(t)*KVBLK*DM,(unsigned)__builtin_amdgcn_readfirstlane(vdst+(slot)))
  const int vb0=(int)(lds0+LDS_V)+((lane>>4)&1)*32+(lane&3)*8+(4*hi+((lane&15)>>2))*64;
  const char*Kbase=shm+LDS_K; bf16x8 kf[8];
  const lds_cptr shm3=(lds_cptr)shm; const lds_cptr kp0=shm3+LDS_K+hi*1024+r32*16; const lds_cptr vp0=shm3+LDS_V+((lane>>4)&1)*32+(lane&3)*8+(4*hi+((lane&15)>>2))*64;
  const int NT=(q0+QB)/KVBLK;
  DMA_K(0,0);DMA_V(0,0);DMA_K(1,SLOTB);
  bf16x8 qr[4];
  #pragma unroll
  for(int d0=0;d0<4;++d0)qr[d0]=*reinterpret_cast<const bf16x8*>(&Qw[(long)r32*DM+d0*16+hi*8]);
  float m0;
  { const bf16*Kd=Kh+(long)(q0+wid*QBLK+r32)*DM+hi*8; float acc_=0.f;
    #pragma unroll
    for(int d0=0;d0<4;++d0){ const bf16x8 kd=*reinterpret_cast<const bf16x8*>(&Kd[d0*16]);
      #pragma unroll
      for(int j_=0;j_<8;++j_) acc_+=__uint_as_float((unsigned)(unsigned short)qr[d0][j_]<<16)*__uint_as_float((unsigned)(unsigned short)kd[j_]<<16); }
    auto rr_=__builtin_amdgcn_permlane32_swap(__float_as_uint(acc_),__float_as_uint(acc_),false,false);
    m0=__uint_as_float(rr_[0])+__uint_as_float(rr_[1])+((__attribute__((address_space(3))) const float*)((lds_cptr)shm+LDS_BETA))[q0+wid*QBLK+r32]; }
  float mhat=0.f,l_reg=0.f;f32x16 o[2];o[0]=f32x16{};o[1]=f32x16{};f32x16 negm=f32x16{};asm volatile("":"+v"(negm));
  const int qrel=wid*QBLK+r32;
  #define CMASK(P0,P1,t) do{int jb_=(t)-(NT-4); if(jb_>=0)cmask(P0,P1,jb_,qrel,hi);}while(0)
  typedef __attribute__((address_space(3))) const f32x4_t* lds_f4ptr;
  const lds_f4ptr betab=(lds_f4ptr)((lds_cptr)shm+LDS_BETA+16*hi);
  #define BIAS(P0,P1,t) do{ const lds_f4ptr bp_=betab+16*(t); \
    _Pragma("unroll") for(int g_=0;g_<4;++g_){ const f32x4_t b0_=bp_[2*g_], b1_=bp_[8+2*g_]; \
      _Pragma("unroll") for(int i_=0;i_<4;++i_){ P0[4*g_+i_]+=b0_[i_]; P1[4*g_+i_]+=b1_[i_]; } if(g_&1)SBAR(); } }while(0)
  bool resc=false;
  #define START(P0,P1) do{ const float rm=rowmax(P0,P1); resc=false; \
    { const float dl=max2f(rm,m0); mhat=fadd_s(mhat,dl); \
      _Pragma("unroll") for(int r=0;r<16;++r){P0[r]=fsub_s(P0[r],dl);P1[r]=fsub_s(P1[r],dl);} \
      _Pragma("unroll") for(int r=0;r<16;++r)negm[r]=-mhat; asm volatile("":"+v"(negm)); } \
    _Pragma("unroll") for(int r=0;r<16;++r)P0[r]=__builtin_amdgcn_exp2f(P0[r]); }while(0)
  #define RESC() do{ if(resc){ asm volatile("s_waitcnt lgkmcnt(0)":::"memory"); \
      _Pragma("unroll") for(int d_=0;d_<2;++d_) _Pragma("unroll") for(int r=0;r<16;++r)o[d_][r]*=wsf[crow(r,hi)]; } }while(0)
  f32x16 pA0,pA1,pB0,pB1;
  int sl_prev=0,sl_cur=0,sl_next=SLOTB;
  #define ROT() do{sl_prev=sl_cur;sl_cur=sl_next;sl_next=(sl_next==(NSLOT-1)*SLOTB)?0:sl_next+SLOTB;}while(0)
  DMA_K(2,2*SLOTB);
  WAIT_BAR(3);
  qkt(pA0,pA1,Kbase,qr,negm,r32,hi);asm volatile("s_nop 15\n\ts_nop 7":"+v"(pA0),"+v"(pA1));BIAS(pA0,pA1,0);CMASK(pA0,pA1,0);
  START(pA0,pA1);
  _Pragma("unroll") for(int r=0;r<16;++r)pA1[r]=__builtin_amdgcn_exp2f(pA1[r]);
  WAIT_BAR(0);
  DMA_K(3,0);DMA_V(1,SLOTB);
  ROT();
  kload8(kf,kp0+sl_cur);
  WAIT_BAR(2);
  s16x4 vlo[8],vhi[8]; u32x4 pw0,pw1,pw2,pw3;
  #define PKW(P,B) cvtpk_s(P[B],P[B+1])
  #define PAF(k) __builtin_bit_cast(bf16x8,pw##k)
  #define VFR(i) (bf16x8){vlo[i][0],vlo[i][1],vlo[i][2],vlo[i][3],vhi[i][0],vhi[i][1],vhi[i][2],vhi[i][3]}
  #define PIN(x) asm volatile("":"+v"(x))
  #define MX3(a,b,c) __builtin_fmaxf(__builtin_fmaxf((a),(b)),(c))
  #define GAPA(MF,A0,A1,A2,A3,W0,W1,PW) do{ MF; sacc+=A0; sacc+=A1; sacc+=A2; sacc+=A3; PIN(sacc); W0; W1; PIN(PW); SBAR(); }while(0)
  #define EX(v) __builtin_amdgcn_exp2f(v)
  #define GAPB(MF,X,B) do{ MF; X[B]=EX(X[B]); X[B+1]=EX(X[B+1]); X[B+2]=EX(X[B+2]); X[B+3]=EX(X[B+3]); PIN(X); SBAR(); }while(0)
  #define VRD(i) do{ vlo[i]=vtr(vp_+(((i)>>2)*4096+((i)&3)*1024)); vhi[i]=vtr(vp_+(((i)>>2)*4096+((i)&3)*1024+512)); }while(0)
  #define KRD(G,j) do{ if(G){ kload2(kf,kp0+sl_next,j); SBAR(); } }while(0)
  #define STEP(C0,C1,P0,P1,t,GK,GV,GL) do{ SBAR(); \
    const lds_cptr vp_=vp0+sl_prev; \
    VRD(0); SBAR(); float sacc=(P0[0]+P0[1]); \
    GAPA(C0=__builtin_amdgcn_mfma_f32_32x32x16_bf16(kf[0],qr[0],negm,0,0,0), P0[2],P0[3],P0[4],P0[5],     pw0[0]=PKW(P0,0), pw0[1]=PKW(P0,2), pw0); \
    VRD(4); SBAR(); GAPA(C1=__builtin_amdgcn_mfma_f32_32x32x16_bf16(kf[1],qr[0],negm,0,0,0), P0[6],P0[7],P0[8],P0[9],     pw0[2]=PKW(P0,4), pw0[3]=PKW(P0,6), pw0); \
    VRD(1); SBAR(); GAPA(C0=__builtin_amdgcn_mfma_f32_32x32x16_bf16(kf[2],qr[1],C0,0,0,0),   P0[10],P0[11],P0[12],P0[13], pw1[0]=PKW(P0,8), pw1[1]=PKW(P0,10), pw1); \
    VRD(5); SBAR(); GAPA(C1=__builtin_amdgcn_mfma_f32_32x32x16_bf16(kf[3],qr[1],C1,0,0,0),   P0[14],P0[15],P1[0],P1[1],   pw1[2]=PKW(P0,12),pw1[3]=PKW(P0,14), pw1); \
    VRD(2); SBAR(); GAPA(C0=__builtin_amdgcn_mfma_f32_32x32x16_bf16(kf[4],qr[2],C0,0,0,0),   P1[2],P1[3],P1[4],P1[5],     pw2[0]=PKW(P1,0), pw2[1]=PKW(P1,2), pw2); \
    VRD(6); SBAR(); GAPA(C1=__builtin_amdgcn_mfma_f32_32x32x16_bf16(kf[5],qr[2],C1,0,0,0),   P1[6],P1[7],P1[8],P1[9],     pw2[2]=PKW(P1,4), pw2[3]=PKW(P1,6), pw2); \
    VRD(3); SBAR(); GAPA(C0=__builtin_amdgcn_mfma_f32_32x32x16_bf16(kf[6],qr[3],C0,0,0,0),   P1[10],P1[11],P1[12],P1[13], pw3[0]=PKW(P1,8), pw3[1]=PKW(P1,10), pw3); \
    VRD(7); SBAR(); GAPA(C1=__builtin_amdgcn_mfma_f32_32x32x16_bf16(kf[7],qr[3],C1,0,0,0),   P1[14],P1[15],0.f,0.f,       pw3[2]=PKW(P1,12),pw3[3]=PKW(P1,14), pw3); \
    l_reg+=sacc; \
    if(GK){DMA_K((t)+3,sl_cur);} if(GV){DMA_V((t)+1,sl_next);} \
    BIAS(C0,C1,t); CMASK(C0,C1,t); \
    { float a=MX3(C0[0],C0[1],C1[0]),b=MX3(C0[2],C0[3],C1[1]); a=MX3(a,C1[2],C1[3]); \
      _Pragma("unroll") for(int r=4;r<16;r+=4){a=MX3(a,C0[r],C0[r+1]);b=MX3(b,C0[r+2],C0[r+3]);a=MX3(a,C1[r],C1[r+1]);b=MX3(b,C1[r+2],C1[r+3]);} \
      float rm=__builtin_fmaxf(a,b); { auto rr=__builtin_amdgcn_permlane32_swap(__float_as_uint(rm),__float_as_uint(rm),false,false); rm=__builtin_fmaxf(__uint_as_float(rr[0]),__uint_as_float(rr[1])); } \
      resc=false; \
      if(__builtin_expect(__any(rm>(float)THRL),0)){ const float dl=__builtin_fmaxf(rm,0.f); mhat+=dl; \
        _Pragma("unroll") for(int r=0;r<16;++r){C0[r]-=dl;C1[r]-=dl;} \
        _Pragma("unroll") for(int r=0;r<16;++r)negm[r]=-mhat; asm volatile("":"+v"(negm)); \
        const float f=__builtin_amdgcn_exp2f(-dl); l_reg*=f; if(hi==0)wsf[r32]=f; resc=true; } } \
    SBAR(); \
    GAPB(o[0]=__builtin_amdgcn_mfma_f32_32x32x16_bf16(PAF(0),VFR(0),o[0],0,0,0), C0,0); \
    GAPB(o[1]=__builtin_amdgcn_mfma_f32_32x32x16_bf16(PAF(0),VFR(4),o[1],0,0,0), C0,4); \
    KRD(GL,0); GAPB(o[0]=__builtin_amdgcn_mfma_f32_32x32x16_bf16(PAF(1),VFR(1),o[0],0,0,0), C0,8); \
    KRD(GL,1); GAPB(o[1]=__builtin_amdgcn_mfma_f32_32x32x16_bf16(PAF(1),VFR(5),o[1],0,0,0), C0,12); \
    KRD(GL,2); GAPB(o[0]=__builtin_amdgcn_mfma_f32_32x32x16_bf16(PAF(2),VFR(2),o[0],0,0,0), C1,0); \
    KRD(GL,3); GAPB(o[1]=__builtin_amdgcn_mfma_f32_32x32x16_bf16(PAF(2),VFR(6),o[1],0,0,0), C1,4); \
    GAPB(o[0]=__builtin_amdgcn_mfma_f32_32x32x16_bf16(PAF(3),VFR(3),o[0],0,0,0), C1,8); \
    GAPB(o[1]=__builtin_amdgcn_mfma_f32_32x32x16_bf16(PAF(3),VFR(7),o[1],0,0,0), C1,12); \
    }while(0)
  int t=1;
  #undef CMASK
  #define CMASK(P0,P1,t) do{}while(0)
  for(;t+5<NT;t+=2){
    STEP(pB0,pB1,pA0,pA1,t,true,true,true);     WAIT_BAR(2); RESC(); ROT();
    STEP(pA0,pA1,pB0,pB1,t+1,true,true,true);   WAIT_BAR(2); RESC(); ROT();
  }
  #undef CMASK
  #define CMASK(P0,P1,t) do{int jb_=(t)-(NT-4); if(jb_>=0)cmask(P0,P1,jb_,qrel,hi);}while(0)
  #define ENDW(tt) do{ if((tt)+3<NT){WAIT_BAR(2);} else if((tt)+2<NT){WAIT_BAR(1);} else {WAIT_BAR(0);} }while(0)
  for(;t+1<NT;t+=2){
    STEP(pB0,pB1,pA0,pA1,t,(t+3<NT),(t+1<NT),(t+1<NT));       ENDW(t);   RESC(); ROT();
    STEP(pA0,pA1,pB0,pB1,t+1,(t+4<NT),(t+2<NT),(t+2<NT));     ENDW(t+1); RESC(); ROT();
  }
  STEP(pB0,pB1,pA0,pA1,NT-1,false,false,false); RESC();
  { float sacc=pB0[0]+pB0[1]; _Pragma("unroll") for(int r=2;r<16;++r)sacc+=pB0[r]; _Pragma("unroll") for(int r=0;r<16;++r)sacc+=pB1[r]; l_reg+=sacc;
    pw0=(u32x4){PKW(pB0,0),PKW(pB0,2),PKW(pB0,4),PKW(pB0,6)};pw1=(u32x4){PKW(pB0,8),PKW(pB0,10),PKW(pB0,12),PKW(pB0,14)};pw2=(u32x4){PKW(pB1,0),PKW(pB1,2),PKW(pB1,4),PKW(pB1,6)};pw3=(u32x4){PKW(pB1,8),PKW(pB1,10),PKW(pB1,12),PKW(pB1,14)};
    SBAR(); pv(o,vb0+sl_cur,PAF(0),PAF(1),PAF(2),PAF(3)); }
  #undef PKW
  #undef PAF
  #undef VFR
  #undef PIN
  #undef MX3
  #undef GAPA
  #undef GAPB
  #undef EX
  #undef VRD
  #undef KRD
  #undef STEP
  #undef ENDW
  {auto rr=__builtin_amdgcn_permlane32_swap(__float_as_uint(l_reg),__float_as_uint(l_reg),false,false);l_reg=__uint_as_float(rr[0])+__uint_as_float(rr[1]);}
  if(hi==0)wsf[32+r32]=l_reg;asm volatile("s_waitcnt lgkmcnt(0)":::"memory");
  float rli[16];
  #pragma unroll
  for(int r=0;r<16;++r)rli[r]=__builtin_amdgcn_rcpf(wsf[32+crow(r,hi)]);
  bf16*Ow=O+(rowbase+q0+wid*QBLK)*OPITCH+h*D;
  { bf16*stg=(bf16*)(shm+LDS_OST)+wid*2048;
    #pragma unroll
    for(int r=0;r<16;++r){const int orow=crow(r,hi);
      #pragma unroll
      for(int d0=0;d0<2;++d0)stg[orow*64+d0*32+r32]=__float2bfloat16(o[d0][r]*rli[r]);}
    asm volatile("s_waitcnt lgkmcnt(0)":::"memory");
    #pragma unroll
    for(int i=0;i<4;++i){const int row=i*8+(lane>>3),ch=lane&7; const u32x4 v=*(const u32x4*)(stg+row*64+ch*8); ATTN_STORE16(Ow+(long)row*OPITCH+ch*8,v);} }
  asm volatile("s_waitcnt lgkmcnt(0)\n\ts_barrier":::"memory");
  #undef DMA_K
  #undef DMA_V
  #undef CMASK
  #undef BIAS
  #undef START
  #undef RESC
  #undef ROT
}
constexpr int ATTN_LDS_BYTES=LDS_BYTES;
struct AttnTensors { const bf16* Q; const bf16* K; const bf16* V; bf16* O; const float* cl; const float* bt; };
struct AttnUnit { int bh; int qb; };
struct StaticOrder {
  int vcu,grid;
  __device__ __forceinline__ explicit StaticOrder(int grid_,int block):vcu((grid_%8==0)?(block%8)*(grid_/8)+block/8:block),grid(grid_){}
  __device__ __forceinline__ bool next(int i,AttnUnit&u)const{ const int v=vcu+(i>>1)*grid; if(v>=BATCH*NHEAD*4)return false; const int s=v&3; u.bh=v>>2; u.qb=((i&1)==0)?7-s:s; return true; }
  __device__ __forceinline__ void a_ready(const AttnUnit&)const{}
  __device__ __forceinline__ void done(const AttnUnit&)const{}
};
__device__ __forceinline__ void build_beta(char*lds,const float*cl,const float*bt,int bh){
  int tid_o=threadIdx.x; asm volatile("":"+v"(tid_o)); const int tid=tid_o,b=bh/NHEAD,h=bh%NHEAD;
  __attribute__((address_space(3))) float*beta=(__attribute__((address_space(3))) float*)((lds_cptr)lds+LDS_BETA);
  __attribute__((address_space(3))) float*pre=(__attribute__((address_space(3))) float*)((lds_cptr)lds+LDS_PRE);
  if(tid<64){ float v=(tid<32)?bt[(b*32+tid)*8+h]:0.f; const float own=v;
    #pragma unroll
    for(int o=1;o<32;o<<=1){ const float n=__shfl_up(v,o); if((tid&63)>=o)v+=n; }
    if(tid<32)pre[tid]=v-own; }
  asm volatile("s_waitcnt lgkmcnt(0)":::"memory"); __syncthreads();
  for(int s=tid;s<SEQ;s+=NW*64) beta[s]=-(pre[s>>6]+cl[(long)(b*SEQ+s)*8+h])*ATT_LOG2E;
  asm volatile("s_waitcnt lgkmcnt(0)":::"memory"); __syncthreads();
}
template<class Sched,int THRL=8> __device__ __forceinline__ void attn_phase(char*lds,const AttnTensors&T,const Sched&S){
  AttnUnit u;
  for(int i=0;S.next(i,u);++i){ if((i&1)==0) build_beta(lds,T.cl,T.bt,u.bh);
    S.a_ready(u); attn_unit<THRL>(u.bh/NHEAD,u.bh%NHEAD,u.qb,T.Q,T.K,T.V,T.O,lds); S.done(u); }
}
#undef SBAR
#undef WAIT_BAR
}

namespace hg {
typedef short bf16x8 __attribute__((ext_vector_type(8)));
typedef short s16x4 __attribute__((ext_vector_type(4)));
typedef float f32x16 __attribute__((ext_vector_type(16)));
typedef float f32x4 __attribute__((ext_vector_type(4)));
typedef unsigned u32x4 __attribute__((ext_vector_type(4)));
typedef unsigned u32x2 __attribute__((ext_vector_type(2)));
#define HG_LAS __attribute__((address_space(3)))
#define HG_BAR() do { asm volatile("s_waitcnt lgkmcnt(0)" ::: "memory"); __builtin_amdgcn_s_barrier(); asm volatile("" ::: "memory"); } while (0)
constexpr int CH = 32, NCH = 2048 / CH;
constexpr int S_QA = 0, S_KD = 8192, S_KT = 16384, S_V = 24576, S_DEC = 26624, SLOT_BYTES = 27136;
constexpr int OFF_OPART = 2 * SLOT_BYTES, OPART_BYTES = 4 * 4096, LDS_BYTES = OFF_OPART + 2 * OPART_BYTES;
__device__ __forceinline__ int qa_off(int t, int d) { return t * 256 + ((((d >> 3) ^ (t & 15))) << 4) + (d & 7) * 2; }
__device__ __forceinline__ int kt_off(int s, int d) { return s * 256 + ((((d >> 3) ^ ((s & 3) << 2))) << 4) + (d & 7) * 2; }
__device__ __forceinline__ int v_off(int s, int e) { return s * 64 + e * 2; }
typedef short v4i16_t __attribute__((ext_vector_type(4)));
__device__ __forceinline__ s16x4 trd(const HG_LAS unsigned char* p) { return __builtin_bit_cast(s16x4, __builtin_amdgcn_ds_read_tr16_b64_v4i16((HG_LAS v4i16_t*)p)); }
__device__ __forceinline__ unsigned cvtpk(float lo, float hi) { typedef float f2 __attribute__((ext_vector_type(2))); typedef __bf16 b2 __attribute__((ext_vector_type(2))); f2 v = {lo, hi}; b2 b = __builtin_convertvector(v, b2); return __builtin_bit_cast(unsigned, b); }
__device__ __forceinline__ int crow(int r, int hi) { return (r & 3) + 8 * (r >> 2) + 4 * hi; }
__device__ __forceinline__ bf16x8 pack8(const f32x16& x, int base) {
    u32x4 w; w.x = cvtpk(x[base], x[base + 1]); w.y = cvtpk(x[base + 2], x[base + 3]); w.z = cvtpk(x[base + 4], x[base + 5]); w.w = cvtpk(x[base + 6], x[base + 7]); return __builtin_bit_cast(bf16x8, w); }
__device__ __forceinline__ bf16x8 cat64(s16x4 a, s16x4 b) { return (bf16x8){a[0], a[1], a[2], a[3], b[0], b[1], b[2], b[3]}; }

__device__ __forceinline__ void hgrn_unit(HG_LAS unsigned char* lds, const unsigned short* QA, const unsigned short* KD, const unsigned short* KT, const float* DEC, const unsigned short* V, unsigned short* O, int unit) {
    int tid_o = threadIdx.x; asm volatile("" : "+v"(tid_o));
    const int tid = tid_o, lane = tid & 63, wid = __builtin_amdgcn_readfirstlane(tid >> 6), r32 = lane & 31, hi = lane >> 5;
    const int b = unit >> 5, h = (unit >> 2) & 7, eq = unit & 3;
    const size_t gbase = (size_t)b * 2048 * 1024 + h * 128;
    __syncthreads();
    if (wid < 4) {
        const int w = wid;
        const int tq = (lane & 15) >> 2, tc = 16 * ((lane >> 4) & 1) + 4 * (lane & 3);
        f32x16 S = {};
#pragma unroll 1
        for (int i = -1; i <= NCH; ++i) {
            if (i >= 0 && i < NCH) {
                HG_LAS unsigned char* sl = lds + (i & 1) * SLOT_BYTES;
                bf16x8 kdf[2], qaf[2]; s16x4 qp[2][2], vp[2][2], ktf[2][2], vf[2][2]; f32x4 dcv[4];
#pragma unroll
                for (int ks = 0; ks < 2; ++ks) { const int o = qa_off(r32, 32 * w + 16 * ks + 8 * hi), d0 = 32 * w + 16 * ks + 4 * hi, sp = 16 * ks + 4 * hi, sn = 16 * ks + 8 * hi;
                    kdf[ks] = *(const HG_LAS bf16x8*)(sl + S_KD + o); qaf[ks] = *(const HG_LAS bf16x8*)(sl + S_QA + o);
                    qp[ks][0] = *(const HG_LAS s16x4*)(sl + S_QA + qa_off(r32, d0)); qp[ks][1] = *(const HG_LAS s16x4*)(sl + S_QA + qa_off(r32, d0 + 8));
                    vp[ks][0] = trd(sl + S_V + v_off(sp + tq, tc)); vp[ks][1] = trd(sl + S_V + v_off(sp + 8 + tq, tc));
                    ktf[ks][0] = trd(sl + S_KT + kt_off(sn + tq, 32 * w + tc)); ktf[ks][1] = trd(sl + S_KT + kt_off(sn + 4 + tq, 32 * w + tc));
                    vf[ks][0] = trd(sl + S_V + v_off(sn + tq, tc)); vf[ks][1] = trd(sl + S_V + v_off(sn + 4 + tq, tc)); }
#pragma unroll
                for (int g = 0; g < 4; ++g) dcv[g] = *(const HG_LAS f32x4*)(sl + S_DEC + (32 * w + 8 * g + 4 * hi) * 4);
                __builtin_amdgcn_sched_barrier(0);
                const bf16x8 sb0 = pack8(S, 0), sb1 = pack8(S, 8);
                f32x16 X = {}, ow = {};
#pragma unroll
                for (int g = 0; g < 4; ++g)
#pragma unroll
                    for (int q = 0; q < 4; ++q) S[4 * g + q] *= dcv[g][q];
                X = __builtin_amdgcn_mfma_f32_32x32x16_bf16(kdf[0], qaf[0], X, 0, 0, 0);
                ow = __builtin_amdgcn_mfma_f32_32x32x16_bf16(cat64(qp[0][0], qp[0][1]), sb0, ow, 0, 0, 0);
                S = __builtin_amdgcn_mfma_f32_32x32x16_bf16(cat64(ktf[0][0], ktf[0][1]), cat64(vf[0][0], vf[0][1]), S, 0, 0, 0);
                X = __builtin_amdgcn_mfma_f32_32x32x16_bf16(kdf[1], qaf[1], X, 0, 0, 0);
                ow = __builtin_amdgcn_mfma_f32_32x32x16_bf16(cat64(qp[1][0], qp[1][1]), sb1, ow, 0, 0, 0);
                S = __builtin_amdgcn_mfma_f32_32x32x16_bf16(cat64(ktf[1][0], ktf[1][1]), cat64(vf[1][0], vf[1][1]), S, 0, 0, 0);
#pragma unroll
                for (int r = 0; r < 16; ++r) X[r] = (crow(r, hi) <= r32) ? X[r] : 0.f;
                ow = __builtin_amdgcn_mfma_f32_32x32x16_bf16(pack8(X, 0), cat64(vp[0][0], vp[0][1]), ow, 0, 0, 0);
                ow = __builtin_amdgcn_mfma_f32_32x32x16_bf16(pack8(X, 8), cat64(vp[1][0], vp[1][1]), ow, 0, 0, 0);
                { HG_LAS float* op = (HG_LAS float*)(lds + OFF_OPART + (i & 1) * OPART_BYTES + w * 4096) + lane;
#pragma unroll
                  for (int r = 0; r < 16; ++r) op[r * 64] = ow[r]; }
            }
            HG_BAR();
        }
    } else {
        const int pt = tid - 256;
        const int t0 = pt >> 4, d0 = (pt & 15) * 8;
        const int vs = pt >> 3, ve = (pt & 7) * 4;
        u32x4 qaA[2], kdA[2], ktA[2], qaB[2], kdB[2], ktB[2]; u32x2 vA, vB; float dcA = 0.f, dcB = 0.f;
#define HG_LOAD(qa, kd, kt, vr, dc, c) do { const int c_ = (c) < NCH ? (c) : NCH - 1;      \
            const size_t ro_ = gbase + (size_t)c_ * CH * 1024; \
            _Pragma("unroll") for (int k_ = 0; k_ < 2; ++k_) { const size_t o_ = ro_ + (size_t)(t0 + 16 * k_) * 1024 + d0; \
                qa[k_] = *(const u32x4*)(QA + o_); kd[k_] = *(const u32x4*)(KD + o_); kt[k_] = *(const u32x4*)(KT + o_); } \
            vr = *(const u32x2*)(V + ro_ + (size_t)vs * 1024 + eq * 32 + ve); \
            dc = DEC[(size_t)(b * NCH + c_) * 1024 + h * 128 + (pt & 127)]; } while (0)
#define HG_PSTEP(i, RED, PREP, qa, kd, kt, vr, dc) do { \
            if (PREP) { \
                HG_LAS unsigned char* sl = lds + (((i) + 1) & 1) * SLOT_BYTES; \
                _Pragma("unroll") for (int k_ = 0; k_ < 2; ++k_) { const int t_ = t0 + 16 * k_; \
                    *(HG_LAS u32x4*)(sl + S_QA + qa_off(t_, d0)) = qa[k_]; *(HG_LAS u32x4*)(sl + S_KD + qa_off(t_, d0)) = kd[k_]; \
                    *(HG_LAS u32x4*)(sl + S_KT + kt_off(t_, d0)) = kt[k_]; } \
                *(HG_LAS u32x2*)(sl + S_V + v_off(vs, ve)) = vr; \
                *(HG_LAS float*)(sl + S_DEC + (pt & 127) * 4) = dc; \
                HG_LOAD(qa, kd, kt, vr, dc, (i) + 3); } \
            if (RED) { const HG_LAS float* op = (const HG_LAS float*)(lds + OFF_OPART + (((i) - 1) & 1) * OPART_BYTES); \
                const int idx = 4 * pt, reg = idx >> 6, ln = idx & 63; const HG_LAS f32x4* op4 = (const HG_LAS f32x4*)(op + idx); \
                const f32x4 v = (op4[0] + op4[256]) + (op4[512] + op4[768]);              \
                const int t = crow(reg, ln >> 5), e = ln & 31; u32x2 wv; wv.x = cvtpk(v[0], v[1]); wv.y = cvtpk(v[2], v[3]); \
                *(u32x2*)(O + gbase + (size_t)(((i) - 1) * CH + t) * 1024 + eq * 32 + e) = wv; } \
            HG_BAR(); } while (0)
        HG_LOAD(qaA, kdA, ktA, vA, dcA, 0); HG_LOAD(qaB, kdB, ktB, vB, dcB, 1);
        HG_PSTEP(-1, false, true, qaA, kdA, ktA, vA, dcA); HG_PSTEP(0, false, true, qaB, kdB, ktB, vB, dcB);
#pragma unroll 1
        for (int i = 1; i + 1 < NCH; i += 2) { HG_PSTEP(i, true, true, qaA, kdA, ktA, vA, dcA); HG_PSTEP(i + 1, true, true, qaB, kdB, ktB, vB, dcB); }
        HG_PSTEP(NCH - 1, true, false, qaA, kdA, ktA, vA, dcA); HG_PSTEP(NCH, true, false, qaB, kdB, ktB, vB, dcB);
#undef HG_PSTEP
#undef HG_LOAD
    }
}
#undef HG_LAS
#undef HG_BAR
}

#define GAS __attribute__((address_space(1)))
#define LAS __attribute__((address_space(3)))
typedef unsigned short bf16;
typedef unsigned v4u __attribute__((ext_vector_type(4)));
typedef float f32x4 __attribute__((ext_vector_type(4)));
typedef short bf16x8 __attribute__((ext_vector_type(8)));
typedef GAS unsigned gu32;
typedef GAS unsigned long long gu64;
#define RLX_AGENT __ATOMIC_RELAXED, __HIP_MEMORY_SCOPE_AGENT
#define LDS_WAIT() asm volatile("s_waitcnt lgkmcnt(0)" ::: "memory")
#define VM_WAIT() asm volatile("s_waitcnt vmcnt(0)" ::: "memory")
__device__ __forceinline__ unsigned long long rt() { return __builtin_amdgcn_s_memrealtime(); }
__device__ __forceinline__ unsigned f2bf(float f) { unsigned u = __builtin_bit_cast(unsigned, f); return (u + 0x7fffu + ((u >> 16) & 1u)) >> 16; }
__device__ __forceinline__ unsigned pk2(float lo, float hi) { return f2bf(lo) | (f2bf(hi) << 16); }

#define XB_TMO      128
#define XB_XCNT(j)  (256  + 64 * (j))
#define XB_XSUB(j)  (1280 + 64 * (j))
#define XB_XGEN(j)  (2304 + 64 * (j))
#define XB_TOP      3328
#define XB_TOPGEN   3392
#define XCD_BAR_WORDS 3456
#define XB_SPIN_CAP (1u << 18)

__device__ __forceinline__ unsigned xb_ld(unsigned* p)              { return __hip_atomic_load(p, __ATOMIC_RELAXED, __HIP_MEMORY_SCOPE_AGENT); }
__device__ __forceinline__ unsigned xb_add(unsigned* p, unsigned v) { return __hip_atomic_fetch_add(p, v, __ATOMIC_RELAXED, __HIP_MEMORY_SCOPE_AGENT); }
__device__ __forceinline__ unsigned xb_xcc_id() { return (unsigned)__builtin_amdgcn_s_getreg((3 << 11) | 20) & 0xFu; }
#define XB_SPIN(cond, bar) do { unsigned _sp = 0; while (cond) { __builtin_amdgcn_s_sleep(1); \
    if ((++_sp & 255u) == 0u) { if (xb_ld(&(bar)[XB_TMO])) break; if (_sp > XB_SPIN_CAP) { atomicAdd(&(bar)[XB_TMO], 1u); break; } } } } while (0)

struct XcdBarrier {
    unsigned* bar; unsigned x;
    volatile LAS unsigned* st;
};

__device__ __forceinline__ XcdBarrier xcd_barrier_post(unsigned* bar, volatile LAS unsigned* st) {
    XcdBarrier b; b.bar = bar; b.x = xb_xcc_id(); b.st = st;
    if (threadIdx.x == 0) (void)xb_add(&bar[XB_XCNT(b.x)], 1u);
    return b;
}
__device__ __forceinline__ void xcd_barrier_complete(unsigned* bar, unsigned x, unsigned& nloc, unsigned& nx) {
    const unsigned G = gridDim.x * gridDim.y * gridDim.z;
    unsigned sum, cnt, mine, sp = 0u;
    for (;;) {
        sum = 0u; cnt = 0u; mine = 0u;
#pragma unroll
        for (unsigned j = 0; j < 16; ++j) { const unsigned c = xb_ld(&bar[XB_XCNT(j)]); sum += c; cnt += (c > 0u) ? 1u : 0u; mine = (j == x) ? c : mine; }
        if (sum == G) break;
        __builtin_amdgcn_s_sleep(1);
        if ((++sp & 255u) == 0u) { if (xb_ld(&bar[XB_TMO])) break; if (sp > XB_SPIN_CAP) { atomicAdd(&bar[XB_TMO], 1u); break; } }
    }
    nloc = mine > 0u ? mine : 1u; nx = cnt > 0u ? cnt : 1u;
}

__device__ __forceinline__ void xcd_barrier(const XcdBarrier& b) {
    asm volatile("s_waitcnt vmcnt(0)" ::: "memory");
    __syncthreads();
    if (threadIdx.x == 0) {
        unsigned* bar = b.bar;
        __builtin_amdgcn_s_waitcnt(0);
        unsigned nloc = b.st[0], nx = b.st[1];
        if (nloc == 0u) { xcd_barrier_complete(bar, b.x, nloc, nx); b.st[0] = nloc; b.st[1] = nx; }
        const unsigned old = xb_add(&bar[XB_XSUB(b.x)], 1u);
        const unsigned gen = old / nloc;
        if (old + 1u == (gen + 1u) * nloc) {
            __builtin_amdgcn_fence(__ATOMIC_RELEASE, "agent");
            asm volatile("s_waitcnt vmcnt(0)" ::: "memory");
            const unsigned og = xb_add(&bar[XB_TOP], 1u);
            const unsigned tg = og / nx;
            if (og + 1u == (tg + 1u) * nx) xb_add(&bar[XB_TOPGEN], 1u);
            else XB_SPIN(xb_ld(&bar[XB_TOPGEN]) == tg, bar);
            __builtin_amdgcn_fence(__ATOMIC_ACQUIRE, "agent");
            xb_add(&bar[XB_XGEN(b.x)], 1u);
            asm volatile("s_waitcnt vmcnt(0)" ::: "memory");
        } else {
            XB_SPIN(xb_ld(&bar[XB_XGEN(b.x)]) == gen, bar);
            __builtin_amdgcn_fence(__ATOMIC_ACQUIRE, "agent");
            asm volatile("s_waitcnt vmcnt(0)" ::: "memory");
        }
    }
    __syncthreads();
}

#ifndef L0_SPLIT
#define L0_SPLIT 1
#endif

#ifndef TS_P0
#define TS_P0 0
#endif

#ifndef FUSE_FINAL_NORM
#define FUSE_FINAL_NORM 0
#endif

#ifndef TS_CLOCK
#define TS_CLOCK 0
#endif

#ifndef TS_PHASE_END
#define TS_PHASE_END -1
#endif

#ifndef TS_AFTER_BAR
#define TS_AFTER_BAR 0
#endif

#ifndef TS_PHASE
#define TS_PHASE -1
#endif
#ifndef TS_DIV
#define TS_DIV 1000.0f
#endif

#ifndef PROBE_P0
#define PROBE_P0 0
#endif

constexpr int NWAVES = 8;
constexpr int BATCH = 8, SEQ = 2048, D = 1024, DEPTH = 4, M = BATCH * SEQ;
constexpr int FOXH = 8, FOXD = 64, FOXW = 512, CONVW = 512, AB_COLS = 3080, AB_N = 3072;
constexpr int HGH = 8, HGD = 128, C_COLS = 4096;
constexpr int FFH = 2816, FF2 = 5632;
constexpr float EPS = 1e-6f;
constexpr float LOG2E = 1.4426950408889634f;
constexpr float QSCALE = 0.125f * LOG2E;

constexpr size_t MiB = 1u << 20;
constexpr size_t WS_CTL = 0, CTL_ZERO_BYTES = 64 * 1024;
constexpr size_t WS_SSQ = 1 * MiB;
constexpr size_t WS_CL = 2 * MiB;
constexpr size_t WS_BT = WS_CL + 512 * 1024;
constexpr size_t WS_WF = WS_BT + 64 * 1024;
constexpr size_t WS_LB = WS_WF + 64 * 1024;
constexpr size_t WS_W = 4 * MiB;
constexpr size_t W_ABIN = 0, SZ_ABIN = (size_t)AB_N * D * 2;
constexpr size_t W_ABOUT = W_ABIN + 2 * SZ_ABIN, SZ_ABOUT = (size_t)D * D * 2;
constexpr size_t W_CIN = W_ABOUT + 2 * SZ_ABOUT, SZ_CIN = (size_t)C_COLS * D * 2;
constexpr size_t W_COUT = W_CIN + 2 * SZ_CIN, SZ_COUT = (size_t)D * D * 2;
constexpr size_t W_FIN = W_COUT + 2 * SZ_COUT, SZ_FIN = (size_t)FF2 * D * 2;
constexpr size_t W_FOUT = W_FIN + 4 * SZ_FIN, SZ_FOUT = (size_t)D * FFH * 2;
constexpr size_t W_END = W_FOUT + 4 * SZ_FOUT;
static_assert(WS_W + W_END <= 108 * MiB, "weights region");
constexpr size_t WS_XB = 108 * MiB;
constexpr size_t WS_MIX = 140 * MiB;
constexpr size_t WS_H = WS_MIX;
constexpr size_t WS_QKVU = WS_MIX, T512 = (size_t)M * 512 * 2, WS_AO = WS_MIX + 6 * T512;
constexpr size_t WS_KD = WS_MIX, WS_KT = WS_MIX + 32 * MiB, WS_HQ = WS_MIX + 64 * MiB, WS_HV = WS_HQ + 32 * MiB, WS_HG = WS_HV + 32 * MiB, WS_HO = WS_HG + 32 * MiB, WS_DEC = WS_HO + 32 * MiB, WS_END = WS_DEC + 2 * MiB;
static_assert(WS_END <= 352 * MiB, "workspace budget");
constexpr int CW_TMO = 0, CW_BAR = 4096, CW_FIN = 8192;
constexpr size_t WS_XS = 3 * MiB;

constexpr int RING_OFF = 0, RING_BYTES = 131072;
constexpr int LDSCTL_OFF = RING_BYTES, MISC_OFF = LDSCTL_OFF + 320;
constexpr int LDS_BYTES = 147456;
static_assert(MISC_OFF + 128 <= LDS_BYTES, "LDS map");
static_assert(attn_body::ATTN_LDS_BYTES <= RING_BYTES && hg::LDS_BYTES <= RING_BYTES, "mixer LDS inside the ring region");

struct Args { const float* in[14]; float* out; unsigned char* ws; int ph_lo, ph_hi, li, pad; };
typedef const __attribute__((address_space(4))) Args* KArgP;

struct Frame {
    LAS unsigned char* lds; volatile LAS unsigned* MISC; gu32* ctl;
    int wave, vcu, G;
};
#define LANE_IDS() int tid_l = threadIdx.x; asm volatile("" : "+v"(tid_l)); const int TID = tid_l, LANE = tid_l & 63
__device__ __forceinline__ float wave_sum(float v) {
#pragma unroll
    for (int o = 1; o < 64; o <<= 1) v += __shfl_xor(v, o);
    return v;
}
__device__ __forceinline__ float bf_lo(unsigned w) { return __uint_as_float(w << 16); }
__device__ __forceinline__ float bf_hi(unsigned w) { return __uint_as_float(w & 0xffff0000u); }

struct WItem { const float* W; const float* gain; bf16* WT; int ldn, ksrc0, nsrc0, K, drow0; };
constexpr int I_ABIN = 16 * (AB_N / 32), I_SQ = 16 * (D / 32), I_CIN = 16 * (C_COLS / 32), I_FIN = 16 * (FF2 / 32), I_FOUT = (FFH / 64) * (D / 32);
__host__ __device__ constexpr int layer_items(int l) { return ((l & 1) ? I_CIN : I_ABIN) + I_SQ + I_FIN + I_FOUT; }
__device__ __forceinline__ WItem layer_item(const Args& a, int l, int it) {
    unsigned char* wb = a.ws + WS_W; const int j = l >> 1; WItem w;
    const int n_in = (l & 1) ? I_CIN : I_ABIN;
    if (it < n_in) {
        if (l & 1) { const int nb = it % 128, kb = it / 128, c0 = 32 * nb;
            const int drow = c0 < 1024 ? 256 * (c0 / 128) + (c0 % 128) : (c0 < 2048 ? 256 * ((c0 - 1024) / 128) + 128 + ((c0 - 1024) % 128) : c0);
            w = WItem{a.in[8] + (size_t)j * D * C_COLS, a.in[1] + (size_t)l * D, (bf16*)(wb + W_CIN + j * SZ_CIN), C_COLS, 64 * kb, c0, D, drow}; }
        else { const int nb = it % (AB_N / 32), kb = it / (AB_N / 32), n0 = 32 * nb;
            w = WItem{a.in[4] + (size_t)j * D * AB_COLS, a.in[1] + (size_t)l * D, (bf16*)(wb + W_ABIN + j * SZ_ABIN), AB_COLS, 64 * kb, n0 + (n0 >= 1536 ? 8 : 0), D, n0}; }
        return w; }
    it -= n_in;
    if (it < I_SQ) { const int nb = it % 32, kb = it / 32;
        w = WItem{((l & 1) ? a.in[11] : a.in[7]) + (size_t)j * D * D, nullptr, (bf16*)(wb + ((l & 1) ? W_COUT + j * SZ_COUT : W_ABOUT + j * SZ_ABOUT)), D, 64 * kb, 32 * nb, D, 32 * nb}; return w; }
    it -= I_SQ;
    if (it < I_FIN) { const int nb = it % (FF2 / 32), kb = it / (FF2 / 32), c0 = 32 * nb;
        const int drow = c0 < FFH ? 256 * (c0 / 128) + (c0 % 128) : 256 * ((c0 - FFH) / 128) + 128 + ((c0 - FFH) % 128);
        w = WItem{a.in[12] + (size_t)l * D * FF2, a.in[2] + (size_t)l * D, (bf16*)(wb + W_FIN + l * SZ_FIN), FF2, 64 * kb, c0, D, drow}; return w; }
    it -= I_FIN;
    { const int nb = it % 32, kb = it / 32;
      w = WItem{a.in[13] + (size_t)l * FFH * D, nullptr, (bf16*)(wb + W_FOUT + l * SZ_FOUT), D, 64 * kb, 32 * nb, FFH, 32 * nb}; }
    return w;
}
__device__ __forceinline__ void witem_load(const WItem& w, f32x4 (&r)[8], int lane) {
    const int n4 = (lane & 7) * 4;
#pragma unroll
    for (int i = 0; i < 8; ++i) { const int kk = 8 * i + (lane >> 3); r[i] = *(const f32x4*)(w.W + (size_t)(w.ksrc0 + kk) * w.ldn + w.nsrc0 + n4); }
}
__device__ __forceinline__ void witem_finish(const WItem& w, const f32x4 (&r)[8], LAS float* scr, int lane) {
    const int n4 = (lane & 7) * 4;
#pragma unroll
    for (int i = 0; i < 8; ++i) { const int kk = 8 * i + (lane >> 3); f32x4 v = r[i]; if (w.gain) v = v * w.gain[w.ksrc0 + kk];
        LAS float* s = scr + kk * 33 + n4; s[0] = v[0]; s[1] = v[1]; s[2] = v[2]; s[3] = v[3]; }
    LDS_WAIT(); asm volatile("" ::: "memory");
    const int c = lane & 7;
#pragma unroll
    for (int j = 0; j < 4; ++j) { const int n = (lane >> 3) + 8 * j; const LAS float* s = scr + (8 * c) * 33 + n;
        v4u o; o.x = pk2(s[0 * 33], s[1 * 33]); o.y = pk2(s[2 * 33], s[3 * 33]); o.z = pk2(s[4 * 33], s[5 * 33]); o.w = pk2(s[6 * 33], s[7 * 33]);
        *(v4u*)(w.WT + (size_t)(w.drow0 + n) * w.K + w.ksrc0 + 8 * c) = o; }
    LDS_WAIT(); asm volatile("" ::: "memory");
}
__device__ __forceinline__ void convert_layer_weights(Frame& F, const Args& a, int l, int gw, int ngw, int it_lo = 0, int it_hi = 1 << 30) {
    LANE_IDS(); (void)TID;
    LAS float* scr = (LAS float*)(F.lds + RING_OFF + F.wave * 16384);
    const int n = layer_items(l) < it_hi ? layer_items(l) : it_hi; int it = it_lo + gw; if (it >= n) return;
    WItem cur = layer_item(a, l, it); f32x4 rc[8], rn[8]; witem_load(cur, rc, LANE);
    for (;;) { const int itn = it + ngw; const bool more = itn < n; WItem nxt = cur;
        if (more) { nxt = layer_item(a, l, itn); witem_load(nxt, rn, LANE); }
        witem_finish(cur, rc, scr, LANE);
        if (!more) break;
#pragma unroll
        for (int i = 0; i < 8; ++i) rc[i] = rn[i];
        cur = nxt; it = itn; }
}
__device__ __forceinline__ void p0_prologue(Frame& F, const Args& a) {
    LANE_IDS();
    const int gw = F.vcu * NWAVES + F.wave, NGW = F.G * NWAVES;
    unsigned char* ws = a.ws;
    if (TS_P0 && blockIdx.x == 0 && TID == 0) __hip_atomic_store((unsigned*)(a.ws + WS_CTL) + 17, (unsigned)__builtin_amdgcn_s_memrealtime(), __ATOMIC_RELAXED, __HIP_MEMORY_SCOPE_AGENT);
    for (int r_ = 0; r_ < ((PROBE_P0 & 1) ? 2 : 1); ++r_)
    convert_layer_weights(F, a, 0, gw, NGW, 0, L0_SPLIT ? I_ABIN : (1 << 30));
#if !WCONV_IN_FFN_TAIL
    for (int l = 1; l < DEPTH; ++l) convert_layer_weights(F, a, l, gw, NGW);
#endif
    if (TS_P0 == 1 && blockIdx.x == 0 && TID == 0) __hip_atomic_store((unsigned*)(a.ws + WS_CTL) + 16, (unsigned)__builtin_amdgcn_s_memrealtime() - __hip_atomic_load((unsigned*)(a.ws + WS_CTL) + 17, __ATOMIC_RELAXED, __HIP_MEMORY_SCOPE_AGENT), __ATOMIC_RELAXED, __HIP_MEMORY_SCOPE_AGENT);
    for (int r_ = 0; r_ < ((PROBE_P0 & 2) ? 2 : 1); ++r_)
    { const float* __restrict__ x = a.in[0]; bf16* __restrict__ xb = (bf16*)(ws + WS_XB); float* __restrict__ ssq = (float*)(ws + WS_SSQ);
      f32x4 v[2][4], vn[2][4];
#pragma unroll
      for (int h = 0; h < 2; ++h) { const int m0 = gw + h * NGW; const int mr = m0 < M ? m0 : gw; const f32x4* xr = (const f32x4*)(x + (size_t)mr * D) + LANE;
#pragma unroll
        for (int j = 0; j < 4; ++j) v[h][j] = xr[64 * j]; }
      for (int m = gw; m < M; m += 2 * NGW) {
#pragma unroll
        for (int h = 0; h < 2; ++h) { const int mn0 = m + (2 + h) * NGW; const int mn = mn0 < M ? mn0 : gw; const f32x4* xr = (const f32x4*)(x + (size_t)mn * D) + LANE;
#pragma unroll
          for (int j = 0; j < 4; ++j) vn[h][j] = xr[64 * j]; }
#pragma unroll
        for (int h = 0; h < 2; ++h) { const int mm = m + h * NGW; if (mm < M) { float s = 0.f;
          unsigned long long* o8 = (unsigned long long*)(xb + (size_t)mm * D) + LANE;
#pragma unroll
          for (int j = 0; j < 4; ++j) { const unsigned w0 = pk2(v[h][j][0], v[h][j][1]), w1 = pk2(v[h][j][2], v[h][j][3]); o8[64 * j] = (unsigned long long)w0 | ((unsigned long long)w1 << 32);
              const float r0 = bf_lo(w0), r1 = bf_hi(w0), r2 = bf_lo(w1), r3 = bf_hi(w1); s += (r0 * r0 + r1 * r1) + (r2 * r2 + r3 * r3); }
          s = wave_sum(s);
          if (LANE < 16) ssq[(size_t)mm * 16 + LANE] = LANE == 0 ? s : 0.f; } }
#pragma unroll
        for (int h = 0; h < 2; ++h)
#pragma unroll
          for (int j = 0; j < 4; ++j) v[h][j] = vn[h][j];
      } }
    if (TS_P0 == 2 && blockIdx.x == 0 && TID == 0) __hip_atomic_store((unsigned*)(a.ws + WS_CTL) + 16, (unsigned)__builtin_amdgcn_s_memrealtime() - __hip_atomic_load((unsigned*)(a.ws + WS_CTL) + 17, __ATOMIC_RELAXED, __HIP_MEMORY_SCOPE_AGENT), __ATOMIC_RELAXED, __HIP_MEMORY_SCOPE_AGENT);
    for (int r_ = 0; r_ < ((PROBE_P0 & 4) ? 2 : 1); ++r_)
    { const int gt = (F.vcu * NWAVES + F.wave) * 64 + LANE, NGT = NGW * 64; float* wf = (float*)(ws + WS_WF); float* lb = (float*)(ws + WS_LB);
      for (int i = gt; i < 2 * 8 * D; i += NGT) { const int j = i / (8 * D), h = (i / D) % 8, k = i % D; wf[i] = a.in[4][(size_t)j * D * AB_COLS + (size_t)k * AB_COLS + 1536 + h] * a.in[1][(2 * j) * D + k]; }
      for (int i = gt; i < D; i += NGT) { const float c0 = a.in[9][i], c1 = a.in[9][D + i]; lb[i] = 0.f; lb[D + i] = 1.0f / (1.0f + expf(c0 - c1)); } }
}

__device__ __forceinline__ void fgate_job(Frame& F, const Args& a, int j, int jb) {
    LANE_IDS();
    unsigned char* ws = a.ws; const float* wf = (const float*)(ws + WS_WF) + (size_t)j * 8 * D; const float* ssq = (const float*)(ws + WS_SSQ); const bf16* xb = (const bf16*)(ws + WS_XB);
    float* cl = (float*)(ws + WS_CL); float* bt = (float*)(ws + WS_BT); const float* bias = a.in[5] + j * 8;
    LAS float* tmp = (LAS float*)(F.lds + RING_OFF);
    f32x4 w[8][4];
#pragma unroll
    for (int h = 0; h < 8; ++h)
#pragma unroll
        for (int q = 0; q < 4; ++q) w[h][q] = *(const f32x4*)(wf + (size_t)h * D + (q >> 1) * 512 + 8 * LANE + 4 * (q & 1));
    v4u v[2], vn[2];
    { const v4u* xr = (const v4u*)(xb + (size_t)(jb * 64 + F.wave * 8) * D) + LANE; v[0] = xr[0]; v[1] = xr[64]; }
#pragma unroll 1
    for (int i = 0; i < 8; ++i) { const int rl = F.wave * 8 + i, row = jb * 64 + rl;
        { const v4u* xr = (const v4u*)(xb + (size_t)(row + (i < 7 ? 1 : 0)) * D) + LANE; vn[0] = xr[0]; vn[1] = xr[64]; }
        const float rs = pg8::row_rstd(ssq, row); float s8[8]; f32x4 xf[4];
#pragma unroll
        for (int q = 0; q < 4; ++q) { const unsigned a0 = v[q >> 1][2 * (q & 1)], a1 = v[q >> 1][2 * (q & 1) + 1]; xf[q] = (f32x4){bf_lo(a0), bf_hi(a0), bf_lo(a1), bf_hi(a1)}; }
#pragma unroll
        for (int h = 0; h < 8; ++h) { float s = 0.f;
#pragma unroll
            for (int q = 0; q < 4; ++q) s += (xf[q][0] * w[h][q][0] + xf[q][1] * w[h][q][1]) + (xf[q][2] * w[h][q][2] + xf[q][3] * w[h][q][3]);
            s8[h] = s; }
#pragma unroll
        for (int h = 0; h < 4; ++h) { const float a = s8[2 * h], b = s8[2 * h + 1]; const bool up = (LANE & 1) != 0; const float send = up ? a : b, keep = up ? b : a; s8[h] = keep + __shfl_xor(send, 1); }
#pragma unroll
        for (int h = 0; h < 2; ++h) { const float a = s8[2 * h], b = s8[2 * h + 1]; const bool up = (LANE & 2) != 0; const float send = up ? a : b, keep = up ? b : a; s8[h] = keep + __shfl_xor(send, 2); }
        { const float a = s8[0], b = s8[1]; const bool up = (LANE & 4) != 0; const float send = up ? a : b, keep = up ? b : a; s8[0] = keep + __shfl_xor(send, 4); }
        float mine = s8[0]; mine += __shfl_xor(mine, 8); mine += __shfl_xor(mine, 16); mine += __shfl_xor(mine, 32);
        const int hd = LANE & 7;
        if (LANE < 8) { const float z = mine * rs + bias[hd]; tmp[rl * 8 + hd] = fminf(z, 0.f) - log1pf(expf(-fabsf(z))); }
        v[0] = vn[0]; v[1] = vn[1];
    }
    LDS_WAIT(); __syncthreads();
    { const int h = F.wave; float c = tmp[LANE * 8 + h];
#pragma unroll
      for (int o = 1; o < 64; o <<= 1) { const float n = __shfl_up(c, o); if (LANE >= o) c += n; }
      cl[(size_t)(jb * 64 + LANE) * 8 + h] = c; if (LANE == 63) bt[jb * 8 + h] = c; }
    __syncthreads();
}

__device__ __forceinline__ void conv_job(Frame& F, const Args& a, int j, int jb) {
    LANE_IDS();
    unsigned char* ws = a.ws; const bf16* __restrict__ ub = (const bf16*)(ws + WS_QKVU + 3 * T512); const bf16* __restrict__ uc = (const bf16*)(ws + WS_QKVU + 4 * T512); const bf16* __restrict__ ux = (const bf16*)(ws + WS_QKVU + 5 * T512);
    bf16* __restrict__ ao = (bf16*)(ws + WS_AO); const float* __restrict__ cw = a.in[6] + (size_t)j * 3 * CONVW;
#pragma unroll 4
    for (int it = TID; it < 64 * 64; it += NWAVES * 64) { const int rl = it >> 6, ch = (it & 63) * 8, row = jb * 64 + rl, t = row & (SEQ - 1);
        float z[3][8];
#pragma unroll
        for (int d = 0; d < 3; ++d) { const int tt = t - 2 + d;
            if (tt >= 0) { const v4u cv = *(const v4u*)(uc + (size_t)(row - 2 + d) * 512 + ch), xv = *(const v4u*)(ux + (size_t)(row - 2 + d) * 512 + ch);
#pragma unroll
                for (int q = 0; q < 4; ++q) { z[d][2 * q] = bf_lo(cv[q]) * bf_lo(xv[q]); z[d][2 * q + 1] = bf_hi(cv[q]) * bf_hi(xv[q]); } }
            else {
#pragma unroll
                for (int q = 0; q < 8; ++q) z[d][q] = 0.f; } }
        const v4u bv = *(const v4u*)(ub + (size_t)row * 512 + ch); float y[8];
#pragma unroll
        for (int q = 0; q < 8; ++q) { const float b = (q & 1) ? bf_hi(bv[q >> 1]) : bf_lo(bv[q >> 1]);
            y[q] = b * (cw[ch + q] * z[0][q] + cw[CONVW + ch + q] * z[1][q] + cw[2 * CONVW + ch + q] * z[2][q]); }
        v4u o; o.x = pk2(y[0], y[1]); o.y = pk2(y[2], y[3]); o.z = pk2(y[4], y[5]); o.w = pk2(y[6], y[7]);
        *(v4u*)(ao + (size_t)row * D + 512 + ch) = o; }
}

__device__ __forceinline__ void attn_naive_unit(Frame& F, const Args& a, int unit) {
    LANE_IDS();
    unsigned char* ws = a.ws; const bf16* Q = (const bf16*)(ws + WS_QKVU); const bf16* K = (const bf16*)(ws + WS_QKVU + T512); const bf16* V = (const bf16*)(ws + WS_QKVU + 2 * T512);
    bf16* ao = (bf16*)(ws + WS_AO); const float* cl = (const float*)(ws + WS_CL); const float* bt = (const float*)(ws + WS_BT);
    const int b = unit >> 5, h = (unit >> 2) & 7, blk = unit & 3;
    LAS float* beta = (LAS float*)(F.lds + RING_OFF);
    LAS float* pre = beta + 2048;
    __syncthreads();
    if (TID == 0) { float c = 0.f; for (int i = 0; i < 32; ++i) { pre[i] = c; c += bt[(b * 32 + i) * 8 + h]; } }
    LDS_WAIT(); __syncthreads();
    for (int s = TID; s < SEQ; s += NWAVES * 64) beta[s] = -(pre[s >> 6] + cl[(size_t)(b * SEQ + s) * 8 + h]) * LOG2E;
    LDS_WAIT(); __syncthreads();
    const int t = blk * 512 + TID; const size_t rowq = (size_t)(b * SEQ + t);
    float q[64], o[64];
#pragma unroll
    for (int c = 0; c < 8; ++c) { const v4u w = *(const v4u*)(Q + rowq * 512 + h * 64 + 8 * c);
#pragma unroll
        for (int i = 0; i < 4; ++i) { q[8 * c + 2 * i] = bf_lo(w[i]); q[8 * c + 2 * i + 1] = bf_hi(w[i]); } }
#pragma unroll
    for (int d = 0; d < 64; ++d) o[d] = 0.f;
    float mx = -INFINITY, l = 0.f;
    const int send = blk * 512 + 511;
    for (int s = 0; s <= send; ++s) {
        const bf16* kr = K + (size_t)(b * SEQ + s) * 512 + h * 64; const bf16* vr = V + (size_t)(b * SEQ + s) * 512 + h * 64;
        float sc = 0.f;
#pragma unroll
        for (int c = 0; c < 8; ++c) { const v4u w = *(const v4u*)(kr + 8 * c);
#pragma unroll
            for (int i = 0; i < 4; ++i) sc += q[8 * c + 2 * i] * bf_lo(w[i]) + q[8 * c + 2 * i + 1] * bf_hi(w[i]); }
        sc += beta[s];
        if (s <= t) {
            const float mn = fmaxf(mx, sc), f = exp2f(mx - mn), p = exp2f(sc - mn); mx = mn; l = l * f + p;
#pragma unroll
            for (int c = 0; c < 8; ++c) { const v4u w = *(const v4u*)(vr + 8 * c);
#pragma unroll
                for (int i = 0; i < 4; ++i) { o[8 * c + 2 * i] = o[8 * c + 2 * i] * f + p * bf_lo(w[i]); o[8 * c + 2 * i + 1] = o[8 * c + 2 * i + 1] * f + p * bf_hi(w[i]); } }
        }
    }
    const float rl = 1.0f / l;
#pragma unroll
    for (int c = 0; c < 8; ++c) { v4u w; w.x = pk2(o[8 * c] * rl, o[8 * c + 1] * rl); w.y = pk2(o[8 * c + 2] * rl, o[8 * c + 3] * rl); w.z = pk2(o[8 * c + 4] * rl, o[8 * c + 5] * rl); w.w = pk2(o[8 * c + 6] * rl, o[8 * c + 7] * rl);
        *(v4u*)(ao + rowq * D + h * 64 + 8 * c) = w; }
}

__device__ __forceinline__ void hgrn_gate(Frame& F, const Args& a, int j) {
    LANE_IDS();
    unsigned char* ws = a.ws; const bf16* __restrict__ O = (const bf16*)(ws + WS_HO); const bf16* __restrict__ G = (const bf16*)(ws + WS_HG); bf16* __restrict__ AOP = (bf16*)(ws + WS_HQ); const float* __restrict__ hn = a.in[10] + (size_t)j * D;
    const int gw = F.vcu * NWAVES + F.wave, NGW = F.G * NWAVES; (void)TID;
#pragma unroll 4
    for (int m = gw; m < M; m += NGW) {
#pragma unroll
        for (int jj = 0; jj < 2; ++jj) { const int c = (4 * jj + (LANE >> 4)) * HGD + 8 * (LANE & 15); const size_t off = (size_t)m * D + c;
            const v4u ow = *(const v4u*)(O + off), gv = *(const v4u*)(G + off); float o[8], g[8];
#pragma unroll
            for (int q = 0; q < 4; ++q) { o[2 * q] = bf_lo(ow[q]); o[2 * q + 1] = bf_hi(ow[q]); g[2 * q] = bf_lo(gv[q]); g[2 * q + 1] = bf_hi(gv[q]); }
            float s = 0.f;
#pragma unroll
            for (int q = 0; q < 8; ++q) s += o[q] * o[q];
            s += __shfl_xor(s, 1); s += __shfl_xor(s, 2); s += __shfl_xor(s, 4); s += __shfl_xor(s, 8);
            const float r = __builtin_amdgcn_rsqf(s * (1.0f / HGD) + EPS); const f32x4 h0 = *(const f32x4*)(hn + c), h1 = *(const f32x4*)(hn + c + 4);
            v4u w; w.x = pk2(o[0] * r * h0[0] * g[0], o[1] * r * h0[1] * g[1]); w.y = pk2(o[2] * r * h0[2] * g[2], o[3] * r * h0[3] * g[3]);
            w.z = pk2(o[4] * r * h1[0] * g[4], o[5] * r * h1[1] * g[5]); w.w = pk2(o[6] * r * h1[2] * g[6], o[7] * r * h1[3] * g[7]);
            *(v4u*)(AOP + off) = w; }
    }
}
__device__ __forceinline__ void final_norm(Frame& F, const Args& a) {
    LANE_IDS(); (void)TID;
    const int gw = F.vcu * NWAVES + F.wave, NGW = F.G * NWAVES; const float* __restrict__ g = a.in[3]; const bf16* __restrict__ xb = (const bf16*)(a.ws + WS_XB); float* __restrict__ outp = a.out;
    f32x4 gv[4];
#pragma unroll
    for (int q = 0; q < 4; ++q) gv[q] = *(const f32x4*)(g + (q >> 1) * 512 + 8 * LANE + 4 * (q & 1));
#pragma unroll 4
    for (int m = gw; m < M; m += NGW) { const v4u* xr = (const v4u*)(xb + (size_t)m * D) + LANE; const v4u v0 = xr[0], v1 = xr[64]; f32x4 x[4]; float s = 0.f;
#pragma unroll
        for (int q = 0; q < 4; ++q) { const unsigned a0 = (q >> 1) ? v1[2 * (q & 1)] : v0[2 * (q & 1)], a1 = (q >> 1) ? v1[2 * (q & 1) + 1] : v0[2 * (q & 1) + 1];
            x[q] = (f32x4){bf_lo(a0), bf_hi(a0), bf_lo(a1), bf_hi(a1)}; s += (x[q][0] * x[q][0] + x[q][1] * x[q][1]) + (x[q][2] * x[q][2] + x[q][3] * x[q][3]); }
        const float r = __builtin_amdgcn_rsqf(wave_sum(s) * (1.0f / D) + EPS); float* orow = outp + (size_t)m * D;
#pragma unroll
        for (int q = 0; q < 4; ++q) { f32x4 ov = x[q] * r * gv[q]; if ((TS_PHASE != -1 || TS_P0) && m == 0 && LANE == 0 && q == 0) ov[0] += (float)__hip_atomic_load((unsigned*)(F.ctl + 16), __ATOMIC_RELAXED, __HIP_MEMORY_SCOPE_AGENT) * (1.0f / TS_DIV);
            *(f32x4*)(orow + (q >> 1) * 512 + 8 * LANE + 4 * (q & 1)) = ov; } }
}

constexpr int N_PHASES = 26;
#ifndef WCONV_IN_FFN_TAIL
#define WCONV_IN_FFN_TAIL 1
#endif
#ifndef PROBE_MASK
#define PROBE_MASK 0
#endif
#ifndef HGRN_NAIVE
#define HGRN_NAIVE 0
#endif
#ifndef ATTN_NAIVE
#define ATTN_NAIVE 0
#endif
#ifndef MK_PER_PHASE
#define MK_PER_PHASE 0
#endif
__global__ void __launch_bounds__(NWAVES * 64, 2) trunk_fwd(Args args) {
    extern __shared__ __attribute__((aligned(16))) unsigned char lds[];
    Frame F_;
    if (TS_PHASE == -2 && blockIdx.x == 0 && threadIdx.x == 0) __hip_atomic_store((unsigned*)(args.ws + WS_CTL) + 17, (unsigned)__builtin_amdgcn_s_memrealtime(), __ATOMIC_RELAXED, __HIP_MEMORY_SCOPE_AGENT);
    F_.lds = (LAS unsigned char*)lds; F_.MISC = (volatile LAS unsigned*)(F_.lds + MISC_OFF);
    F_.wave = __builtin_amdgcn_readfirstlane((int)threadIdx.x >> 6);
    F_.G = gridDim.x; { const int bx = blockIdx.x; F_.vcu = (F_.G % 8 == 0) ? (bx % 8) * (F_.G / 8) + bx / 8 : bx; }
    unsigned char* ws = args.ws; F_.ctl = (gu32*)(ws + WS_CTL);
    for (int u = threadIdx.x; u < (LDS_BYTES - LDSCTL_OFF) / 4; u += NWAVES * 64) ((LAS unsigned*)(F_.lds + LDSCTL_OFF))[u] = 0u;
    __syncthreads();
    const int lo = args.ph_lo, hi = args.ph_hi;
    XcdBarrier bar; bar.bar = (unsigned*)(F_.ctl + CW_BAR); bar.x = 0; bar.st = nullptr;
    if (hi - lo > 1) bar = xcd_barrier_post((unsigned*)(F_.ctl + CW_BAR), F_.MISC + 8);
#pragma unroll 1
    for (int p = lo; p < hi; ++p) {
        const int l = (p - 1) / 6, s = (p - 1) - 6 * l, j = l >> 1; const bool even = (l & 1) == 0, mid = (p >= 1 && p <= 24);
#if defined(__HIP_DEVICE_COMPILE__)
        KArgP ap = (KArgP)__builtin_amdgcn_kernarg_segment_ptr(); asm volatile("" : "+s"(ap));
        Args A2; for (int q_ = 0; q_ < 14; ++q_) A2.in[q_] = (const float*)(const GAS float*)ap->in[q_]; A2.out = (float*)(GAS float*)ap->out; A2.ws = (unsigned char*)(GAS unsigned char*)ap->ws;     A2.ph_lo = lo; A2.ph_hi = hi; A2.li = 0; A2.pad = 0;
#else
        Args A2 = args;
#endif
        Frame FL = F_; { int w_ = F_.wave, v_ = F_.vcu, g_ = F_.G; asm volatile("" : "+s"(w_), "+s"(v_), "+s"(g_)); FL.wave = w_; FL.vcu = v_; FL.G = g_; }
        int bx = blockIdx.x; asm volatile("" : "+s"(bx));
        Frame& F = FL;
        GAS unsigned char* wsg = (GAS unsigned char*)A2.ws; asm volatile("" : "+s"(wsg)); unsigned char* ws = (unsigned char*)wsg; A2.ws = ws;
        bf16* const wb = (bf16*)(ws + WS_W); bf16* const XB = (bf16*)(ws + WS_XB); float* const SSQ = (float*)(ws + WS_SSQ);
        const int cls = p == 0 ? 1 : p == 25 ? 11 : (s == 0 ? (even ? 2 : 3) : s == 1 ? (even ? 4 : 5) : s == 2 ? 6 : s == 3 ? 7 : s == 4 ? 8 : 9);
        if (mid && s == 2 && even) continue;
        const int nrep = ((PROBE_MASK >> cls) & 1) ? 2 : 1;
        if (TS_PHASE == -2 && p == 0 && bx == 0 && threadIdx.x == 0) __hip_atomic_store((unsigned*)(F.ctl + 16), (unsigned)__builtin_amdgcn_s_memrealtime() - __hip_atomic_load((unsigned*)(F.ctl + 17), __ATOMIC_RELAXED, __HIP_MEMORY_SCOPE_AGENT), __ATOMIC_RELAXED, __HIP_MEMORY_SCOPE_AGENT);
        if (TS_PHASE >= 0 && (p == TS_PHASE || p == TS_PHASE_END) && bx == 0 && threadIdx.x == 0) { const unsigned now_ = TS_CLOCK ? (unsigned)__builtin_amdgcn_s_memtime() : (unsigned)__builtin_amdgcn_s_memrealtime();
            if (p == TS_PHASE) __hip_atomic_store((unsigned*)(F.ctl + 17), now_, __ATOMIC_RELAXED, __HIP_MEMORY_SCOPE_AGENT);
            else __hip_atomic_store((unsigned*)(F.ctl + 16), now_ - __hip_atomic_load((unsigned*)(F.ctl + 17), __ATOMIC_RELAXED, __HIP_MEMORY_SCOPE_AGENT), __ATOMIC_RELAXED, __HIP_MEMORY_SCOPE_AGENT); }
#define GRID_BARRIER() do { XcdBarrier b2 = bar; GAS unsigned* bg = (GAS unsigned*)bar.bar; asm volatile("" : "+s"(bg), "+s"(b2.x)); b2.bar = (unsigned*)bg; xcd_barrier(b2); } while (0)
#pragma unroll 1
        for (int rp = 0; rp < nrep; ++rp) { const bool dummy = rp + 1 < nrep; (void)dummy;
        if (p == 0) p0_prologue(F, A2);
        else if (p == 25) { if (!(FUSE_FINAL_NORM && F.G == 256)) final_norm(F, A2); }
        else if (s == 0 && even) {
            pg8::Gemm g{XB, (const bf16*)((unsigned char*)wb + W_ABIN + j * SZ_ABIN), M, AB_N, D}; pg8::StaticOrder S; S.init(M, AB_N, F.G, bx);
            pg8::EpiAB E{(bf16*)(ws + WS_QKVU), (size_t)M * 512, SSQ, QSCALE};
            pg8::gemm_phase<pg8::EpiAB, pg8::StaticOrder, true, true>(F.lds + RING_OFF, g, S, E);
            for (int jb = F.vcu; jb < M / 64; jb += F.G) fgate_job(F, A2, j, jb);
            if (L0_SPLIT && l == 0 && !dummy) convert_layer_weights(F, A2, 0, F.vcu * NWAVES + F.wave, F.G * NWAVES, I_ABIN, I_ABIN + I_SQ + I_FIN);
        } else if (s == 0) {
            pg8::Gemm g{XB, (const bf16*)((unsigned char*)wb + W_CIN + j * SZ_CIN), M, C_COLS, D}; pg8::StaticOrder S; S.init(M, C_COLS, F.G, bx);
            pg8::EpiHG E{(bf16*)(ws + WS_HQ), (bf16*)(ws + WS_KD), (bf16*)(ws + WS_KT), (bf16*)(ws + WS_HV), (size_t)M * D, (float*)(ws + WS_DEC), (const float*)(ws + WS_LB) + (size_t)j * D, SSQ, j == 0};
            static_assert(WS_HG == WS_HV + (size_t)M * D * 2, "V | G consecutive");
            pg8::gemm_phase<pg8::EpiHG, pg8::StaticOrder, true, true>(F.lds + RING_OFF, g, S, E);
        } else if (s == 1 && even) {
            if (F.vcu & 1) for (int jb = F.vcu; jb < M / 64; jb += F.G) conv_job(F, A2, j, jb);
#if ATTN_NAIVE
            for (int u = F.vcu; u < 256; u += F.G) attn_naive_unit(F, A2, u);
#else
            { const attn_body::AttnTensors AT{(const attn_body::bf16*)(ws + WS_QKVU), (const attn_body::bf16*)(ws + WS_QKVU + T512), (const attn_body::bf16*)(ws + WS_QKVU + 2 * T512), (attn_body::bf16*)(ws + WS_AO),
                                               (const float*)(ws + WS_CL), (const float*)(ws + WS_BT)};
              const attn_body::StaticOrder S((int)F.G, bx);
              attn_body::attn_phase<attn_body::StaticOrder>((char*)lds + RING_OFF, AT, S); }
#endif
            if (!(F.vcu & 1)) for (int jb = F.vcu; jb < M / 64; jb += F.G) conv_job(F, A2, j, jb);
            if (L0_SPLIT && l == 0 && !dummy) { __syncthreads(); convert_layer_weights(F, A2, 0, F.vcu * NWAVES + F.wave, F.G * NWAVES, I_ABIN + I_SQ + I_FIN, 1 << 30); }
        } else if (s == 1) {
            for (int u = F.vcu; u < 256; u += F.G) hg::hgrn_unit(F.lds + RING_OFF, (const unsigned short*)(ws + WS_HQ), (const unsigned short*)(ws + WS_KD), (const unsigned short*)(ws + WS_KT), (const float*)(ws + WS_DEC), (const unsigned short*)(ws + WS_HV), (unsigned short*)(ws + WS_HO), u);
        } else if (s == 2) {
            hgrn_gate(F, A2, j);
        } else if (s == 4) {
            pg8::Gemm g{XB, (const bf16*)((unsigned char*)wb + W_FIN + l * SZ_FIN), M, FF2, D}; pg8::StaticOrder S; S.init(M, FF2, F.G, bx);
            pg8::EpiSwi E{(bf16*)(ws + WS_H), SSQ};
            pg8::gemm_phase<pg8::EpiSwi, pg8::StaticOrder, true, true>(F.lds + RING_OFF, g, S, E, (TS_EPI && p == TS_PHASE) ? (unsigned*)(F.ctl + 16) : (unsigned*)(F.ctl + 20));
#if WCONV_IN_FFN_TAIL
            { const int nfull = (M / 256) * (FF2 / 256) - (((M / 256) * (FF2 / 256)) / F.G) * F.G;
              if (l + 1 < DEPTH && !dummy && bx >= nfull) convert_layer_weights(F, A2, l + 1, (bx - nfull) * NWAVES + F.wave, (F.G - nfull) * NWAVES); }
#endif
        } else {
            const bool dn = (s == 5);
            const bf16* A = dn ? (const bf16*)(ws + WS_H) : (even ? (const bf16*)(ws + WS_AO) : (const bf16*)(ws + WS_HQ));
            const size_t wo = dn ? (W_FOUT + l * SZ_FOUT) : (even ? (W_ABOUT + j * SZ_ABOUT) : (W_COUT + j * SZ_COUT));
            pg8::Gemm g{A, (const bf16*)((unsigned char*)wb + wo), M, D, dn ? FFH : D}; pg8::StaticOrder S; S.init(M, D, F.G, bx);
#if FUSE_FINAL_NORM
            if (p == 24 && !dummy && F.G == 256) {
                pg8::EpiResFinal E{XB, A2.out, (float*)(ws + WS_XS), (unsigned*)(F.ctl + CW_FIN), A2.in[3]};
                pg8::gemm_phase<pg8::EpiResFinal, pg8::StaticOrder, true, true>(F.lds + RING_OFF, g, S, E);
            } else
#endif
            { pg8::EpiRes E{XB, dummy ? (bf16*)(ws + WS_MIX + (dn ? 96 * MiB : 0)) : XB, SSQ};
              pg8::gemm_phase<pg8::EpiRes, pg8::StaticOrder, true, true>(F.lds + RING_OFF, g, S, E); }
        }
        if (dummy) GRID_BARRIER();
        }
        if (TS_PHASE_END < 0 && TS_PHASE >= 0 && p == TS_PHASE && bx == 0 && threadIdx.x == 0) { const unsigned dt_ = (unsigned)__builtin_amdgcn_s_memrealtime() - __hip_atomic_load((unsigned*)(F.ctl + 17), __ATOMIC_RELAXED, __HIP_MEMORY_SCOPE_AGENT); __hip_atomic_store((unsigned*)(F.ctl + 16), dt_, __ATOMIC_RELAXED, __HIP_MEMORY_SCOPE_AGENT); }
        if (p + 1 < hi && !(FUSE_FINAL_NORM && F.G == 256 && p >= 24)) { GRID_BARRIER(); if ((PROBE_MASK >> 10) & 1) GRID_BARRIER(); }
    }
}

extern "C" void kernel_launch(void* const* d_in, const int* in_sizes, int n_in, void* d_out, int out_size, void* d_ws, size_t ws_size, hipStream_t stream) {
    static int grid = 0;
    if (grid == 0) {
        if (n_in != 14 || in_sizes[0] != M * D || out_size != M * D || ws_size < WS_END) { fprintf(stderr, "kernel_launch: unexpected shapes / workspace (n_in %d, ws %zu, need %zu)\n", n_in, ws_size, (size_t)WS_END); grid = -1; return; }
        int dev = 0, cus = 0;
        if (hipGetDevice(&dev) != hipSuccess || hipDeviceGetAttribute(&cus, hipDeviceAttributeMultiprocessorCount, dev) != hipSuccess) { grid = -1; return; }
        if (hipFuncSetAttribute((const void*)trunk_fwd, hipFuncAttributeMaxDynamicSharedMemorySize, LDS_BYTES) != hipSuccess) { fprintf(stderr, "kernel_launch: hipFuncSetAttribute failed\n"); grid = -1; return; }
        int per_cu = 0; (void)hipOccupancyMaxActiveBlocksPerMultiprocessor(&per_cu, (const void*)trunk_fwd, NWAVES * 64, LDS_BYTES); (void)hipGetLastError();
        grid = cus;
    }
    if (grid < 0) return;
    (void)hipMemsetAsync((char*)d_ws + WS_CTL, 0, CTL_ZERO_BYTES, stream);
    Args a{};
    for (int i = 0; i < 14; ++i) a.in[i] = (const float*)d_in[i];
    a.out = (float*)d_out; a.ws = (unsigned char*)d_ws;
#if MK_PER_PHASE
    for (int p = 0; p < N_PHASES; ++p) { const int l = (p - 1) / 6, s = (p - 1) % 6; if (p >= 1 && p <= 24 && s == 2 && (l & 1) == 0) continue;
        a.ph_lo = p; a.ph_hi = p + 1; a.li = 0; hipLaunchKernelGGL(trunk_fwd, dim3(grid), dim3(NWAVES * 64), LDS_BYTES, stream, a); }
#else
    a.ph_lo = 0; a.ph_hi = N_PHASES; a.li = 0;
    hipLaunchKernelGGL(trunk_fwd, dim3(grid), dim3(NWAVES * 64), LDS_BYTES, stream, a);
#endif
}
```

```cpp
#include <hip/hip_runtime.h>
#include <cstdio>
#include <cstdint>
#include <cmath>
#ifndef TS_EPI
#define TS_EPI 0
#endif
namespace pg8 {
#define PG8_LAS __attribute__((address_space(3)))
typedef unsigned short bf16_t;
typedef short bf16x8 __attribute__((ext_vector_type(8)));
typedef float f32x4 __attribute__((ext_vector_type(4)));
typedef unsigned u32x4 __attribute__((ext_vector_type(4)));
constexpr int BM = 256, BK = 64, HALF = 128, HTB = HALF * BK * 2  , STAGE_BYTES = 8 * HTB, NXCD = 8, WGM = 4;

__host__ __device__ __forceinline__ int lds_byte(int r, int c) { const int st = (r >> 4) * 2 + (c >> 5), rr = r & 15, cc = c & 31, ob = rr * 64 + cc * 2; return st * 1024 + (ob ^ (((ob >> 9) & 1) << 5)); }
__host__ __device__ __forceinline__ void stage_rc(int b, int& R, int& C) { const int st = b / 1024, sb = b % 1024, swz = sb ^ (((sb >> 9) & 1) << 5); R = (st >> 1) * 16 + swz / 64; C = (st & 1) * 32 + (swz % 64) / 2; }
__host__ __device__ __forceinline__ int perm32(int rho) { const int n = rho >> 4, i = rho & 15; return 8 * (i >> 2) + 4 * n + (i & 3); }

struct Unit { int pm, pn; };
struct Gemm { const bf16_t* A; const bf16_t* Bt; int M, N, K; };

struct StaticOrder {
    int nM, nN, nwg, G, c;
    __host__ __device__ void init(int M, int N, int G_, int c_) { nM = M / BM; nN = N / BM; nwg = nM * nN; G = G_; c = c_; }
    __host__ __device__ bool next(int i, Unit& u) const {
        const long L = (long)i * G + c; if (L >= nwg) return false;
        int wgid = (int)L; { const int q = nwg / NXCD, r = nwg % NXCD, xcd = wgid % NXCD, off = wgid / NXCD; wgid = (xcd < r ? xcd * (q + 1) : r * (q + 1) + (xcd - r) * q) + off; }
        const int nig = WGM * nN, gid = wgid / nig, fm = gid * WGM, gsz = (nM - fm) < WGM ? (nM - fm) : WGM;
        u.pm = fm + ((wgid % nig) % gsz); u.pn = (wgid % nig) / gsz; return true;
    }
    __device__ __forceinline__ void a_ready(const Unit&) const {}
    __device__ __forceinline__ void done(const Unit&) const {}
};


__device__ __forceinline__ unsigned cvt_pk_bf16(float lo, float hi) { typedef float f2_ __attribute__((ext_vector_type(2))); typedef __bf16 b2_ __attribute__((ext_vector_type(2))); f2_ v = {lo, hi}; b2_ b = __builtin_convertvector(v, b2_); return __builtin_bit_cast(unsigned, b); }
typedef unsigned u32x2 __attribute__((ext_vector_type(2)));
constexpr float RMS_EPS = 1e-6f;
__device__ __forceinline__ float row_rstd(const float* ssq, int row) {
    const f32x4* p = (const f32x4*)(ssq + (size_t)row * 16);
    const f32x4 a = p[0], b = p[1], c = p[2], d = p[3];
    const float s = (((a[0] + a[1]) + (a[2] + a[3])) + ((b[0] + b[1]) + (b[2] + b[3]))) + (((c[0] + c[1]) + (c[2] + c[3])) + ((d[0] + d[1]) + (d[2] + d[3])));
    return __builtin_amdgcn_rsqf(s * (1.0f / 1024.0f) + RMS_EPS);
}
__device__ __forceinline__ float row_rstd_q(const float* ssq, int row, int fq) {
    const f32x4 a = *((const f32x4*)(ssq + (size_t)row * 16) + fq);
    float s = (a[0] + a[1]) + (a[2] + a[3]);
    s += __shfl_xor(s, 16); s += __shfl_xor(s, 32);
    return __builtin_amdgcn_rsqf(s * (1.0f / 1024.0f) + RMS_EPS);
}
__device__ __forceinline__ void row_rstd_half(const float* ssq, int rowh, int fq, float (&rs)[4]) {
    f32x4 a[4];
#pragma unroll
    for (int m = 0; m < 4; ++m) a[m] = *((const f32x4*)(ssq + (size_t)(rowh + m * 16) * 16) + fq);
#pragma unroll
    for (int m = 0; m < 4; ++m) { float s = (a[m][0] + a[m][1]) + (a[m][2] + a[m][3]); s += __shfl_xor(s, 16); s += __shfl_xor(s, 32); rs[m] = __builtin_amdgcn_rsqf(s * (1.0f / 1024.0f) + RMS_EPS); }
}
__device__ __forceinline__ float sigmoid_f(float z) { return __builtin_amdgcn_rcpf(1.0f + __expf(-z)); }

struct EpiAB {
    static constexpr bool PERM = true, AFTER_DRAIN = false; static constexpr int NS_MIN = 16;
    bf16_t* O; size_t tstride; const float* ssq; float qscale;
    __device__ __forceinline__ void operator()(const f32x4 (&acc)[2][2][4][2], const Unit& u, int wr, int wc, int fr, int fq) const {
        const int t = u.pn >> 1; bf16_t* base = O + (size_t)t * tstride;
        const int col0 = (u.pn & 1) * 256 + wc * 32 + 8 * fq, row0 = u.pm * BM + wr * 64 + fr;
        const float sc0 = (t == 0) ? qscale : 1.0f;
#pragma unroll
        for (int ai = 0; ai < 2; ++ai) { float rsv[4]; row_rstd_half(ssq, row0 + ai * HALF, fq, rsv);
#pragma unroll
            for (int m = 0; m < 4; ++m) { const int row = row0 + ai * HALF + m * 16; const float rs = rsv[m] * sc0; bf16_t* rowp = base + (size_t)row * 512 + col0;
#pragma unroll
                for (int bj = 0; bj < 2; ++bj) { const f32x4 v0 = acc[ai][bj][m][0] * rs, v1 = acc[ai][bj][m][1] * rs;
                    u32x4 w; w.x = cvt_pk_bf16(v0[0], v0[1]); w.y = cvt_pk_bf16(v0[2], v0[3]); w.z = cvt_pk_bf16(v1[0], v1[1]); w.w = cvt_pk_bf16(v1[2], v1[3]);
                    *(u32x4*)(rowp + bj * HALF) = w; } } }
    }
};
struct EpiRes {
    static constexpr bool PERM = true, AFTER_DRAIN = false; static constexpr int NS_MIN = 16;
    const bf16_t* base; bf16_t* out; float* ssq;
    __device__ __forceinline__ void operator()(const f32x4 (&acc)[2][2][4][2], const Unit& u, int wr, int wc, int fr, int fq) const {
        const int col0 = u.pn * BM + wc * 32 + 8 * fq;
#pragma unroll
        for (int ai = 0; ai < 2; ++ai) {
            u32x4 b[4][2];
#pragma unroll
            for (int m = 0; m < 4; ++m)
#pragma unroll
                for (int bj = 0; bj < 2; ++bj) b[m][bj] = *(const u32x4*)(base + (size_t)(u.pm * BM + ai * HALF + wr * 64 + m * 16 + fr) * 1024 + col0 + bj * HALF);
#pragma unroll
            for (int m = 0; m < 4; ++m) { const int row = u.pm * BM + ai * HALF + wr * 64 + m * 16 + fr; const size_t off = (size_t)row * 1024 + col0; float s = 0.f;
#pragma unroll
                for (int bj = 0; bj < 2; ++bj) { const u32x4 bb = b[m][bj]; f32x4 x0 = acc[ai][bj][m][0], x1 = acc[ai][bj][m][1];
                    x0[0] += __uint_as_float(bb.x << 16); x0[1] += __uint_as_float(bb.x & 0xffff0000u); x0[2] += __uint_as_float(bb.y << 16); x0[3] += __uint_as_float(bb.y & 0xffff0000u);
                    x1[0] += __uint_as_float(bb.z << 16); x1[1] += __uint_as_float(bb.z & 0xffff0000u); x1[2] += __uint_as_float(bb.w << 16); x1[3] += __uint_as_float(bb.w & 0xffff0000u);
                    u32x4 w; w.x = cvt_pk_bf16(x0[0], x0[1]); w.y = cvt_pk_bf16(x0[2], x0[3]); w.z = cvt_pk_bf16(x1[0], x1[1]); w.w = cvt_pk_bf16(x1[2], x1[3]);
                    *(u32x4*)(out + off + bj * HALF) = w;
                    const float r0 = __uint_as_float(w.x << 16), r1 = __uint_as_float(w.x & 0xffff0000u), r2 = __uint_as_float(w.y << 16), r3 = __uint_as_float(w.y & 0xffff0000u);
                    const float r4 = __uint_as_float(w.z << 16), r5 = __uint_as_float(w.z & 0xffff0000u), r6 = __uint_as_float(w.w << 16), r7 = __uint_as_float(w.w & 0xffff0000u);
                    s += ((r0 * r0 + r1 * r1) + (r2 * r2 + r3 * r3)) + ((r4 * r4 + r5 * r5) + (r6 * r6 + r7 * r7)); }
                s += __shfl_xor(s, 16); s += __shfl_xor(s, 32);
                if (fq == 0) ssq[(size_t)row * 16 + u.pn * 4 + wc] = s; }
        }
    }
};
struct EpiResFinal {
    static constexpr bool PERM = true, AFTER_DRAIN = false; static constexpr int NS_MIN = 0;
    const bf16_t* base; float* out; float* xs; unsigned* cnt; const float* gain;
    __device__ __forceinline__ void operator()(const f32x4 (&acc)[2][2][4][2], const Unit& u, int wr, int wc, int fr, int fq) const {
        const int col0 = u.pn * BM + wc * 32 + 8 * fq, rowb = u.pm * BM + wr * 64 + fr;
#pragma unroll
        for (int ai = 0; ai < 2; ++ai) { u32x4 b[4][2];
#pragma unroll
            for (int m = 0; m < 4; ++m)
#pragma unroll
                for (int bj = 0; bj < 2; ++bj) b[m][bj] = *(const u32x4*)(base + (size_t)(rowb + ai * HALF + m * 16) * 1024 + col0 + bj * HALF);
#pragma unroll
            for (int m = 0; m < 4; ++m) { const int row = rowb + ai * HALF + m * 16; float s = 0.f;
#pragma unroll
                for (int bj = 0; bj < 2; ++bj) { const u32x4 bb = b[m][bj]; const f32x4 a0 = acc[ai][bj][m][0], a1 = acc[ai][bj][m][1];
                    const float x0 = a0[0] + __uint_as_float(bb.x << 16), x1 = a0[1] + __uint_as_float(bb.x & 0xffff0000u), x2 = a0[2] + __uint_as_float(bb.y << 16), x3 = a0[3] + __uint_as_float(bb.y & 0xffff0000u);
                    const float x4 = a1[0] + __uint_as_float(bb.z << 16), x5 = a1[1] + __uint_as_float(bb.z & 0xffff0000u), x6 = a1[2] + __uint_as_float(bb.w << 16), x7 = a1[3] + __uint_as_float(bb.w & 0xffff0000u);
                    s += ((x0 * x0 + x1 * x1) + (x2 * x2 + x3 * x3)) + ((x4 * x4 + x5 * x5) + (x6 * x6 + x7 * x7)); }
                s += __shfl_xor(s, 16); s += __shfl_xor(s, 32);
                if (fq == 0) __hip_atomic_store(xs + (size_t)row * 16 + u.pn * 4 + wc, s, __ATOMIC_RELAXED, __HIP_MEMORY_SCOPE_AGENT); } }
        asm volatile("s_waitcnt vmcnt(0)" ::: "memory");
        unsigned* const pc = cnt + 64 * u.pm;
        if ((threadIdx.x & 63) == 0) __hip_atomic_fetch_add(pc, 1u, __ATOMIC_RELAXED, __HIP_MEMORY_SCOPE_AGENT);
        { const unsigned long long t0 = __builtin_amdgcn_s_memrealtime();
          while ((unsigned)__builtin_amdgcn_readfirstlane(__hip_atomic_load(pc, __ATOMIC_RELAXED, __HIP_MEMORY_SCOPE_AGENT)) < 32u) {
              if (__builtin_amdgcn_s_memrealtime() - t0 > 2000000ull) break;
              __builtin_amdgcn_s_sleep(2); } }
        asm volatile("" ::: "memory");
        const f32x4 g0 = *(const f32x4*)(gain + col0), g1 = *(const f32x4*)(gain + col0 + 4), g2 = *(const f32x4*)(gain + col0 + HALF), g3 = *(const f32x4*)(gain + col0 + HALF + 4);
#pragma unroll
        for (int ai = 0; ai < 2; ++ai) { u32x4 b[4][2]; float rs[4];
#pragma unroll
            for (int m = 0; m < 4; ++m) { const int row = rowb + ai * HALF + m * 16; const float* xp = xs + (size_t)row * 16 + 4 * fq;
                float s = (__hip_atomic_load(xp, __ATOMIC_RELAXED, __HIP_MEMORY_SCOPE_AGENT) + __hip_atomic_load(xp + 1, __ATOMIC_RELAXED, __HIP_MEMORY_SCOPE_AGENT))
                        + (__hip_atomic_load(xp + 2, __ATOMIC_RELAXED, __HIP_MEMORY_SCOPE_AGENT) + __hip_atomic_load(xp + 3, __ATOMIC_RELAXED, __HIP_MEMORY_SCOPE_AGENT));
                s += __shfl_xor(s, 16); s += __shfl_xor(s, 32); rs[m] = __builtin_amdgcn_rsqf(s * (1.0f / 1024.0f) + RMS_EPS);
#pragma unroll
                for (int bj = 0; bj < 2; ++bj) b[m][bj] = *(const u32x4*)(base + (size_t)row * 1024 + col0 + bj * HALF); }
#pragma unroll
            for (int m = 0; m < 4; ++m) { const int row = rowb + ai * HALF + m * 16; const float r = rs[m]; float* op = out + (size_t)row * 1024 + col0;
#pragma unroll
                for (int bj = 0; bj < 2; ++bj) { const u32x4 bb = b[m][bj]; const f32x4 a0 = acc[ai][bj][m][0], a1 = acc[ai][bj][m][1]; const f32x4 ga = bj ? g2 : g0, gb = bj ? g3 : g1;
                    f32x4 o0, o1;
                    o0[0] = (a0[0] + __uint_as_float(bb.x << 16)) * r * ga[0]; o0[1] = (a0[1] + __uint_as_float(bb.x & 0xffff0000u)) * r * ga[1];
                    o0[2] = (a0[2] + __uint_as_float(bb.y << 16)) * r * ga[2]; o0[3] = (a0[3] + __uint_as_float(bb.y & 0xffff0000u)) * r * ga[3];
                    o1[0] = (a1[0] + __uint_as_float(bb.z << 16)) * r * gb[0]; o1[1] = (a1[1] + __uint_as_float(bb.z & 0xffff0000u)) * r * gb[1];
                    o1[2] = (a1[2] + __uint_as_float(bb.w << 16)) * r * gb[2]; o1[3] = (a1[3] + __uint_as_float(bb.w & 0xffff0000u)) * r * gb[3];
                    *(f32x4*)(op + bj * HALF) = o0; *(f32x4*)(op + bj * HALF + 4) = o1; } } }
    }
};
template <int SH> __device__ __forceinline__ float row_shr(float v) { return __builtin_bit_cast(float, __builtin_amdgcn_update_dpp(0, __builtin_bit_cast(int, v), 0x110 + SH, 0xf, 0xf, true)); }
__device__ __forceinline__ float rowscan16(float v) { v += row_shr<1>(v); v += row_shr<2>(v); v += row_shr<4>(v); v += row_shr<8>(v); return v; }
__device__ __forceinline__ float rowlast16(float v) { return __shfl(v, 15, 16); }
struct EpiHG {
    static constexpr bool PERM = true, AFTER_DRAIN = false; static constexpr int NS_MIN = 16;
    bf16_t* QA; bf16_t* KD; bf16_t* KT; bf16_t* V; size_t tstride; float* DEC; const float* lb; const float* ssq; bool lbzero;
    __device__ __forceinline__ void operator()(const f32x4 (&acc)[2][2][4][2], const Unit& u, int wr, int wc, int fr, int fq) const {
        const int row0 = u.pm * BM + wr * 64 + fr;
        if (u.pn >= 8) {
            const int tt = (u.pn >= 12) ? 1 : 0; const int col0 = ((u.pn - 8) & 3) * 256 + wc * 32 + 8 * fq; bf16_t* const dbase = V + (size_t)tt * tstride;
#pragma unroll
            for (int ai = 0; ai < 2; ++ai) { float rsv[4]; row_rstd_half(ssq, row0 + ai * HALF, fq, rsv);
#pragma unroll
                for (int m = 0; m < 4; ++m) { const int row = row0 + ai * HALF + m * 16; const float rs = rsv[m]; const size_t off = (size_t)row * 1024 + col0;
#pragma unroll
                    for (int bj = 0; bj < 2; ++bj) { f32x4 v0 = acc[ai][bj][m][0] * rs, v1 = acc[ai][bj][m][1] * rs;
                        if (tt == 1) {
#pragma unroll
                            for (int i = 0; i < 4; ++i) { v0[i] = v0[i] * sigmoid_f(v0[i]); v1[i] = v1[i] * sigmoid_f(v1[i]); } }
                        u32x4 w; w.x = cvt_pk_bf16(v0[0], v0[1]); w.y = cvt_pk_bf16(v0[2], v0[3]); w.z = cvt_pk_bf16(v1[0], v1[1]); w.w = cvt_pk_bf16(v1[2], v1[3]);
                        *(u32x4*)(dbase + off + bj * HALF) = w; } } }
            return;
        }
        const int colh = u.pn * HALF + wc * 32 + 8 * fq;
        f32x4 lbv[2];
#pragma unroll
        for (int n = 0; n < 2; ++n) lbv[n] = *(const f32x4*)(lb + colh + 4 * n);
#pragma unroll
        for (int ai = 0; ai < 2; ++ai) { float rsv[4]; row_rstd_half(ssq, row0 + ai * HALF, fq, rsv);
#pragma unroll
            for (int c2 = 0; c2 < 2; ++c2) {
                const int rowE = row0 + ai * HALF + (2 * c2) * 16, rowO = rowE + 16;
                const float rsE = rsv[2 * c2], rsO = rsv[2 * c2 + 1];
#pragma unroll
                for (int n = 0; n < 2; ++n) { float oq[2][4], od[2][4], ot[2][4]; f32x4 dec;
#pragma unroll
                    for (int i = 0; i < 4; ++i) {
                        float lf[2], kk[2], qq[2];
#pragma unroll
                        for (int eo = 0; eo < 2; ++eo) { const float rs = eo ? rsO : rsE; const float z = acc[ai][1][2 * c2 + eo][n][i] * rs; qq[eo] = acc[ai][0][2 * c2 + eo][n][i] * rs;
                            const float e = __builtin_amdgcn_exp2f(-fabsf(z) * 1.4426950408889634f), d = __builtin_amdgcn_rcpf(1.0f + e), sg = z >= 0.f ? d : e * d; float f;
                            if (lbzero) { f = sg; lf[eo] = fminf(z, 0.f) * 1.4426950408889634f - __builtin_amdgcn_logf(1.0f + e); }
                            else { const float l = lbv[n][i]; f = l + (1.0f - l) * sg; lf[eo] = __builtin_amdgcn_logf(f); }
                            kk[eo] = 1.0f - f; }
                        const float bE = rowscan16(lf[0]); const float totE = rowlast16(bE); const float bO = rowscan16(lf[1]) + totE; const float bl = rowlast16(bO);
                        oq[0][i] = qq[0] * __builtin_amdgcn_exp2f(bE); oq[1][i] = qq[1] * __builtin_amdgcn_exp2f(bO);
                        od[0][i] = kk[0] * __builtin_amdgcn_exp2f(fminf(-bE, 100.f)); od[1][i] = kk[1] * __builtin_amdgcn_exp2f(fminf(-bO, 100.f));
                        ot[0][i] = kk[0] * __builtin_amdgcn_exp2f(bl - bE); ot[1][i] = kk[1] * __builtin_amdgcn_exp2f(bl - bO);
                        dec[i] = __builtin_amdgcn_exp2f(bl); }
#pragma unroll
                    for (int eo = 0; eo < 2; ++eo) { const size_t off = (size_t)(eo ? rowO : rowE) * 1024 + colh + 4 * n; u32x2 w;
                        w.x = cvt_pk_bf16(oq[eo][0], oq[eo][1]); w.y = cvt_pk_bf16(oq[eo][2], oq[eo][3]); *(u32x2*)(QA + off) = w;
                        w.x = cvt_pk_bf16(od[eo][0], od[eo][1]); w.y = cvt_pk_bf16(od[eo][2], od[eo][3]); *(u32x2*)(KD + off) = w;
                        w.x = cvt_pk_bf16(ot[eo][0], ot[eo][1]); w.y = cvt_pk_bf16(ot[eo][2], ot[eo][3]); *(u32x2*)(KT + off) = w; }
                    if (fr == 0) *(f32x4*)(DEC + (size_t)(rowE >> 5) * 1024 + colh + 4 * n) = dec;
                    asm volatile("" ::: "memory"); }
            } }
    }
};
struct EpiSwi {
    static constexpr bool PERM = true, AFTER_DRAIN = false; static constexpr int NS_MIN = 8;
    bf16_t* H; const float* ssq;
    __device__ __forceinline__ void operator()(const f32x4 (&acc)[2][2][4][2], const Unit& u, int wr, int wc, int fr, int fq) const {
        const int col0 = u.pn * HALF + wc * 32 + 8 * fq, row0 = u.pm * BM + wr * 64 + fr;
#pragma unroll
        for (int ai = 0; ai < 2; ++ai) { float rsv[4]; row_rstd_half(ssq, row0 + ai * HALF, fq, rsv);
#pragma unroll
            for (int m = 0; m < 4; ++m) { const int row = row0 + ai * HALF + m * 16; const float rs = rsv[m];
                f32x4 h[2];
#pragma unroll
                for (int n = 0; n < 2; ++n) { const f32x4 g = acc[ai][0][m][n] * rs, uu = acc[ai][1][m][n] * rs;
#pragma unroll
                    for (int i = 0; i < 4; ++i) h[n][i] = g[i] * sigmoid_f(g[i]) * uu[i]; }
                u32x4 w; w.x = cvt_pk_bf16(h[0][0], h[0][1]); w.y = cvt_pk_bf16(h[0][2], h[0][3]); w.z = cvt_pk_bf16(h[1][0], h[1][1]); w.w = cvt_pk_bf16(h[1][2], h[1][3]);
                *(u32x4*)(H + (size_t)row * 2816 + col0) = w; } }
    }
};
template <class Epi, class Sched, bool ALIGN_EPI = false, bool SP2 = false>
__device__ __forceinline__ void gemm_phase(PG8_LAS unsigned char* lds, const Gemm g, const Sched& S, const Epi& E, unsigned* ts_out = nullptr) {
    int tid_ = threadIdx.x; asm volatile("" : "+v"(tid_));
    const int tid = tid_, wid = __builtin_amdgcn_readfirstlane(tid >> 6), lane = tid & 63, wr = wid >> 2, wc = wid & 3, fr = lane & 15, fq = lane >> 4;
    const int K = g.K, nt = K / BK;
    unsigned voffA[2], voffB[2];
#pragma unroll
    for (int i = 0; i < 2; ++i) { int R, C; stage_rc(tid * 16 + i * 8192, R, C); const int Rb = Epi::PERM ? ((R & ~31) + perm32(R & 31)) : R;
        voffA[i] = (unsigned)(R * K + C) * 2u; voffB[i] = (unsigned)(Rb * K + C) * 2u; }
    const size_t kstep = (size_t)(BK * 2);
    const size_t hstep = (size_t)HALF * K * 2;
    const size_t tstep = 2 * hstep;
    const unsigned ldsw = (unsigned)wid * 1024u;
    const int aoff = lds_byte(wr * 64 + fr, fq * 8), boff = lds_byte(wc * 32 + fr, fq * 8);
#define PG8_SA(b, h) (((b) * 2 + (h)) * HTB)
#define PG8_SB(b, h) ((4 + (b) * 2 + (h)) * HTB)
#define PG8_STAGE(bufoff, gbase, voff) do { _Pragma("unroll") for (int _i = 0; _i < 2; ++_i) \
        __builtin_amdgcn_global_load_lds((const unsigned*)((const char*)(gbase) + (voff)[_i]), (PG8_LAS unsigned*)(lds + (bufoff) + ldsw + _i * 8192), 16, 0, 0); } while (0)
#define PG8_LDA(dst, b, h) do { _Pragma("unroll") for (int m = 0; m < 4; ++m) _Pragma("unroll") for (int k = 0; k < 2; ++k) dst[m][k] = *(const PG8_LAS bf16x8*)(lds + PG8_SA(b, h) + aoff + m * 2048 + k * 1024); } while (0)
#define PG8_LDB(dst, b, h) do { _Pragma("unroll") for (int n = 0; n < 2; ++n) _Pragma("unroll") for (int k = 0; k < 2; ++k) dst[n][k] = *(const PG8_LAS bf16x8*)(lds + PG8_SB(b, h) + boff + n * 2048 + k * 1024); } while (0)
#define PG8_MMA(ai, bj, At, Bt) do { __builtin_amdgcn_s_setprio(1); _Pragma("unroll") for (int m = 0; m < 4; ++m) _Pragma("unroll") for (int n = 0; n < 2; ++n) _Pragma("unroll") for (int k = 0; k < 2; ++k) \
        acc[ai][bj][m][n] = __builtin_amdgcn_mfma_f32_16x16x32_bf16(Bt[n][k], At[m][k], acc[ai][bj][m][n], 0, 0, 0); __builtin_amdgcn_s_setprio(0); } while (0)
#define PG8_WAIT_V(n) asm volatile("s_waitcnt vmcnt(" #n ")" ::: "memory")
#define PG8_WAIT_V8_SEL(rlx, n) asm volatile("s_cmp_lg_u32 %0, 0\n\ts_cbranch_scc1 .Lpg8_rlx_%=\n\ts_waitcnt vmcnt(8)\n\ts_branch .Lpg8_end_%=\n.Lpg8_rlx_%=:\n\ts_waitcnt vmcnt(" #n ")\n.Lpg8_end_%=:" :: "s"(rlx) : "scc", "memory")
#define PG8_WAIT_V8_FIRST(rlx) do { if constexpr (Epi::NS_MIN >= 16) PG8_WAIT_V8_SEL(rlx, 24); else if constexpr (Epi::NS_MIN >= 8) PG8_WAIT_V8_SEL(rlx, 16); else PG8_WAIT_V(8); } while (0)
#define PG8_WAIT_L(n) asm volatile("s_waitcnt lgkmcnt(" #n ")" ::: "memory")
#define PG8_BAR __builtin_amdgcn_s_barrier()
#define PG8_SCHED __builtin_amdgcn_sched_barrier(0)
    Unit cur, nxt; int ui = 0;
#if TS_EPI
    unsigned ts_epi_ = 0;
#endif
    if (!S.next(0, cur)) return;
    f32x4 acc[2][2][4][2];
#pragma unroll
    for (int a = 0; a < 2; ++a)
#pragma unroll
        for (int b = 0; b < 2; ++b)
#pragma unroll
            for (int m = 0; m < 4; ++m)
#pragma unroll
                for (int n = 0; n < 2; ++n) acc[a][b][m][n] = (f32x4){0.f, 0.f, 0.f, 0.f};
    bf16x8 At[4][2], B0[2][2], B1[2][2];
    const char* cA = (const char*)g.A + (size_t)cur.pm * tstep; const char* cB = (const char*)g.Bt + (size_t)cur.pn * tstep;
    S.a_ready(cur);
    if constexpr (SP2) {
        PG8_STAGE(PG8_SB(0, 0), cB, voffB); PG8_STAGE(PG8_SB(0, 1), cB + hstep, voffB); PG8_STAGE(PG8_SA(0, 0), cA, voffA); PG8_STAGE(PG8_SA(0, 1), cA + hstep, voffA);
        if (wr == 1) PG8_BAR;
        PG8_WAIT_V(2); PG8_BAR;
        PG8_STAGE(PG8_SB(1, 0), cB + kstep, voffB); PG8_STAGE(PG8_SA(1, 0), cA + kstep, voffA); PG8_STAGE(PG8_SB(1, 1), cB + hstep + kstep, voffB);
        PG8_WAIT_V(6); PG8_BAR;
    } else {
        PG8_STAGE(PG8_SB(0, 0), cB, voffB); PG8_STAGE(PG8_SA(0, 0), cA, voffA); PG8_STAGE(PG8_SB(0, 1), cB + hstep, voffB); PG8_STAGE(PG8_SA(0, 1), cA + hstep, voffA);
        if (wr == 1) PG8_BAR;
        PG8_WAIT_V(4); PG8_BAR;
        PG8_STAGE(PG8_SB(1, 0), cB + kstep, voffB); PG8_STAGE(PG8_SA(1, 0), cA + kstep, voffA); PG8_STAGE(PG8_SB(1, 1), cB + hstep + kstep, voffB);
        PG8_WAIT_V(6); PG8_BAR;
    }
    for (;;) {
        const bool has_next = S.next(ui + 1, nxt);
        const char* nA = has_next ? (const char*)g.A + (size_t)nxt.pm * tstep : cA; const char* nB = has_next ? (const char*)g.Bt + (size_t)nxt.pn * tstep : cB;
#if TS_EPI == 2
        const unsigned long long tk0_ = __builtin_amdgcn_s_memtime();
#endif
        for (int t = 0; t < nt; t += 2) {
            const bool last = (t == nt - 2);
            const char* a1 = cA + (size_t)(t + 1) * kstep;
            const char* a2 = last ? nA : cA + (size_t)(t + 2) * kstep; const char* b2 = last ? nB : cB + (size_t)(t + 2) * kstep;
            const char* a3 = a2 + kstep; const char* b3 = b2 + kstep;
            if (last && has_next) S.a_ready(nxt);
            const int relax_ = __builtin_amdgcn_readfirstlane(((t == 0) && (ui > 0)) ? 1 : 0);
            if constexpr (SP2) {
            PG8_LDB(B0, 0, 0); PG8_LDB(B1, 0, 1); PG8_SCHED; PG8_LDA(At, 0, 0); PG8_STAGE(PG8_SA(1, 1), a1 + hstep, voffA);
            PG8_WAIT_V8_FIRST(relax_); PG8_WAIT_L(0); PG8_BAR; PG8_MMA(0, 0, At, B0); PG8_MMA(0, 1, At, B1); PG8_BAR; PG8_SCHED;
            PG8_LDA(At, 0, 1); PG8_STAGE(PG8_SB(0, 0), b2, voffB); PG8_STAGE(PG8_SB(0, 1), b2 + hstep, voffB); PG8_STAGE(PG8_SA(0, 0), a2, voffA);
            PG8_WAIT_V8_FIRST(relax_); PG8_WAIT_L(0); PG8_BAR; PG8_MMA(1, 0, At, B0); PG8_MMA(1, 1, At, B1); PG8_BAR; PG8_SCHED;
            PG8_LDB(B0, 1, 0); PG8_LDB(B1, 1, 1); PG8_SCHED; PG8_LDA(At, 1, 0); PG8_STAGE(PG8_SA(0, 1), a2 + hstep, voffA);
            PG8_WAIT_V(8); PG8_WAIT_L(0); PG8_BAR; PG8_MMA(0, 0, At, B0); PG8_MMA(0, 1, At, B1); PG8_BAR; PG8_SCHED;
            PG8_LDA(At, 1, 1); PG8_STAGE(PG8_SB(1, 0), b3, voffB); PG8_STAGE(PG8_SB(1, 1), b3 + hstep, voffB); PG8_STAGE(PG8_SA(1, 0), a3, voffA);
            PG8_WAIT_V(8); PG8_WAIT_L(0); PG8_BAR; PG8_MMA(1, 0, At, B0); PG8_MMA(1, 1, At, B1); PG8_BAR; PG8_SCHED;
            } else {
            PG8_LDB(B0, 0, 0); PG8_SCHED; PG8_LDA(At, 0, 0); PG8_STAGE(PG8_SA(1, 1), a1 + hstep, voffA);
            PG8_WAIT_L(8); PG8_BAR; PG8_WAIT_L(0); PG8_MMA(0, 0, At, B0); PG8_BAR; PG8_SCHED;
            PG8_LDB(B1, 0, 1); PG8_STAGE(PG8_SB(0, 0), b2, voffB);
            PG8_BAR; PG8_WAIT_L(0); PG8_MMA(0, 1, At, B1); PG8_BAR;
            PG8_LDA(At, 0, 1); PG8_STAGE(PG8_SA(0, 0), a2, voffA);
            PG8_BAR; PG8_WAIT_L(0); PG8_MMA(1, 0, At, B0); PG8_BAR; PG8_SCHED;
            PG8_STAGE(PG8_SB(0, 1), b2 + hstep, voffB);
            PG8_WAIT_V(6); PG8_BAR; PG8_MMA(1, 1, At, B1); PG8_BAR;
            PG8_LDB(B0, 1, 0); PG8_SCHED; PG8_LDA(At, 1, 0); PG8_STAGE(PG8_SA(0, 1), a2 + hstep, voffA);
            PG8_WAIT_L(8); PG8_BAR; PG8_WAIT_L(0); PG8_MMA(0, 0, At, B0); PG8_BAR; PG8_SCHED;
            PG8_LDB(B1, 1, 1); PG8_STAGE(PG8_SB(1, 0), b3, voffB);
            PG8_BAR; PG8_WAIT_L(0); PG8_MMA(0, 1, At, B1); PG8_BAR;
            PG8_LDA(At, 1, 1); PG8_STAGE(PG8_SA(1, 0), a3, voffA);
            PG8_BAR; PG8_WAIT_L(0); PG8_MMA(1, 0, At, B0); PG8_BAR; PG8_SCHED;
            PG8_STAGE(PG8_SB(1, 1), b3 + hstep, voffB);
            PG8_WAIT_V(6); PG8_BAR; PG8_MMA(1, 1, At, B1); PG8_BAR;
            }
        }
#if TS_EPI == 2
        ts_epi_ += (unsigned)(__builtin_amdgcn_s_memtime() - tk0_);
#endif
        if constexpr (ALIGN_EPI) { if (wr == 0) PG8_BAR; }
#if TS_EPI == 1
        const unsigned long long te0_ = __builtin_amdgcn_s_memrealtime();
#endif
        if constexpr (!Epi::AFTER_DRAIN) { E(acc, cur, wr, wc, fr, fq); S.done(cur); }
#if TS_EPI == 1
        asm volatile("s_waitcnt vmcnt(0)" ::: "memory");
        ts_epi_ += (unsigned)(__builtin_amdgcn_s_memrealtime() - te0_);
#endif
        if (!has_next) break;
#pragma unroll
        for (int a = 0; a < 2; ++a)
#pragma unroll
            for (int b = 0; b < 2; ++b)
#pragma unroll
                for (int m = 0; m < 4; ++m)
#pragma unroll
                    for (int n = 0; n < 2; ++n) acc[a][b][m][n] = (f32x4){0.f, 0.f, 0.f, 0.f};
        cur = nxt; cA = nA; cB = nB; ++ui;
        if constexpr (ALIGN_EPI) { if (wr == 1) PG8_BAR; }
    }
#if TS_EPI
    if (blockIdx.x == 0 && threadIdx.x == 0) *ts_out = ts_epi_;
#endif
    PG8_WAIT_V(0);
    if constexpr (!ALIGN_EPI) { if (wr == 0) PG8_BAR; }
    PG8_BAR;
    if constexpr (Epi::AFTER_DRAIN) { E.fused(acc, cur, wr, wc, fr, fq, lds, wid, lane); S.done(cur); }
#undef PG8_SA
#undef PG8_SB
#undef PG8_STAGE
#undef PG8_LDA
#undef PG8_LDB
#undef PG8_MMA
#undef PG8_WAIT_V
#undef PG8_WAIT_V8_FIRST
#undef PG8_WAIT_V8_SEL
#undef PG8_WAIT_L
#undef PG8_BAR
#undef PG8_SCHED
}
}

#include <hip/hip_bf16.h>
#include <cmath>
namespace attn_body {
using bf16=__hip_bfloat16;
using bf16x8=__attribute__((ext_vector_type(8)))short;
using s16x4=__attribute__((ext_vector_type(4)))short;
using f32x16=__attribute__((ext_vector_type(16)))float;
using u32x4=__attribute__((ext_vector_type(4)))unsigned;
using f32x4_t=__attribute__((ext_vector_type(4)))float;
constexpr int BATCH=8,NHEAD=8,SEQ=2048,D=64,DM=NHEAD*D,OPITCH=1024;
constexpr int NW=8,QBLK=32,QB=QBLK*NW,KVBLK=64,NQB=SEQ/QB;
constexpr int ATTN_PITCH=DM, ATTN_UNIT_ROWS=QB;
constexpr float ATT_LOG2E=1.4426950408889634f;
__device__ __forceinline__ int crow(int r,int hi){return (r&3)+8*(r>>2)+4*hi;}
#define SBAR() __builtin_amdgcn_sched_barrier(0)
__device__ __forceinline__ void cmask(f32x16&p0,f32x16&p1,int jb,int qrel,int hi){
  const float NEG=-INFINITY; int kb=64*jb+4*hi;
  #pragma unroll
  for(int r=0;r<16;++r){int kv=kb+(r&3)+8*(r>>2); if(kv>qrel)p0[r]=NEG; if(kv+32>qrel)p1[r]=NEG;}
}

constexpr int NSLOT=3, SLOTB=8192;
constexpr int LDS_K=0, LDS_V=NSLOT*SLOTB, LDS_WS=2*NSLOT*SLOTB, LDS_OST=LDS_WS+NW*64*4, LDS_BETA=LDS_OST+NW*4096, LDS_PRE=LDS_BETA+SEQ*4, LDS_BYTES=LDS_PRE+256;
constexpr float C2=0.125f*1.4426950408889634f;
__device__ __forceinline__ void glds16(const void*gsrc,unsigned lds_dst){unsigned keep;
  asm volatile("s_mov_b32 %0, m0\n\ts_mov_b32 m0, %2\n\ts_nop 0\n\tglobal_load_lds_dwordx4 %1, off\n\ts_mov_b32 m0, %0":"=&s"(keep):"v"(gsrc),"s"(lds_dst):"memory");}
__device__ __forceinline__ float max3f(float a,float b,float c){float r;asm("v_max3_f32 %0, %1, %2, %3":"=v"(r):"v"(a),"v"(b),"v"(c));return r;}
__device__ __forceinline__ float max2f(float a,float b){float r;asm("v_max_f32_e32 %0, %1, %2":"=v"(r):"v"(a),"v"(b));return r;}
__device__ __forceinline__ float fadd_s(float a,float b){float r;asm("v_add_f32_e32 %0, %1, %2":"=v"(r):"v"(a),"v"(b));return r;}
__device__ __forceinline__ float fsub_s(float a,float b){float r;asm("v_sub_f32_e32 %0, %1, %2":"=v"(r):"v"(a),"v"(b));return r;}
typedef float f32x2_t __attribute__((ext_vector_type(2))); typedef __bf16 bf16x2_t __attribute__((ext_vector_type(2)));
__device__ __forceinline__ unsigned cvtpk_s(float lo,float hi){f32x2_t v={lo,hi};bf16x2_t b=__builtin_convertvector(v,bf16x2_t);return __builtin_bit_cast(unsigned,b);}
#define WAIT_BAR(N) asm volatile("s_waitcnt vmcnt(" #N ") lgkmcnt(0)\n\ts_barrier":::"memory")

__device__ __forceinline__ void qkt(f32x16&p0,f32x16&p1,const char*Kslot,const bf16x8*qr,const f32x16&negm,int r32,int hi){
  const char*kb=Kslot+hi*1024+r32*16;
  #pragma unroll
  for(int d0=0;d0<4;++d0){
    const bf16x8 b0=*reinterpret_cast<const bf16x8*>(kb+d0*2048);
    const bf16x8 b1=*reinterpret_cast<const bf16x8*>(kb+d0*2048+512);
    if(d0==0){p0=__builtin_amdgcn_mfma_f32_32x32x16_bf16(b0,qr[0],negm,0,0,0);p1=__builtin_amdgcn_mfma_f32_32x32x16_bf16(b1,qr[0],negm,0,0,0);}
    else{p0=__builtin_amdgcn_mfma_f32_32x32x16_bf16(b0,qr[d0],p0,0,0,0);p1=__builtin_amdgcn_mfma_f32_32x32x16_bf16(b1,qr[d0],p1,0,0,0);}}
}
typedef __attribute__((address_space(3))) const char* lds_cptr;
typedef short v4i16_t __attribute__((ext_vector_type(4)));
__device__ __forceinline__ void kload8(bf16x8*kf,lds_cptr kp){
  kf[0]=*(const __attribute__((address_space(3))) bf16x8*)(kp);      kf[1]=*(const __attribute__((address_space(3))) bf16x8*)(kp+512);
  kf[2]=*(const __attribute__((address_space(3))) bf16x8*)(kp+2048); kf[3]=*(const __attribute__((address_space(3))) bf16x8*)(kp+2560);
  kf[4]=*(const __attribute__((address_space(3))) bf16x8*)(kp+4096); kf[5]=*(const __attribute__((address_space(3))) bf16x8*)(kp+4608);
  kf[6]=*(const __attribute__((address_space(3))) bf16x8*)(kp+6144); kf[7]=*(const __attribute__((address_space(3))) bf16x8*)(kp+6656);
}
__device__ __forceinline__ void kload2(bf16x8*kf,lds_cptr kp,int j){ kf[2*j]=*(const __attribute__((address_space(3))) bf16x8*)(kp+j*2048); kf[2*j+1]=*(const __attribute__((address_space(3))) bf16x8*)(kp+j*2048+512); }
__device__ __forceinline__ s16x4 vtr(lds_cptr p){ return __builtin_bit_cast(s16x4,__builtin_amdgcn_ds_read_tr16_b64_v4i16((__attribute__((address_space(3))) v4i16_t*)p)); }
__device__ __forceinline__ float rowmax(const f32x16&p0,const f32x16&p1){
  float a=max3f(p0[0],p0[1],p1[0]),b=max3f(p0[2],p0[3],p1[1]);a=max3f(a,p1[2],p1[3]);
  #pragma unroll
  for(int r=4;r<16;r+=4){a=max3f(a,p0[r],p0[r+1]);b=max3f(b,p0[r+2],p0[r+3]);a=max3f(a,p1[r],p1[r+1]);b=max3f(b,p1[r+2],p1[r+3]);}
  const float m=max2f(a,b);
  auto rr=__builtin_amdgcn_permlane32_swap(__float_as_uint(m),__float_as_uint(m),false,false);
  return max2f(__uint_as_float(rr[0]),__uint_as_float(rr[1]));
}
__device__ __forceinline__ void pv(f32x16*o,int vb,bf16x8 pa0,bf16x8 pa1,bf16x8 pa2,bf16x8 pa3){
  #pragma unroll
  for(int d0=0;d0<2;++d0){s16x4 lo[4],hi[4];
    #pragma unroll
    for(int ks=0;ks<4;++ks){
      asm volatile("ds_read_b64_tr_b16 %0,%1 offset:%c2":"=&v"(lo[ks]):"v"(vb),"i"(d0*4096+ks*1024):"memory");
      asm volatile("ds_read_b64_tr_b16 %0,%1 offset:%c2":"=&v"(hi[ks]):"v"(vb),"i"(d0*4096+ks*1024+512):"memory");}
    asm volatile("s_waitcnt lgkmcnt(0)":::"memory");SBAR();
    #define PK(k) (bf16x8){lo[k][0],lo[k][1],lo[k][2],lo[k][3],hi[k][0],hi[k][1],hi[k][2],hi[k][3]}
    o[d0]=__builtin_amdgcn_mfma_f32_32x32x16_bf16(pa0,PK(0),o[d0],0,0,0);
    o[d0]=__builtin_amdgcn_mfma_f32_32x32x16_bf16(pa1,PK(1),o[d0],0,0,0);
    o[d0]=__builtin_amdgcn_mfma_f32_32x32x16_bf16(pa2,PK(2),o[d0],0,0,0);
    o[d0]=__builtin_amdgcn_mfma_f32_32x32x16_bf16(pa3,PK(3),o[d0],0,0,0);
    #undef PK
  }
}

#ifndef ATTN_STORE16
#define ATTN_STORE16(p,v) (*(u32x4*)(p)=(v))
#endif
template<int THRL> __device__ __forceinline__ void attn_unit(int b,int h,int qb,const bf16*Q,const bf16*__restrict__ K,const bf16*__restrict__ V,bf16*O,char*shm){
  int tid_o=threadIdx.x; asm volatile("":"+v"(tid_o));
  const int tid=tid_o,lane=tid&63,r32=lane&31,hi=lane>>5; const int wid=__builtin_amdgcn_readfirstlane(tid>>6);
  const long rowbase=(long)b*SEQ; const int q0=qb*QB;
  const bf16*Qw=Q+(rowbase+q0+wid*QBLK)*DM+h*D;
  const bf16*Kh=K+rowbase*DM+h*D,*Vh=V+rowbase*DM+h*D;
  const unsigned lds0=(unsigned)(uintptr_t)shm;
  float*wsf=(float*)(shm+LDS_WS)+wid*64;
  const bf16*ksrc=Kh+(long)lane*DM+wid*8;
  const bf16*vsrc=Vh+(long)(16*(wid&3)+(lane>>2))*DM+(wid>>2)*32+(lane&3)*8;
  const unsigned kdst=lds0+LDS_K+wid*1024, vdst=lds0+LDS_V+wid*1024;
  #define DMA_K(t,slot) glds16(ksrc+(long)(t)*KVBLK*DM,(unsigned)__builtin_amdgcn_readfirstlane(kdst+(slot)))
  #define DMA_V(t,slot) glds16(vsrc+(long)(t)*KVBLK*DM,(unsigned)__builtin_amdgcn_readfirstlane(vdst+(slot)))
  const int vb0=(int)(lds0+LDS_V)+((lane>>4)&1)*32+(lane&3)*8+(4*hi+((lane&15)>>2))*64;
  const char*Kbase=shm+LDS_K; bf16x8 kf[8];
  const lds_cptr shm3=(lds_cptr)shm; const lds_cptr kp0=shm3+LDS_K+hi*1024+r32*16; const lds_cptr vp0=shm3+LDS_V+((lane>>4)&1)*32+(lane&3)*8+(4*hi+((lane&15)>>2))*64;
  const int NT=(q0+QB)/KVBLK;
  DMA_K(0,0);DMA_V(0,0);DMA_K(1,SLOTB);
  bf16x8 qr[4];
  #pragma unroll
  for(int d0=0;d0<4;++d0)qr[d0]=*reinterpret_cast<const bf16x8*>(&Qw[(long)r32*DM+d0*16+hi*8]);
  float m0;
  { const bf16*Kd=Kh+(long)(q0+wid*QBLK+r32)*DM+hi*8; float acc_=0.f;
    #pragma unroll
    for(int d0=0;d0<4;++d0){ const bf16x8 kd=*reinterpret_cast<const bf16x8*>(&Kd[d0*16]);
      #pragma unroll
      for(int j_=0;j_<8;++j_) acc_+=__uint_as_float((unsigned)(unsigned short)qr[d0][j_]<<16)*__uint_as_float((unsigned)(unsigned short)kd[j_]<<16); }
    auto rr_=__builtin_amdgcn_permlane32_swap(__float_as_uint(acc_),__float_as_uint(acc_),false,false);
    m0=__uint_as_float(rr_[0])+__uint_as_float(rr_[1])+((__attribute__((address_space(3))) const float*)((lds_cptr)shm+LDS_BETA))[q0+wid*QBLK+r32]; }
  float mhat=0.f,l_reg=0.f;f32x16 o[2];o[0]=f32x16{};o[1]=f32x16{};f32x16 negm=f32x16{};asm volatile("":"+v"(negm));
  const int qrel=wid*QBLK+r32;
  #define CMASK(P0,P1,t) do{int jb_=(t)-(NT-4); if(jb_>=0)cmask(P0,P1,jb_,qrel,hi);}while(0)
  typedef __attribute__((address_space(3))) const f32x4_t* lds_f4ptr;
  const lds_f4ptr betab=(lds_f4ptr)((lds_cptr)shm+LDS_BETA+16*hi);
  #define BIAS(P0,P1,t) do{ const lds_f4ptr bp_=betab+16*(t); \
    _Pragma("unroll") for(int g_=0;g_<4;++g_){ const f32x4_t b0_=bp_[2*g_], b1_=bp_[8+2*g_]; \
      _Pragma("unroll") for(int i_=0;i_<4;++i_){ P0[4*g_+i_]+=b0_[i_]; P1[4*g_+i_]+=b1_[i_]; } if(g_&1)SBAR(); } }while(0)
  bool resc=false;
  #define START(P0,P1) do{ const float rm=rowmax(P0,P1); resc=false; \
    { const float dl=max2f(rm,m0); mhat=fadd_s(mhat,dl); \
      _Pragma("unroll") for(int r=0;r<16;++r){P0[r]=fsub_s(P0[r],dl);P1[r]=fsub_s(P1[r],dl);} \
      _Pragma("unroll") for(int r=0;r<16;++r)negm[r]=-mhat; asm volatile("":"+v"(negm)); } \
    _Pragma("unroll") for(int r=0;r<16;++r)P0[r]=__builtin_amdgcn_exp2f(P0[r]); }while(0)
  #define RESC() do{ if(resc){ asm volatile("s_waitcnt lgkmcnt(0)":::"memory"); \
      _Pragma("unroll") for(int d_=0;d_<2;++d_) _Pragma("unroll") for(int r=0;r<16;++r)o[d_][r]*=wsf[crow(r,hi)]; } }while(0)
  f32x16 pA0,pA1,pB0,pB1;
  int sl_prev=0,sl_cur=0,sl_next=SLOTB;
  #define ROT() do{sl_prev=sl_cur;sl_cur=sl_next;sl_next=(sl_next==(NSLOT-1)*SLOTB)?0:sl_next+SLOTB;}while(0)
  DMA_K(2,2*SLOTB);
  WAIT_BAR(3);
  qkt(pA0,pA1,Kbase,qr,negm,r32,hi);asm volatile("s_nop 15\n\ts_nop 7":"+v"(pA0),"+v"(pA1));BIAS(pA0,pA1,0);CMASK(pA0,pA1,0);
  START(pA0,pA1);
  _Pragma("unroll") for(int r=0;r<16;++r)pA1[r]=__builtin_amdgcn_exp2f(pA1[r]);
  WAIT_BAR(0);
  DMA_K(3,0);DMA_V(1,SLOTB);
  ROT();
  kload8(kf,kp0+sl_cur);
  WAIT_BAR(2);
  s16x4 vlo[8],vhi[8]; u32x4 pw0,pw1,pw2,pw3;
  #define PKW(P,B) cvtpk_s(P[B],P[B+1])
  #define PAF(k) __builtin_bit_cast(bf16x8,pw##k)
  #define VFR(i) (bf16x8){vlo[i][0],vlo[i][1],vlo[i][2],vlo[i][3],vhi[i][0],vhi[i][1],vhi[i][2],vhi[i][3]}
  #define PIN(x) asm volatile("":"+v"(x))
  #define MX3(a,b,c) __builtin_fmaxf(__builtin_fmaxf((a),(b)),(c))
  #define GAPA(MF,A0,A1,A2,A3,W0,W1,PW) do{ MF; sacc+=A0; sacc+=A1; sacc+=A2; sacc+=A3; PIN(sacc); W0; W1; PIN(PW); SBAR(); }while(0)
  #define EX(v) __builtin_amdgcn_exp2f(v)
  #define GAPB(MF,X,B) do{ MF; X[B]=EX(X[B]); X[B+1]=EX(X[B+1]); X[B+2]=EX(X[B+2]); X[B+3]=EX(X[B+3]); PIN(X); SBAR(); }while(0)
  #define VRD(i) do{ vlo[i]=vtr(vp_+(((i)>>2)*4096+((i)&3)*1024)); vhi[i]=vtr(vp_+(((i)>>2)*4096+((i)&3)*1024+512)); }while(0)
  #define KRD(G,j) do{ if(G){ kload2(kf,kp0+sl_next,j); SBAR(); } }while(0)
  #define STEP(C0,C1,P0,P1,t,GK,GV,GL) do{ SBAR(); \
    const lds_cptr vp_=vp0+sl_prev; \
    VRD(0); SBAR(); float sacc=(P0[0]+P0[1]); \
    GAPA(C0=__builtin_amdgcn_mfma_f32_32x32x16_bf16(kf[0],qr[0],negm,0,0,0), P0[2],P0[3],P0[4],P0[5],     pw0[0]=PKW(P0,0), pw0[1]=PKW(P0,2), pw0); \
    VRD(4); SBAR(); GAPA(C1=__builtin_amdgcn_mfma_f32_32x32x16_bf16(kf[1],qr[0],negm,0,0,0), P0[6],P0[7],P0[8],P0[9],     pw0[2]=PKW(P0,4), pw0[3]=PKW(P0,6), pw0); \
    VRD(1); SBAR(); GAPA(C0=__builtin_amdgcn_mfma_f32_32x32x16_bf16(kf[2],qr[1],C0,0,0,0),   P0[10],P0[11],P0[12],P0[13], pw1[0]=PKW(P0,8), pw1[1]=PKW(P0,10), pw1); \
    VRD(5); SBAR(); GAPA(C1=__builtin_amdgcn_mfma_f32_32x32x16_bf16(kf[3],qr[1],C1,0,0,0),   P0[14],P0[15],P1[0],P1[1],   pw1[2]=PKW(P0,12),pw1[3]=PKW(P0,14), pw1); \
    VRD(2); SBAR(); GAPA(C0=__builtin_amdgcn_mfma_f32_32x32x16_bf16(kf[4],qr[2],C0,0,0,0),   P1[2],P1[3],P1[4],P1[5],     pw2[0]=PKW(P1,0), pw2[1]=PKW(P1,2), pw2); \
    VRD(6); SBAR(); GAPA(C1=__builtin_amdgcn_mfma_f32_32x32x16_bf16(kf[5],qr[2],C1,0,0,0),   P1[6],P1[7],P1[8],P1[9],     pw2[2]=PKW(P1,4), pw2[3]=PKW(P1,6), pw2); \
    VRD(3); SBAR(); GAPA(C0=__builtin_amdgcn_mfma_f32_32x32x16_bf16(kf[6],qr[3],C0,0,0,0),   P1[10],P1[11],P1[12],P1[13], pw3[0]=PKW(P1,8), pw3[1]=PKW(P1,10), pw3); \
    VRD(7); SBAR(); GAPA(C1=__builtin_amdgcn_mfma_f32_32x32x16_bf16(kf[7],qr[3],C1,0,0,0),   P1[14],P1[15],0.f,0.f,       pw3[2]=PKW(P1,12),pw3[3]=PKW(P1,14), pw3); \
    l_reg+=sacc; \
    if(GK){DMA_K((t)+3,sl_cur);} if(GV){DMA_V((t)+1,sl_next);} \
    BIAS(C0,C1,t); CMASK(C0,C1,t); \
    { float a=MX3(C0[0],C0[1],C1[0]),b=MX3(C0[2],C0[3],C1[1]); a=MX3(a,C1[2],C1[3]); \
      _Pragma("unroll") for(int r=4;r<16;r+=4){a=MX3(a,C0[r],C0[r+1]);b=MX3(b,C0[r+2],C0[r+3]);a=MX3(a,C1[r],C1[r+1]);b=MX3(b,C1[r+2],C1[r+3]);} \
      float rm=__builtin_fmaxf(a,b); { auto rr=__builtin_amdgcn_permlane32_swap(__float_as_uint(rm),__float_as_uint(rm),false,false); rm=__builtin_fmaxf(__uint_as_float(rr[0]),__uint_as_float(rr[1])); } \
      resc=false; \
      if(__builtin_expect(__any(rm>(float)THRL),0)){ const float dl=__builtin_fmaxf(rm,0.f); mhat+=dl; \
        _Pragma("unroll") for(int r=0;r<16;++r){C0[r]-=dl;C1[r]-=dl;} \
        _Pragma("unroll") for(int r=0;r<16;++r)negm[r]=-mhat; asm volatile("":"+v"(negm)); \
        const float f=__builtin_amdgcn_exp2f(-dl); l_reg*=f; if(hi==0)wsf[r32]=f; resc=true; } } \
    SBAR(); \
    GAPB(o[0]=__builtin_amdgcn_mfma_f32_32x32x16_bf16(PAF(0),VFR(0),o[0],0,0,0), C0,0); \
    GAPB(o[1]=__builtin_amdgcn_mfma_f32_32x32x16_bf16(PAF(0),VFR(4),o[1],0,0,0), C0,4); \
    KRD(GL,0); GAPB(o[0]=__builtin_amdgcn_mfma_f32_32x32x16_bf16(PAF(1),VFR(1),o[0],0,0,0), C0,8); \
    KRD(GL,1); GAPB(o[1]=__builtin_amdgcn_mfma_f32_32x32x16_bf16(PAF(1),VFR(5),o[1],0,0,0), C0,12); \
    KRD(GL,2); GAPB(o[0]=__builtin_amdgcn_mfma_f32_32x32x16_bf16(PAF(2),VFR(2),o[0],0,0,0), C1,0); \
    KRD(GL,3); GAPB(o[1]=__builtin_amdgcn_mfma_f32_32x32x16_bf16(PAF(2),VFR(6),o[1],0,0,0), C1,4); \
    GAPB(o[0]=__builtin_amdgcn_mfma_f32_32x32x16_bf16(PAF(3),VFR(3),o[0],0,0,0), C1,8); \
    GAPB(o[1]=__builtin_amdgcn_mfma_f32_32x32x16_bf16(PAF(3),VFR(7),o[1],0,0,0), C1,12); \
    }while(0)
  int t=1;
  #undef CMASK
  #define CMASK(P0,P1,t) do{}while(0)
  for(;t+5<NT;t+=2){
    STEP(pB0,pB1,pA0,pA1,t,true,true,true);     WAIT_BAR(2); RESC(); ROT();
    STEP(pA0,pA1,pB0,pB1,t+1,true,true,true);   WAIT_BAR(2); RESC(); ROT();
  }
  #undef CMASK
  #define CMASK(P0,P1,t) do{int jb_=(t)-(NT-4); if(jb_>=0)cmask(P0,P1,jb_,qrel,hi);}while(0)
  #define ENDW(tt) do{ if((tt)+3<NT){WAIT_BAR(2);} else if((tt)+2<NT){WAIT_BAR(1);} else {WAIT_BAR(0);} }while(0)
  for(;t+1<NT;t+=2){
    STEP(pB0,pB1,pA0,pA1,t,(t+3<NT),(t+1<NT),(t+1<NT));       ENDW(t);   RESC(); ROT();
    STEP(pA0,pA1,pB0,pB1,t+1,(t+4<NT),(t+2<NT),(t+2<NT));     ENDW(t+1); RESC(); ROT();
  }
  STEP(pB0,pB1,pA0,pA1,NT-1,false,false,false); RESC();
  { float sacc=pB0[0]+pB0[1]; _Pragma("unroll") for(int r=2;r<16;++r)sacc+=pB0[r]; _Pragma("unroll") for(int r=0;r<16;++r)sacc+=pB1[r]; l_reg+=sacc;
    pw0=(u32x4){PKW(pB0,0),PKW(pB0,2),PKW(pB0,4),PKW(pB0,6)};pw1=(u32x4){PKW(pB0,8),PKW(pB0,10),PKW(pB0,12),PKW(pB0,14)};pw2=(u32x4){PKW(pB1,0),PKW(pB1,2),PKW(pB1,4),PKW(pB1,6)};pw3=(u32x4){PKW(pB1,8),PKW(pB1,10),PKW(pB1,12),PKW(pB1,14)};
    SBAR(); pv(o,vb0+sl_cur,PAF(0),PAF(1),PAF(2),PAF(3)); }
  #undef PKW
  #undef PAF
  #undef VFR
  #undef PIN
  #undef MX3
  #undef GAPA
  #undef GAPB
  #undef EX
  #undef VRD
  #undef KRD
  #undef STEP
  #undef ENDW
  {auto rr=__builtin_amdgcn_permlane32_swap(__float_as_uint(l_reg),__float_as_uint(l_reg),false,false);l_reg=__uint_as_float(rr[0])+__uint_as_float(rr[1]);}
  if(hi==0)wsf[32+r32]=l_reg;asm volatile("s_waitcnt lgkmcnt(0)":::"memory");
  float rli[16];
  #pragma unroll
  for(int r=0;r<16;++r)rli[r]=__builtin_amdgcn_rcpf(wsf[32+crow(r,hi)]);
  bf16*Ow=O+(rowbase+q0+wid*QBLK)*OPITCH+h*D;
  { bf16*stg=(bf16*)(shm+LDS_OST)+wid*2048;
    #pragma unroll
    for(int r=0;r<16;++r){const int orow=crow(r,hi);
      #pragma unroll
      for(int d0=0;d0<2;++d0)stg[orow*64+d0*32+r32]=__float2bfloat16(o[d0][r]*rli[r]);}
    asm volatile("s_waitcnt lgkmcnt(0)":::"memory");
    #pragma unroll
    for(int i=0;i<4;++i){const int row=i*8+(lane>>3),ch=lane&7; const u32x4 v=*(const u32x4*)(stg+row*64+ch*8); ATTN_STORE16(Ow+(long)row*OPITCH+ch*8,v);} }
  asm volatile("s_waitcnt lgkmcnt(0)\n\ts_barrier":::"memory");
  #undef DMA_K
  #undef DMA_V
  #undef CMASK
  #undef BIAS
  #undef START
  #undef RESC
  #undef ROT
}
constexpr int ATTN_LDS_BYTES=LDS_BYTES;
struct AttnTensors { const bf16* Q; const bf16* K; const bf16* V; bf16* O; const float* cl; const float* bt; };
struct AttnUnit { int bh; int qb; };
struct StaticOrder {
  int vcu,grid;
  __device__ __forceinline__ explicit StaticOrder(int grid_,int block):vcu((grid_%8==0)?(block%8)*(grid_/8)+block/8:block),grid(grid_){}
  __device__ __forceinline__ bool next(int i,AttnUnit&u)const{ const int v=vcu+(i>>1)*grid; if(v>=BATCH*NHEAD*4)return false; const int s=v&3; u.bh=v>>2; u.qb=((i&1)==0)?7-s:s; return true; }
  __device__ __forceinline__ void a_ready(const AttnUnit&)const{}
  __device__ __forceinline__ void done(const AttnUnit&)const{}
};
__device__ __forceinline__ void build_beta(char*lds,const float*cl,const float*bt,int bh){
  int tid_o=threadIdx.x; asm volatile("":"+v"(tid_o)); const int tid=tid_o,b=bh/NHEAD,h=bh%NHEAD;
  __attribute__((address_space(3))) float*beta=(__attribute__((address_space(3))) float*)((lds_cptr)lds+LDS_BETA);
  __attribute__((address_space(3))) float*pre=(__attribute__((address_space(3))) float*)((lds_cptr)lds+LDS_PRE);
  if(tid<64){ float v=(tid<32)?bt[(b*32+tid)*8+h]:0.f; const float own=v;
    #pragma unroll
    for(int o=1;o<32;o<<=1){ const float n=__shfl_up(v,o); if((tid&63)>=o)v+=n; }
    if(tid<32)pre[tid]=v-own; }
  asm volatile("s_waitcnt lgkmcnt(0)":::"memory"); __syncthreads();
  for(int s=tid;s<SEQ;s+=NW*64) beta[s]=-(pre[s>>6]+cl[(long)(b*SEQ+s)*8+h])*ATT_LOG2E;
  asm volatile("s_waitcnt lgkmcnt(0)":::"memory"); __syncthreads();
}
template<class Sched,int THRL=8> __device__ __forceinline__ void attn_phase(char*lds,const AttnTensors&T,const Sched&S){
  AttnUnit u;
  for(int i=0;S.next(i,u);++i){ if((i&1)==0) build_beta(lds,T.cl,T.bt,u.bh);
    S.a_ready(u); attn_unit<THRL>(u.bh/NHEAD,u.bh%NHEAD,u.qb,T.Q,T.K,T.V,T.O,lds); S.done(u); }
}
#undef SBAR
#undef WAIT_BAR
}

namespace hg {
typedef short bf16x8 __attribute__((ext_vector_type(8)));
typedef short s16x4 __attribute__((ext_vector_type(4)));
typedef float f32x16 __attribute__((ext_vector_type(16)));
typedef float f32x4 __attribute__((ext_vector_type(4)));
typedef unsigned u32x4 __attribute__((ext_vector_type(4)));
typedef unsigned u32x2 __attribute__((ext_vector_type(2)));
#define HG_LAS __attribute__((address_space(3)))
#define HG_BAR() do { asm volatile("s_waitcnt lgkmcnt(0)" ::: "memory"); __builtin_amdgcn_s_barrier(); asm volatile("" ::: "memory"); } while (0)
constexpr int CH = 32, NCH = 2048 / CH;
constexpr int S_QA = 0, S_KD = 8192, S_KT = 16384, S_V = 24576, S_DEC = 26624, SLOT_BYTES = 27136;
constexpr int OFF_OPART = 2 * SLOT_BYTES, OPART_BYTES = 4 * 4096, LDS_BYTES = OFF_OPART + 2 * OPART_BYTES;
__device__ __forceinline__ int qa_off(int t, int d) { return t * 256 + ((((d >> 3) ^ (t & 15))) << 4) + (d & 7) * 2; }
__device__ __forceinline__ int kt_off(int s, int d) { return s * 256 + ((((d >> 3) ^ ((s & 3) << 2))) << 4) + (d & 7) * 2; }
__device__ __forceinline__ int v_off(int s, int e) { return s * 64 + e * 2; }
typedef short v4i16_t __attribute__((ext_vector_type(4)));
__device__ __forceinline__ s16x4 trd(const HG_LAS unsigned char* p) { return __builtin_bit_cast(s16x4, __builtin_amdgcn_ds_read_tr16_b64_v4i16((HG_LAS v4i16_t*)p)); }
__device__ __forceinline__ unsigned cvtpk(float lo, float hi) { typedef float f2 __attribute__((ext_vector_type(2))); typedef __bf16 b2 __attribute__((ext_vector_type(2))); f2 v = {lo, hi}; b2 b = __builtin_convertvector(v, b2); return __builtin_bit_cast(unsigned, b); }
__device__ __forceinline__ int crow(int r, int hi) { return (r & 3) + 8 * (r >> 2) + 4 * hi; }
__device__ __forceinline__ bf16x8 pack8(const f32x16& x, int base) {
    u32x4 w; w.x = cvtpk(x[base], x[base + 1]); w.y = cvtpk(x[base + 2], x[base + 3]); w.z = cvtpk(x[base + 4], x[base + 5]); w.w = cvtpk(x[base + 6], x[base + 7]); return __builtin_bit_cast(bf16x8, w); }
__device__ __forceinline__ bf16x8 cat64(s16x4 a, s16x4 b) { return (bf16x8){a[0], a[1], a[2], a[3], b[0], b[1], b[2], b[3]}; }

__device__ __forceinline__ void hgrn_unit(HG_LAS unsigned char* lds, const unsigned short* QA, const unsigned short* KD, const unsigned short* KT, const float* DEC, const unsigned short* V, unsigned short* O, int unit) {
    int tid_o = threadIdx.x; asm volatile("" : "+v"(tid_o));
    const int tid = tid_o, lane = tid & 63, wid = __builtin_amdgcn_readfirstlane(tid >> 6), r32 = lane & 31, hi = lane >> 5;
    const int b = unit >> 5, h = (unit >> 2) & 7, eq = unit & 3;
    const size_t gbase = (size_t)b * 2048 * 1024 + h * 128;
    __syncthreads();
    if (wid < 4) {
        const int w = wid;
        const int tq = (lane & 15) >> 2, tc = 16 * ((lane >> 4) & 1) + 4 * (lane & 3);
        f32x16 S = {};
#pragma unroll 1
        for (int i = -1; i <= NCH; ++i) {
            if (i >= 0 && i < NCH) {
                HG_LAS unsigned char* sl = lds + (i & 1) * SLOT_BYTES;
                bf16x8 kdf[2], qaf[2]; s16x4 qp[2][2], vp[2][2], ktf[2][2], vf[2][2]; f32x4 dcv[4];
#pragma unroll
                for (int ks = 0; ks < 2; ++ks) { const int o = qa_off(r32, 32 * w + 16 * ks + 8 * hi), d0 = 32 * w + 16 * ks + 4 * hi, sp = 16 * ks + 4 * hi, sn = 16 * ks + 8 * hi;
                    kdf[ks] = *(const HG_LAS bf16x8*)(sl + S_KD + o); qaf[ks] = *(const HG_LAS bf16x8*)(sl + S_QA + o);
                    qp[ks][0] = *(const HG_LAS s16x4*)(sl + S_QA + qa_off(r32, d0)); qp[ks][1] = *(const HG_LAS s16x4*)(sl + S_QA + qa_off(r32, d0 + 8));
                    vp[ks][0] = trd(sl + S_V + v_off(sp + tq, tc)); vp[ks][1] = trd(sl + S_V + v_off(sp + 8 + tq, tc));
                    ktf[ks][0] = trd(sl + S_KT + kt_off(sn + tq, 32 * w + tc)); ktf[ks][1] = trd(sl + S_KT + kt_off(sn + 4 + tq, 32 * w + tc));
                    vf[ks][0] = trd(sl + S_V + v_off(sn + tq, tc)); vf[ks][1] = trd(sl + S_V + v_off(sn + 4 + tq, tc)); }
#pragma unroll
                for (int g = 0; g < 4; ++g) dcv[g] = *(const HG_LAS f32x4*)(sl + S_DEC + (32 * w + 8 * g + 4 * hi) * 4);
                __builtin_amdgcn_sched_barrier(0);
                const bf16x8 sb0 = pack8(S, 0), sb1 = pack8(S, 8);
                f32x16 X = {}, ow = {};
#pragma unroll
                for (int g = 0; g < 4; ++g)
#pragma unroll
                    for (int q = 0; q < 4; ++q) S[4 * g + q] *= dcv[g][q];
                X = __builtin_amdgcn_mfma_f32_32x32x16_bf16(kdf[0], qaf[0], X, 0, 0, 0);
                ow = __builtin_amdgcn_mfma_f32_32x32x16_bf16(cat64(qp[0][0], qp[0][1]), sb0, ow, 0, 0, 0);
                S = __builtin_amdgcn_mfma_f32_32x32x16_bf16(cat64(ktf[0][0], ktf[0][1]), cat64(vf[0][0], vf[0][1]), S, 0, 0, 0);
                X = __builtin_amdgcn_mfma_f32_32x32x16_bf16(kdf[1], qaf[1], X, 0, 0, 0);
                ow = __builtin_amdgcn_mfma_f32_32x32x16_bf16(cat64(qp[1][0], qp[1][1]), sb1, ow, 0, 0, 0);
                S = __builtin_amdgcn_mfma_f32_32x32x16_bf16(cat64(ktf[1][0], ktf[1][1]), cat64(vf[1][0], vf[1][1]), S, 0, 0, 0);
#pragma unroll
                for (int r = 0; r < 16; ++r) X[r] = (crow(r, hi) <= r32) ? X[r] : 0.f;
                ow = __builtin_amdgcn_mfma_f32_32x32x16_bf16(pack8(X, 0), cat64(vp[0][0], vp[0][1]), ow, 0, 0, 0);
                ow = __builtin_amdgcn_mfma_f32_32x32x16_bf16(pack8(X, 8), cat64(vp[1][0], vp[1][1]), ow, 0, 0, 0);
                { HG_LAS float* op = (HG_LAS float*)(lds + OFF_OPART + (i & 1) * OPART_BYTES + w * 4096) + lane;
#pragma unroll
                  for (int r = 0; r < 16; ++r) op[r * 64] = ow[r]; }
            }
            HG_BAR();
        }
    } else {
        const int pt = tid - 256;
        const int t0 = pt >> 4, d0 = (pt & 15) * 8;
        const int vs = pt >> 3, ve = (pt & 7) * 4;
        u32x4 qaA[2], kdA[2], ktA[2], qaB[2], kdB[2], ktB[2]; u32x2 vA, vB; float dcA = 0.f, dcB = 0.f;
#define HG_LOAD(qa, kd, kt, vr, dc, c) do { const int c_ = (c) < NCH ? (c) : NCH - 1;      \
            const size_t ro_ = gbase + (size_t)c_ * CH * 1024; \
            _Pragma("unroll") for (int k_ = 0; k_ < 2; ++k_) { const size_t o_ = ro_ + (size_t)(t0 + 16 * k_) * 1024 + d0; \
                qa[k_] = *(const u32x4*)(QA + o_); kd[k_] = *(const u32x4*)(KD + o_); kt[k_] = *(const u32x4*)(KT + o_); } \
            vr = *(const u32x2*)(V + ro_ + (size_t)vs * 1024 + eq * 32 + ve); \
            dc = DEC[(size_t)(b * NCH + c_) * 1024 + h * 128 + (pt & 127)]; } while (0)
#define HG_PSTEP(i, RED, PREP, qa, kd, kt, vr, dc) do { \
            if (PREP) { \
                HG_LAS unsigned char* sl = lds + (((i) + 1) & 1) * SLOT_BYTES; \
                _Pragma("unroll") for (int k_ = 0; k_ < 2; ++k_) { const int t_ = t0 + 16 * k_; \
                    *(HG_LAS u32x4*)(sl + S_QA + qa_off(t_, d0)) = qa[k_]; *(HG_LAS u32x4*)(sl + S_KD + qa_off(t_, d0)) = kd[k_]; \
                    *(HG_LAS u32x4*)(sl + S_KT + kt_off(t_, d0)) = kt[k_]; } \
                *(HG_LAS u32x2*)(sl + S_V + v_off(vs, ve)) = vr; \
                *(HG_LAS float*)(sl + S_DEC + (pt & 127) * 4) = dc; \
                HG_LOAD(qa, kd, kt, vr, dc, (i) + 3); } \
            if (RED) { const HG_LAS float* op = (const HG_LAS float*)(lds + OFF_OPART + (((i) - 1) & 1) * OPART_BYTES); \
                const int idx = 4 * pt, reg = idx >> 6, ln = idx & 63; const HG_LAS f32x4* op4 = (const HG_LAS f32x4*)(op + idx); \
                const f32x4 v = (op4[0] + op4[256]) + (op4[512] + op4[768]);              \
                const int t = crow(reg, ln >> 5), e = ln & 31; u32x2 wv; wv.x = cvtpk(v[0], v[1]); wv.y = cvtpk(v[2], v[3]); \
                *(u32x2*)(O + gbase + (size_t)(((i) - 1) * CH + t) * 1024 + eq * 32 + e) = wv; } \
            HG_BAR(); } while (0)
        HG_LOAD(qaA, kdA, ktA, vA, dcA, 0); HG_LOAD(qaB, kdB, ktB, vB, dcB, 1);
        HG_PSTEP(-1, false, true, qaA, kdA, ktA, vA, dcA); HG_PSTEP(0, false, true, qaB, kdB, ktB, vB, dcB);
#pragma unroll 1
        for (int i = 1; i + 1 < NCH; i += 2) { HG_PSTEP(i, true, true, qaA, kdA, ktA, vA, dcA); HG_PSTEP(i + 1, true, true, qaB, kdB, ktB, vB, dcB); }
        HG_PSTEP(NCH - 1, true, false, qaA, kdA, ktA, vA, dcA); HG_PSTEP(NCH, true, false, qaB, kdB, ktB, vB, dcB);
#undef HG_PSTEP
#undef HG_LOAD
    }
}
#undef HG_LAS
#undef HG_BAR
}

#define GAS __attribute__((address_space(1)))
#define LAS __attribute__((address_space(3)))
typedef unsigned short bf16;
typedef unsigned v4u __attribute__((ext_vector_type(4)));
typedef float f32x4 __attribute__((ext_vector_type(4)));
typedef short bf16x8 __attribute__((ext_vector_type(8)));
typedef GAS unsigned gu32;
typedef GAS unsigned long long gu64;
#define RLX_AGENT __ATOMIC_RELAXED, __HIP_MEMORY_SCOPE_AGENT
#define LDS_WAIT() asm volatile("s_waitcnt lgkmcnt(0)" ::: "memory")
#define VM_WAIT() asm volatile("s_waitcnt vmcnt(0)" ::: "memory")
__device__ __forceinline__ unsigned long long rt() { return __builtin_amdgcn_s_memrealtime(); }
__device__ __forceinline__ unsigned f2bf(float f) { unsigned u = __builtin_bit_cast(unsigned, f); return (u + 0x7fffu + ((u >> 16) & 1u)) >> 16; }
__device__ __forceinline__ unsigned pk2(float lo, float hi) { typedef float f2_ __attribute__((ext_vector_type(2))); typedef __bf16 b2_ __attribute__((ext_vector_type(2))); f2_ v = {lo, hi}; b2_ b = __builtin_convertvector(v, b2_); return __builtin_bit_cast(unsigned, b); }

#define XB_TMO      128
#define XB_XCNT(j)  (256  + 64 * (j))
#define XB_XSUB(j)  (1280 + 64 * (j))
#define XB_XGEN(j)  (2304 + 64 * (j))
#define XB_TOP      3328
#define XB_TOPGEN   3392
#define XCD_BAR_WORDS 3456
#define XB_SPIN_CAP (1u << 18)

__device__ __forceinline__ unsigned xb_ld(unsigned* p)              { return __hip_atomic_load(p, __ATOMIC_RELAXED, __HIP_MEMORY_SCOPE_AGENT); }
__device__ __forceinline__ unsigned xb_add(unsigned* p, unsigned v) { return __hip_atomic_fetch_add(p, v, __ATOMIC_RELAXED, __HIP_MEMORY_SCOPE_AGENT); }
__device__ __forceinline__ unsigned xb_xcc_id() { return (unsigned)__builtin_amdgcn_s_getreg((3 << 11) | 20) & 0xFu; }
#define XB_SPIN(cond, bar) do { unsigned _sp = 0; while (cond) { __builtin_amdgcn_s_sleep(1); \
    if ((++_sp & 255u) == 0u) { if (xb_ld(&(bar)[XB_TMO])) break; if (_sp > XB_SPIN_CAP) { atomicAdd(&(bar)[XB_TMO], 1u); break; } } } } while (0)

struct XcdBarrier {
    unsigned* bar; unsigned x;
    volatile LAS unsigned* st;
};

__device__ __forceinline__ XcdBarrier xcd_barrier_post(unsigned* bar, volatile LAS unsigned* st) {
    XcdBarrier b; b.bar = bar; b.x = xb_xcc_id(); b.st = st;
    if (threadIdx.x == 0) (void)xb_add(&bar[XB_XCNT(b.x)], 1u);
    return b;
}
__device__ __forceinline__ void xcd_barrier_complete(unsigned* bar, unsigned x, unsigned& nloc, unsigned& nx) {
    const unsigned G = gridDim.x * gridDim.y * gridDim.z;
    unsigned sum, cnt, mine, sp = 0u;
    for (;;) {
        sum = 0u; cnt = 0u; mine = 0u;
#pragma unroll
        for (unsigned j = 0; j < 16; ++j) { const unsigned c = xb_ld(&bar[XB_XCNT(j)]); sum += c; cnt += (c > 0u) ? 1u : 0u; mine = (j == x) ? c : mine; }
        if (sum == G) break;
        __builtin_amdgcn_s_sleep(1);
        if ((++sp & 255u) == 0u) { if (xb_ld(&bar[XB_TMO])) break; if (sp > XB_SPIN_CAP) { atomicAdd(&bar[XB_TMO], 1u); break; } }
    }
    nloc = mine > 0u ? mine : 1u; nx = cnt > 0u ? cnt : 1u;
}

__device__ __forceinline__ void xcd_barrier(const XcdBarrier& b) {
    asm volatile("s_waitcnt vmcnt(0)" ::: "memory");
    __syncthreads();
    if (threadIdx.x == 0) {
        unsigned* bar = b.bar;
        __builtin_amdgcn_s_waitcnt(0);
        unsigned nloc = b.st[0], nx = b.st[1];
        if (nloc == 0u) { xcd_barrier_complete(bar, b.x, nloc, nx); b.st[0] = nloc; b.st[1] = nx; }
        const unsigned old = xb_add(&bar[XB_XSUB(b.x)], 1u);
        const unsigned gen = old / nloc;
        if (old + 1u == (gen + 1u) * nloc) {
            __builtin_amdgcn_fence(__ATOMIC_RELEASE, "agent");
            asm volatile("s_waitcnt vmcnt(0)" ::: "memory");
            const unsigned og = xb_add(&bar[XB_TOP], 1u);
            const unsigned tg = og / nx;
            if (og + 1u == (tg + 1u) * nx) xb_add(&bar[XB_TOPGEN], 1u);
            else XB_SPIN(xb_ld(&bar[XB_TOPGEN]) == tg, bar);
            __builtin_amdgcn_fence(__ATOMIC_ACQUIRE, "agent");
            xb_add(&bar[XB_XGEN(b.x)], 1u);
            asm volatile("s_waitcnt vmcnt(0)" ::: "memory");
        } else {
            XB_SPIN(xb_ld(&bar[XB_XGEN(b.x)]) == gen, bar);
            __builtin_amdgcn_fence(__ATOMIC_ACQUIRE, "agent");
            asm volatile("s_waitcnt vmcnt(0)" ::: "memory");
        }
    }
    __syncthreads();
}

#ifndef L0_SPLIT
#define L0_SPLIT 1
#endif

#ifndef TS_P0
#define TS_P0 0
#endif

#ifndef FUSE_FINAL_NORM
#define FUSE_FINAL_NORM 0
#endif

#ifndef TS_CLOCK
#define TS_CLOCK 0
#endif

#ifndef TS_PHASE_END
#define TS_PHASE_END -1
#endif

#ifndef TS_AFTER_BAR
#define TS_AFTER_BAR 0
#endif

#ifndef TS_PHASE
#define TS_PHASE -1
#endif
#ifndef TS_DIV
#define TS_DIV 1000.0f
#endif

#ifndef PROBE_P0
#define PROBE_P0 0
#endif

constexpr int NWAVES = 8;
constexpr int BATCH = 8, SEQ = 2048, D = 1024, DEPTH = 4, M = BATCH * SEQ;
constexpr int FOXH = 8, FOXD = 64, FOXW = 512, CONVW = 512, AB_COLS = 3080, AB_N = 3072;
constexpr int HGH = 8, HGD = 128, C_COLS = 4096;
constexpr int FFH = 2816, FF2 = 5632;
constexpr float EPS = 1e-6f;
constexpr float LOG2E = 1.4426950408889634f;
constexpr float QSCALE = 0.125f * LOG2E;

constexpr size_t MiB = 1u << 20;
constexpr size_t WS_CTL = 0, CTL_ZERO_BYTES = 64 * 1024;
constexpr size_t WS_SSQ = 1 * MiB;
constexpr size_t WS_CL = 2 * MiB;
constexpr size_t WS_BT = WS_CL + 512 * 1024;
constexpr size_t WS_WF = WS_BT + 64 * 1024;
constexpr size_t WS_LB = WS_WF + 64 * 1024;
constexpr size_t WS_W = 4 * MiB;
constexpr size_t W_ABIN = 0, SZ_ABIN = (size_t)AB_N * D * 2;
constexpr size_t W_ABOUT = W_ABIN + 2 * SZ_ABIN, SZ_ABOUT = (size_t)D * D * 2;
constexpr size_t W_CIN = W_ABOUT + 2 * SZ_ABOUT, SZ_CIN = (size_t)C_COLS * D * 2;
constexpr size_t W_COUT = W_CIN + 2 * SZ_CIN, SZ_COUT = (size_t)D * D * 2;
constexpr size_t W_FIN = W_COUT + 2 * SZ_COUT, SZ_FIN = (size_t)FF2 * D * 2;
constexpr size_t W_FOUT = W_FIN + 4 * SZ_FIN, SZ_FOUT = (size_t)D * FFH * 2;
constexpr size_t W_END = W_FOUT + 4 * SZ_FOUT;
static_assert(WS_W + W_END <= 108 * MiB, "weights region");
constexpr size_t WS_XB = 108 * MiB;
constexpr size_t WS_MIX = 140 * MiB;
constexpr size_t WS_H = WS_MIX;
constexpr size_t WS_QKVU = WS_MIX, T512 = (size_t)M * 512 * 2, WS_AO = WS_MIX + 6 * T512;
constexpr size_t WS_KD = WS_MIX, WS_KT = WS_MIX + 32 * MiB, WS_HQ = WS_MIX + 64 * MiB, WS_HV = WS_HQ + 32 * MiB, WS_HG = WS_HV + 32 * MiB, WS_HO = WS_HG + 32 * MiB, WS_DEC = WS_HO + 32 * MiB, WS_END = WS_DEC + 2 * MiB;
static_assert(WS_END <= 352 * MiB, "workspace budget");
constexpr int CW_TMO = 0, CW_BAR = 4096, CW_FIN = 8192;
constexpr size_t WS_XS = 3 * MiB;

constexpr int RING_OFF = 0, RING_BYTES = 131072;
constexpr int LDSCTL_OFF = RING_BYTES, MISC_OFF = LDSCTL_OFF + 320;
constexpr int LDS_BYTES = 147456;
static_assert(MISC_OFF + 128 <= LDS_BYTES, "LDS map");
static_assert(attn_body::ATTN_LDS_BYTES <= RING_BYTES && hg::LDS_BYTES <= RING_BYTES, "mixer LDS inside the ring region");

struct Args { const float* in[14]; float* out; unsigned char* ws; int ph_lo, ph_hi, li, pad; };
typedef const __attribute__((address_space(4))) Args* KArgP;

struct Frame {
    LAS unsigned char* lds; volatile LAS unsigned* MISC; gu32* ctl;
    int wave, vcu, G;
};
#define LANE_IDS() int tid_l = threadIdx.x; asm volatile("" : "+v"(tid_l)); const int TID = tid_l, LANE = tid_l & 63
__device__ __forceinline__ float wave_sum(float v) {
#pragma unroll
    for (int o = 1; o < 64; o <<= 1) v += __shfl_xor(v, o);
    return v;
}
__device__ __forceinline__ float bf_lo(unsigned w) { return __uint_as_float(w << 16); }
__device__ __forceinline__ float bf_hi(unsigned w) { return __uint_as_float(w & 0xffff0000u); }

struct WItem { const float* W; const float* gain; bf16* WT; int ldn, ksrc0, nsrc0, K, drow0; };
constexpr int I_ABIN = 16 * (AB_N / 32), I_SQ = 16 * (D / 32), I_CIN = 16 * (C_COLS / 32), I_FIN = 16 * (FF2 / 32), I_FOUT = (FFH / 64) * (D / 32);
__host__ __device__ constexpr int layer_items(int l) { return ((l & 1) ? I_CIN : I_ABIN) + I_SQ + I_FIN + I_FOUT; }
__device__ __forceinline__ WItem layer_item(const Args& a, int l, int it) {
    unsigned char* wb = a.ws + WS_W; const int j = l >> 1; WItem w;
    const int n_in = (l & 1) ? I_CIN : I_ABIN;
    if (it < n_in) {
        if (l & 1) { const int nb = it % 128, kb = it / 128, c0 = 32 * nb;
            const int drow = c0 < 1024 ? 256 * (c0 / 128) + (c0 % 128) : (c0 < 2048 ? 256 * ((c0 - 1024) / 128) + 128 + ((c0 - 1024) % 128) : c0);
            w = WItem{a.in[8] + (size_t)j * D * C_COLS, a.in[1] + (size_t)l * D, (bf16*)(wb + W_CIN + j * SZ_CIN), C_COLS, 64 * kb, c0, D, drow}; }
        else { const int nb = it % (AB_N / 32), kb = it / (AB_N / 32), n0 = 32 * nb;
            w = WItem{a.in[4] + (size_t)j * D * AB_COLS, a.in[1] + (size_t)l * D, (bf16*)(wb + W_ABIN + j * SZ_ABIN), AB_COLS, 64 * kb, n0 + (n0 >= 1536 ? 8 : 0), D, n0}; }
        return w; }
    it -= n_in;
    if (it < I_SQ) { const int nb = it % 32, kb = it / 32;
        w = WItem{((l & 1) ? a.in[11] : a.in[7]) + (size_t)j * D * D, nullptr, (bf16*)(wb + ((l & 1) ? W_COUT + j * SZ_COUT : W_ABOUT + j * SZ_ABOUT)), D, 64 * kb, 32 * nb, D, 32 * nb}; return w; }
    it -= I_SQ;
    if (it < I_FIN) { const int nb = it % (FF2 / 32), kb = it / (FF2 / 32), c0 = 32 * nb;
        const int drow = c0 < FFH ? 256 * (c0 / 128) + (c0 % 128) : 256 * ((c0 - FFH) / 128) + 128 + ((c0 - FFH) % 128);
        w = WItem{a.in[12] + (size_t)l * D * FF2, a.in[2] + (size_t)l * D, (bf16*)(wb + W_FIN + l * SZ_FIN), FF2, 64 * kb, c0, D, drow}; return w; }
    it -= I_FIN;
    { const int nb = it % 32, kb = it / 32;
      w = WItem{a.in[13] + (size_t)l * FFH * D, nullptr, (bf16*)(wb + W_FOUT + l * SZ_FOUT), D, 64 * kb, 32 * nb, FFH, 32 * nb}; }
    return w;
}
__device__ __forceinline__ void witem_load(const WItem& w, f32x4 (&r)[8], int lane) {
    const int n4 = (lane & 7) * 4;
#pragma unroll
    for (int i = 0; i < 8; ++i) { const int kk = 8 * i + (lane >> 3); r[i] = *(const f32x4*)(w.W + (size_t)(w.ksrc0 + kk) * w.ldn + w.nsrc0 + n4); }
}
__device__ __forceinline__ void witem_finish(const WItem& w, const f32x4 (&r)[8], LAS float* scr, int lane) {
    const int n4 = (lane & 7) * 4;
#pragma unroll
    for (int i = 0; i < 8; ++i) { const int kk = 8 * i + (lane >> 3); f32x4 v = r[i]; if (w.gain) v = v * w.gain[w.ksrc0 + kk];
        LAS float* s = scr + kk * 33 + n4; s[0] = v[0]; s[1] = v[1]; s[2] = v[2]; s[3] = v[3]; }
    LDS_WAIT(); asm volatile("" ::: "memory");
    const int c = lane & 7;
#pragma unroll
    for (int j = 0; j < 4; ++j) { const int n = (lane >> 3) + 8 * j; const LAS float* s = scr + (8 * c) * 33 + n;
        v4u o; o.x = pk2(s[0 * 33], s[1 * 33]); o.y = pk2(s[2 * 33], s[3 * 33]); o.z = pk2(s[4 * 33], s[5 * 33]); o.w = pk2(s[6 * 33], s[7 * 33]);
        *(v4u*)(w.WT + (size_t)(w.drow0 + n) * w.K + w.ksrc0 + 8 * c) = o; }
    LDS_WAIT(); asm volatile("" ::: "memory");
}
__device__ __forceinline__ void convert_layer_weights(Frame& F, const Args& a, int l, int gw, int ngw, int it_lo = 0, int it_hi = 1 << 30) {
    LANE_IDS(); (void)TID;
    LAS float* scr = (LAS float*)(F.lds + RING_OFF + F.wave * 16384);
    const int n = layer_items(l) < it_hi ? layer_items(l) : it_hi; int it = it_lo + gw; if (it >= n) return;
    WItem cur = layer_item(a, l, it); f32x4 rc[8], rn[8]; witem_load(cur, rc, LANE);
    for (;;) { const int itn = it + ngw; const bool more = itn < n; WItem nxt = cur;
        if (more) { nxt = layer_item(a, l, itn); witem_load(nxt, rn, LANE); }
        witem_finish(cur, rc, scr, LANE);
        if (!more) break;
#pragma unroll
        for (int i = 0; i < 8; ++i) rc[i] = rn[i];
        cur = nxt; it = itn; }
}
__device__ __forceinline__ void p0_prologue(Frame& F, const Args& a) {
    LANE_IDS();
    const int gw = F.vcu * NWAVES + F.wave, NGW = F.G * NWAVES;
    unsigned char* ws = a.ws;
    if (TS_P0 && blockIdx.x == 0 && TID == 0) __hip_atomic_store((unsigned*)(a.ws + WS_CTL) + 17, (unsigned)__builtin_amdgcn_s_memrealtime(), __ATOMIC_RELAXED, __HIP_MEMORY_SCOPE_AGENT);
    for (int r_ = 0; r_ < ((PROBE_P0 & 1) ? 2 : 1); ++r_)
    convert_layer_weights(F, a, 0, gw, NGW, 0, L0_SPLIT ? I_ABIN : (1 << 30));
#if !WCONV_IN_FFN_TAIL
    for (int l = 1; l < DEPTH; ++l) convert_layer_weights(F, a, l, gw, NGW);
#endif
    if (TS_P0 == 1 && blockIdx.x == 0 && TID == 0) __hip_atomic_store((unsigned*)(a.ws + WS_CTL) + 16, (unsigned)__builtin_amdgcn_s_memrealtime() - __hip_atomic_load((unsigned*)(a.ws + WS_CTL) + 17, __ATOMIC_RELAXED, __HIP_MEMORY_SCOPE_AGENT), __ATOMIC_RELAXED, __HIP_MEMORY_SCOPE_AGENT);
    for (int r_ = 0; r_ < ((PROBE_P0 & 2) ? 2 : 1); ++r_)
    { const float* __restrict__ x = a.in[0]; bf16* __restrict__ xb = (bf16*)(ws + WS_XB); float* __restrict__ ssq = (float*)(ws + WS_SSQ);
      f32x4 v[2][4], vn[2][4];
#pragma unroll
      for (int h = 0; h < 2; ++h) { const int m0 = gw + h * NGW; const int mr = m0 < M ? m0 : gw; const f32x4* xr = (const f32x4*)(x + (size_t)mr * D) + LANE;
#pragma unroll
        for (int j = 0; j < 4; ++j) v[h][j] = xr[64 * j]; }
      for (int m = gw; m < M; m += 2 * NGW) {
#pragma unroll
        for (int h = 0; h < 2; ++h) { const int mn0 = m + (2 + h) * NGW; const int mn = mn0 < M ? mn0 : gw; const f32x4* xr = (const f32x4*)(x + (size_t)mn * D) + LANE;
#pragma unroll
          for (int j = 0; j < 4; ++j) vn[h][j] = xr[64 * j]; }
#pragma unroll
        for (int h = 0; h < 2; ++h) { const int mm = m + h * NGW; if (mm < M) { float s = 0.f;
          unsigned long long* o8 = (unsigned long long*)(xb + (size_t)mm * D) + LANE;
#pragma unroll
          for (int j = 0; j < 4; ++j) { const unsigned w0 = pk2(v[h][j][0], v[h][j][1]), w1 = pk2(v[h][j][2], v[h][j][3]); o8[64 * j] = (unsigned long long)w0 | ((unsigned long long)w1 << 32);
              const float r0 = bf_lo(w0), r1 = bf_hi(w0), r2 = bf_lo(w1), r3 = bf_hi(w1); s += (r0 * r0 + r1 * r1) + (r2 * r2 + r3 * r3); }
          s = wave_sum(s);
          if (LANE < 16) ssq[(size_t)mm * 16 + LANE] = LANE == 0 ? s : 0.f; } }
#pragma unroll
        for (int h = 0; h < 2; ++h)
#pragma unroll
          for (int j = 0; j < 4; ++j) v[h][j] = vn[h][j];
      } }
    if (TS_P0 == 2 && blockIdx.x == 0 && TID == 0) __hip_atomic_store((unsigned*)(a.ws + WS_CTL) + 16, (unsigned)__builtin_amdgcn_s_memrealtime() - __hip_atomic_load((unsigned*)(a.ws + WS_CTL) + 17, __ATOMIC_RELAXED, __HIP_MEMORY_SCOPE_AGENT), __ATOMIC_RELAXED, __HIP_MEMORY_SCOPE_AGENT);
    for (int r_ = 0; r_ < ((PROBE_P0 & 4) ? 2 : 1); ++r_)
    { const int gt = (F.vcu * NWAVES + F.wave) * 64 + LANE, NGT = NGW * 64; float* wf = (float*)(ws + WS_WF); float* lb = (float*)(ws + WS_LB);
      for (int i = gt; i < 2 * 8 * D; i += NGT) { const int j = i / (8 * D), h = (i / D) % 8, k = i % D; wf[i] = a.in[4][(size_t)j * D * AB_COLS + (size_t)k * AB_COLS + 1536 + h] * a.in[1][(2 * j) * D + k]; }
      for (int i = gt; i < D; i += NGT) { const float c0 = a.in[9][i], c1 = a.in[9][D + i]; lb[i] = 0.f; lb[D + i] = 1.0f / (1.0f + expf(c0 - c1)); } }
}

__device__ __forceinline__ void fgate_job(Frame& F, const Args& a, int j, int jb) {
    LANE_IDS();
    unsigned char* ws = a.ws; const float* wf = (const float*)(ws + WS_WF) + (size_t)j * 8 * D; const float* ssq = (const float*)(ws + WS_SSQ); const bf16* xb = (const bf16*)(ws + WS_XB);
    float* cl = (float*)(ws + WS_CL); float* bt = (float*)(ws + WS_BT); const float* bias = a.in[5] + j * 8;
    LAS float* tmp = (LAS float*)(F.lds + RING_OFF);
    f32x4 w[8][4];
#pragma unroll
    for (int h = 0; h < 8; ++h)
#pragma unroll
        for (int q = 0; q < 4; ++q) w[h][q] = *(const f32x4*)(wf + (size_t)h * D + (q >> 1) * 512 + 8 * LANE + 4 * (q & 1));
    v4u v[2], vn[2];
    { const v4u* xr = (const v4u*)(xb + (size_t)(jb * 64 + F.wave * 8) * D) + LANE; v[0] = xr[0]; v[1] = xr[64]; }
#pragma unroll 1
    for (int i = 0; i < 8; ++i) { const int rl = F.wave * 8 + i, row = jb * 64 + rl;
        { const v4u* xr = (const v4u*)(xb + (size_t)(row + (i < 7 ? 1 : 0)) * D) + LANE; vn[0] = xr[0]; vn[1] = xr[64]; }
        const float rs = pg8::row_rstd(ssq, row); float s8[8]; f32x4 xf[4];
#pragma unroll
        for (int q = 0; q < 4; ++q) { const unsigned a0 = v[q >> 1][2 * (q & 1)], a1 = v[q >> 1][2 * (q & 1) + 1]; xf[q] = (f32x4){bf_lo(a0), bf_hi(a0), bf_lo(a1), bf_hi(a1)}; }
#pragma unroll
        for (int h = 0; h < 8; ++h) { float s = 0.f;
#pragma unroll
            for (int q = 0; q < 4; ++q) s += (xf[q][0] * w[h][q][0] + xf[q][1] * w[h][q][1]) + (xf[q][2] * w[h][q][2] + xf[q][3] * w[h][q][3]);
            s8[h] = s; }
#pragma unroll
        for (int h = 0; h < 4; ++h) { const float a = s8[2 * h], b = s8[2 * h + 1]; const bool up = (LANE & 1) != 0; const float send = up ? a : b, keep = up ? b : a; s8[h] = keep + __shfl_xor(send, 1); }
#pragma unroll
        for (int h = 0; h < 2; ++h) { const float a = s8[2 * h], b = s8[2 * h + 1]; const bool up = (LANE & 2) != 0; const float send = up ? a : b, keep = up ? b : a; s8[h] = keep + __shfl_xor(send, 2); }
        { const float a = s8[0], b = s8[1]; const bool up = (LANE & 4) != 0; const float send = up ? a : b, keep = up ? b : a; s8[0] = keep + __shfl_xor(send, 4); }
        float mine = s8[0]; mine += __shfl_xor(mine, 8); mine += __shfl_xor(mine, 16); mine += __shfl_xor(mine, 32);
        const int hd = LANE & 7;
        if (LANE < 8) { const float z = mine * rs + bias[hd]; tmp[rl * 8 + hd] = fminf(z, 0.f) - log1pf(expf(-fabsf(z))); }
        v[0] = vn[0]; v[1] = vn[1];
    }
    LDS_WAIT(); __syncthreads();
    { const int h = F.wave; float c = tmp[LANE * 8 + h];
#pragma unroll
      for (int o = 1; o < 64; o <<= 1) { const float n = __shfl_up(c, o); if (LANE >= o) c += n; }
      cl[(size_t)(jb * 64 + LANE) * 8 + h] = c; if (LANE == 63) bt[jb * 8 + h] = c; }
    __syncthreads();
}

__device__ __forceinline__ void conv_job(Frame& F, const Args& a, int j, int jb) {
    LANE_IDS();
    unsigned char* ws = a.ws; const bf16* __restrict__ ub = (const bf16*)(ws + WS_QKVU + 3 * T512); const bf16* __restrict__ uc = (const bf16*)(ws + WS_QKVU + 4 * T512); const bf16* __restrict__ ux = (const bf16*)(ws + WS_QKVU + 5 * T512);
    bf16* __restrict__ ao = (bf16*)(ws + WS_AO); const float* __restrict__ cw = a.in[6] + (size_t)j * 3 * CONVW;
#pragma unroll 4
    for (int it = TID; it < 64 * 64; it += NWAVES * 64) { const int rl = it >> 6, ch = (it & 63) * 8, row = jb * 64 + rl, t = row & (SEQ - 1);
        float z[3][8];
#pragma unroll
        for (int d = 0; d < 3; ++d) { const int tt = t - 2 + d;
            if (tt >= 0) { const v4u cv = *(const v4u*)(uc + (size_t)(row - 2 + d) * 512 + ch), xv = *(const v4u*)(ux + (size_t)(row - 2 + d) * 512 + ch);
#pragma unroll
                for (int q = 0; q < 4; ++q) { z[d][2 * q] = bf_lo(cv[q]) * bf_lo(xv[q]); z[d][2 * q + 1] = bf_hi(cv[q]) * bf_hi(xv[q]); } }
            else {
#pragma unroll
                for (int q = 0; q < 8; ++q) z[d][q] = 0.f; } }
        const v4u bv = *(const v4u*)(ub + (size_t)row * 512 + ch); float y[8];
#pragma unroll
        for (int q = 0; q < 8; ++q) { const float b = (q & 1) ? bf_hi(bv[q >> 1]) : bf_lo(bv[q >> 1]);
            y[q] = b * (cw[ch + q] * z[0][q] + cw[CONVW + ch + q] * z[1][q] + cw[2 * CONVW + ch + q] * z[2][q]); }
        v4u o; o.x = pk2(y[0], y[1]); o.y = pk2(y[2], y[3]); o.z = pk2(y[4], y[5]); o.w = pk2(y[6], y[7]);
        *(v4u*)(ao + (size_t)row * D + 512 + ch) = o; }
}

__device__ __forceinline__ void attn_naive_unit(Frame& F, const Args& a, int unit) {
    LANE_IDS();
    unsigned char* ws = a.ws; const bf16* Q = (const bf16*)(ws + WS_QKVU); const bf16* K = (const bf16*)(ws + WS_QKVU + T512); const bf16* V = (const bf16*)(ws + WS_QKVU + 2 * T512);
    bf16* ao = (bf16*)(ws + WS_AO); const float* cl = (const float*)(ws + WS_CL); const float* bt = (const float*)(ws + WS_BT);
    const int b = unit >> 5, h = (unit >> 2) & 7, blk = unit & 3;
    LAS float* beta = (LAS float*)(F.lds + RING_OFF);
    LAS float* pre = beta + 2048;
    __syncthreads();
    if (TID == 0) { float c = 0.f; for (int i = 0; i < 32; ++i) { pre[i] = c; c += bt[(b * 32 + i) * 8 + h]; } }
    LDS_WAIT(); __syncthreads();
    for (int s = TID; s < SEQ; s += NWAVES * 64) beta[s] = -(pre[s >> 6] + cl[(size_t)(b * SEQ + s) * 8 + h]) * LOG2E;
    LDS_WAIT(); __syncthreads();
    const int t = blk * 512 + TID; const size_t rowq = (size_t)(b * SEQ + t);
    float q[64], o[64];
#pragma unroll
    for (int c = 0; c < 8; ++c) { const v4u w = *(const v4u*)(Q + rowq * 512 + h * 64 + 8 * c);
#pragma unroll
        for (int i = 0; i < 4; ++i) { q[8 * c + 2 * i] = bf_lo(w[i]); q[8 * c + 2 * i + 1] = bf_hi(w[i]); } }
#pragma unroll
    for (int d = 0; d < 64; ++d) o[d] = 0.f;
    float mx = -INFINITY, l = 0.f;
    const int send = blk * 512 + 511;
    for (int s = 0; s <= send; ++s) {
        const bf16* kr = K + (size_t)(b * SEQ + s) * 512 + h * 64; const bf16* vr = V + (size_t)(b * SEQ + s) * 512 + h * 64;
        float sc = 0.f;
#pragma unroll
        for (int c = 0; c < 8; ++c) { const v4u w = *(const v4u*)(kr + 8 * c);
#pragma unroll
            for (int i = 0; i < 4; ++i) sc += q[8 * c + 2 * i] * bf_lo(w[i]) + q[8 * c + 2 * i + 1] * bf_hi(w[i]); }
        sc += beta[s];
        if (s <= t) {
            const float mn = fmaxf(mx, sc), f = exp2f(mx - mn), p = exp2f(sc - mn); mx = mn; l = l * f + p;
#pragma unroll
            for (int c = 0; c < 8; ++c) { const v4u w = *(const v4u*)(vr + 8 * c);
#pragma unroll
                for (int i = 0; i < 4; ++i) { o[8 * c + 2 * i] = o[8 * c + 2 * i] * f + p * bf_lo(w[i]); o[8 * c + 2 * i + 1] = o[8 * c + 2 * i + 1] * f + p * bf_hi(w[i]); } }
        }
    }
    const float rl = 1.0f / l;
#pragma unroll
    for (int c = 0; c < 8; ++c) { v4u w; w.x = pk2(o[8 * c] * rl, o[8 * c + 1] * rl); w.y = pk2(o[8 * c + 2] * rl, o[8 * c + 3] * rl); w.z = pk2(o[8 * c + 4] * rl, o[8 * c + 5] * rl); w.w = pk2(o[8 * c + 6] * rl, o[8 * c + 7] * rl);
        *(v4u*)(ao + rowq * D + h * 64 + 8 * c) = w; }
}

__device__ __forceinline__ void hgrn_gate(Frame& F, const Args& a, int j) {
    LANE_IDS();
    unsigned char* ws = a.ws; const bf16* __restrict__ O = (const bf16*)(ws + WS_HO); const bf16* __restrict__ G = (const bf16*)(ws + WS_HG); bf16* __restrict__ AOP = (bf16*)(ws + WS_HQ); const float* __restrict__ hn = a.in[10] + (size_t)j * D;
    const int gw = F.vcu * NWAVES + F.wave, NGW = F.G * NWAVES; (void)TID;
#pragma unroll 4
    for (int m = gw; m < M; m += NGW) {
#pragma unroll
        for (int jj = 0; jj < 2; ++jj) { const int c = (4 * jj + (LANE >> 4)) * HGD + 8 * (LANE & 15); const size_t off = (size_t)m * D + c;
            const v4u ow = *(const v4u*)(O + off), gv = *(const v4u*)(G + off); float o[8], g[8];
#pragma unroll
            for (int q = 0; q < 4; ++q) { o[2 * q] = bf_lo(ow[q]); o[2 * q + 1] = bf_hi(ow[q]); g[2 * q] = bf_lo(gv[q]); g[2 * q + 1] = bf_hi(gv[q]); }
            float s = 0.f;
#pragma unroll
            for (int q = 0; q < 8; ++q) s += o[q] * o[q];
            s += __shfl_xor(s, 1); s += __shfl_xor(s, 2); s += __shfl_xor(s, 4); s += __shfl_xor(s, 8);
            const float r = __builtin_amdgcn_rsqf(s * (1.0f / HGD) + EPS); const f32x4 h0 = *(const f32x4*)(hn + c), h1 = *(const f32x4*)(hn + c + 4);
            v4u w; w.x = pk2(o[0] * r * h0[0] * g[0], o[1] * r * h0[1] * g[1]); w.y = pk2(o[2] * r * h0[2] * g[2], o[3] * r * h0[3] * g[3]);
            w.z = pk2(o[4] * r * h1[0] * g[4], o[5] * r * h1[1] * g[5]); w.w = pk2(o[6] * r * h1[2] * g[6], o[7] * r * h1[3] * g[7]);
            *(v4u*)(AOP + off) = w; }
    }
}
__device__ __forceinline__ void final_norm(Frame& F, const Args& a) {
    LANE_IDS(); (void)TID;
    const int gw = F.vcu * NWAVES + F.wave, NGW = F.G * NWAVES; const float* __restrict__ g = a.in[3]; const bf16* __restrict__ xb = (const bf16*)(a.ws + WS_XB); float* __restrict__ outp = a.out;
    f32x4 gv[4];
#pragma unroll
    for (int q = 0; q < 4; ++q) gv[q] = *(const f32x4*)(g + (q >> 1) * 512 + 8 * LANE + 4 * (q & 1));
#pragma unroll 4
    for (int m = gw; m < M; m += NGW) { const v4u* xr = (const v4u*)(xb + (size_t)m * D) + LANE; const v4u v0 = xr[0], v1 = xr[64]; f32x4 x[4]; float s = 0.f;
#pragma unroll
        for (int q = 0; q < 4; ++q) { const unsigned a0 = (q >> 1) ? v1[2 * (q & 1)] : v0[2 * (q & 1)], a1 = (q >> 1) ? v1[2 * (q & 1) + 1] : v0[2 * (q & 1) + 1];
            x[q] = (f32x4){bf_lo(a0), bf_hi(a0), bf_lo(a1), bf_hi(a1)}; s += (x[q][0] * x[q][0] + x[q][1] * x[q][1]) + (x[q][2] * x[q][2] + x[q][3] * x[q][3]); }
        const float r = __builtin_amdgcn_rsqf(wave_sum(s) * (1.0f / D) + EPS); float* orow = outp + (size_t)m * D;
#pragma unroll
        for (int q = 0; q < 4; ++q) { f32x4 ov = x[q] * r * gv[q]; if ((TS_PHASE != -1 || TS_P0) && m == 0 && LANE == 0 && q == 0) ov[0] += (float)__hip_atomic_load((unsigned*)(F.ctl + 16), __ATOMIC_RELAXED, __HIP_MEMORY_SCOPE_AGENT) * (1.0f / TS_DIV);
            *(f32x4*)(orow + (q >> 1) * 512 + 8 * LANE + 4 * (q & 1)) = ov; } }
}

constexpr int N_PHASES = 26;
#ifndef WCONV_IN_FFN_TAIL
#define WCONV_IN_FFN_TAIL 1
#endif
#ifndef PROBE_MASK
#define PROBE_MASK 0
#endif
#ifndef HGRN_NAIVE
#define HGRN_NAIVE 0
#endif
#ifndef ATTN_NAIVE
#define ATTN_NAIVE 0
#endif
#ifndef MK_PER_PHASE
#define MK_PER_PHASE 0
#endif
__global__ void __launch_bounds__(NWAVES * 64, 2) trunk_fwd(Args args) {
    extern __shared__ __attribute__((aligned(16))) unsigned char lds[];
    Frame F_;
    if (TS_PHASE == -2 && blockIdx.x == 0 && threadIdx.x == 0) __hip_atomic_store((unsigned*)(args.ws + WS_CTL) + 17, (unsigned)__builtin_amdgcn_s_memrealtime(), __ATOMIC_RELAXED, __HIP_MEMORY_SCOPE_AGENT);
    F_.lds = (LAS unsigned char*)lds; F_.MISC = (volatile LAS unsigned*)(F_.lds + MISC_OFF);
    F_.wave = __builtin_amdgcn_readfirstlane((int)threadIdx.x >> 6);
    F_.G = gridDim.x; { const int bx = blockIdx.x; F_.vcu = (F_.G % 8 == 0) ? (bx % 8) * (F_.G / 8) + bx / 8 : bx; }
    unsigned char* ws = args.ws; F_.ctl = (gu32*)(ws + WS_CTL);
    for (int u = threadIdx.x; u < (LDS_BYTES - LDSCTL_OFF) / 4; u += NWAVES * 64) ((LAS unsigned*)(F_.lds + LDSCTL_OFF))[u] = 0u;
    __syncthreads();
    const int lo = args.ph_lo, hi = args.ph_hi;
    XcdBarrier bar; bar.bar = (unsigned*)(F_.ctl + CW_BAR); bar.x = 0; bar.st = nullptr;
    if (hi - lo > 1) bar = xcd_barrier_post((unsigned*)(F_.ctl + CW_BAR), F_.MISC + 8);
#pragma unroll 1
    for (int p = lo; p < hi; ++p) {
        const int l = (p - 1) / 6, s = (p - 1) - 6 * l, j = l >> 1; const bool even = (l & 1) == 0, mid = (p >= 1 && p <= 24);
#if defined(__HIP_DEVICE_COMPILE__)
        KArgP ap = (KArgP)__builtin_amdgcn_kernarg_segment_ptr(); asm volatile("" : "+s"(ap));
        Args A2; for (int q_ = 0; q_ < 14; ++q_) A2.in[q_] = (const float*)(const GAS float*)ap->in[q_]; A2.out = (float*)(GAS float*)ap->out; A2.ws = (unsigned char*)(GAS unsigned char*)ap->ws;     A2.ph_lo = lo; A2.ph_hi = hi; A2.li = 0; A2.pad = 0;
#else
        Args A2 = args;
#endif
        Frame FL = F_; { int w_ = F_.wave, v_ = F_.vcu, g_ = F_.G; asm volatile("" : "+s"(w_), "+s"(v_), "+s"(g_)); FL.wave = w_; FL.vcu = v_; FL.G = g_; }
        int bx = blockIdx.x; asm volatile("" : "+s"(bx));
        Frame& F = FL;
        GAS unsigned char* wsg = (GAS unsigned char*)A2.ws; asm volatile("" : "+s"(wsg)); unsigned char* ws = (unsigned char*)wsg; A2.ws = ws;
        bf16* const wb = (bf16*)(ws + WS_W); bf16* const XB = (bf16*)(ws + WS_XB); float* const SSQ = (float*)(ws + WS_SSQ);
        const int cls = p == 0 ? 1 : p == 25 ? 11 : (s == 0 ? (even ? 2 : 3) : s == 1 ? (even ? 4 : 5) : s == 2 ? 6 : s == 3 ? 7 : s == 4 ? 8 : 9);
        if (mid && s == 2 && even) continue;
        const int nrep = ((PROBE_MASK >> cls) & 1) ? 2 : 1;
        if (TS_PHASE == -2 && p == 0 && bx == 0 && threadIdx.x == 0) __hip_atomic_store((unsigned*)(F.ctl + 16), (unsigned)__builtin_amdgcn_s_memrealtime() - __hip_atomic_load((unsigned*)(F.ctl + 17), __ATOMIC_RELAXED, __HIP_MEMORY_SCOPE_AGENT), __ATOMIC_RELAXED, __HIP_MEMORY_SCOPE_AGENT);
        if (TS_PHASE >= 0 && (p == TS_PHASE || p == TS_PHASE_END) && bx == 0 && threadIdx.x == 0) { const unsigned now_ = TS_CLOCK ? (unsigned)__builtin_amdgcn_s_memtime() : (unsigned)__builtin_amdgcn_s_memrealtime();
            if (p == TS_PHASE) __hip_atomic_store((unsigned*)(F.ctl + 17), now_, __ATOMIC_RELAXED, __HIP_MEMORY_SCOPE_AGENT);
            else __hip_atomic_store((unsigned*)(F.ctl + 16), now_ - __hip_atomic_load((unsigned*)(F.ctl + 17), __ATOMIC_RELAXED, __HIP_MEMORY_SCOPE_AGENT), __ATOMIC_RELAXED, __HIP_MEMORY_SCOPE_AGENT); }
#define GRID_BARRIER() do { XcdBarrier b2 = bar; GAS unsigned* bg = (GAS unsigned*)bar.bar; asm volatile("" : "+s"(bg), "+s"(b2.x)); b2.bar = (unsigned*)bg; xcd_barrier(b2); } while (0)
#pragma unroll 1
        for (int rp = 0; rp < nrep; ++rp) { const bool dummy = rp + 1 < nrep; (void)dummy;
        if (p == 0) p0_prologue(F, A2);
        else if (p == 25) { if (!(FUSE_FINAL_NORM && F.G == 256)) final_norm(F, A2); }
        else if (s == 0 && even) {
            pg8::Gemm g{XB, (const bf16*)((unsigned char*)wb + W_ABIN + j * SZ_ABIN), M, AB_N, D}; pg8::StaticOrder S; S.init(M, AB_N, F.G, bx);
            pg8::EpiAB E{(bf16*)(ws + WS_QKVU), (size_t)M * 512, SSQ, QSCALE};
            pg8::gemm_phase<pg8::EpiAB, pg8::StaticOrder, true, true>(F.lds + RING_OFF, g, S, E);
            for (int jb = F.vcu; jb < M / 64; jb += F.G) fgate_job(F, A2, j, jb);
            if (L0_SPLIT && l == 0 && !dummy) convert_layer_weights(F, A2, 0, F.vcu * NWAVES + F.wave, F.G * NWAVES, I_ABIN, I_ABIN + I_SQ + I_FIN);
        } else if (s == 0) {
            pg8::Gemm g{XB, (const bf16*)((unsigned char*)wb + W_CIN + j * SZ_CIN), M, C_COLS, D}; pg8::StaticOrder S; S.init(M, C_COLS, F.G, bx);
            pg8::EpiHG E{(bf16*)(ws + WS_HQ), (bf16*)(ws + WS_KD), (bf16*)(ws + WS_KT), (bf16*)(ws + WS_HV), (size_t)M * D, (float*)(ws + WS_DEC), (const float*)(ws + WS_LB) + (size_t)j * D, SSQ, j == 0};
            static_assert(WS_HG == WS_HV + (size_t)M * D * 2, "V | G consecutive");
            pg8::gemm_phase<pg8::EpiHG, pg8::StaticOrder, true, true>(F.lds + RING_OFF, g, S, E);
        } else if (s == 1 && even) {
            if (F.vcu & 1) for (int jb = F.vcu; jb < M / 64; jb += F.G) conv_job(F, A2, j, jb);
#if ATTN_NAIVE
            for (int u = F.vcu; u < 256; u += F.G) attn_naive_unit(F, A2, u);
#else
            { const attn_body::AttnTensors AT{(const attn_body::bf16*)(ws + WS_QKVU), (const attn_body::bf16*)(ws + WS_QKVU + T512), (const attn_body::bf16*)(ws + WS_QKVU + 2 * T512), (attn_body::bf16*)(ws + WS_AO),
                                               (const float*)(ws + WS_CL), (const float*)(ws + WS_BT)};
              const attn_body::StaticOrder S((int)F.G, bx);
              attn_body::attn_phase<attn_body::StaticOrder>((char*)lds + RING_OFF, AT, S); }
#endif
            if (!(F.vcu & 1)) for (int jb = F.vcu; jb < M / 64; jb += F.G) conv_job(F, A2, j, jb);
            if (L0_SPLIT && l == 0 && !dummy) { __syncthreads(); convert_layer_weights(F, A2, 0, F.vcu * NWAVES + F.wave, F.G * NWAVES, I_ABIN + I_SQ + I_FIN, 1 << 30); }
        } else if (s == 1) {
            for (int u = F.vcu; u < 256; u += F.G) hg::hgrn_unit(F.lds + RING_OFF, (const unsigned short*)(ws + WS_HQ), (const unsigned short*)(ws + WS_KD), (const unsigned short*)(ws + WS_KT), (const float*)(ws + WS_DEC), (const unsigned short*)(ws + WS_HV), (unsigned short*)(ws + WS_HO), u);
        } else if (s == 2) {
            hgrn_gate(F, A2, j);
        } else if (s == 4) {
            pg8::Gemm g{XB, (const bf16*)((unsigned char*)wb + W_FIN + l * SZ_FIN), M, FF2, D}; pg8::StaticOrder S; S.init(M, FF2, F.G, bx);
            pg8::EpiSwi E{(bf16*)(ws + WS_H), SSQ};
            pg8::gemm_phase<pg8::EpiSwi, pg8::StaticOrder, true, true>(F.lds + RING_OFF, g, S, E, (TS_EPI && p == TS_PHASE) ? (unsigned*)(F.ctl + 16) : (unsigned*)(F.ctl + 20));
#if WCONV_IN_FFN_TAIL
            { const int nfull = (M / 256) * (FF2 / 256) - (((M / 256) * (FF2 / 256)) / F.G) * F.G;
              if (l + 1 < DEPTH && !dummy && bx >= nfull) convert_layer_weights(F, A2, l + 1, (bx - nfull) * NWAVES + F.wave, (F.G - nfull) * NWAVES); }
#endif
        } else {
            const bool dn = (s == 5);
            const bf16* A = dn ? (const bf16*)(ws + WS_H) : (even ? (const bf16*)(ws + WS_AO) : (const bf16*)(ws + WS_HQ));
            const size_t wo = dn ? (W_FOUT + l * SZ_FOUT) : (even ? (W_ABOUT + j * SZ_ABOUT) : (W_COUT + j * SZ_COUT));
            pg8::Gemm g{A, (const bf16*)((unsigned char*)wb + wo), M, D, dn ? FFH : D}; pg8::StaticOrder S; S.init(M, D, F.G, bx);
#if FUSE_FINAL_NORM
            if (p == 24 && !dummy && F.G == 256) {
                pg8::EpiResFinal E{XB, A2.out, (float*)(ws + WS_XS), (unsigned*)(F.ctl + CW_FIN), A2.in[3]};
                pg8::gemm_phase<pg8::EpiResFinal, pg8::StaticOrder, true, true>(F.lds + RING_OFF, g, S, E);
            } else
#endif
            { pg8::EpiRes E{XB, dummy ? (bf16*)(ws + WS_MIX + (dn ? 96 * MiB : 0)) : XB, SSQ};
              pg8::gemm_phase<pg8::EpiRes, pg8::StaticOrder, true, true>(F.lds + RING_OFF, g, S, E); }
        }
        if (dummy) GRID_BARRIER();
        }
        if (TS_PHASE_END < 0 && TS_PHASE >= 0 && p == TS_PHASE && bx == 0 && threadIdx.x == 0) { const unsigned dt_ = (unsigned)__builtin_amdgcn_s_memrealtime() - __hip_atomic_load((unsigned*)(F.ctl + 17), __ATOMIC_RELAXED, __HIP_MEMORY_SCOPE_AGENT); __hip_atomic_store((unsigned*)(F.ctl + 16), dt_, __ATOMIC_RELAXED, __HIP_MEMORY_SCOPE_AGENT); }
        if (p + 1 < hi && !(FUSE_FINAL_NORM && F.G == 256 && p >= 24)) { GRID_BARRIER(); if ((PROBE_MASK >> 10) & 1) GRID_BARRIER(); }
    }
}

extern "C" void kernel_launch(void* const* d_in, const int* in_sizes, int n_in, void* d_out, int out_size, void* d_ws, size_t ws_size, hipStream_t stream) {
    static int grid = 0;
    if (grid == 0) {
        if (n_in != 14 || in_sizes[0] != M * D || out_size != M * D || ws_size < WS_END) { fprintf(stderr, "kernel_launch: unexpected shapes / workspace (n_in %d, ws %zu, need %zu)\n", n_in, ws_size, (size_t)WS_END); grid = -1; return; }
        int dev = 0, cus = 0;
        if (hipGetDevice(&dev) != hipSuccess || hipDeviceGetAttribute(&cus, hipDeviceAttributeMultiprocessorCount, dev) != hipSuccess) { grid = -1; return; }
        if (hipFuncSetAttribute((const void*)trunk_fwd, hipFuncAttributeMaxDynamicSharedMemorySize, LDS_BYTES) != hipSuccess) { fprintf(stderr, "kernel_launch: hipFuncSetAttribute failed\n"); grid = -1; return; }
        int per_cu = 0; (void)hipOccupancyMaxActiveBlocksPerMultiprocessor(&per_cu, (const void*)trunk_fwd, NWAVES * 64, LDS_BYTES); (void)hipGetLastError();
        grid = cus;
    }
    if (grid < 0) return;
    (void)hipMemsetAsync((char*)d_ws + WS_CTL, 0, CTL_ZERO_BYTES, stream);
    Args a{};
    for (int i = 0; i < 14; ++i) a.in[i] = (const float*)d_in[i];
    a.out = (float*)d_out; a.ws = (unsigned char*)d_ws;
#if MK_PER_PHASE
    for (int p = 0; p < N_PHASES; ++p) { const int l = (p - 1) / 6, s = (p - 1) % 6; if (p >= 1 && p <= 24 && s == 2 && (l & 1) == 0) continue;
        a.ph_lo = p; a.ph_hi = p + 1; a.li = 0; hipLaunchKernelGGL(trunk_fwd, dim3(grid), dim3(NWAVES * 64), LDS_BYTES, stream, a); }
#else
    a.ph_lo = 0; a.ph_hi = N_PHASES; a.li = 0;
    hipLaunchKernelGGL(trunk_fwd, dim3(grid), dim3(NWAVES * 64), LDS_BYTES, stream, a);
#endif
}
```

```cpp
#include <hip/hip_runtime.h>
#include <cstdio>
#include <cstdint>
#include <cmath>
#ifndef TS_EPI
#define TS_EPI 0
#endif
namespace pg8 {
#define PG8_LAS __attribute__((address_space(3)))
typedef unsigned short bf16_t;
typedef short bf16x8 __attribute__((ext_vector_type(8)));
typedef float f32x4 __attribute__((ext_vector_type(4)));
typedef unsigned u32x4 __attribute__((ext_vector_type(4)));
constexpr int BM = 256, BK = 64, HALF = 128, HTB = HALF * BK * 2  , STAGE_BYTES = 8 * HTB, NXCD = 8, WGM = 4;

__host__ __device__ __forceinline__ int lds_byte(int r, int c) { const int st = (r >> 4) * 2 + (c >> 5), rr = r & 15, cc = c & 31, ob = rr * 64 + cc * 2; return st * 1024 + (ob ^ (((ob >> 9) & 1) << 5)); }
__host__ __device__ __forceinline__ void stage_rc(int b, int& R, int& C) { const int st = b / 1024, sb = b % 1024, swz = sb ^ (((sb >> 9) & 1) << 5); R = (st >> 1) * 16 + swz / 64; C = (st & 1) * 32 + (swz % 64) / 2; }
__host__ __device__ __forceinline__ int perm32(int rho) { const int n = rho >> 4, i = rho & 15; return 8 * (i >> 2) + 4 * n + (i & 3); }

struct Unit { int pm, pn; };
struct Gemm { const bf16_t* A; const bf16_t* Bt; int M, N, K; };

struct StaticOrder {
    int nM, nN, nwg, G, c;
    __host__ __device__ void init(int M, int N, int G_, int c_) { nM = M / BM; nN = N / BM; nwg = nM * nN; G = G_; c = c_; }
    __host__ __device__ bool next(int i, Unit& u) const {
        const long L = (long)i * G + c; if (L >= nwg) return false;
        int wgid = (int)L; { const int q = nwg / NXCD, r = nwg % NXCD, xcd = wgid % NXCD, off = wgid / NXCD; wgid = (xcd < r ? xcd * (q + 1) : r * (q + 1) + (xcd - r) * q) + off; }
        const int nig = WGM * nN, gid = wgid / nig, fm = gid * WGM, gsz = (nM - fm) < WGM ? (nM - fm) : WGM;
        u.pm = fm + ((wgid % nig) % gsz); u.pn = (wgid % nig) / gsz; return true;
    }
    __device__ __forceinline__ void a_ready(const Unit&) const {}
    __device__ __forceinline__ void done(const Unit&) const {}
};


__device__ __forceinline__ unsigned cvt_pk_bf16(float lo, float hi) { typedef float f2_ __attribute__((ext_vector_type(2))); typedef __bf16 b2_ __attribute__((ext_vector_type(2))); f2_ v = {lo, hi}; b2_ b = __builtin_convertvector(v, b2_); return __builtin_bit_cast(unsigned, b); }
typedef unsigned u32x2 __attribute__((ext_vector_type(2)));
constexpr float RMS_EPS = 1e-6f;
__device__ __forceinline__ float row_rstd(const float* ssq, int row) {
    const f32x4* p = (const f32x4*)(ssq + (size_t)row * 16);
    const f32x4 a = p[0], b = p[1], c = p[2], d = p[3];
    const float s = (((a[0] + a[1]) + (a[2] + a[3])) + ((b[0] + b[1]) + (b[2] + b[3]))) + (((c[0] + c[1]) + (c[2] + c[3])) + ((d[0] + d[1]) + (d[2] + d[3])));
    return __builtin_amdgcn_rsqf(s * (1.0f / 1024.0f) + RMS_EPS);
}
__device__ __forceinline__ float row_rstd_q(const float* ssq, int row, int fq) {
    const f32x4 a = *((const f32x4*)(ssq + (size_t)row * 16) + fq);
    float s = (a[0] + a[1]) + (a[2] + a[3]);
    s += __shfl_xor(s, 16); s += __shfl_xor(s, 32);
    return __builtin_amdgcn_rsqf(s * (1.0f / 1024.0f) + RMS_EPS);
}
__device__ __forceinline__ void row_rstd_half(const float* ssq, int rowh, int fq, float (&rs)[4]) {
    f32x4 a[4];
#pragma unroll
    for (int m = 0; m < 4; ++m) a[m] = *((const f32x4*)(ssq + (size_t)(rowh + m * 16) * 16) + fq);
#pragma unroll
    for (int m = 0; m < 4; ++m) { float s = (a[m][0] + a[m][1]) + (a[m][2] + a[m][3]); s += __shfl_xor(s, 16); s += __shfl_xor(s, 32); rs[m] = __builtin_amdgcn_rsqf(s * (1.0f / 1024.0f) + RMS_EPS); }
}
__device__ __forceinline__ float sigmoid_f(float z) { return __builtin_amdgcn_rcpf(1.0f + __expf(-z)); }

struct EpiAB {
    static constexpr bool PERM = true, AFTER_DRAIN = false; static constexpr int NS_MIN = 16;
    bf16_t* O; size_t tstride; const float* ssq; float qscale;
    __device__ __forceinline__ void operator()(const f32x4 (&acc)[2][2][4][2], const Unit& u, int wr, int wc, int fr, int fq) const {
        const int t = u.pn >> 1; bf16_t* base = O + (size_t)t * tstride;
        const int col0 = (u.pn & 1) * 256 + wc * 32 + 8 * fq, row0 = u.pm * BM + wr * 64 + fr;
        const float sc0 = (t == 0) ? qscale : 1.0f;
#pragma unroll
        for (int ai = 0; ai < 2; ++ai) { float rsv[4]; row_rstd_half(ssq, row0 + ai * HALF, fq, rsv);
#pragma unroll
            for (int m = 0; m < 4; ++m) { const int row = row0 + ai * HALF + m * 16; const float rs = rsv[m] * sc0; bf16_t* rowp = base + (size_t)row * 512 + col0;
#pragma unroll
                for (int bj = 0; bj < 2; ++bj) { const f32x4 v0 = acc[ai][bj][m][0] * rs, v1 = acc[ai][bj][m][1] * rs;
                    u32x4 w; w.x = cvt_pk_bf16(v0[0], v0[1]); w.y = cvt_pk_bf16(v0[2], v0[3]); w.z = cvt_pk_bf16(v1[0], v1[1]); w.w = cvt_pk_bf16(v1[2], v1[3]);
                    *(u32x4*)(rowp + bj * HALF) = w; } } }
    }
};
struct EpiRes {
    static constexpr bool PERM = true, AFTER_DRAIN = false; static constexpr int NS_MIN = 16;
    const bf16_t* base; bf16_t* out; float* ssq;
    __device__ __forceinline__ void operator()(const f32x4 (&acc)[2][2][4][2], const Unit& u, int wr, int wc, int fr, int fq) const {
        const int col0 = u.pn * BM + wc * 32 + 8 * fq;
#pragma unroll
        for (int ai = 0; ai < 2; ++ai) {
            u32x4 b[4][2];
#pragma unroll
            for (int m = 0; m < 4; ++m)
#pragma unroll
                for (int bj = 0; bj < 2; ++bj) b[m][bj] = *(const u32x4*)(base + (size_t)(u.pm * BM + ai * HALF + wr * 64 + m * 16 + fr) * 1024 + col0 + bj * HALF);
#pragma unroll
            for (int m = 0; m < 4; ++m) { const int row = u.pm * BM + ai * HALF + wr * 64 + m * 16 + fr; const size_t off = (size_t)row * 1024 + col0; float s = 0.f;
#pragma unroll
                for (int bj = 0; bj < 2; ++bj) { const u32x4 bb = b[m][bj]; f32x4 x0 = acc[ai][bj][m][0], x1 = acc[ai][bj][m][1];
                    x0[0] += __uint_as_float(bb.x << 16); x0[1] += __uint_as_float(bb.x & 0xffff0000u); x0[2] += __uint_as_float(bb.y << 16); x0[3] += __uint_as_float(bb.y & 0xffff0000u);
                    x1[0] += __uint_as_float(bb.z << 16); x1[1] += __uint_as_float(bb.z & 0xffff0000u); x1[2] += __uint_as_float(bb.w << 16); x1[3] += __uint_as_float(bb.w & 0xffff0000u);
                    u32x4 w; w.x = cvt_pk_bf16(x0[0], x0[1]); w.y = cvt_pk_bf16(x0[2], x0[3]); w.z = cvt_pk_bf16(x1[0], x1[1]); w.w = cvt_pk_bf16(x1[2], x1[3]);
                    *(u32x4*)(out + off + bj * HALF) = w;
                    const float r0 = __uint_as_float(w.x << 16), r1 = __uint_as_float(w.x & 0xffff0000u), r2 = __uint_as_float(w.y << 16), r3 = __uint_as_float(w.y & 0xffff0000u);
                    const float r4 = __uint_as_float(w.z << 16), r5 = __uint_as_float(w.z & 0xffff0000u), r6 = __uint_as_float(w.w << 16), r7 = __uint_as_float(w.w & 0xffff0000u);
                    s += ((r0 * r0 + r1 * r1) + (r2 * r2 + r3 * r3)) + ((r4 * r4 + r5 * r5) + (r6 * r6 + r7 * r7)); }
                s += __shfl_xor(s, 16); s += __shfl_xor(s, 32);
                if (fq == 0) ssq[(size_t)row * 16 + u.pn * 4 + wc] = s; }
        }
    }
};
struct EpiResFinal {
    static constexpr bool PERM = true, AFTER_DRAIN = false; static constexpr int NS_MIN = 0;
    const bf16_t* base; float* out; float* xs; unsigned* cnt; const float* gain;
    __device__ __forceinline__ void operator()(const f32x4 (&acc)[2][2][4][2], const Unit& u, int wr, int wc, int fr, int fq) const {
        const int col0 = u.pn * BM + wc * 32 + 8 * fq, rowb = u.pm * BM + wr * 64 + fr;
#pragma unroll
        for (int ai = 0; ai < 2; ++ai) { u32x4 b[4][2];
#pragma unroll
            for (int m = 0; m < 4; ++m)
#pragma unroll
                for (int bj = 0; bj < 2; ++bj) b[m][bj] = *(const u32x4*)(base + (size_t)(rowb + ai * HALF + m * 16) * 1024 + col0 + bj * HALF);
#pragma unroll
            for (int m = 0; m < 4; ++m) { const int row = rowb + ai * HALF + m * 16; float s = 0.f;
#pragma unroll
                for (int bj = 0; bj < 2; ++bj) { const u32x4 bb = b[m][bj]; const f32x4 a0 = acc[ai][bj][m][0], a1 = acc[ai][bj][m][1];
                    const float x0 = a0[0] + __uint_as_float(bb.x << 16), x1 = a0[1] + __uint_as_float(bb.x & 0xffff0000u), x2 = a0[2] + __uint_as_float(bb.y << 16), x3 = a0[3] + __uint_as_float(bb.y & 0xffff0000u);
                    const float x4 = a1[0] + __uint_as_float(bb.z << 16), x5 = a1[1] + __uint_as_float(bb.z & 0xffff0000u), x6 = a1[2] + __uint_as_float(bb.w << 16), x7 = a1[3] + __uint_as_float(bb.w & 0xffff0000u);
                    s += ((x0 * x0 + x1 * x1) + (x2 * x2 + x3 * x3)) + ((x4 * x4 + x5 * x5) + (x6 * x6 + x7 * x7)); }
                s += __shfl_xor(s, 16); s += __shfl_xor(s, 32);
                if (fq == 0) __hip_atomic_store(xs + (size_t)row * 16 + u.pn * 4 + wc, s, __ATOMIC_RELAXED, __HIP_MEMORY_SCOPE_AGENT); } }
        asm volatile("s_waitcnt vmcnt(0)" ::: "memory");
        unsigned* const pc = cnt + 64 * u.pm;
        if ((threadIdx.x & 63) == 0) __hip_atomic_fetch_add(pc, 1u, __ATOMIC_RELAXED, __HIP_MEMORY_SCOPE_AGENT);
        { const unsigned long long t0 = __builtin_amdgcn_s_memrealtime();
          while ((unsigned)__builtin_amdgcn_readfirstlane(__hip_atomic_load(pc, __ATOMIC_RELAXED, __HIP_MEMORY_SCOPE_AGENT)) < 32u) {
              if (__builtin_amdgcn_s_memrealtime() - t0 > 2000000ull) break;
              __builtin_amdgcn_s_sleep(2); } }
        asm volatile("" ::: "memory");
        const f32x4 g0 = *(const f32x4*)(gain + col0), g1 = *(const f32x4*)(gain + col0 + 4), g2 = *(const f32x4*)(gain + col0 + HALF), g3 = *(const f32x4*)(gain + col0 + HALF + 4);
#pragma unroll
        for (int ai = 0; ai < 2; ++ai) { u32x4 b[4][2]; float rs[4];
#pragma unroll
            for (int m = 0; m < 4; ++m) { const int row = rowb + ai * HALF + m * 16; const float* xp = xs + (size_t)row * 16 + 4 * fq;
                float s = (__hip_atomic_load(xp, __ATOMIC_RELAXED, __HIP_MEMORY_SCOPE_AGENT) + __hip_atomic_load(xp + 1, __ATOMIC_RELAXED, __HIP_MEMORY_SCOPE_AGENT))
                        + (__hip_atomic_load(xp + 2, __ATOMIC_RELAXED, __HIP_MEMORY_SCOPE_AGENT) + __hip_atomic_load(xp + 3, __ATOMIC_RELAXED, __HIP_MEMORY_SCOPE_AGENT));
                s += __shfl_xor(s, 16); s += __shfl_xor(s, 32); rs[m] = __builtin_amdgcn_rsqf(s * (1.0f / 1024.0f) + RMS_EPS);
#pragma unroll
                for (int bj = 0; bj < 2; ++bj) b[m][bj] = *(const u32x4*)(base + (size_t)row * 1024 + col0 + bj * HALF); }
#pragma unroll
            for (int m = 0; m < 4; ++m) { const int row = rowb + ai * HALF + m * 16; const float r = rs[m]; float* op = out + (size_t)row * 1024 + col0;
#pragma unroll
                for (int bj = 0; bj < 2; ++bj) { const u32x4 bb = b[m][bj]; const f32x4 a0 = acc[ai][bj][m][0], a1 = acc[ai][bj][m][1]; const f32x4 ga = bj ? g2 : g0, gb = bj ? g3 : g1;
                    f32x4 o0, o1;
                    o0[0] = (a0[0] + __uint_as_float(bb.x << 16)) * r * ga[0]; o0[1] = (a0[1] + __uint_as_float(bb.x & 0xffff0000u)) * r * ga[1];
                    o0[2] = (a0[2] + __uint_as_float(bb.y << 16)) * r * ga[2]; o0[3] = (a0[3] + __uint_as_float(bb.y & 0xffff0000u)) * r * ga[3];
                    o1[0] = (a1[0] + __uint_as_float(bb.z << 16)) * r * gb[0]; o1[1] = (a1[1] + __uint_as_float(bb.z & 0xffff0000u)) * r * gb[1];
                    o1[2] = (a1[2] + __uint_as_float(bb.w << 16)) * r * gb[2]; o1[3] = (a1[3] + __uint_as_float(bb.w & 0xffff0000u)) * r * gb[3];
                    *(f32x4*)(op + bj * HALF) = o0; *(f32x4*)(op + bj * HALF + 4) = o1; } } }
    }
};
template <int SH> __device__ __forceinline__ float row_shr(float v) { return __builtin_bit_cast(float, __builtin_amdgcn_update_dpp(0, __builtin_bit_cast(int, v), 0x110 + SH, 0xf, 0xf, true)); }
__device__ __forceinline__ float rowscan16(float v) { v += row_shr<1>(v); v += row_shr<2>(v); v += row_shr<4>(v); v += row_shr<8>(v); return v; }
__device__ __forceinline__ float rowlast16(float v) { return __builtin_bit_cast(float, __builtin_amdgcn_update_dpp(0, __builtin_bit_cast(int, v), 0x15F, 0xf, 0xf, true)); }
struct EpiHG {
    static constexpr bool PERM = true, AFTER_DRAIN = false; static constexpr int NS_MIN = 16;
    bf16_t* QA; bf16_t* KD; bf16_t* KT; bf16_t* V; size_t tstride; float* DEC; const float* lb; const float* ssq; bool lbzero;
    __device__ __forceinline__ void operator()(const f32x4 (&acc)[2][2][4][2], const Unit& u, int wr, int wc, int fr, int fq) const {
        const int row0 = u.pm * BM + wr * 64 + fr;
        if (u.pn >= 8) {
            const int tt = (u.pn >= 12) ? 1 : 0; const int col0 = ((u.pn - 8) & 3) * 256 + wc * 32 + 8 * fq; bf16_t* const dbase = V + (size_t)tt * tstride;
#pragma unroll
            for (int ai = 0; ai < 2; ++ai) { float rsv[4]; row_rstd_half(ssq, row0 + ai * HALF, fq, rsv);
#pragma unroll
                for (int m = 0; m < 4; ++m) { const int row = row0 + ai * HALF + m * 16; const float rs = rsv[m]; const size_t off = (size_t)row * 1024 + col0;
#pragma unroll
                    for (int bj = 0; bj < 2; ++bj) { f32x4 v0 = acc[ai][bj][m][0] * rs, v1 = acc[ai][bj][m][1] * rs;
                        if (tt == 1) {
#pragma unroll
                            for (int i = 0; i < 4; ++i) { v0[i] = v0[i] * sigmoid_f(v0[i]); v1[i] = v1[i] * sigmoid_f(v1[i]); } }
                        u32x4 w; w.x = cvt_pk_bf16(v0[0], v0[1]); w.y = cvt_pk_bf16(v0[2], v0[3]); w.z = cvt_pk_bf16(v1[0], v1[1]); w.w = cvt_pk_bf16(v1[2], v1[3]);
                        *(u32x4*)(dbase + off + bj * HALF) = w; } } }
            return;
        }
        if (lbzero) heavy<true>(acc, u, wc, fr, fq, row0); else heavy<false>(acc, u, wc, fr, fq, row0);
    }
    template <bool LBZ> __device__ __forceinline__ void heavy(const f32x4 (&acc)[2][2][4][2], const Unit& u, int wc, int fr, int fq, int row0) const {
        const int colh = u.pn * HALF + wc * 32 + 8 * fq;
        f32x4 lbv[2], oml[2];
#pragma unroll
        for (int n = 0; n < 2; ++n) { lbv[n] = LBZ ? (f32x4){0.f, 0.f, 0.f, 0.f} : *(const f32x4*)(lb + colh + 4 * n); oml[n] = 1.0f - lbv[n]; }
#pragma unroll
        for (int ai = 0; ai < 2; ++ai) { float rsv[4]; row_rstd_half(ssq, row0 + ai * HALF, fq, rsv);
#pragma unroll
            for (int c2 = 0; c2 < 2; ++c2) {
                const int rowE = row0 + ai * HALF + (2 * c2) * 16, rowO = rowE + 16;
                const float rsE = rsv[2 * c2], rsO = rsv[2 * c2 + 1];
#pragma unroll
                for (int n = 0; n < 2; ++n) { float oq[2][4], od[2][4], ot[2][4]; f32x4 dec;
#pragma unroll
                    for (int i = 0; i < 4; ++i) {
                        float lf[2], kk[2], qq[2];
#pragma unroll
                        for (int eo = 0; eo < 2; ++eo) { const float rs = eo ? rsO : rsE; const float z = acc[ai][1][2 * c2 + eo][n][i] * rs; qq[eo] = acc[ai][0][2 * c2 + eo][n][i] * rs;
                            const float e = __builtin_amdgcn_exp2f(-fabsf(z) * 1.4426950408889634f), d = __builtin_amdgcn_rcpf(1.0f + e), ed = e * d; const bool pos = z >= 0.f;
                            if (LBZ) { kk[eo] = pos ? ed : d; lf[eo] = fminf(z, 0.f) * 1.4426950408889634f - __builtin_amdgcn_logf(1.0f + e); }
                            else { kk[eo] = oml[n][i] * (pos ? ed : d); lf[eo] = __builtin_amdgcn_logf(lbv[n][i] + oml[n][i] * (pos ? d : ed)); } }
                        const float bE = rowscan16(lf[0]); const float totE = rowlast16(bE); const float bO = rowscan16(lf[1]) + totE; const float bl = rowlast16(bO);
                        oq[0][i] = qq[0] * __builtin_amdgcn_exp2f(bE); oq[1][i] = qq[1] * __builtin_amdgcn_exp2f(bO);
                        od[0][i] = kk[0] * __builtin_amdgcn_exp2f(fminf(-bE, 100.f)); od[1][i] = kk[1] * __builtin_amdgcn_exp2f(fminf(-bO, 100.f));
                        ot[0][i] = kk[0] * __builtin_amdgcn_exp2f(bl - bE); ot[1][i] = kk[1] * __builtin_amdgcn_exp2f(bl - bO);
                        dec[i] = __builtin_amdgcn_exp2f(bl); }
#pragma unroll
                    for (int eo = 0; eo < 2; ++eo) { const size_t off = (size_t)(eo ? rowO : rowE) * 1024 + colh + 4 * n; u32x2 w;
                        w.x = cvt_pk_bf16(oq[eo][0], oq[eo][1]); w.y = cvt_pk_bf16(oq[eo][2], oq[eo][3]); *(u32x2*)(QA + off) = w;
                        w.x = cvt_pk_bf16(od[eo][0], od[eo][1]); w.y = cvt_pk_bf16(od[eo][2], od[eo][3]); *(u32x2*)(KD + off) = w;
                        w.x = cvt_pk_bf16(ot[eo][0], ot[eo][1]); w.y = cvt_pk_bf16(ot[eo][2], ot[eo][3]); *(u32x2*)(KT + off) = w; }
                    if (fr == 0) *(f32x4*)(DEC + (size_t)(rowE >> 5) * 1024 + colh + 4 * n) = dec;
                    asm volatile("" ::: "memory"); }
            } }
    }
};
struct EpiSwi {
    static constexpr bool PERM = true, AFTER_DRAIN = false; static constexpr int NS_MIN = 8;
    bf16_t* H; const float* ssq;
    __device__ __forceinline__ void operator()(const f32x4 (&acc)[2][2][4][2], const Unit& u, int wr, int wc, int fr, int fq) const {
        const int col0 = u.pn * HALF + wc * 32 + 8 * fq, row0 = u.pm * BM + wr * 64 + fr;
#pragma unroll
        for (int ai = 0; ai < 2; ++ai) { float rsv[4]; row_rstd_half(ssq, row0 + ai * HALF, fq, rsv);
#pragma unroll
            for (int m = 0; m < 4; ++m) { const int row = row0 + ai * HALF + m * 16; const float rs = rsv[m];
                f32x4 h[2];
#pragma unroll
                for (int n = 0; n < 2; ++n) { const f32x4 g = acc[ai][0][m][n] * rs, uu = acc[ai][1][m][n] * rs;
#pragma unroll
                    for (int i = 0; i < 4; ++i) h[n][i] = g[i] * sigmoid_f(g[i]) * uu[i]; }
                u32x4 w; w.x = cvt_pk_bf16(h[0][0], h[0][1]); w.y = cvt_pk_bf16(h[0][2], h[0][3]); w.z = cvt_pk_bf16(h[1][0], h[1][1]); w.w = cvt_pk_bf16(h[1][2], h[1][3]);
                *(u32x4*)(H + (size_t)row * 2816 + col0) = w; } }
    }
};
template <class Epi, class Sched, bool ALIGN_EPI = false, bool SP2 = false>
__device__ __forceinline__ void gemm_phase(PG8_LAS unsigned char* lds, const Gemm g, const Sched& S, const Epi& E, unsigned* ts_out = nullptr) {
    int tid_ = threadIdx.x; asm volatile("" : "+v"(tid_));
    const int tid = tid_, wid = __builtin_amdgcn_readfirstlane(tid >> 6), lane = tid & 63, wr = wid >> 2, wc = wid & 3, fr = lane & 15, fq = lane >> 4;
    const int K = g.K, nt = K / BK;
    unsigned voffA[2], voffB[2];
#pragma unroll
    for (int i = 0; i < 2; ++i) { int R, C; stage_rc(tid * 16 + i * 8192, R, C); const int Rb = Epi::PERM ? ((R & ~31) + perm32(R & 31)) : R;
        voffA[i] = (unsigned)(R * K + C) * 2u; voffB[i] = (unsigned)(Rb * K + C) * 2u; }
    const size_t kstep = (size_t)(BK * 2);
    const size_t hstep = (size_t)HALF * K * 2;
    const size_t tstep = 2 * hstep;
    const unsigned ldsw = (unsigned)wid * 1024u;
    const int aoff = lds_byte(wr * 64 + fr, fq * 8), boff = lds_byte(wc * 32 + fr, fq * 8);
#define PG8_SA(b, h) (((b) * 2 + (h)) * HTB)
#define PG8_SB(b, h) ((4 + (b) * 2 + (h)) * HTB)
#define PG8_STAGE(bufoff, gbase, voff) do { _Pragma("unroll") for (int _i = 0; _i < 2; ++_i) \
        __builtin_amdgcn_global_load_lds((const unsigned*)((const char*)(gbase) + (voff)[_i]), (PG8_LAS unsigned*)(lds + (bufoff) + ldsw + _i * 8192), 16, 0, 0); } while (0)
#define PG8_LDA(dst, b, h) do { _Pragma("unroll") for (int m = 0; m < 4; ++m) _Pragma("unroll") for (int k = 0; k < 2; ++k) dst[m][k] = *(const PG8_LAS bf16x8*)(lds + PG8_SA(b, h) + aoff + m * 2048 + k * 1024); } while (0)
#define PG8_LDB(dst, b, h) do { _Pragma("unroll") for (int n = 0; n < 2; ++n) _Pragma("unroll") for (int k = 0; k < 2; ++k) dst[n][k] = *(const PG8_LAS bf16x8*)(lds + PG8_SB(b, h) + boff + n * 2048 + k * 1024); } while (0)
#define PG8_MMA(ai, bj, At, Bt) do { __builtin_amdgcn_s_setprio(1); _Pragma("unroll") for (int m = 0; m < 4; ++m) _Pragma("unroll") for (int n = 0; n < 2; ++n) _Pragma("unroll") for (int k = 0; k < 2; ++k) \
        acc[ai][bj][m][n] = __builtin_amdgcn_mfma_f32_16x16x32_bf16(Bt[n][k], At[m][k], acc[ai][bj][m][n], 0, 0, 0); __builtin_amdgcn_s_setprio(0); } while (0)
#define PG8_WAIT_V(n) asm volatile("s_waitcnt vmcnt(" #n ")" ::: "memory")
#define PG8_WAIT_V8_SEL(rlx, n) asm volatile("s_cmp_lg_u32 %0, 0\n\ts_cbranch_scc1 .Lpg8_rlx_%=\n\ts_waitcnt vmcnt(8)\n\ts_branch .Lpg8_end_%=\n.Lpg8_rlx_%=:\n\ts_waitcnt vmcnt(" #n ")\n.Lpg8_end_%=:" :: "s"(rlx) : "scc", "memory")
#define PG8_WAIT_V8_FIRST(rlx) do { if constexpr (Epi::NS_MIN >= 16) PG8_WAIT_V8_SEL(rlx, 24); else if constexpr (Epi::NS_MIN >= 8) PG8_WAIT_V8_SEL(rlx, 16); else PG8_WAIT_V(8); } while (0)
#define PG8_WAIT_L(n) asm volatile("s_waitcnt lgkmcnt(" #n ")" ::: "memory")
#define PG8_BAR __builtin_amdgcn_s_barrier()
#define PG8_SCHED __builtin_amdgcn_sched_barrier(0)
    Unit cur, nxt; int ui = 0;
#if TS_EPI
    unsigned ts_epi_ = 0;
#endif
    if (!S.next(0, cur)) return;
    f32x4 acc[2][2][4][2];
#pragma unroll
    for (int a = 0; a < 2; ++a)
#pragma unroll
        for (int b = 0; b < 2; ++b)
#pragma unroll
            for (int m = 0; m < 4; ++m)
#pragma unroll
                for (int n = 0; n < 2; ++n) acc[a][b][m][n] = (f32x4){0.f, 0.f, 0.f, 0.f};
    bf16x8 At[4][2], B0[2][2], B1[2][2];
    const char* cA = (const char*)g.A + (size_t)cur.pm * tstep; const char* cB = (const char*)g.Bt + (size_t)cur.pn * tstep;
    S.a_ready(cur);
    if constexpr (SP2) {
        PG8_STAGE(PG8_SB(0, 0), cB, voffB); PG8_STAGE(PG8_SB(0, 1), cB + hstep, voffB); PG8_STAGE(PG8_SA(0, 0), cA, voffA); PG8_STAGE(PG8_SA(0, 1), cA + hstep, voffA);
        if (wr == 1) PG8_BAR;
        PG8_WAIT_V(2); PG8_BAR;
        PG8_STAGE(PG8_SB(1, 0), cB + kstep, voffB); PG8_STAGE(PG8_SA(1, 0), cA + kstep, voffA); PG8_STAGE(PG8_SB(1, 1), cB + hstep + kstep, voffB);
        PG8_WAIT_V(6); PG8_BAR;
    } else {
        PG8_STAGE(PG8_SB(0, 0), cB, voffB); PG8_STAGE(PG8_SA(0, 0), cA, voffA); PG8_STAGE(PG8_SB(0, 1), cB + hstep, voffB); PG8_STAGE(PG8_SA(0, 1), cA + hstep, voffA);
        if (wr == 1) PG8_BAR;
        PG8_WAIT_V(4); PG8_BAR;
        PG8_STAGE(PG8_SB(1, 0), cB + kstep, voffB); PG8_STAGE(PG8_SA(1, 0), cA + kstep, voffA); PG8_STAGE(PG8_SB(1, 1), cB + hstep + kstep, voffB);
        PG8_WAIT_V(6); PG8_BAR;
    }
    for (;;) {
        const bool has_next = S.next(ui + 1, nxt);
        const char* nA = has_next ? (const char*)g.A + (size_t)nxt.pm * tstep : cA; const char* nB = has_next ? (const char*)g.Bt + (size_t)nxt.pn * tstep : cB;
#if TS_EPI == 2
        const unsigned long long tk0_ = __builtin_amdgcn_s_memtime();
#endif
        for (int t = 0; t < nt; t += 2) {
            const bool last = (t == nt - 2);
            const char* a1 = cA + (size_t)(t + 1) * kstep;
            const char* a2 = last ? nA : cA + (size_t)(t + 2) * kstep; const char* b2 = last ? nB : cB + (size_t)(t + 2) * kstep;
            const char* a3 = a2 + kstep; const char* b3 = b2 + kstep;
            if (last && has_next) S.a_ready(nxt);
            const int relax_ = __builtin_amdgcn_readfirstlane(((t == 0) && (ui > 0)) ? 1 : 0);
            if constexpr (SP2) {
            PG8_LDB(B0, 0, 0); PG8_LDB(B1, 0, 1); PG8_SCHED; PG8_LDA(At, 0, 0); PG8_STAGE(PG8_SA(1, 1), a1 + hstep, voffA);
            PG8_WAIT_V8_FIRST(relax_); PG8_WAIT_L(0); PG8_BAR; PG8_MMA(0, 0, At, B0); PG8_MMA(0, 1, At, B1); PG8_BAR; PG8_SCHED;
            PG8_LDA(At, 0, 1); PG8_STAGE(PG8_SB(0, 0), b2, voffB); PG8_STAGE(PG8_SB(0, 1), b2 + hstep, voffB); PG8_STAGE(PG8_SA(0, 0), a2, voffA);
            PG8_WAIT_V8_FIRST(relax_); PG8_WAIT_L(0); PG8_BAR; PG8_MMA(1, 0, At, B0); PG8_MMA(1, 1, At, B1); PG8_BAR; PG8_SCHED;
            PG8_LDB(B0, 1, 0); PG8_LDB(B1, 1, 1); PG8_SCHED; PG8_LDA(At, 1, 0); PG8_STAGE(PG8_SA(0, 1), a2 + hstep, voffA);
            PG8_WAIT_V(8); PG8_WAIT_L(0); PG8_BAR; PG8_MMA(0, 0, At, B0); PG8_MMA(0, 1, At, B1); PG8_BAR; PG8_SCHED;
            PG8_LDA(At, 1, 1); PG8_STAGE(PG8_SB(1, 0), b3, voffB); PG8_STAGE(PG8_SB(1, 1), b3 + hstep, voffB); PG8_STAGE(PG8_SA(1, 0), a3, voffA);
            PG8_WAIT_V(8); PG8_WAIT_L(0); PG8_BAR; PG8_MMA(1, 0, At, B0); PG8_MMA(1, 1, At, B1); PG8_BAR; PG8_SCHED;
            } else {
            PG8_LDB(B0, 0, 0); PG8_SCHED; PG8_LDA(At, 0, 0); PG8_STAGE(PG8_SA(1, 1), a1 + hstep, voffA);
            PG8_WAIT_L(8); PG8_BAR; PG8_WAIT_L(0); PG8_MMA(0, 0, At, B0); PG8_BAR; PG8_SCHED;
            PG8_LDB(B1, 0, 1); PG8_STAGE(PG8_SB(0, 0), b2, voffB);
            PG8_BAR; PG8_WAIT_L(0); PG8_MMA(0, 1, At, B1); PG8_BAR;
            PG8_LDA(At, 0, 1); PG8_STAGE(PG8_SA(0, 0), a2, voffA);
            PG8_BAR; PG8_WAIT_L(0); PG8_MMA(1, 0, At, B0); PG8_BAR; PG8_SCHED;
            PG8_STAGE(PG8_SB(0, 1), b2 + hstep, voffB);
            PG8_WAIT_V(6); PG8_BAR; PG8_MMA(1, 1, At, B1); PG8_BAR;
            PG8_LDB(B0, 1, 0); PG8_SCHED; PG8_LDA(At, 1, 0); PG8_STAGE(PG8_SA(0, 1), a2 + hstep, voffA);
            PG8_WAIT_L(8); PG8_BAR; PG8_WAIT_L(0); PG8_MMA(0, 0, At, B0); PG8_BAR; PG8_SCHED;
            PG8_LDB(B1, 1, 1); PG8_STAGE(PG8_SB(1, 0), b3, voffB);
            PG8_BAR; PG8_WAIT_L(0); PG8_MMA(0, 1, At, B1); PG8_BAR;
            PG8_LDA(At, 1, 1); PG8_STAGE(PG8_SA(1, 0), a3, voffA);
            PG8_BAR; PG8_WAIT_L(0); PG8_MMA(1, 0, At, B0); PG8_BAR; PG8_SCHED;
            PG8_STAGE(PG8_SB(1, 1), b3 + hstep, voffB);
            PG8_WAIT_V(6); PG8_BAR; PG8_MMA(1, 1, At, B1); PG8_BAR;
            }
        }
#if TS_EPI == 2
        ts_epi_ += (unsigned)(__builtin_amdgcn_s_memtime() - tk0_);
#endif
        if constexpr (ALIGN_EPI) { if (wr == 0) PG8_BAR; }
#if TS_EPI == 1
        const unsigned long long te0_ = __builtin_amdgcn_s_memrealtime();
#endif
        if constexpr (!Epi::AFTER_DRAIN) { E(acc, cur, wr, wc, fr, fq); S.done(cur); }
#if TS_EPI == 1
        asm volatile("s_waitcnt vmcnt(0)" ::: "memory");
        ts_epi_ += (unsigned)(__builtin_amdgcn_s_memrealtime() - te0_);
#endif
        if (!has_next) break;
#pragma unroll
        for (int a = 0; a < 2; ++a)
#pragma unroll
            for (int b = 0; b < 2; ++b)
#pragma unroll
                for (int m = 0; m < 4; ++m)
#pragma unroll
                    for (int n = 0; n < 2; ++n) acc[a][b][m][n] = (f32x4){0.f, 0.f, 0.f, 0.f};
        cur = nxt; cA = nA; cB = nB; ++ui;
        if constexpr (ALIGN_EPI) { if (wr == 1) PG8_BAR; }
    }
#if TS_EPI
    if (blockIdx.x == 0 && threadIdx.x == 0) *ts_out = ts_epi_;
#endif
    PG8_WAIT_V(0);
    if constexpr (!ALIGN_EPI) { if (wr == 0) PG8_BAR; }
    PG8_BAR;
    if constexpr (Epi::AFTER_DRAIN) { E.fused(acc, cur, wr, wc, fr, fq, lds, wid, lane); S.done(cur); }
#undef PG8_SA
#undef PG8_SB
#undef PG8_STAGE
#undef PG8_LDA
#undef PG8_LDB
#undef PG8_MMA
#undef PG8_WAIT_V
#undef PG8_WAIT_V8_FIRST
#undef PG8_WAIT_V8_SEL
#undef PG8_WAIT_L
#undef PG8_BAR
#undef PG8_SCHED
}
}

#include <hip/hip_bf16.h>
#include <cmath>
namespace attn_body {
using bf16=__hip_bfloat16;
using bf16x8=__attribute__((ext_vector_type(8)))short;
using s16x4=__attribute__((ext_vector_type(4)))short;
using f32x16=__attribute__((ext_vector_type(16)))float;
using u32x4=__attribute__((ext_vector_type(4)))unsigned;
using f32x4_t=__attribute__((ext_vector_type(4)))float;
constexpr int BATCH=8,NHEAD=8,SEQ=2048,D=64,DM=NHEAD*D,OPITCH=1024;
constexpr int NW=8,QBLK=32,QB=QBLK*NW,KVBLK=64,NQB=SEQ/QB;
constexpr int ATTN_PITCH=DM, ATTN_UNIT_ROWS=QB;
constexpr float ATT_LOG2E=1.4426950408889634f;
__device__ __forceinline__ int crow(int r,int hi){return (r&3)+8*(r>>2)+4*hi;}
#define SBAR() __builtin_amdgcn_sched_barrier(0)
__device__ __forceinline__ void cmask(f32x16&p0,f32x16&p1,int jb,int qrel,int hi){
  const float NEG=-INFINITY; int kb=64*jb+4*hi;
  #pragma unroll
  for(int r=0;r<16;++r){int kv=kb+(r&3)+8*(r>>2); if(kv>qrel)p0[r]=NEG; if(kv+32>qrel)p1[r]=NEG;}
}

constexpr int NSLOT=3, SLOTB=8192;
constexpr int LDS_K=0, LDS_V=NSLOT*SLOTB, LDS_WS=2*NSLOT*SLOTB, LDS_OST=LDS_WS+NW*64*4, LDS_BETA=LDS_OST+NW*4096, LDS_PRE=LDS_BETA+SEQ*4, LDS_BYTES=LDS_PRE+256;
constexpr float C2=0.125f*1.4426950408889634f;
__device__ __forceinline__ void glds16(const void*gsrc,unsigned lds_dst){unsigned keep;
  asm volatile("s_mov_b32 %0, m0\n\ts_mov_b32 m0, %2\n\ts_nop 0\n\tglobal_load_lds_dwordx4 %1, off\n\ts_mov_b32 m0, %0":"=&s"(keep):"v"(gsrc),"s"(lds_dst):"memory");}
__device__ __forceinline__ float max3f(float a,float b,float c){float r;asm("v_max3_f32 %0, %1, %2, %3":"=v"(r):"v"(a),"v"(b),"v"(c));return r;}
__device__ __forceinline__ float max2f(float a,float b){float r;asm("v_max_f32_e32 %0, %1, %2":"=v"(r):"v"(a),"v"(b));return r;}
__device__ __forceinline__ float fadd_s(float a,float b){float r;asm("v_add_f32_e32 %0, %1, %2":"=v"(r):"v"(a),"v"(b));return r;}
__device__ __forceinline__ float fsub_s(float a,float b){float r;asm("v_sub_f32_e32 %0, %1, %2":"=v"(r):"v"(a),"v"(b));return r;}
typedef float f32x2_t __attribute__((ext_vector_type(2))); typedef __bf16 bf16x2_t __attribute__((ext_vector_type(2)));
__device__ __forceinline__ unsigned cvtpk_s(float lo,float hi){f32x2_t v={lo,hi};bf16x2_t b=__builtin_convertvector(v,bf16x2_t);return __builtin_bit_cast(unsigned,b);}
#define WAIT_BAR(N) asm volatile("s_waitcnt vmcnt(" #N ") lgkmcnt(0)\n\ts_barrier":::"memory")

__device__ __forceinline__ void qkt(f32x16&p0,f32x16&p1,const char*Kslot,const bf16x8*qr,const f32x16&negm,int r32,int hi){
  const char*kb=Kslot+hi*1024+r32*16;
  #pragma unroll
  for(int d0=0;d0<4;++d0){
    const bf16x8 b0=*reinterpret_cast<const bf16x8*>(kb+d0*2048);
    const bf16x8 b1=*reinterpret_cast<const bf16x8*>(kb+d0*2048+512);
    if(d0==0){p0=__builtin_amdgcn_mfma_f32_32x32x16_bf16(b0,qr[0],negm,0,0,0);p1=__builtin_amdgcn_mfma_f32_32x32x16_bf16(b1,qr[0],negm,0,0,0);}
    else{p0=__builtin_amdgcn_mfma_f32_32x32x16_bf16(b0,qr[d0],p0,0,0,0);p1=__builtin_amdgcn_mfma_f32_32x32x16_bf16(b1,qr[d0],p1,0,0,0);}}
}
typedef __attribute__((address_space(3))) const char* lds_cptr;
typedef short v4i16_t __attribute__((ext_vector_type(4)));
__device__ __forceinline__ void kload8(bf16x8*kf,lds_cptr kp){
  kf[0]=*(const __attribute__((address_space(3))) bf16x8*)(kp);      kf[1]=*(const __attribute__((address_space(3))) bf16x8*)(kp+512);
  kf[2]=*(const __attribute__((address_space(3))) bf16x8*)(kp+2048); kf[3]=*(const __attribute__((address_space(3))) bf16x8*)(kp+2560);
  kf[4]=*(const __attribute__((address_space(3))) bf16x8*)(kp+4096); kf[5]=*(const __attribute__((address_space(3))) bf16x8*)(kp+4608);
  kf[6]=*(const __attribute__((address_space(3))) bf16x8*)(kp+6144); kf[7]=*(const __attribute__((address_space(3))) bf16x8*)(kp+6656);
}
__device__ __forceinline__ void kload2(bf16x8*kf,lds_cptr kp,int j){ kf[2*j]=*(const __attribute__((address_space(3))) bf16x8*)(kp+j*2048); kf[2*j+1]=*(const __attribute__((address_space(3))) bf16x8*)(kp+j*2048+512); }
__device__ __forceinline__ s16x4 vtr(lds_cptr p){ return __builtin_bit_cast(s16x4,__builtin_amdgcn_ds_read_tr16_b64_v4i16((__attribute__((address_space(3))) v4i16_t*)p)); }
__device__ __forceinline__ float rowmax(const f32x16&p0,const f32x16&p1){
  float a=max3f(p0[0],p0[1],p1[0]),b=max3f(p0[2],p0[3],p1[1]);a=max3f(a,p1[2],p1[3]);
  #pragma unroll
  for(int r=4;r<16;r+=4){a=max3f(a,p0[r],p0[r+1]);b=max3f(b,p0[r+2],p0[r+3]);a=max3f(a,p1[r],p1[r+1]);b=max3f(b,p1[r+2],p1[r+3]);}
  const float m=max2f(a,b);
  auto rr=__builtin_amdgcn_permlane32_swap(__float_as_uint(m),__float_as_uint(m),false,false);
  return max2f(__uint_as_float(rr[0]),__uint_as_float(rr[1]));
}
__device__ __forceinline__ void pv(f32x16*o,int vb,bf16x8 pa0,bf16x8 pa1,bf16x8 pa2,bf16x8 pa3){
  #pragma unroll
  for(int d0=0;d0<2;++d0){s16x4 lo[4],hi[4];
    #pragma unroll
    for(int ks=0;ks<4;++ks){
      asm volatile("ds_read_b64_tr_b16 %0,%1 offset:%c2":"=&v"(lo[ks]):"v"(vb),"i"(d0*4096+ks*1024):"memory");
      asm volatile("ds_read_b64_tr_b16 %0,%1 offset:%c2":"=&v"(hi[ks]):"v"(vb),"i"(d0*4096+ks*1024+512):"memory");}
    asm volatile("s_waitcnt lgkmcnt(0)":::"memory");SBAR();
    #define PK(k) (bf16x8){lo[k][0],lo[k][1],lo[k][2],lo[k][3],hi[k][0],hi[k][1],hi[k][2],hi[k][3]}
    o[d0]=__builtin_amdgcn_mfma_f32_32x32x16_bf16(pa0,PK(0),o[d0],0,0,0);
    o[d0]=__builtin_amdgcn_mfma_f32_32x32x16_bf16(pa1,PK(1),o[d0],0,0,0);
    o[d0]=__builtin_amdgcn_mfma_f32_32x32x16_bf16(pa2,PK(2),o[d0],0,0,0);
    o[d0]=__builtin_amdgcn_mfma_f32_32x32x16_bf16(pa3,PK(3),o[d0],0,0,0);
    #undef PK
  }
}

#ifndef ATTN_STORE16
#define ATTN_STORE16(p,v) (*(u32x4*)(p)=(v))
#endif
template<int THRL> __device__ __forceinline__ void attn_unit(int b,int h,int qb,const bf16*Q,const bf16*__restrict__ K,const bf16*__restrict__ V,bf16*O,char*shm){
  int tid_o=threadIdx.x; asm volatile("":"+v"(tid_o));
  const int tid=tid_o,lane=tid&63,r32=lane&31,hi=lane>>5; const int wid=__builtin_amdgcn_readfirstlane(tid>>6);
  const long rowbase=(long)b*SEQ; const int q0=qb*QB;
  const bf16*Qw=Q+(rowbase+q0+wid*QBLK)*DM+h*D;
  const bf16*Kh=K+rowbase*DM+h*D,*Vh=V+rowbase*DM+h*D;
  const unsigned lds0=(unsigned)(uintptr_t)shm;
  float*wsf=(float*)(shm+LDS_WS)+wid*64;
  const bf16*ksrc=Kh+(long)lane*DM+wid*8;
  const bf16*vsrc=Vh+(long)(16*(wid&3)+(lane>>2))*DM+(wid>>2)*32+(lane&3)*8;
  const unsigned kdst=lds0+LDS_K+wid*1024, vdst=lds0+LDS_V+wid*1024;
  #define DMA_K(t,slot) glds16(ksrc+(long)(t)*KVBLK*DM,(unsigned)__builtin_amdgcn_readfirstlane(kdst+(slot)))
  #define DMA_V(t,slot) glds16(vsrc+(long)(t)*KVBLK*DM,(unsigned)__builtin_amdgcn_readfirstlane(vdst+(slot)))
  const int vb0=(int)(lds0+LDS_V)+((lane>>4)&1)*32+(lane&3)*8+(4*hi+((lane&15)>>2))*64;
  const char*Kbase=shm+LDS_K; bf16x8 kf[8];
  const lds_cptr shm3=(lds_cptr)shm; const lds_cptr kp0=shm3+LDS_K+hi*1024+r32*16; const lds_cptr vp0=shm3+LDS_V+((lane>>4)&1)*32+(lane&3)*8+(4*hi+((lane&15)>>2))*64;
  const int NT=(q0+QB)/KVBLK;
  DMA_K(0,0);DMA_V(0,0);DMA_K(1,SLOTB);
  bf16x8 qr[4];
  #pragma unroll
  for(int d0=0;d0<4;++d0)qr[d0]=*reinterpret_cast<const bf16x8*>(&Qw[(long)r32*DM+d0*16+hi*8]);
  float m0;
  { const bf16*Kd=Kh+(long)(q0+wid*QBLK+r32)*DM+hi*8; float acc_=0.f;
    #pragma unroll
    for(int d0=0;d0<4;++d0){ const bf16x8 kd=*reinterpret_cast<const bf16x8*>(&Kd[d0*16]);
      #pragma unroll
      for(int j_=0;j_<8;++j_) acc_+=__uint_as_float((unsigned)(unsigned short)qr[d0][j_]<<16)*__uint_as_float((unsigned)(unsigned short)kd[j_]<<16); }
    auto rr_=__builtin_amdgcn_permlane32_swap(__float_as_uint(acc_),__float_as_uint(acc_),false,false);
    m0=__uint_as_float(rr_[0])+__uint_as_float(rr_[1])+((__attribute__((address_space(3))) const float*)((lds_cptr)shm+LDS_BETA))[q0+wid*QBLK+r32]; }
  float mhat=0.f,l_reg=0.f;f32x16 o[2];o[0]=f32x16{};o[1]=f32x16{};f32x16 negm=f32x16{};asm volatile("":"+v"(negm));
  const int qrel=wid*QBLK+r32;
  #define CMASK(P0,P1,t) do{int jb_=(t)-(NT-4); if(jb_>=0)cmask(P0,P1,jb_,qrel,hi);}while(0)
  typedef __attribute__((address_space(3))) const f32x4_t* lds_f4ptr;
  const lds_f4ptr betab=(lds_f4ptr)((lds_cptr)shm+LDS_BETA+16*hi);
  #define BIAS(P0,P1,t) do{ const lds_f4ptr bp_=betab+16*(t); \
    _Pragma("unroll") for(int g_=0;g_<4;++g_){ const f32x4_t b0_=bp_[2*g_], b1_=bp_[8+2*g_]; \
      _Pragma("unroll") for(int i_=0;i_<4;++i_){ P0[4*g_+i_]+=b0_[i_]; P1[4*g_+i_]+=b1_[i_]; } if(g_&1)SBAR(); } }while(0)
  bool resc=false;
  #define START(P0,P1) do{ const float rm=rowmax(P0,P1); resc=false; \
    { const float dl=max2f(rm,m0); mhat=fadd_s(mhat,dl); \
      _Pragma("unroll") for(int r=0;r<16;++r){P0[r]=fsub_s(P0[r],dl);P1[r]=fsub_s(P1[r],dl);} \
      _Pragma("unroll") for(int r=0;r<16;++r)negm[r]=-mhat; asm volatile("":"+v"(negm)); } \
    _Pragma("unroll") for(int r=0;r<16;++r)P0[r]=__builtin_amdgcn_exp2f(P0[r]); }while(0)
  #define RESC() do{ if(resc){ asm volatile("s_waitcnt lgkmcnt(0)":::"memory"); \
      _Pragma("unroll") for(int d_=0;d_<2;++d_) _Pragma("unroll") for(int r=0;r<16;++r)o[d_][r]*=wsf[crow(r,hi)]; } }while(0)
  f32x16 pA0,pA1,pB0,pB1;
  int sl_prev=0,sl_cur=0,sl_next=SLOTB;
  #define ROT() do{sl_prev=sl_cur;sl_cur=sl_next;sl_next=(sl_next==(NSLOT-1)*SLOTB)?0:sl_next+SLOTB;}while(0)
  DMA_K(2,2*SLOTB);
  WAIT_BAR(3);
  qkt(pA0,pA1,Kbase,qr,negm,r32,hi);asm volatile("s_nop 15\n\ts_nop 7":"+v"(pA0),"+v"(pA1));BIAS(pA0,pA1,0);CMASK(pA0,pA1,0);
  START(pA0,pA1);
  _Pragma("unroll") for(int r=0;r<16;++r)pA1[r]=__builtin_amdgcn_exp2f(pA1[r]);
  WAIT_BAR(0);
  DMA_K(3,0);DMA_V(1,SLOTB);
  ROT();
  kload8(kf,kp0+sl_cur);
  WAIT_BAR(2);
  s16x4 vlo[8],vhi[8]; u32x4 pw0,pw1,pw2,pw3;
  #define PKW(P,B) cvtpk_s(P[B],P[B+1])
  #define PAF(k) __builtin_bit_cast(bf16x8,pw##k)
  #define VFR(i) (bf16x8){vlo[i][0],vlo[i][1],vlo[i][2],vlo[i][3],vhi[i][0],vhi[i][1],vhi[i][2],vhi[i][3]}
  #define PIN(x) asm volatile("":"+v"(x))
  #define MX3(a,b,c) __builtin_fmaxf(__builtin_fmaxf((a),(b)),(c))
  #define GAPA(MF,A0,A1,A2,A3,W0,W1,PW) do{ MF; sacc+=A0; sacc+=A1; sacc+=A2; sacc+=A3; PIN(sacc); W0; W1; PIN(PW); SBAR(); }while(0)
  #define EX(v) __builtin_amdgcn_exp2f(v)
  #define GAPB(MF,X,B) do{ MF; X[B]=EX(X[B]); X[B+1]=EX(X[B+1]); X[B+2]=EX(X[B+2]); X[B+3]=EX(X[B+3]); PIN(X); SBAR(); }while(0)
  #define VRD(i) do{ vlo[i]=vtr(vp_+(((i)>>2)*4096+((i)&3)*1024)); vhi[i]=vtr(vp_+(((i)>>2)*4096+((i)&3)*1024+512)); }while(0)
  #define KRD(G,j) do{ if(G){ kload2(kf,kp0+sl_next,j); SBAR(); } }while(0)
  #define STEP(C0,C1,P0,P1,t,GK,GV,GL) do{ SBAR(); \
    const lds_cptr vp_=vp0+sl_prev; \
    VRD(0); SBAR(); float sacc=(P0[0]+P0[1]); \
    GAPA(C0=__builtin_amdgcn_mfma_f32_32x32x16_bf16(kf[0],qr[0],negm,0,0,0), P0[2],P0[3],P0[4],P0[5],     pw0[0]=PKW(P0,0), pw0[1]=PKW(P0,2), pw0); \
    VRD(4); SBAR(); GAPA(C1=__builtin_amdgcn_mfma_f32_32x32x16_bf16(kf[1],qr[0],negm,0,0,0), P0[6],P0[7],P0[8],P0[9],     pw0[2]=PKW(P0,4), pw0[3]=PKW(P0,6), pw0); \
    VRD(1); SBAR(); GAPA(C0=__builtin_amdgcn_mfma_f32_32x32x16_bf16(kf[2],qr[1],C0,0,0,0),   P0[10],P0[11],P0[12],P0[13], pw1[0]=PKW(P0,8), pw1[1]=PKW(P0,10), pw1); \
    VRD(5); SBAR(); GAPA(C1=__builtin_amdgcn_mfma_f32_32x32x16_bf16(kf[3],qr[1],C1,0,0,0),   P0[14],P0[15],P1[0],P1[1],   pw1[2]=PKW(P0,12),pw1[3]=PKW(P0,14), pw1); \
    VRD(2); SBAR(); GAPA(C0=__builtin_amdgcn_mfma_f32_32x32x16_bf16(kf[4],qr[2],C0,0,0,0),   P1[2],P1[3],P1[4],P1[5],     pw2[0]=PKW(P1,0), pw2[1]=PKW(P1,2), pw2); \
    VRD(6); SBAR(); GAPA(C1=__builtin_amdgcn_mfma_f32_32x32x16_bf16(kf[5],qr[2],C1,0,0,0),   P1[6],P1[7],P1[8],P1[9],     pw2[2]=PKW(P1,4), pw2[3]=PKW(P1,6), pw2); \
    VRD(3); SBAR(); GAPA(C0=__builtin_amdgcn_mfma_f32_32x32x16_bf16(kf[6],qr[3],C0,0,0,0),   P1[10],P1[11],P1[12],P1[13], pw3[0]=PKW(P1,8), pw3[1]=PKW(P1,10), pw3); \
    VRD(7); SBAR(); GAPA(C1=__builtin_amdgcn_mfma_f32_32x32x16_bf16(kf[7],qr[3],C1,0,0,0),   P1[14],P1[15],0.f,0.f,       pw3[2]=PKW(P1,12),pw3[3]=PKW(P1,14), pw3); \
    l_reg+=sacc; \
    if(GK){DMA_K((t)+3,sl_cur);} if(GV){DMA_V((t)+1,sl_next);} \
    BIAS(C0,C1,t); CMASK(C0,C1,t); \
    { float a=MX3(C0[0],C0[1],C1[0]),b=MX3(C0[2],C0[3],C1[1]); a=MX3(a,C1[2],C1[3]); \
      _Pragma("unroll") for(int r=4;r<16;r+=4){a=MX3(a,C0[r],C0[r+1]);b=MX3(b,C0[r+2],C0[r+3]);a=MX3(a,C1[r],C1[r+1]);b=MX3(b,C1[r+2],C1[r+3]);} \
      float rm=__builtin_fmaxf(a,b); { auto rr=__builtin_amdgcn_permlane32_swap(__float_as_uint(rm),__float_as_uint(rm),false,false); rm=__builtin_fmaxf(__uint_as_float(rr[0]),__uint_as_float(rr[1])); } \
      resc=false; \
      if(__builtin_expect(__any(rm>(float)THRL),0)){ const float dl=__builtin_fmaxf(rm,0.f); mhat+=dl; \
        _Pragma("unroll") for(int r=0;r<16;++r){C0[r]-=dl;C1[r]-=dl;} \
        _Pragma("unroll") for(int r=0;r<16;++r)negm[r]=-mhat; asm volatile("":"+v"(negm)); \
        const float f=__builtin_amdgcn_exp2f(-dl); l_reg*=f; if(hi==0)wsf[r32]=f; resc=true; } } \
    SBAR(); \
    GAPB(o[0]=__builtin_amdgcn_mfma_f32_32x32x16_bf16(PAF(0),VFR(0),o[0],0,0,0), C0,0); \
    GAPB(o[1]=__builtin_amdgcn_mfma_f32_32x32x16_bf16(PAF(0),VFR(4),o[1],0,0,0), C0,4); \
    KRD(GL,0); GAPB(o[0]=__builtin_amdgcn_mfma_f32_32x32x16_bf16(PAF(1),VFR(1),o[0],0,0,0), C0,8); \
    KRD(GL,1); GAPB(o[1]=__builtin_amdgcn_mfma_f32_32x32x16_bf16(PAF(1),VFR(5),o[1],0,0,0), C0,12); \
    KRD(GL,2); GAPB(o[0]=__builtin_amdgcn_mfma_f32_32x32x16_bf16(PAF(2),VFR(2),o[0],0,0,0), C1,0); \
    KRD(GL,3); GAPB(o[1]=__builtin_amdgcn_mfma_f32_32x32x16_bf16(PAF(2),VFR(6),o[1],0,0,0), C1,4); \
    GAPB(o[0]=__builtin_amdgcn_mfma_f32_32x32x16_bf16(PAF(3),VFR(3),o[0],0,0,0), C1,8); \
    GAPB(o[1]=__builtin_amdgcn_mfma_f32_32x32x16_bf16(PAF(3),VFR(7),o[1],0,0,0), C1,12); \
    }while(0)
  int t=1;
  #undef CMASK
  #define CMASK(P0,P1,t) do{}while(0)
  for(;t+5<NT;t+=2){
    STEP(pB0,pB1,pA0,pA1,t,true,true,true);     WAIT_BAR(2); RESC(); ROT();
    STEP(pA0,pA1,pB0,pB1,t+1,true,true,true);   WAIT_BAR(2); RESC(); ROT();
  }
  #undef CMASK
  #define CMASK(P0,P1,t) do{int jb_=(t)-(NT-4); if(jb_>=0)cmask(P0,P1,jb_,qrel,hi);}while(0)
  #define ENDW(tt) do{ if((tt)+3<NT){WAIT_BAR(2);} else if((tt)+2<NT){WAIT_BAR(1);} else {WAIT_BAR(0);} }while(0)
  for(;t+1<NT;t+=2){
    STEP(pB0,pB1,pA0,pA1,t,(t+3<NT),(t+1<NT),(t+1<NT));       ENDW(t);   RESC(); ROT();
    STEP(pA0,pA1,pB0,pB1,t+1,(t+4<NT),(t+2<NT),(t+2<NT));     ENDW(t+1); RESC(); ROT();
  }
  STEP(pB0,pB1,pA0,pA1,NT-1,false,false,false); RESC();
  { float sacc=pB0[0]+pB0[1]; _Pragma("unroll") for(int r=2;r<16;++r)sacc+=pB0[r]; _Pragma("unroll") for(int r=0;r<16;++r)sacc+=pB1[r]; l_reg+=sacc;
    pw0=(u32x4){PKW(pB0,0),PKW(pB0,2),PKW(pB0,4),PKW(pB0,6)};pw1=(u32x4){PKW(pB0,8),PKW(pB0,10),PKW(pB0,12),PKW(pB0,14)};pw2=(u32x4){PKW(pB1,0),PKW(pB1,2),PKW(pB1,4),PKW(pB1,6)};pw3=(u32x4){PKW(pB1,8),PKW(pB1,10),PKW(pB1,12),PKW(pB1,14)};
    SBAR(); pv(o,vb0+sl_cur,PAF(0),PAF(1),PAF(2),PAF(3)); }
  #undef PKW
  #undef PAF
  #undef VFR
  #undef PIN
  #undef MX3
  #undef GAPA
  #undef GAPB
  #undef EX
  #undef VRD
  #undef KRD
  #undef STEP
  #undef ENDW
  {auto rr=__builtin_amdgcn_permlane32_swap(__float_as_uint(l_reg),__float_as_uint(l_reg),false,false);l_reg=__uint_as_float(rr[0])+__uint_as_float(rr[1]);}
  if(hi==0)wsf[32+r32]=l_reg;asm volatile("s_waitcnt lgkmcnt(0)":::"memory");
  float rli[16];
  #pragma unroll
  for(int r=0;r<16;++r)rli[r]=__builtin_amdgcn_rcpf(wsf[32+crow(r,hi)]);
  bf16*Ow=O+(rowbase+q0+wid*QBLK)*OPITCH+h*D;
  { bf16*stg=(bf16*)(shm+LDS_OST)+wid*2048;
    #pragma unroll
    for(int r=0;r<16;++r){const int orow=crow(r,hi);
      #pragma unroll
      for(int d0=0;d0<2;++d0)stg[orow*64+d0*32+r32]=__float2bfloat16(o[d0][r]*rli[r]);}
    asm volatile("s_waitcnt lgkmcnt(0)":::"memory");
    #pragma unroll
    for(int i=0;i<4;++i){const int row=i*8+(lane>>3),ch=lane&7; const u32x4 v=*(const u32x4*)(stg+row*64+ch*8); ATTN_STORE16(Ow+(long)row*OPITCH+ch*8,v);} }
  asm volatile("s_waitcnt lgkmcnt(0)\n\ts_barrier":::"memory");
  #undef DMA_K
  #undef DMA_V
  #undef CMASK
  #undef BIAS
  #undef START
  #undef RESC
  #undef ROT
}
constexpr int ATTN_LDS_BYTES=LDS_BYTES;
struct AttnTensors { const bf16* Q; const bf16* K; const bf16* V; bf16* O; const float* cl; const float* bt; };
struct AttnUnit { int bh; int qb; };
struct StaticOrder {
  int vcu,grid;
  __device__ __forceinline__ explicit StaticOrder(int grid_,int block):vcu((grid_%8==0)?(block%8)*(grid_/8)+block/8:block),grid(grid_){}
  __device__ __forceinline__ bool next(int i,AttnUnit&u)const{ const int v=vcu+(i>>1)*grid; if(v>=BATCH*NHEAD*4)return false; const int s=v&3; u.bh=v>>2; u.qb=((i&1)==0)?7-s:s; return true; }
  __device__ __forceinline__ void a_ready(const AttnUnit&)const{}
  __device__ __forceinline__ void done(const AttnUnit&)const{}
};
__device__ __forceinline__ void build_beta(char*lds,const float*cl,const float*bt,int bh){
  int tid_o=threadIdx.x; asm volatile("":"+v"(tid_o)); const int tid=tid_o,b=bh/NHEAD,h=bh%NHEAD;
  __attribute__((address_space(3))) float*beta=(__attribute__((address_space(3))) float*)((lds_cptr)lds+LDS_BETA);
  __attribute__((address_space(3))) float*pre=(__attribute__((address_space(3))) float*)((lds_cptr)lds+LDS_PRE);
  if(tid<64){ float v=(tid<32)?bt[(b*32+tid)*8+h]:0.f; const float own=v;
    #pragma unroll
    for(int o=1;o<32;o<<=1){ const float n=__shfl_up(v,o); if((tid&63)>=o)v+=n; }
    if(tid<32)pre[tid]=v-own; }
  asm volatile("s_waitcnt lgkmcnt(0)":::"memory"); __syncthreads();
  for(int s=tid;s<SEQ;s+=NW*64) beta[s]=-(pre[s>>6]+cl[(long)(b*SEQ+s)*8+h])*ATT_LOG2E;
  asm volatile("s_waitcnt lgkmcnt(0)":::"memory"); __syncthreads();
}
template<class Sched,int THRL=8> __device__ __forceinline__ void attn_phase(char*lds,const AttnTensors&T,const Sched&S){
  AttnUnit u;
  for(int i=0;S.next(i,u);++i){ if((i&1)==0) build_beta(lds,T.cl,T.bt,u.bh);
    S.a_ready(u); attn_unit<THRL>(u.bh/NHEAD,u.bh%NHEAD,u.qb,T.Q,T.K,T.V,T.O,lds); S.done(u); }
}
#undef SBAR
#undef WAIT_BAR
}

namespace hg {
typedef short bf16x8 __attribute__((ext_vector_type(8)));
typedef short s16x4 __attribute__((ext_vector_type(4)));
typedef float f32x16 __attribute__((ext_vector_type(16)));
typedef float f32x4 __attribute__((ext_vector_type(4)));
typedef unsigned u32x4 __attribute__((ext_vector_type(4)));
typedef unsigned u32x2 __attribute__((ext_vector_type(2)));
#define HG_LAS __attribute__((address_space(3)))
#define HG_BAR() do { asm volatile("s_waitcnt lgkmcnt(0)" ::: "memory"); __builtin_amdgcn_s_barrier(); asm volatile("" ::: "memory"); } while (0)
constexpr int CH = 32, NCH = 2048 / CH;
constexpr int S_QA = 0, S_KD = 8192, S_KT = 16384, S_V = 24576, S_DEC = 26624, SLOT_BYTES = 27136;
constexpr int OFF_OPART = 2 * SLOT_BYTES, OPART_BYTES = 4 * 4096, LDS_BYTES = OFF_OPART + 2 * OPART_BYTES;
__device__ __forceinline__ int qa_off(int t, int d) { return t * 256 + ((((d >> 3) ^ (t & 15))) << 4) + (d & 7) * 2; }
__device__ __forceinline__ int kt_off(int s, int d) { return s * 256 + ((((d >> 3) ^ ((s & 3) << 2))) << 4) + (d & 7) * 2; }
__device__ __forceinline__ int v_off(int s, int e) { return s * 64 + e * 2; }
typedef short v4i16_t __attribute__((ext_vector_type(4)));
__device__ __forceinline__ s16x4 trd(const HG_LAS unsigned char* p) { return __builtin_bit_cast(s16x4, __builtin_amdgcn_ds_read_tr16_b64_v4i16((HG_LAS v4i16_t*)p)); }
__device__ __forceinline__ unsigned cvtpk(float lo, float hi) { typedef float f2 __attribute__((ext_vector_type(2))); typedef __bf16 b2 __attribute__((ext_vector_type(2))); f2 v = {lo, hi}; b2 b = __builtin_convertvector(v, b2); return __builtin_bit_cast(unsigned, b); }
__device__ __forceinline__ int crow(int r, int hi) { return (r & 3) + 8 * (r >> 2) + 4 * hi; }
__device__ __forceinline__ bf16x8 pack8(const f32x16& x, int base) {
    u32x4 w; w.x = cvtpk(x[base], x[base + 1]); w.y = cvtpk(x[base + 2], x[base + 3]); w.z = cvtpk(x[base + 4], x[base + 5]); w.w = cvtpk(x[base + 6], x[base + 7]); return __builtin_bit_cast(bf16x8, w); }
__device__ __forceinline__ bf16x8 cat64(s16x4 a, s16x4 b) { return (bf16x8){a[0], a[1], a[2], a[3], b[0], b[1], b[2], b[3]}; }

__device__ __forceinline__ void hgrn_unit(HG_LAS unsigned char* lds, const unsigned short* QA, const unsigned short* KD, const unsigned short* KT, const float* DEC, const unsigned short* V, unsigned short* O, int unit) {
    int tid_o = threadIdx.x; asm volatile("" : "+v"(tid_o));
    const int tid = tid_o, lane = tid & 63, wid = __builtin_amdgcn_readfirstlane(tid >> 6), r32 = lane & 31, hi = lane >> 5;
    const int b = unit >> 5, h = (unit >> 2) & 7, eq = unit & 3;
    const size_t gbase = (size_t)b * 2048 * 1024 + h * 128;
    __syncthreads();
    if (wid < 4) {
        const int w = wid;
        const int tq = (lane & 15) >> 2, tc = 16 * ((lane >> 4) & 1) + 4 * (lane & 3);
        f32x16 S = {};
#pragma unroll 1
        for (int i = -1; i <= NCH; ++i) {
            if (i >= 0 && i < NCH) {
                HG_LAS unsigned char* sl = lds + (i & 1) * SLOT_BYTES;
                bf16x8 kdf[2], qaf[2]; s16x4 qp[2][2], vp[2][2], ktf[2][2], vf[2][2]; f32x4 dcv[4];
#pragma unroll
                for (int ks = 0; ks < 2; ++ks) { const int o = qa_off(r32, 32 * w + 16 * ks + 8 * hi), d0 = 32 * w + 16 * ks + 4 * hi, sp = 16 * ks + 4 * hi, sn = 16 * ks + 8 * hi;
                    kdf[ks] = *(const HG_LAS bf16x8*)(sl + S_KD + o); qaf[ks] = *(const HG_LAS bf16x8*)(sl + S_QA + o);
                    qp[ks][0] = *(const HG_LAS s16x4*)(sl + S_QA + qa_off(r32, d0)); qp[ks][1] = *(const HG_LAS s16x4*)(sl + S_QA + qa_off(r32, d0 + 8));
                    vp[ks][0] = trd(sl + S_V + v_off(sp + tq, tc)); vp[ks][1] = trd(sl + S_V + v_off(sp + 8 + tq, tc));
                    ktf[ks][0] = trd(sl + S_KT + kt_off(sn + tq, 32 * w + tc)); ktf[ks][1] = trd(sl + S_KT + kt_off(sn + 4 + tq, 32 * w + tc));
                    vf[ks][0] = trd(sl + S_V + v_off(sn + tq, tc)); vf[ks][1] = trd(sl + S_V + v_off(sn + 4 + tq, tc)); }
#pragma unroll
                for (int g = 0; g < 4; ++g) dcv[g] = *(const HG_LAS f32x4*)(sl + S_DEC + (32 * w + 8 * g + 4 * hi) * 4);
                __builtin_amdgcn_sched_barrier(0);
                const bf16x8 sb0 = pack8(S, 0), sb1 = pack8(S, 8);
                f32x16 X = {}, ow = {};
#pragma unroll
                for (int g = 0; g < 4; ++g)
#pragma unroll
                    for (int q = 0; q < 4; ++q) S[4 * g + q] *= dcv[g][q];
                X = __builtin_amdgcn_mfma_f32_32x32x16_bf16(kdf[0], qaf[0], X, 0, 0, 0);
                ow = __builtin_amdgcn_mfma_f32_32x32x16_bf16(cat64(qp[0][0], qp[0][1]), sb0, ow, 0, 0, 0);
                S = __builtin_amdgcn_mfma_f32_32x32x16_bf16(cat64(ktf[0][0], ktf[0][1]), cat64(vf[0][0], vf[0][1]), S, 0, 0, 0);
                X = __builtin_amdgcn_mfma_f32_32x32x16_bf16(kdf[1], qaf[1], X, 0, 0, 0);
                ow = __builtin_amdgcn_mfma_f32_32x32x16_bf16(cat64(qp[1][0], qp[1][1]), sb1, ow, 0, 0, 0);
                S = __builtin_amdgcn_mfma_f32_32x32x16_bf16(cat64(ktf[1][0], ktf[1][1]), cat64(vf[1][0], vf[1][1]), S, 0, 0, 0);
#pragma unroll
                for (int r = 0; r < 16; ++r) X[r] = (crow(r, hi) <= r32) ? X[r] : 0.f;
                ow = __builtin_amdgcn_mfma_f32_32x32x16_bf16(pack8(X, 0), cat64(vp[0][0], vp[0][1]), ow, 0, 0, 0);
                ow = __builtin_amdgcn_mfma_f32_32x32x16_bf16(pack8(X, 8), cat64(vp[1][0], vp[1][1]), ow, 0, 0, 0);
                { HG_LAS float* op = (HG_LAS float*)(lds + OFF_OPART + (i & 1) * OPART_BYTES + w * 4096) + lane;
#pragma unroll
                  for (int r = 0; r < 16; ++r) op[r * 64] = ow[r]; }
            }
            HG_BAR();
        }
    } else {
        const int pt = tid - 256;
        const int t0 = pt >> 4, d0 = (pt & 15) * 8;
        const int vs = pt >> 3, ve = (pt & 7) * 4;
        u32x4 qaA[2], kdA[2], ktA[2], qaB[2], kdB[2], ktB[2]; u32x2 vA, vB; float dcA = 0.f, dcB = 0.f;
#define HG_LOAD(qa, kd, kt, vr, dc, c) do { const int c_ = (c) < NCH ? (c) : NCH - 1;      \
            const size_t ro_ = gbase + (size_t)c_ * CH * 1024; \
            _Pragma("unroll") for (int k_ = 0; k_ < 2; ++k_) { const size_t o_ = ro_ + (size_t)(t0 + 16 * k_) * 1024 + d0; \
                qa[k_] = *(const u32x4*)(QA + o_); kd[k_] = *(const u32x4*)(KD + o_); kt[k_] = *(const u32x4*)(KT + o_); } \
            vr = *(const u32x2*)(V + ro_ + (size_t)vs * 1024 + eq * 32 + ve); \
            dc = DEC[(size_t)(b * NCH + c_) * 1024 + h * 128 + (pt & 127)]; } while (0)
#define HG_PSTEP(i, RED, PREP, qa, kd, kt, vr, dc) do { \
            if (PREP) { \
                HG_LAS unsigned char* sl = lds + (((i) + 1) & 1) * SLOT_BYTES; \
                _Pragma("unroll") for (int k_ = 0; k_ < 2; ++k_) { const int t_ = t0 + 16 * k_; \
                    *(HG_LAS u32x4*)(sl + S_QA + qa_off(t_, d0)) = qa[k_]; *(HG_LAS u32x4*)(sl + S_KD + qa_off(t_, d0)) = kd[k_]; \
                    *(HG_LAS u32x4*)(sl + S_KT + kt_off(t_, d0)) = kt[k_]; } \
                *(HG_LAS u32x2*)(sl + S_V + v_off(vs, ve)) = vr; \
                *(HG_LAS float*)(sl + S_DEC + (pt & 127) * 4) = dc; \
                HG_LOAD(qa, kd, kt, vr, dc, (i) + 3); } \
            if (RED) { const HG_LAS float* op = (const HG_LAS float*)(lds + OFF_OPART + (((i) - 1) & 1) * OPART_BYTES); \
                const int idx = 4 * pt, reg = idx >> 6, ln = idx & 63; const HG_LAS f32x4* op4 = (const HG_LAS f32x4*)(op + idx); \
                const f32x4 v = (op4[0] + op4[256]) + (op4[512] + op4[768]);              \
                const int t = crow(reg, ln >> 5), e = ln & 31; u32x2 wv; wv.x = cvtpk(v[0], v[1]); wv.y = cvtpk(v[2], v[3]); \
                *(u32x2*)(O + gbase + (size_t)(((i) - 1) * CH + t) * 1024 + eq * 32 + e) = wv; } \
            HG_BAR(); } while (0)
        HG_LOAD(qaA, kdA, ktA, vA, dcA, 0); HG_LOAD(qaB, kdB, ktB, vB, dcB, 1);
        HG_PSTEP(-1, false, true, qaA, kdA, ktA, vA, dcA); HG_PSTEP(0, false, true, qaB, kdB, ktB, vB, dcB);
#pragma unroll 1
        for (int i = 1; i + 1 < NCH; i += 2) { HG_PSTEP(i, true, true, qaA, kdA, ktA, vA, dcA); HG_PSTEP(i + 1, true, true, qaB, kdB, ktB, vB, dcB); }
        HG_PSTEP(NCH - 1, true, false, qaA, kdA, ktA, vA, dcA); HG_PSTEP(NCH, true, false, qaB, kdB, ktB, vB, dcB);
#undef HG_PSTEP
#undef HG_LOAD
    }
}
#undef HG_LAS
#undef HG_BAR
}

#define GAS __attribute__((address_space(1)))
#define LAS __attribute__((address_space(3)))
typedef unsigned short bf16;
typedef unsigned v4u __attribute__((ext_vector_type(4)));
typedef float f32x4 __attribute__((ext_vector_type(4)));
typedef short bf16x8 __attribute__((ext_vector_type(8)));
typedef GAS unsigned gu32;
typedef GAS unsigned long long gu64;
#define RLX_AGENT __ATOMIC_RELAXED, __HIP_MEMORY_SCOPE_AGENT
#define LDS_WAIT() asm volatile("s_waitcnt lgkmcnt(0)" ::: "memory")
#define VM_WAIT() asm volatile("s_waitcnt vmcnt(0)" ::: "memory")
__device__ __forceinline__ unsigned long long rt() { return __builtin_amdgcn_s_memrealtime(); }
__device__ __forceinline__ unsigned f2bf(float f) { unsigned u = __builtin_bit_cast(unsigned, f); return (u + 0x7fffu + ((u >> 16) & 1u)) >> 16; }
__device__ __forceinline__ unsigned pk2(float lo, float hi) { typedef float f2_ __attribute__((ext_vector_type(2))); typedef __bf16 b2_ __attribute__((ext_vector_type(2))); f2_ v = {lo, hi}; b2_ b = __builtin_convertvector(v, b2_); return __builtin_bit_cast(unsigned, b); }

#define XB_TMO      128
#define XB_XCNT(j)  (256  + 64 * (j))
#define XB_XSUB(j)  (1280 + 64 * (j))
#define XB_XGEN(j)  (2304 + 64 * (j))
#define XB_TOP      3328
#define XB_TOPGEN   3392
#define XCD_BAR_WORDS 3456
#define XB_SPIN_CAP (1u << 18)

__device__ __forceinline__ unsigned xb_ld(unsigned* p)              { return __hip_atomic_load(p, __ATOMIC_RELAXED, __HIP_MEMORY_SCOPE_AGENT); }
__device__ __forceinline__ unsigned xb_add(unsigned* p, unsigned v) { return __hip_atomic_fetch_add(p, v, __ATOMIC_RELAXED, __HIP_MEMORY_SCOPE_AGENT); }
__device__ __forceinline__ unsigned xb_xcc_id() { return (unsigned)__builtin_amdgcn_s_getreg((3 << 11) | 20) & 0xFu; }
#define XB_SPIN(cond, bar) do { unsigned _sp = 0; while (cond) { __builtin_amdgcn_s_sleep(1); \
    if ((++_sp & 255u) == 0u) { if (xb_ld(&(bar)[XB_TMO])) break; if (_sp > XB_SPIN_CAP) { atomicAdd(&(bar)[XB_TMO], 1u); break; } } } } while (0)

struct XcdBarrier {
    unsigned* bar; unsigned x;
    volatile LAS unsigned* st;
};

__device__ __forceinline__ XcdBarrier xcd_barrier_post(unsigned* bar, volatile LAS unsigned* st) {
    XcdBarrier b; b.bar = bar; b.x = xb_xcc_id(); b.st = st;
    if (threadIdx.x == 0) (void)xb_add(&bar[XB_XCNT(b.x)], 1u);
    return b;
}
__device__ __forceinline__ void xcd_barrier_complete(unsigned* bar, unsigned x, unsigned& nloc, unsigned& nx) {
    const unsigned G = gridDim.x * gridDim.y * gridDim.z;
    unsigned sum, cnt, mine, sp = 0u;
    for (;;) {
        sum = 0u; cnt = 0u; mine = 0u;
#pragma unroll
        for (unsigned j = 0; j < 16; ++j) { const unsigned c = xb_ld(&bar[XB_XCNT(j)]); sum += c; cnt += (c > 0u) ? 1u : 0u; mine = (j == x) ? c : mine; }
        if (sum == G) break;
        __builtin_amdgcn_s_sleep(1);
        if ((++sp & 255u) == 0u) { if (xb_ld(&bar[XB_TMO])) break; if (sp > XB_SPIN_CAP) { atomicAdd(&bar[XB_TMO], 1u); break; } }
    }
    nloc = mine > 0u ? mine : 1u; nx = cnt > 0u ? cnt : 1u;
}

__device__ __forceinline__ void xcd_barrier(const XcdBarrier& b) {
    asm volatile("s_waitcnt vmcnt(0)" ::: "memory");
    __syncthreads();
    if (threadIdx.x == 0) {
        unsigned* bar = b.bar;
        __builtin_amdgcn_s_waitcnt(0);
        unsigned nloc = b.st[0], nx = b.st[1];
        if (nloc == 0u) { xcd_barrier_complete(bar, b.x, nloc, nx); b.st[0] = nloc; b.st[1] = nx; }
        const unsigned old = xb_add(&bar[XB_XSUB(b.x)], 1u);
        const unsigned gen = old / nloc;
        if (old + 1u == (gen + 1u) * nloc) {
            __builtin_amdgcn_fence(__ATOMIC_RELEASE, "agent");
            asm volatile("s_waitcnt vmcnt(0)" ::: "memory");
            const unsigned og = xb_add(&bar[XB_TOP], 1u);
            const unsigned tg = og / nx;
            if (og + 1u == (tg + 1u) * nx) xb_add(&bar[XB_TOPGEN], 1u);
            else XB_SPIN(xb_ld(&bar[XB_TOPGEN]) == tg, bar);
            __builtin_amdgcn_fence(__ATOMIC_ACQUIRE, "agent");
            xb_add(&bar[XB_XGEN(b.x)], 1u);
            asm volatile("s_waitcnt vmcnt(0)" ::: "memory");
        } else {
            XB_SPIN(xb_ld(&bar[XB_XGEN(b.x)]) == gen, bar);
            __builtin_amdgcn_fence(__ATOMIC_ACQUIRE, "agent");
            asm volatile("s_waitcnt vmcnt(0)" ::: "memory");
        }
    }
    __syncthreads();
}

#ifndef L0_SPLIT
#define L0_SPLIT 1
#endif

#ifndef TS_P0
#define TS_P0 0
#endif

#ifndef FUSE_FINAL_NORM
#define FUSE_FINAL_NORM 0
#endif

#ifndef TS_CLOCK
#define TS_CLOCK 0
#endif

#ifndef TS_PHASE_END
#define TS_PHASE_END -1
#endif

#ifndef TS_AFTER_BAR
#define TS_AFTER_BAR 0
#endif

#ifndef TS_PHASE
#define TS_PHASE -1
#endif
#ifndef TS_DIV
#define TS_DIV 1000.0f
#endif

#ifndef PROBE_P0
#define PROBE_P0 0
#endif

constexpr int NWAVES = 8;
constexpr int BATCH = 8, SEQ = 2048, D = 1024, DEPTH = 4, M = BATCH * SEQ;
constexpr int FOXH = 8, FOXD = 64, FOXW = 512, CONVW = 512, AB_COLS = 3080, AB_N = 3072;
constexpr int HGH = 8, HGD = 128, C_COLS = 4096;
constexpr int FFH = 2816, FF2 = 5632;
constexpr float EPS = 1e-6f;
constexpr float LOG2E = 1.4426950408889634f;
constexpr float QSCALE = 0.125f * LOG2E;

constexpr size_t MiB = 1u << 20;
constexpr size_t WS_CTL = 0, CTL_ZERO_BYTES = 64 * 1024;
constexpr size_t WS_SSQ = 1 * MiB;
constexpr size_t WS_CL = 2 * MiB;
constexpr size_t WS_BT = WS_CL + 512 * 1024;
constexpr size_t WS_WF = WS_BT + 64 * 1024;
constexpr size_t WS_LB = WS_WF + 64 * 1024;
constexpr size_t WS_W = 4 * MiB;
constexpr size_t W_ABIN = 0, SZ_ABIN = (size_t)AB_N * D * 2;
constexpr size_t W_ABOUT = W_ABIN + 2 * SZ_ABIN, SZ_ABOUT = (size_t)D * D * 2;
constexpr size_t W_CIN = W_ABOUT + 2 * SZ_ABOUT, SZ_CIN = (size_t)C_COLS * D * 2;
constexpr size_t W_COUT = W_CIN + 2 * SZ_CIN, SZ_COUT = (size_t)D * D * 2;
constexpr size_t W_FIN = W_COUT + 2 * SZ_COUT, SZ_FIN = (size_t)FF2 * D * 2;
constexpr size_t W_FOUT = W_FIN + 4 * SZ_FIN, SZ_FOUT = (size_t)D * FFH * 2;
constexpr size_t W_END = W_FOUT + 4 * SZ_FOUT;
static_assert(WS_W + W_END <= 108 * MiB, "weights region");
constexpr size_t WS_XB = 108 * MiB;
constexpr size_t WS_MIX = 140 * MiB;
constexpr size_t WS_H = WS_MIX;
constexpr size_t WS_QKVU = WS_MIX, T512 = (size_t)M * 512 * 2, WS_AO = WS_MIX + 6 * T512;
constexpr size_t WS_KD = WS_MIX, WS_KT = WS_MIX + 32 * MiB, WS_HQ = WS_MIX + 64 * MiB, WS_HV = WS_HQ + 32 * MiB, WS_HG = WS_HV + 32 * MiB, WS_HO = WS_HG + 32 * MiB, WS_DEC = WS_HO + 32 * MiB, WS_END = WS_DEC + 2 * MiB;
static_assert(WS_END <= 352 * MiB, "workspace budget");
constexpr int CW_TMO = 0, CW_BAR = 4096, CW_FIN = 8192;
constexpr size_t WS_XS = 3 * MiB;

constexpr int RING_OFF = 0, RING_BYTES = 131072;
constexpr int LDSCTL_OFF = RING_BYTES, MISC_OFF = LDSCTL_OFF + 320;
constexpr int LDS_BYTES = 147456;
static_assert(MISC_OFF + 128 <= LDS_BYTES, "LDS map");
static_assert(attn_body::ATTN_LDS_BYTES <= RING_BYTES && hg::LDS_BYTES <= RING_BYTES, "mixer LDS inside the ring region");

struct Args { const float* in[14]; float* out; unsigned char* ws; int ph_lo, ph_hi, li, pad; };
typedef const __attribute__((address_space(4))) Args* KArgP;

struct Frame {
    LAS unsigned char* lds; volatile LAS unsigned* MISC; gu32* ctl;
    int wave, vcu, G;
};
#define LANE_IDS() int tid_l = threadIdx.x; asm volatile("" : "+v"(tid_l)); const int TID = tid_l, LANE = tid_l & 63
__device__ __forceinline__ float wave_sum(float v) {
#pragma unroll
    for (int o = 1; o < 64; o <<= 1) v += __shfl_xor(v, o);
    return v;
}
__device__ __forceinline__ float bf_lo(unsigned w) { return __uint_as_float(w << 16); }
__device__ __forceinline__ float bf_hi(unsigned w) { return __uint_as_float(w & 0xffff0000u); }

struct WItem { const float* W; const float* gain; bf16* WT; int ldn, ksrc0, nsrc0, K, drow0; };
constexpr int I_ABIN = 16 * (AB_N / 32), I_SQ = 16 * (D / 32), I_CIN = 16 * (C_COLS / 32), I_FIN = 16 * (FF2 / 32), I_FOUT = (FFH / 64) * (D / 32);
__host__ __device__ constexpr int layer_items(int l) { return ((l & 1) ? I_CIN : I_ABIN) + I_SQ + I_FIN + I_FOUT; }
__device__ __forceinline__ WItem layer_item(const Args& a, int l, int it) {
    unsigned char* wb = a.ws + WS_W; const int j = l >> 1; WItem w;
    const int n_in = (l & 1) ? I_CIN : I_ABIN;
    if (it < n_in) {
        if (l & 1) { const int nb = it % 128, kb = it / 128, c0 = 32 * nb;
            const int drow = c0 < 1024 ? 256 * (c0 / 128) + (c0 % 128) : (c0 < 2048 ? 256 * ((c0 - 1024) / 128) + 128 + ((c0 - 1024) % 128) : c0);
            w = WItem{a.in[8] + (size_t)j * D * C_COLS, a.in[1] + (size_t)l * D, (bf16*)(wb + W_CIN + j * SZ_CIN), C_COLS, 64 * kb, c0, D, drow}; }
        else { const int nb = it % (AB_N / 32), kb = it / (AB_N / 32), n0 = 32 * nb;
            w = WItem{a.in[4] + (size_t)j * D * AB_COLS, a.in[1] + (size_t)l * D, (bf16*)(wb + W_ABIN + j * SZ_ABIN), AB_COLS, 64 * kb, n0 + (n0 >= 1536 ? 8 : 0), D, n0}; }
        return w; }
    it -= n_in;
    if (it < I_SQ) { const int nb = it % 32, kb = it / 32;
        w = WItem{((l & 1) ? a.in[11] : a.in[7]) + (size_t)j * D * D, nullptr, (bf16*)(wb + ((l & 1) ? W_COUT + j * SZ_COUT : W_ABOUT + j * SZ_ABOUT)), D, 64 * kb, 32 * nb, D, 32 * nb}; return w; }
    it -= I_SQ;
    if (it < I_FIN) { const int nb = it % (FF2 / 32), kb = it / (FF2 / 32), c0 = 32 * nb;
        const int drow = c0 < FFH ? 256 * (c0 / 128) + (c0 % 128) : 256 * ((c0 - FFH) / 128) + 128 + ((c0 - FFH) % 128);
        w = WItem{a.in[12] + (size_t)l * D * FF2, a.in[2] + (size_t)l * D, (bf16*)(wb + W_FIN + l * SZ_FIN), FF2, 64 * kb, c0, D, drow}; return w; }
    it -= I_FIN;
    { const int nb = it % 32, kb = it / 32;
      w = WItem{a.in[13] + (size_t)l * FFH * D, nullptr, (bf16*)(wb + W_FOUT + l * SZ_FOUT), D, 64 * kb, 32 * nb, FFH, 32 * nb}; }
    return w;
}
__device__ __forceinline__ void witem_load(const WItem& w, f32x4 (&r)[8], int lane) {
    const int n4 = (lane & 7) * 4;
#pragma unroll
    for (int i = 0; i < 8; ++i) { const int kk = 8 * i + (lane >> 3); r[i] = *(const f32x4*)(w.W + (size_t)(w.ksrc0 + kk) * w.ldn + w.nsrc0 + n4); }
}
__device__ __forceinline__ void witem_finish(const WItem& w, const f32x4 (&r)[8], LAS float* scr, int lane) {
    const int n4 = (lane & 7) * 4;
#pragma unroll
    for (int i = 0; i < 8; ++i) { const int kk = 8 * i + (lane >> 3); f32x4 v = r[i]; if (w.gain) v = v * w.gain[w.ksrc0 + kk];
        LAS float* s = scr + kk * 33 + n4; s[0] = v[0]; s[1] = v[1]; s[2] = v[2]; s[3] = v[3]; }
    LDS_WAIT(); asm volatile("" ::: "memory");
    const int c = lane & 7;
#pragma unroll
    for (int j = 0; j < 4; ++j) { const int n = (lane >> 3) + 8 * j; const LAS float* s = scr + (8 * c) * 33 + n;
        v4u o; o.x = pk2(s[0 * 33], s[1 * 33]); o.y = pk2(s[2 * 33], s[3 * 33]); o.z = pk2(s[4 * 33], s[5 * 33]); o.w = pk2(s[6 * 33], s[7 * 33]);
        *(v4u*)(w.WT + (size_t)(w.drow0 + n) * w.K + w.ksrc0 + 8 * c) = o; }
    LDS_WAIT(); asm volatile("" ::: "memory");
}
__device__ __forceinline__ void convert_layer_weights(Frame& F, const Args& a, int l, int gw, int ngw, int it_lo = 0, int it_hi = 1 << 30) {
    LANE_IDS(); (void)TID;
    LAS float* scr = (LAS float*)(F.lds + RING_OFF + F.wave * 16384);
    const int n = layer_items(l) < it_hi ? layer_items(l) : it_hi; int it = it_lo + gw; if (it >= n) return;
    WItem cur = layer_item(a, l, it); f32x4 rc[8], rn[8]; witem_load(cur, rc, LANE);
    for (;;) { const int itn = it + ngw; const bool more = itn < n; WItem nxt = cur;
        if (more) { nxt = layer_item(a, l, itn); witem_load(nxt, rn, LANE); }
        witem_finish(cur, rc, scr, LANE);
        if (!more) break;
#pragma unroll
        for (int i = 0; i < 8; ++i) rc[i] = rn[i];
        cur = nxt; it = itn; }
}
__device__ __forceinline__ void p0_prologue(Frame& F, const Args& a) {
    LANE_IDS();
    const int gw = F.vcu * NWAVES + F.wave, NGW = F.G * NWAVES;
    unsigned char* ws = a.ws;
    if (TS_P0 && blockIdx.x == 0 && TID == 0) __hip_atomic_store((unsigned*)(a.ws + WS_CTL) + 17, (unsigned)__builtin_amdgcn_s_memrealtime(), __ATOMIC_RELAXED, __HIP_MEMORY_SCOPE_AGENT);
    for (int r_ = 0; r_ < ((PROBE_P0 & 1) ? 2 : 1); ++r_)
    convert_layer_weights(F, a, 0, gw, NGW, 0, L0_SPLIT ? I_ABIN : (1 << 30));
#if !WCONV_IN_FFN_TAIL
    for (int l = 1; l < DEPTH; ++l) convert_layer_weights(F, a, l, gw, NGW);
#endif
    if (TS_P0 == 1 && blockIdx.x == 0 && TID == 0) __hip_atomic_store((unsigned*)(a.ws + WS_CTL) + 16, (unsigned)__builtin_amdgcn_s_memrealtime() - __hip_atomic_load((unsigned*)(a.ws + WS_CTL) + 17, __ATOMIC_RELAXED, __HIP_MEMORY_SCOPE_AGENT), __ATOMIC_RELAXED, __HIP_MEMORY_SCOPE_AGENT);
    for (int r_ = 0; r_ < ((PROBE_P0 & 2) ? 2 : 1); ++r_)
    { const float* __restrict__ x = a.in[0]; bf16* __restrict__ xb = (bf16*)(ws + WS_XB); float* __restrict__ ssq = (float*)(ws + WS_SSQ);
      f32x4 v[2][4], vn[2][4];
#pragma unroll
      for (int h = 0; h < 2; ++h) { const int m0 = gw + h * NGW; const int mr = m0 < M ? m0 : gw; const f32x4* xr = (const f32x4*)(x + (size_t)mr * D) + LANE;
#pragma unroll
        for (int j = 0; j < 4; ++j) v[h][j] = xr[64 * j]; }
      for (int m = gw; m < M; m += 2 * NGW) {
#pragma unroll
        for (int h = 0; h < 2; ++h) { const int mn0 = m + (2 + h) * NGW; const int mn = mn0 < M ? mn0 : gw; const f32x4* xr = (const f32x4*)(x + (size_t)mn * D) + LANE;
#pragma unroll
          for (int j = 0; j < 4; ++j) vn[h][j] = xr[64 * j]; }
#pragma unroll
        for (int h = 0; h < 2; ++h) { const int mm = m + h * NGW; if (mm < M) { float s = 0.f;
          unsigned long long* o8 = (unsigned long long*)(xb + (size_t)mm * D) + LANE;
#pragma unroll
          for (int j = 0; j < 4; ++j) { const unsigned w0 = pk2(v[h][j][0], v[h][j][1]), w1 = pk2(v[h][j][2], v[h][j][3]); o8[64 * j] = (unsigned long long)w0 | ((unsigned long long)w1 << 32);
              const float r0 = bf_lo(w0), r1 = bf_hi(w0), r2 = bf_lo(w1), r3 = bf_hi(w1); s += (r0 * r0 + r1 * r1) + (r2 * r2 + r3 * r3); }
          s = wave_sum(s);
          if (LANE < 16) ssq[(size_t)mm * 16 + LANE] = LANE == 0 ? s : 0.f; } }
#pragma unroll
        for (int h = 0; h < 2; ++h)
#pragma unroll
          for (int j = 0; j < 4; ++j) v[h][j] = vn[h][j];
      } }
    if (TS_P0 == 2 && blockIdx.x == 0 && TID == 0) __hip_atomic_store((unsigned*)(a.ws + WS_CTL) + 16, (unsigned)__builtin_amdgcn_s_memrealtime() - __hip_atomic_load((unsigned*)(a.ws + WS_CTL) + 17, __ATOMIC_RELAXED, __HIP_MEMORY_SCOPE_AGENT), __ATOMIC_RELAXED, __HIP_MEMORY_SCOPE_AGENT);
    for (int r_ = 0; r_ < ((PROBE_P0 & 4) ? 2 : 1); ++r_)
    { const int gt = (F.vcu * NWAVES + F.wave) * 64 + LANE, NGT = NGW * 64; float* wf = (float*)(ws + WS_WF); float* lb = (float*)(ws + WS_LB);
      for (int i = gt; i < 2 * 8 * D; i += NGT) { const int j = i / (8 * D), h = (i / D) % 8, k = i % D; wf[i] = a.in[4][(size_t)j * D * AB_COLS + (size_t)k * AB_COLS + 1536 + h] * a.in[1][(2 * j) * D + k]; }
      for (int i = gt; i < D; i += NGT) { const float c0 = a.in[9][i], c1 = a.in[9][D + i]; lb[i] = 0.f; lb[D + i] = 1.0f / (1.0f + expf(c0 - c1)); } }
}

__device__ __forceinline__ void fgate_job(Frame& F, const Args& a, int j, int jb) {
    LANE_IDS();
    unsigned char* ws = a.ws; const float* wf = (const float*)(ws + WS_WF) + (size_t)j * 8 * D; const float* ssq = (const float*)(ws + WS_SSQ); const bf16* xb = (const bf16*)(ws + WS_XB);
    float* cl = (float*)(ws + WS_CL); float* bt = (float*)(ws + WS_BT); const float* bias = a.in[5] + j * 8;
    LAS float* tmp = (LAS float*)(F.lds + RING_OFF);
    f32x4 w[8][4];
#pragma unroll
    for (int h = 0; h < 8; ++h)
#pragma unroll
        for (int q = 0; q < 4; ++q) w[h][q] = *(const f32x4*)(wf + (size_t)h * D + (q >> 1) * 512 + 8 * LANE + 4 * (q & 1));
    v4u v[2], vn[2];
    { const v4u* xr = (const v4u*)(xb + (size_t)(jb * 64 + F.wave * 8) * D) + LANE; v[0] = xr[0]; v[1] = xr[64]; }
#pragma unroll 1
    for (int i = 0; i < 8; ++i) { const int rl = F.wave * 8 + i, row = jb * 64 + rl;
        { const v4u* xr = (const v4u*)(xb + (size_t)(row + (i < 7 ? 1 : 0)) * D) + LANE; vn[0] = xr[0]; vn[1] = xr[64]; }
        const float rs = pg8::row_rstd(ssq, row); float s8[8]; f32x4 xf[4];
#pragma unroll
        for (int q = 0; q < 4; ++q) { const unsigned a0 = v[q >> 1][2 * (q & 1)], a1 = v[q >> 1][2 * (q & 1) + 1]; xf[q] = (f32x4){bf_lo(a0), bf_hi(a0), bf_lo(a1), bf_hi(a1)}; }
#pragma unroll
        for (int h = 0; h < 8; ++h) { float s = 0.f;
#pragma unroll
            for (int q = 0; q < 4; ++q) s += (xf[q][0] * w[h][q][0] + xf[q][1] * w[h][q][1]) + (xf[q][2] * w[h][q][2] + xf[q][3] * w[h][q][3]);
            s8[h] = s; }
#pragma unroll
        for (int h = 0; h < 4; ++h) { const float a = s8[2 * h], b = s8[2 * h + 1]; const bool up = (LANE & 1) != 0; const float send = up ? a : b, keep = up ? b : a; s8[h] = keep + __shfl_xor(send, 1); }
#pragma unroll
        for (int h = 0; h < 2; ++h) { const float a = s8[2 * h], b = s8[2 * h + 1]; const bool up = (LANE & 2) != 0; const float send = up ? a : b, keep = up ? b : a; s8[h] = keep + __shfl_xor(send, 2); }
        { const float a = s8[0], b = s8[1]; const bool up = (LANE & 4) != 0; const float send = up ? a : b, keep = up ? b : a; s8[0] = keep + __shfl_xor(send, 4); }
        float mine = s8[0]; mine += __shfl_xor(mine, 8); mine += __shfl_xor(mine, 16); mine += __shfl_xor(mine, 32);
        const int hd = LANE & 7;
        if (LANE < 8) { const float z = mine * rs + bias[hd]; tmp[rl * 8 + hd] = fminf(z, 0.f) - log1pf(expf(-fabsf(z))); }
        v[0] = vn[0]; v[1] = vn[1];
    }
    LDS_WAIT(); __syncthreads();
    { const int h = F.wave; float c = tmp[LANE * 8 + h];
#pragma unroll
      for (int o = 1; o < 64; o <<= 1) { const float n = __shfl_up(c, o); if (LANE >= o) c += n; }
      cl[(size_t)(jb * 64 + LANE) * 8 + h] = c; if (LANE == 63) bt[jb * 8 + h] = c; }
    __syncthreads();
}

__device__ __forceinline__ void conv_job(Frame& F, const Args& a, int j, int jb) {
    LANE_IDS();
    unsigned char* ws = a.ws; const bf16* __restrict__ ub = (const bf16*)(ws + WS_QKVU + 3 * T512); const bf16* __restrict__ uc = (const bf16*)(ws + WS_QKVU + 4 * T512); const bf16* __restrict__ ux = (const bf16*)(ws + WS_QKVU + 5 * T512);
    bf16* __restrict__ ao = (bf16*)(ws + WS_AO); const float* __restrict__ cw = a.in[6] + (size_t)j * 3 * CONVW;
#pragma unroll 4
    for (int it = TID; it < 64 * 64; it += NWAVES * 64) { const int rl = it >> 6, ch = (it & 63) * 8, row = jb * 64 + rl, t = row & (SEQ - 1);
        float z[3][8];
#pragma unroll
        for (int d = 0; d < 3; ++d) { const int tt = t - 2 + d;
            if (tt >= 0) { const v4u cv = *(const v4u*)(uc + (size_t)(row - 2 + d) * 512 + ch), xv = *(const v4u*)(ux + (size_t)(row - 2 + d) * 512 + ch);
#pragma unroll
                for (int q = 0; q < 4; ++q) { z[d][2 * q] = bf_lo(cv[q]) * bf_lo(xv[q]); z[d][2 * q + 1] = bf_hi(cv[q]) * bf_hi(xv[q]); } }
            else {
#pragma unroll
                for (int q = 0; q < 8; ++q) z[d][q] = 0.f; } }
        const v4u bv = *(const v4u*)(ub + (size_t)row * 512 + ch); float y[8];
#pragma unroll
        for (int q = 0; q < 8; ++q) { const float b = (q & 1) ? bf_hi(bv[q >> 1]) : bf_lo(bv[q >> 1]);
            y[q] = b * (cw[ch + q] * z[0][q] + cw[CONVW + ch + q] * z[1][q] + cw[2 * CONVW + ch + q] * z[2][q]); }
        v4u o; o.x = pk2(y[0], y[1]); o.y = pk2(y[2], y[3]); o.z = pk2(y[4], y[5]); o.w = pk2(y[6], y[7]);
        *(v4u*)(ao + (size_t)row * D + 512 + ch) = o; }
}

__device__ __forceinline__ void attn_naive_unit(Frame& F, const Args& a, int unit) {
    LANE_IDS();
    unsigned char* ws = a.ws; const bf16* Q = (const bf16*)(ws + WS_QKVU); const bf16* K = (const bf16*)(ws + WS_QKVU + T512); const bf16* V = (const bf16*)(ws + WS_QKVU + 2 * T512);
    bf16* ao = (bf16*)(ws + WS_AO); const float* cl = (const float*)(ws + WS_CL); const float* bt = (const float*)(ws + WS_BT);
    const int b = unit >> 5, h = (unit >> 2) & 7, blk = unit & 3;
    LAS float* beta = (LAS float*)(F.lds + RING_OFF);
    LAS float* pre = beta + 2048;
    __syncthreads();
    if (TID == 0) { float c = 0.f; for (int i = 0; i < 32; ++i) { pre[i] = c; c += bt[(b * 32 + i) * 8 + h]; } }
    LDS_WAIT(); __syncthreads();
    for (int s = TID; s < SEQ; s += NWAVES * 64) beta[s] = -(pre[s >> 6] + cl[(size_t)(b * SEQ + s) * 8 + h]) * LOG2E;
    LDS_WAIT(); __syncthreads();
    const int t = blk * 512 + TID; const size_t rowq = (size_t)(b * SEQ + t);
    float q[64], o[64];
#pragma unroll
    for (int c = 0; c < 8; ++c) { const v4u w = *(const v4u*)(Q + rowq * 512 + h * 64 + 8 * c);
#pragma unroll
        for (int i = 0; i < 4; ++i) { q[8 * c + 2 * i] = bf_lo(w[i]); q[8 * c + 2 * i + 1] = bf_hi(w[i]); } }
#pragma unroll
    for (int d = 0; d < 64; ++d) o[d] = 0.f;
    float mx = -INFINITY, l = 0.f;
    const int send = blk * 512 + 511;
    for (int s = 0; s <= send; ++s) {
        const bf16* kr = K + (size_t)(b * SEQ + s) * 512 + h * 64; const bf16* vr = V + (size_t)(b * SEQ + s) * 512 + h * 64;
        float sc = 0.f;
#pragma unroll
        for (int c = 0; c < 8; ++c) { const v4u w = *(const v4u*)(kr + 8 * c);
#pragma unroll
            for (int i = 0; i < 4; ++i) sc += q[8 * c + 2 * i] * bf_lo(w[i]) + q[8 * c + 2 * i + 1] * bf_hi(w[i]); }
        sc += beta[s];
        if (s <= t) {
            const float mn = fmaxf(mx, sc), f = exp2f(mx - mn), p = exp2f(sc - mn); mx = mn; l = l * f + p;
#pragma unroll
            for (int c = 0; c < 8; ++c) { const v4u w = *(const v4u*)(vr + 8 * c);
#pragma unroll
                for (int i = 0; i < 4; ++i) { o[8 * c + 2 * i] = o[8 * c + 2 * i] * f + p * bf_lo(w[i]); o[8 * c + 2 * i + 1] = o[8 * c + 2 * i + 1] * f + p * bf_hi(w[i]); } }
        }
    }
    const float rl = 1.0f / l;
#pragma unroll
    for (int c = 0; c < 8; ++c) { v4u w; w.x = pk2(o[8 * c] * rl, o[8 * c + 1] * rl); w.y = pk2(o[8 * c + 2] * rl, o[8 * c + 3] * rl); w.z = pk2(o[8 * c + 4] * rl, o[8 * c + 5] * rl); w.w = pk2(o[8 * c + 6] * rl, o[8 * c + 7] * rl);
        *(v4u*)(ao + rowq * D + h * 64 + 8 * c) = w; }
}

__device__ __forceinline__ void hgrn_gate(Frame& F, const Args& a, int j) {
    LANE_IDS();
    unsigned char* ws = a.ws; const bf16* __restrict__ O = (const bf16*)(ws + WS_HO); const bf16* __restrict__ G = (const bf16*)(ws + WS_HG); bf16* __restrict__ AOP = (bf16*)(ws + WS_HQ); const float* __restrict__ hn = a.in[10] + (size_t)j * D;
    const int gw = F.vcu * NWAVES + F.wave, NGW = F.G * NWAVES; (void)TID;
#pragma unroll 4
    for (int m = gw; m < M; m += NGW) {
#pragma unroll
        for (int jj = 0; jj < 2; ++jj) { const int c = (4 * jj + (LANE >> 4)) * HGD + 8 * (LANE & 15); const size_t off = (size_t)m * D + c;
            const v4u ow = *(const v4u*)(O + off), gv = *(const v4u*)(G + off); float o[8], g[8];
#pragma unroll
            for (int q = 0; q < 4; ++q) { o[2 * q] = bf_lo(ow[q]); o[2 * q + 1] = bf_hi(ow[q]); g[2 * q] = bf_lo(gv[q]); g[2 * q + 1] = bf_hi(gv[q]); }
            float s = 0.f;
#pragma unroll
            for (int q = 0; q < 8; ++q) s += o[q] * o[q];
            s += __shfl_xor(s, 1); s += __shfl_xor(s, 2); s += __shfl_xor(s, 4); s += __shfl_xor(s, 8);
            const float r = __builtin_amdgcn_rsqf(s * (1.0f / HGD) + EPS); const f32x4 h0 = *(const f32x4*)(hn + c), h1 = *(const f32x4*)(hn + c + 4);
            v4u w; w.x = pk2(o[0] * r * h0[0] * g[0], o[1] * r * h0[1] * g[1]); w.y = pk2(o[2] * r * h0[2] * g[2], o[3] * r * h0[3] * g[3]);
            w.z = pk2(o[4] * r * h1[0] * g[4], o[5] * r * h1[1] * g[5]); w.w = pk2(o[6] * r * h1[2] * g[6], o[7] * r * h1[3] * g[7]);
            *(v4u*)(AOP + off) = w; }
    }
}
__device__ __forceinline__ void final_norm(Frame& F, const Args& a) {
    LANE_IDS(); (void)TID;
    const int gw = F.vcu * NWAVES + F.wave, NGW = F.G * NWAVES; const float* __restrict__ g = a.in[3]; const bf16* __restrict__ xb = (const bf16*)(a.ws + WS_XB); float* __restrict__ outp = a.out;
    f32x4 gv[4];
#pragma unroll
    for (int q = 0; q < 4; ++q) gv[q] = *(const f32x4*)(g + (q >> 1) * 512 + 8 * LANE + 4 * (q & 1));
#pragma unroll 4
    for (int m = gw; m < M; m += NGW) { const v4u* xr = (const v4u*)(xb + (size_t)m * D) + LANE; const v4u v0 = xr[0], v1 = xr[64]; f32x4 x[4]; float s = 0.f;
#pragma unroll
        for (int q = 0; q < 4; ++q) { const unsigned a0 = (q >> 1) ? v1[2 * (q & 1)] : v0[2 * (q & 1)], a1 = (q >> 1) ? v1[2 * (q & 1) + 1] : v0[2 * (q & 1) + 1];
            x[q] = (f32x4){bf_lo(a0), bf_hi(a0), bf_lo(a1), bf_hi(a1)}; s += (x[q][0] * x[q][0] + x[q][1] * x[q][1]) + (x[q][2] * x[q][2] + x[q][3] * x[q][3]); }
        const float r = __builtin_amdgcn_rsqf(wave_sum(s) * (1.0f / D) + EPS); float* orow = outp + (size_t)m * D;
#pragma unroll
        for (int q = 0; q < 4; ++q) { f32x4 ov = x[q] * r * gv[q]; if ((TS_PHASE != -1 || TS_P0) && m == 0 && LANE == 0 && q == 0) ov[0] += (float)__hip_atomic_load((unsigned*)(F.ctl + 16), __ATOMIC_RELAXED, __HIP_MEMORY_SCOPE_AGENT) * (1.0f / TS_DIV);
            *(f32x4*)(orow + (q >> 1) * 512 + 8 * LANE + 4 * (q & 1)) = ov; } }
}

constexpr int N_PHASES = 26;
#ifndef WCONV_IN_FFN_TAIL
#define WCONV_IN_FFN_TAIL 1
#endif
#ifndef PROBE_MASK
#define PROBE_MASK 0
#endif
#ifndef HGRN_NAIVE
#define HGRN_NAIVE 0
#endif
#ifndef ATTN_NAIVE
#define ATTN_NAIVE 0
#endif
#ifndef MK_PER_PHASE
#define MK_PER_PHASE 0
#endif
__global__ void __launch_bounds__(NWAVES * 64, 2) trunk_fwd(Args args) {
    extern __shared__ __attribute__((aligned(16))) unsigned char lds[];
    Frame F_;
    if (TS_PHASE == -2 && blockIdx.x == 0 && threadIdx.x == 0) __hip_atomic_store((unsigned*)(args.ws + WS_CTL) + 17, (unsigned)__builtin_amdgcn_s_memrealtime(), __ATOMIC_RELAXED, __HIP_MEMORY_SCOPE_AGENT);
    F_.lds = (LAS unsigned char*)lds; F_.MISC = (volatile LAS unsigned*)(F_.lds + MISC_OFF);
    F_.wave = __builtin_amdgcn_readfirstlane((int)threadIdx.x >> 6);
    F_.G = gridDim.x; { const int bx = blockIdx.x; F_.vcu = (F_.G % 8 == 0) ? (bx % 8) * (F_.G / 8) + bx / 8 : bx; }
    unsigned char* ws = args.ws; F_.ctl = (gu32*)(ws + WS_CTL);
    for (int u = threadIdx.x; u < (LDS_BYTES - LDSCTL_OFF) / 4; u += NWAVES * 64) ((LAS unsigned*)(F_.lds + LDSCTL_OFF))[u] = 0u;
    __syncthreads();
    const int lo = args.ph_lo, hi = args.ph_hi;
    XcdBarrier bar; bar.bar = (unsigned*)(F_.ctl + CW_BAR); bar.x = 0; bar.st = nullptr;
    if (hi - lo > 1) bar = xcd_barrier_post((unsigned*)(F_.ctl + CW_BAR), F_.MISC + 8);
#pragma unroll 1
    for (int p = lo; p < hi; ++p) {
        const int l = (p - 1) / 6, s = (p - 1) - 6 * l, j = l >> 1; const bool even = (l & 1) == 0, mid = (p >= 1 && p <= 24);
#if defined(__HIP_DEVICE_COMPILE__)
        KArgP ap = (KArgP)__builtin_amdgcn_kernarg_segment_ptr(); asm volatile("" : "+s"(ap));
        Args A2; for (int q_ = 0; q_ < 14; ++q_) A2.in[q_] = (const float*)(const GAS float*)ap->in[q_]; A2.out = (float*)(GAS float*)ap->out; A2.ws = (unsigned char*)(GAS unsigned char*)ap->ws;     A2.ph_lo = lo; A2.ph_hi = hi; A2.li = 0; A2.pad = 0;
#else
        Args A2 = args;
#endif
        Frame FL = F_; { int w_ = F_.wave, v_ = F_.vcu, g_ = F_.G; asm volatile("" : "+s"(w_), "+s"(v_), "+s"(g_)); FL.wave = w_; FL.vcu = v_; FL.G = g_; }
        int bx = blockIdx.x; asm volatile("" : "+s"(bx));
        Frame& F = FL;
        GAS unsigned char* wsg = (GAS unsigned char*)A2.ws; asm volatile("" : "+s"(wsg)); unsigned char* ws = (unsigned char*)wsg; A2.ws = ws;
        bf16* const wb = (bf16*)(ws + WS_W); bf16* const XB = (bf16*)(ws + WS_XB); float* const SSQ = (float*)(ws + WS_SSQ);
        const int cls = p == 0 ? 1 : p == 25 ? 11 : (s == 0 ? (even ? 2 : 3) : s == 1 ? (even ? 4 : 5) : s == 2 ? 6 : s == 3 ? 7 : s == 4 ? 8 : 9);
        if (mid && s == 2 && even) continue;
        const int nrep = ((PROBE_MASK >> cls) & 1) ? 2 : 1;
        if (TS_PHASE == -2 && p == 0 && bx == 0 && threadIdx.x == 0) __hip_atomic_store((unsigned*)(F.ctl + 16), (unsigned)__builtin_amdgcn_s_memrealtime() - __hip_atomic_load((unsigned*)(F.ctl + 17), __ATOMIC_RELAXED, __HIP_MEMORY_SCOPE_AGENT), __ATOMIC_RELAXED, __HIP_MEMORY_SCOPE_AGENT);
        if (TS_PHASE >= 0 && (p == TS_PHASE || p == TS_PHASE_END) && bx == 0 && threadIdx.x == 0) { const unsigned now_ = TS_CLOCK ? (unsigned)__builtin_amdgcn_s_memtime() : (unsigned)__builtin_amdgcn_s_memrealtime();
            if (p == TS_PHASE) __hip_atomic_store((unsigned*)(F.ctl + 17), now_, __ATOMIC_RELAXED, __HIP_MEMORY_SCOPE_AGENT);
            else __hip_atomic_store((unsigned*)(F.ctl + 16), now_ - __hip_atomic_load((unsigned*)(F.ctl + 17), __ATOMIC_RELAXED, __HIP_MEMORY_SCOPE_AGENT), __ATOMIC_RELAXED, __HIP_MEMORY_SCOPE_AGENT); }
#define GRID_BARRIER() do { XcdBarrier b2 = bar; GAS unsigned* bg = (GAS unsigned*)bar.bar; asm volatile("" : "+s"(bg), "+s"(b2.x)); b2.bar = (unsigned*)bg; xcd_barrier(b2); } while (0)
#pragma unroll 1
        for (int rp = 0; rp < nrep; ++rp) { const bool dummy = rp + 1 < nrep; (void)dummy;
        if (p == 0) p0_prologue(F, A2);
        else if (p == 25) { if (!(FUSE_FINAL_NORM && F.G == 256)) final_norm(F, A2); }
        else if (s == 0 && even) {
            pg8::Gemm g{XB, (const bf16*)((unsigned char*)wb + W_ABIN + j * SZ_ABIN), M, AB_N, D}; pg8::StaticOrder S; S.init(M, AB_N, F.G, bx);
            pg8::EpiAB E{(bf16*)(ws + WS_QKVU), (size_t)M * 512, SSQ, QSCALE};
            pg8::gemm_phase<pg8::EpiAB, pg8::StaticOrder, true, true>(F.lds + RING_OFF, g, S, E);
            for (int jb = F.vcu; jb < M / 64; jb += F.G) fgate_job(F, A2, j, jb);
            if (L0_SPLIT && l == 0 && !dummy) convert_layer_weights(F, A2, 0, F.vcu * NWAVES + F.wave, F.G * NWAVES, I_ABIN, I_ABIN + I_SQ + I_FIN);
        } else if (s == 0) {
            pg8::Gemm g{XB, (const bf16*)((unsigned char*)wb + W_CIN + j * SZ_CIN), M, C_COLS, D}; pg8::StaticOrder S; S.init(M, C_COLS, F.G, bx);
            pg8::EpiHG E{(bf16*)(ws + WS_HQ), (bf16*)(ws + WS_KD), (bf16*)(ws + WS_KT), (bf16*)(ws + WS_HV), (size_t)M * D, (float*)(ws + WS_DEC), (const float*)(ws + WS_LB) + (size_t)j * D, SSQ, j == 0};
            static_assert(WS_HG == WS_HV + (size_t)M * D * 2, "V | G consecutive");
            pg8::gemm_phase<pg8::EpiHG, pg8::StaticOrder, true, true>(F.lds + RING_OFF, g, S, E);
        } else if (s == 1 && even) {
            if (F.vcu & 1) for (int jb = F.vcu; jb < M / 64; jb += F.G) conv_job(F, A2, j, jb);
#if ATTN_NAIVE
            for (int u = F.vcu; u < 256; u += F.G) attn_naive_unit(F, A2, u);
#else
            { const attn_body::AttnTensors AT{(const attn_body::bf16*)(ws + WS_QKVU), (const attn_body::bf16*)(ws + WS_QKVU + T512), (const attn_body::bf16*)(ws + WS_QKVU + 2 * T512), (attn_body::bf16*)(ws + WS_AO),
                                               (const float*)(ws + WS_CL), (const float*)(ws + WS_BT)};
              const attn_body::StaticOrder S((int)F.G, bx);
              attn_body::attn_phase<attn_body::StaticOrder>((char*)lds + RING_OFF, AT, S); }
#endif
            if (!(F.vcu & 1)) for (int jb = F.vcu; jb < M / 64; jb += F.G) conv_job(F, A2, j, jb);
            if (L0_SPLIT && l == 0 && !dummy) { __syncthreads(); convert_layer_weights(F, A2, 0, F.vcu * NWAVES + F.wave, F.G * NWAVES, I_ABIN + I_SQ + I_FIN, 1 << 30); }
        } else if (s == 1) {
            for (int u = F.vcu; u < 256; u += F.G) hg::hgrn_unit(F.lds + RING_OFF, (const unsigned short*)(ws + WS_HQ), (const unsigned short*)(ws + WS_KD), (const unsigned short*)(ws + WS_KT), (const float*)(ws + WS_DEC), (const unsigned short*)(ws + WS_HV), (unsigned short*)(ws + WS_HO), u);
        } else if (s == 2) {
            hgrn_gate(F, A2, j);
        } else if (s == 4) {
            pg8::Gemm g{XB, (const bf16*)((unsigned char*)wb + W_FIN + l * SZ_FIN), M, FF2, D}; pg8::StaticOrder S; S.init(M, FF2, F.G, bx);
            pg8::EpiSwi E{(bf16*)(ws + WS_H), SSQ};
            pg8::gemm_phase<pg8::EpiSwi, pg8::StaticOrder, true, true>(F.lds + RING_OFF, g, S, E, (TS_EPI && p == TS_PHASE) ? (unsigned*)(F.ctl + 16) : (unsigned*)(F.ctl + 20));
#if WCONV_IN_FFN_TAIL
            { const int nfull = (M / 256) * (FF2 / 256) - (((M / 256) * (FF2 / 256)) / F.G) * F.G;
              if (l + 1 < DEPTH && !dummy && bx >= nfull) convert_layer_weights(F, A2, l + 1, (bx - nfull) * NWAVES + F.wave, (F.G - nfull) * NWAVES); }
#endif
        } else {
            const bool dn = (s == 5);
            const bf16* A = dn ? (const bf16*)(ws + WS_H) : (even ? (const bf16*)(ws + WS_AO) : (const bf16*)(ws + WS_HQ));
            const size_t wo = dn ? (W_FOUT + l * SZ_FOUT) : (even ? (W_ABOUT + j * SZ_ABOUT) : (W_COUT + j * SZ_COUT));
            pg8::Gemm g{A, (const bf16*)((unsigned char*)wb + wo), M, D, dn ? FFH : D}; pg8::StaticOrder S; S.init(M, D, F.G, bx);
#if FUSE_FINAL_NORM
            if (p == 24 && !dummy && F.G == 256) {
                pg8::EpiResFinal E{XB, A2.out, (float*)(ws + WS_XS), (unsigned*)(F.ctl + CW_FIN), A2.in[3]};
                pg8::gemm_phase<pg8::EpiResFinal, pg8::StaticOrder, true, true>(F.lds + RING_OFF, g, S, E);
            } else
#endif
            { pg8::EpiRes E{XB, dummy ? (bf16*)(ws + WS_MIX + (dn ? 96 * MiB : 0)) : XB, SSQ};
              pg8::gemm_phase<pg8::EpiRes, pg8::StaticOrder, true, true>(F.lds + RING_OFF, g, S, E); }
        }
        if (dummy) GRID_BARRIER();
        }
        if (TS_PHASE_END < 0 && TS_PHASE >= 0 && p == TS_PHASE && bx == 0 && threadIdx.x == 0) { const unsigned dt_ = (unsigned)__builtin_amdgcn_s_memrealtime() - __hip_atomic_load((unsigned*)(F.ctl + 17), __ATOMIC_RELAXED, __HIP_MEMORY_SCOPE_AGENT); __hip_atomic_store((unsigned*)(F.ctl + 16), dt_, __ATOMIC_RELAXED, __HIP_MEMORY_SCOPE_AGENT); }
        if (p + 1 < hi && !(FUSE_FINAL_NORM && F.G == 256 && p >= 24)) { GRID_BARRIER(); if ((PROBE_MASK >> 10) & 1) GRID_BARRIER(); }
    }
}

extern "C" void kernel_launch(void* const* d_in, const int* in_sizes, int n_in, void* d_out, int out_size, void* d_ws, size_t ws_size, hipStream_t stream) {
    static int grid = 0;
    if (grid == 0) {
        if (n_in != 14 || in_sizes[0] != M * D || out_size != M * D || ws_size < WS_END) { fprintf(stderr, "kernel_launch: unexpected shapes / workspace (n_in %d, ws %zu, need %zu)\n", n_in, ws_size, (size_t)WS_END); grid = -1; return; }
        int dev = 0, cus = 0;
        if (hipGetDevice(&dev) != hipSuccess || hipDeviceGetAttribute(&cus, hipDeviceAttributeMultiprocessorCount, dev) != hipSuccess) { grid = -1; return; }
        if (hipFuncSetAttribute((const void*)trunk_fwd, hipFuncAttributeMaxDynamicSharedMemorySize, LDS_BYTES) != hipSuccess) { fprintf(stderr, "kernel_launch: hipFuncSetAttribute failed\n"); grid = -1; return; }
        int per_cu = 0; (void)hipOccupancyMaxActiveBlocksPerMultiprocessor(&per_cu, (const void*)trunk_fwd, NWAVES * 64, LDS_BYTES); (void)hipGetLastError();
        grid = cus;
    }
    if (grid < 0) return;
    (void)hipMemsetAsync((char*)d_ws + WS_CTL, 0, CTL_ZERO_BYTES, stream);
    Args a{};
    for (int i = 0; i < 14; ++i) a.in[i] = (const float*)d_in[i];
    a.out = (float*)d_out; a.ws = (unsigned char*)d_ws;
#if MK_PER_PHASE
    for (int p = 0; p < N_PHASES; ++p) { const int l = (p - 1) / 6, s = (p - 1) % 6; if (p >= 1 && p <= 24 && s == 2 && (l & 1) == 0) continue;
        a.ph_lo = p; a.ph_hi = p + 1; a.li = 0; hipLaunchKernelGGL(trunk_fwd, dim3(grid), dim3(NWAVES * 64), LDS_BYTES, stream, a); }
#else
    a.ph_lo = 0; a.ph_hi = N_PHASES; a.li = 0;
    hipLaunchKernelGGL(trunk_fwd, dim3(grid), dim3(NWAVES * 64), LDS_BYTES, stream, a);
#endif
}
```
